# Optimizing an MI355X kernel written in HIP

```python
import jax
import jax.numpy as jnp
from jax import lax
import numpy as np

D_MODEL = 1024
BATCH = 2
SEQ = 8192
DEPTH = 2
DEC_BATCH = 8
DEC_SEQ = 64
PAST_LEN = 4096

CHUNK = 64
Q_BLOCK = 128
PLE_DIM = 256
N_HEADS = 4
BRANCH_WIDTH = D_MODEL // 2
HEAD_DIM = BRANCH_WIDTH // N_HEADS
CONV_WIDTH = 4
N_BRANCH = 3
RMS_EPS = 1e-6
IN_SIZES = (BRANCH_WIDTH,) * 5 + (N_HEADS, N_HEADS) + (BRANCH_WIDTH,) * 8 + (D_MODEL,) * N_BRANCH
N_IN = sum(IN_SIZES)
SPLIT_POINTS = tuple(int(s) for s in np.cumsum(IN_SIZES)[:-1])

kernel_name = "hybrid_mlstm_stickbreak_hgrn2_stream_step"


def rms_norm(x, g):
    xf = x.astype(jnp.float32)
    return xf * lax.rsqrt(jnp.mean(xf * xf, -1, keepdims=True) + RMS_EPS) * g.astype(jnp.float32)


def split_heads(a):
    B, T, _ = a.shape
    return a.reshape(B, T, N_HEADS, -1).transpose(0, 2, 1, 3)


def merge_heads(a):
    B, H, T, d = a.shape
    return a.transpose(0, 2, 1, 3).reshape(B, T, H * d)


def head_rms_norm(h, g):
    hn = h * lax.rsqrt(jnp.mean(h * h, -1, keepdims=True) + RMS_EPS)
    return merge_heads(hn) * g.astype(jnp.float32)


def to_chunks(a, chunk):
    B, H, T = a.shape[:3]
    return jnp.moveaxis(a.reshape(B, H, T // chunk, chunk, *a.shape[3:]), 2, 0)


def from_chunks(a):
    a = jnp.moveaxis(a, 0, 2)
    return a.reshape(a.shape[0], a.shape[1], -1, *a.shape[4:])


def causal_depthwise_conv(xin, buf, w):
    T = xin.shape[1]
    xp = jnp.concatenate([buf.astype(jnp.float32), xin], axis=1)
    wf = w.astype(jnp.float32)
    out = sum(xp[:, j:j + T] * wf[j] for j in range(CONV_WIDTH))
    return out, xp[:, T:]


def mlstm_chunkwise(q, k, v, ig, lf, C0, n0, m0, chunk):
    causal = jnp.tril(jnp.ones((chunk, chunk), dtype=bool))

    def step(carry, inp):
        C, n, m = carry
        qc, kc, vc, igc, lfc = inp
        b = jnp.cumsum(lfc, axis=-1)
        dmat = jnp.where(causal, b[..., :, None] - b[..., None, :] + igc[..., None, :], -jnp.inf)
        inter = b + m[..., None]
        m_t = jnp.maximum(jnp.max(dmat, -1), inter)
        s = jnp.einsum('bhtd,bhsd->bhts', qc, kc) * jnp.exp(dmat - m_t[..., None])
        w_inter = jnp.exp(inter - m_t)
        num = jnp.einsum('bhts,bhse->bhte', s, vc) + w_inter[..., None] * jnp.einsum('bhtd,bhde->bhte', qc, C)
        den = jnp.sum(s, -1) + w_inter * jnp.einsum('bhtd,bhd->bht', qc, n)
        h = num / jnp.maximum(jnp.abs(den), jnp.exp(-m_t))[..., None]
        m_new = m_t[..., -1]
        dec_s = jnp.exp(b[..., -1:] - b + igc - m_new[..., None])
        dec_c = jnp.exp(b[..., -1] + m - m_new)
        C_new = dec_c[..., None, None] * C + jnp.einsum('bhs,bhsd,bhse->bhde', dec_s, kc, vc)
        n_new = dec_c[..., None] * n + jnp.einsum('bhs,bhsd->bhd', dec_s, kc)
        return (C_new, n_new, m_new), h

    xs = (to_chunks(q, chunk), to_chunks(k, chunk), to_chunks(v, chunk), to_chunks(ig, chunk), to_chunks(lf, chunk))
    (C, n, m), h = lax.scan(step, (C0, n0, m0), xs)
    return from_chunks(h), C, n, m


def hgrn2_chunkwise(q, k, g, i, S0, chunk):
    causal = jnp.tril(jnp.ones((chunk, chunk), dtype=bool))

    def step(S, inp):
        qc, kc, gc, ic = inp
        bc = jnp.cumsum(gc, axis=2)
        diff = jnp.where(causal[:, :, None], bc[:, :, :, None, :] - bc[:, :, None, :, :], -jnp.inf)
        a = jnp.einsum('bhtc,bhsc,bhtsc->bhts', qc, kc, jnp.exp(diff))
        o = jnp.einsum('bhts,bhsv->bhtv', a, ic) + jnp.einsum('bhtc,bhcv->bhtv', qc * jnp.exp(bc), S)
        S_new = jnp.exp(bc[:, :, -1])[..., None] * S + jnp.einsum('bhsc,bhsv->bhcv', kc * jnp.exp(bc[:, :, -1:] - bc), ic)
        return S_new, o

    xs = (to_chunks(q, chunk), to_chunks(k, chunk), to_chunks(g, chunk), to_chunks(i, chunk))
    S, o = lax.scan(step, S0, xs)
    return from_chunks(o), S


def sb_attend(q, k, v, q_pos):
    z = jnp.einsum('bhqd,bhkd->bhqk', q, k) * (HEAD_DIM ** -0.5)
    before = jnp.arange(k.shape[2])[None, :] < q_pos[:, None]
    log_1mb = jnp.where(before, -jax.nn.softplus(z), 0.0)
    suffix = lax.cumsum(log_1mb, axis=3, reverse=True) - log_1mb
    a = jnp.where(before, jnp.exp(jax.nn.log_sigmoid(z) + suffix), 0.0)
    return jnp.einsum('bhqk,bhkd->bhqd', a, v)


def sb_prompt(q, k, v):
    B, H, T, d = q.shape
    nb = T // Q_BLOCK
    qb = jnp.moveaxis(q.reshape(B, H, nb, Q_BLOCK, d), 2, 0)
    pos = jnp.arange(T).reshape(nb, Q_BLOCK)
    out = lax.map(lambda a: sb_attend(a[0], k, v, a[1]), (qb, pos))
    return jnp.moveaxis(out, 0, 2).reshape(B, H, T, d)


def mixer_layer(x, p, C0, n0, m0, conv0, S0, k_past, v_past, lb,
                g_pre, w_in, b_i, b_f, w_conv, g_ml, g_hg, w_branch, w_out, g_post, w_pg, w_pp):
    f32 = jnp.float32
    T = x.shape[1]
    chunk = min(CHUNK, T)
    u = rms_norm(x, g_pre)
    proj = (u @ w_in).astype(f32)
    (ml_q, ml_k, ml_v, ml_o, ml_z, ml_i, ml_f, sb_q, sb_k, sb_v, sb_z,
     hg_q, hg_f, hg_i, hg_z, gt_ml, gt_sb, gt_hg) = jnp.split(proj, SPLIT_POINTS, axis=-1)

    qk, conv_new = causal_depthwise_conv(jnp.concatenate([ml_q, ml_k], -1), conv0, w_conv)
    q_m, k_m = jnp.split(jax.nn.silu(qk), 2, axis=-1)
    ig = (ml_i + b_i.astype(f32)).transpose(0, 2, 1)
    lf = jax.nn.log_sigmoid(ml_f + b_f.astype(f32)).transpose(0, 2, 1)
    hm, C_new, n_new, m_new = mlstm_chunkwise(split_heads(q_m), split_heads(k_m) * (HEAD_DIM ** -0.5), split_heads(ml_v),
                                              ig, lf, C0.astype(f32), n0.astype(f32), m0.astype(f32), chunk)
    h_ml = head_rms_norm(hm, g_ml) * jax.nn.sigmoid(ml_o) * jax.nn.silu(ml_z)

    q_s, k_s, v_s = split_heads(sb_q), split_heads(sb_k), split_heads(sb_v)
    if k_past is None:
        o_s = sb_prompt(q_s, k_s, v_s)
    else:
        P = k_past.shape[2]
        k_all = jnp.concatenate([k_past.astype(f32), k_s], axis=2)
        v_all = jnp.concatenate([v_past.astype(f32), v_s], axis=2)
        o_s = sb_attend(q_s, k_all, v_all, P + jnp.arange(T))
    h_sb = merge_heads(o_s) * jax.nn.silu(sb_z)

    log_f = jnp.logaddexp(jnp.log(lb), jnp.log1p(-lb) + jax.nn.log_sigmoid(hg_f))
    k_h = (1.0 - lb) * jax.nn.sigmoid(-hg_f)
    o_h, S_new = hgrn2_chunkwise(split_heads(hg_q), split_heads(k_h), split_heads(log_f), split_heads(hg_i),
                                 S0.astype(f32), chunk)
    h_hg = head_rms_norm(o_h, g_hg) * jax.nn.silu(hg_z)

    merged = (jax.nn.sigmoid(gt_ml) * (h_ml @ w_branch[0])
              + jax.nn.sigmoid(gt_sb) * (h_sb @ w_branch[1])
              + jax.nn.sigmoid(gt_hg) * (h_hg @ w_branch[2]))
    y = merged @ w_out
    r = x.astype(f32) + rms_norm(y, g_post)
    r = r + jax.nn.sigmoid(r @ w_pg) * (p.astype(f32) @ w_pp)
    return r.astype(x.dtype), (C_new, n_new, m_new, conv_new, k_s, v_s, S_new)


def setup_inputs(seed: int = 0) -> dict:
    key = jax.random.key(seed)
    ks = jax.random.split(key, 32)
    n = jax.random.normal
    f32 = jnp.float32
    W, H, d = BRANCH_WIDTH, N_HEADS, HEAD_DIM
    return {
        "x_prompt": n(ks[0], (BATCH, SEQ, D_MODEL), f32),
        "x_sample": n(ks[1], (DEC_BATCH, DEC_SEQ, D_MODEL), f32),
        "p_prompt": n(ks[2], (DEPTH, BATCH, SEQ, PLE_DIM), f32),
        "p_sample": n(ks[3], (DEPTH, DEC_BATCH, DEC_SEQ, PLE_DIM), f32),
        "state_mlstm_C": 0.3 * n(ks[4], (DEPTH, DEC_BATCH, H, d, d), f32),
        "state_mlstm_n": 0.3 * n(ks[5], (DEPTH, DEC_BATCH, H, d), f32),
        "state_mlstm_m": 0.5 * n(ks[6], (DEPTH, DEC_BATCH, H), f32),
        "state_mlstm_conv": n(ks[7], (DEPTH, DEC_BATCH, CONV_WIDTH - 1, 2 * W), f32),
        "cache_sb_k": n(ks[8], (DEPTH, DEC_BATCH, H, PAST_LEN, d), f32),
        "cache_sb_v": n(ks[9], (DEPTH, DEC_BATCH, H, PAST_LEN, d), f32),
        "state_hgrn_S": n(ks[10], (DEPTH, DEC_BATCH, H, d, d), f32),
        "g_pre": 1.0 + 0.02 * n(ks[11], (DEPTH, D_MODEL), f32),
        "w_in": n(ks[12], (DEPTH, D_MODEL, N_IN), f32) * D_MODEL ** -0.5,
        "b_mlstm_i": 0.1 * n(ks[13], (DEPTH, H), f32),
        "b_mlstm_f": jnp.linspace(3.0, 6.0, H, dtype=f32)[None, :] + 0.1 * n(ks[14], (DEPTH, H), f32),
        "w_mlstm_conv": n(ks[15], (DEPTH, CONV_WIDTH, 2 * W), f32) * CONV_WIDTH ** -0.5,
        "g_mlstm_head": 1.0 + 0.02 * n(ks[16], (DEPTH, W), f32),
        "hgrn_lb_logits": 0.5 * n(ks[17], (DEPTH, W), f32),
        "g_hgrn_head": 1.0 + 0.02 * n(ks[18], (DEPTH, W), f32),
        "w_branch": n(ks[19], (DEPTH, N_BRANCH, W, D_MODEL), f32) * W ** -0.5,
        "w_out": n(ks[20], (DEPTH, D_MODEL, D_MODEL), f32) * D_MODEL ** -0.5,
        "g_post": 1.0 + 0.02 * n(ks[21], (DEPTH, D_MODEL), f32),
        "w_ple_gate": n(ks[22], (DEPTH, D_MODEL, D_MODEL), f32) * D_MODEL ** -0.5,
        "w_ple_proj": n(ks[23], (DEPTH, PLE_DIM, D_MODEL), f32) * PLE_DIM ** -0.5,
    }


def reference(x_prompt, x_sample, p_prompt, p_sample, state_mlstm_C, state_mlstm_n, state_mlstm_m,
              state_mlstm_conv, cache_sb_k, cache_sb_v, state_hgrn_S, g_pre, w_in, b_mlstm_i, b_mlstm_f,
              w_mlstm_conv, g_mlstm_head, hgrn_lb_logits, g_hgrn_head, w_branch, w_out, g_post,
              w_ple_gate, w_ple_proj):
    f32 = jnp.float32
    lb_cum = jnp.cumsum(jax.nn.softmax(hgrn_lb_logits.astype(f32), axis=0), axis=0)
    lower_bounds = lb_cum - lb_cum[:1]
    B = x_prompt.shape[0]
    yp, ys = x_prompt, x_sample
    new_p = [[] for _ in range(7)]
    new_s = [[] for _ in range(7)]
    for l in range(DEPTH):
        lw = (g_pre[l], w_in[l], b_mlstm_i[l], b_mlstm_f[l], w_mlstm_conv[l], g_mlstm_head[l], g_hgrn_head[l],
              w_branch[l], w_out[l], g_post[l], w_ple_gate[l], w_ple_proj[l])
        C0 = jnp.zeros((B, N_HEADS, HEAD_DIM, HEAD_DIM), f32)
        n0 = jnp.zeros((B, N_HEADS, HEAD_DIM), f32)
        m0 = jnp.zeros((B, N_HEADS), f32)
        conv0 = jnp.zeros((B, CONV_WIDTH - 1, 2 * BRANCH_WIDTH), f32)
        S0 = jnp.zeros((B, N_HEADS, HEAD_DIM, HEAD_DIM), f32)
        yp, st = mixer_layer(yp, p_prompt[l], C0, n0, m0, conv0, S0, None, None, lower_bounds[l], *lw)
        for lst, a in zip(new_p, st):
            lst.append(a)
        ys, st = mixer_layer(ys, p_sample[l], state_mlstm_C[l], state_mlstm_n[l], state_mlstm_m[l],
                             state_mlstm_conv[l], state_hgrn_S[l], cache_sb_k[l], cache_sb_v[l],
                             lower_bounds[l], *lw)
        for lst, a in zip(new_s, st):
            lst.append(a)
    pC, pn, pm, pconv, pk, pv, pS = [jnp.stack(a) for a in new_p]
    sC, sn, sm, sconv, sk, sv, sS = [jnp.stack(a) for a in new_s]
    return (yp, ys, pC, pn, pm, pconv, pk, pv, pS, sC, sn, sm, sconv, sk, sv, sS)
```

```cpp
#include <hip/hip_runtime.h>
#include <hip/hip_cooperative_groups.h>
#include <stdint.h>
#include <stdio.h>
#include <string.h>
namespace cg = cooperative_groups;

#ifndef FUSED
#define FUSED 1
#endif
#ifndef PHMASK
#define PHMASK 0x3ff
#endif

typedef unsigned short bf16_t;
typedef short bf16x8 __attribute__((ext_vector_type(8)));
typedef float f32x4 __attribute__((ext_vector_type(4)));
typedef unsigned u32x4 __attribute__((ext_vector_type(4)));
typedef unsigned u32x2 __attribute__((ext_vector_type(2)));

constexpr int NTOK = 16896, NPROMPT = 16384, NUNIT = 1056;
constexpr int NINSRC = 9736, NWT = 9728, NMAIN = 6656;
constexpr int SMEM_BYTES = 80896;
constexpr int NPHASE = 19;

constexpr size_t al256(size_t x) { return (x + 255) & ~(size_t)255; }
constexpr size_t WS_WT_IN = 0;
constexpr size_t WS_WT_BR = WS_WT_IN + al256((size_t)2 * NWT * 1024 * 2);
constexpr size_t WS_WT_OUT = WS_WT_BR + al256((size_t)2 * 3 * 1024 * 512 * 2);
constexpr size_t WS_WT_PG = WS_WT_OUT + al256((size_t)2 * 1048576 * 2);
constexpr size_t WS_WT_PP = WS_WT_PG + al256((size_t)2 * 1048576 * 2);
constexpr size_t WS_U = WS_WT_PP + al256((size_t)2 * 262144 * 2);
constexpr size_t WS_PR = WS_U + al256((size_t)NTOK * 1024 * 2);
constexpr size_t WS_QC = WS_PR + al256((size_t)13 * NTOK * 512 * 2);
constexpr size_t WS_KC = WS_QC + al256((size_t)NTOK * 512 * 2);
constexpr size_t WS_SM = WS_KC + al256((size_t)NTOK * 512 * 2);
constexpr size_t WS_SH = WS_SM + al256((size_t)NUNIT * 16384 * 2);
constexpr size_t WS_H = WS_SH + al256((size_t)NUNIT * 16384 * 2);
constexpr size_t WS_IG = WS_H + al256((size_t)3 * NTOK * 512 * 2);
constexpr size_t WS_LF = WS_IG + al256((size_t)NTOK * 16);
constexpr size_t WS_AC = WS_LF + al256((size_t)NTOK * 16);
constexpr size_t WS_BC = WS_AC + al256(NUNIT * 4);
constexpr size_t WS_MIN = WS_BC + al256(NUNIT * 4);
constexpr size_t WS_NLOC = WS_MIN + al256(NUNIT * 4);
constexpr size_t WS_HBC = WS_NLOC + al256((size_t)NUNIT * 512);
constexpr size_t WS_TOTAL = WS_HBC + al256((size_t)NUNIT * 512);
constexpr size_t WS_MERGED = WS_PR;
constexpr size_t WS_Y = WS_MERGED + (size_t)NTOK * 1024 * 2;
constexpr size_t WS_R = WS_Y + (size_t)NTOK * 1024 * 4;
constexpr size_t WS_RB = WS_R + (size_t)NTOK * 1024 * 4;
static_assert(WS_RB + (size_t)NTOK * 1024 * 2 <= WS_QC, "alias overflow");
constexpr size_t O_PC = 16777216 + 524288, O_PN = O_PC + 262144, O_PM = O_PN + 2048, O_PCONV = O_PM + 16, O_PK = O_PCONV + 12288, O_PV = O_PK + 16777216,
                 O_PS = O_PV + 16777216, O_SC = O_PS + 262144, O_SN = O_SC + 1048576, O_SM = O_SN + 8192, O_SCONV = O_SM + 64, O_SK = O_SCONV + 49152,
                 O_SV = O_SK + 524288, O_SS = O_SV + 524288, O_TOTAL = O_SS + 1048576;

struct Params {
  const float *x_p, *x_s, *p_p, *p_s, *st_C, *st_n, *st_m, *st_conv, *ck, *cv, *st_S;
  const float *g_pre, *w_in, *b_i, *b_f, *w_conv, *g_ml, *lb_logits, *g_hg, *w_br, *w_out, *g_post, *w_pg, *w_pp;
  float* out; char* ws;
#define WSP(name, T, off) __device__ __forceinline__ T* name() const { return (T*)(ws + (off)); }
#define OUTP(name, off) __device__ __forceinline__ float* name() const { return out + (off); }
  OUTP(o_y, 0) OUTP(o_pC, O_PC) OUTP(o_pn, O_PN) OUTP(o_pm, O_PM) OUTP(o_pconv, O_PCONV) OUTP(o_pk, O_PK) OUTP(o_pv, O_PV) OUTP(o_pS, O_PS)
  OUTP(o_sC, O_SC) OUTP(o_sn, O_SN) OUTP(o_sm, O_SM) OUTP(o_sconv, O_SCONV) OUTP(o_sk, O_SK) OUTP(o_sv, O_SV) OUTP(o_sS, O_SS)
  WSP(wt_in, bf16_t, WS_WT_IN) WSP(wt_br, bf16_t, WS_WT_BR) WSP(wt_out, bf16_t, WS_WT_OUT) WSP(wt_pg, bf16_t, WS_WT_PG) WSP(wt_pp, bf16_t, WS_WT_PP)
  WSP(U, bf16_t, WS_U) WSP(PR, bf16_t, WS_PR) WSP(QC, bf16_t, WS_QC) WSP(KC, bf16_t, WS_KC) WSP(SM, bf16_t, WS_SM) WSP(SH, bf16_t, WS_SH) WSP(H, bf16_t, WS_H)
  WSP(ig, float, WS_IG) WSP(lf, float, WS_LF) WSP(ac, float, WS_AC) WSP(Bc, float, WS_BC) WSP(min_, float, WS_MIN) WSP(nloc, float, WS_NLOC) WSP(hbc, float, WS_HBC)
  WSP(merged, bf16_t, WS_MERGED) WSP(y, float, WS_Y) WSP(r, float, WS_R) WSP(rb, bf16_t, WS_RB)
};

__device__ __forceinline__ int get_tid() { int t = threadIdx.x; asm volatile("" : "+v"(t)); return t; }
__device__ __forceinline__ bf16_t f2bf(float f) { unsigned u = __float_as_uint(f); u += 0x7fffu + ((u >> 16) & 1u); return (bf16_t)(u >> 16); }
__device__ __forceinline__ float bf2f(bf16_t h) { return __uint_as_float(((unsigned)h) << 16); }
__device__ __forceinline__ unsigned pack2(float a, float b) { return (unsigned)f2bf(a) | ((unsigned)f2bf(b) << 16); }
__device__ __forceinline__ float lo2f(unsigned v) { return __uint_as_float(v << 16); }
__device__ __forceinline__ float hi2f(unsigned v) { return __uint_as_float(v & 0xffff0000u); }
__device__ __forceinline__ float sigm(float x) { return 1.f / (1.f + __expf(-x)); }
__device__ __forceinline__ float silu(float x) { return x / (1.f + __expf(-x)); }
__device__ __forceinline__ float softplus(float x) { return fmaxf(x, 0.f) + __logf(1.f + __expf(-fabsf(x))); }
__device__ __forceinline__ float logsigm(float x) { return fminf(x, 0.f) - __logf(1.f + __expf(-fabsf(x))); }

template <int MT, int NT, int KS>
__device__ __forceinline__ void wmma(f32x4 (&acc)[MT][NT], const bf16_t* A, int lda, const bf16_t* B, int ldb, int fr, int fq) {
#pragma unroll
  for (int kk = 0; kk < KS; ++kk) {
    bf16x8 a[MT], b[NT];
#pragma unroll
    for (int mi = 0; mi < MT; ++mi) a[mi] = *(const bf16x8*)(A + (mi * 16 + fr) * lda + kk * 32 + fq * 8);
#pragma unroll
    for (int ni = 0; ni < NT; ++ni) b[ni] = *(const bf16x8*)(B + (ni * 16 + fr) * ldb + kk * 32 + fq * 8);
#pragma unroll
    for (int mi = 0; mi < MT; ++mi)
#pragma unroll
      for (int ni = 0; ni < NT; ++ni) acc[mi][ni] = __builtin_amdgcn_mfma_f32_16x16x32_bf16(a[mi], b[ni], acc[mi][ni], 0, 0, 0);
  }
}

__device__ __forceinline__ u32x4 ld8(const bf16_t* s) { return *(const u32x4*)s; }
__device__ __forceinline__ u32x4 ld8(const float* s) {
  float4 a = *(const float4*)s, b = *(const float4*)(s + 4);
  u32x4 r; r.x = pack2(a.x, a.y); r.y = pack2(a.z, a.w); r.z = pack2(b.x, b.y); r.w = pack2(b.z, b.w); return r;
}
template <typename T>
__device__ __forceinline__ void ld_tile(bf16_t* dst, const T* src, long ld, int tid) {
#pragma unroll
  for (int i = 0; i < 4; ++i) { int id = tid + 256 * i; int r = id >> 4, c = (id & 15) * 8; *(u32x4*)(dst + r * 136 + c) = ld8(src + (long)r * ld + c); }
}
template <typename T, int ROWS, int DLD>
__device__ __forceinline__ void ld_T(bf16_t* dst, const T* src, long ld, int tid) {
#pragma unroll 2
  for (int id = tid; id < ROWS * 16; id += 256) {
    int r = id % ROWS, c = (id / ROWS) * 8;
    u32x4 v = ld8(src + (long)r * ld + c);
    bf16_t* d = dst + c * DLD + r;
    d[0] = (bf16_t)(v.x & 0xffff); d[DLD] = (bf16_t)(v.x >> 16); d[2 * DLD] = (bf16_t)(v.y & 0xffff); d[3 * DLD] = (bf16_t)(v.y >> 16);
    d[4 * DLD] = (bf16_t)(v.z & 0xffff); d[5 * DLD] = (bf16_t)(v.z >> 16); d[6 * DLD] = (bf16_t)(v.w & 0xffff); d[7 * DLD] = (bf16_t)(v.w >> 16);
  }
}

#define PRG(g) (p.PR() + (size_t)(g) * NTOK * 512)

__device__ __forceinline__ const float* xrow(const Params& p, int l, int row) {
  if (l == 0) return row < NPROMPT ? p.x_p + (size_t)row * 1024 : p.x_s + (size_t)(row - NPROMPT) * 1024;
  return p.o_y() + (size_t)row * 1024;
}

__device__ void wconv_tile(const Params& p, int t, char* smem) {
  float* tile = (float*)smem;
  const int tid = get_tid();
  int l = t / 3392, r = t % 3392;
  const float* src; bf16_t* dst; int K, ldsrc, kt, nt, skip = 1 << 30;
  if (r < 2432) { src = p.w_in + (size_t)l * 1024 * NINSRC; dst = p.wt_in() + (size_t)l * NWT * 1024; K = 1024; ldsrc = NINSRC; kt = r % 16; nt = r / 16; skip = 2560; }
  else if (r < 2816) { r -= 2432; int b = r / 128; r %= 128; src = p.w_br + (size_t)(l * 3 + b) * 512 * 1024; dst = p.wt_br() + (size_t)(l * 3 + b) * 1024 * 512; K = 512; ldsrc = 1024; kt = r % 8; nt = r / 8; }
  else if (r < 3072) { r -= 2816; src = p.w_out + (size_t)l * 1048576; dst = p.wt_out() + (size_t)l * 1048576; K = 1024; ldsrc = 1024; kt = r % 16; nt = r / 16; }
  else if (r < 3328) { r -= 3072; src = p.w_pg + (size_t)l * 1048576; dst = p.wt_pg() + (size_t)l * 1048576; K = 1024; ldsrc = 1024; kt = r % 16; nt = r / 16; }
  else { r -= 3328; src = p.w_pp + (size_t)l * 262144; dst = p.wt_pp() + (size_t)l * 262144; K = 256; ldsrc = 1024; kt = r % 4; nt = r / 4; }
  const int n0 = nt * 64, k0 = kt * 64;
#pragma unroll
  for (int i = 0; i < 16; ++i) {
    int k = i * 4 + (tid >> 6), n = tid & 63; int ns = n0 + n; if (ns >= skip) ns += 8;
    tile[k * 65 + n] = src[(size_t)(k0 + k) * ldsrc + ns];
  }
  __syncthreads();
#pragma unroll
  for (int i = 0; i < 8; ++i) {
    int n = i * 8 + (tid >> 5), k = (tid & 31) * 2;
    *(unsigned*)(dst + (size_t)(n0 + n) * K + k0 + k) = pack2(tile[k * 65 + n], tile[(k + 1) * 65 + n]);
  }
  __syncthreads();
}

__device__ void norm_phase(const Params& p, int l) {
  const int lane = threadIdx.x & 63, wid = threadIdx.x >> 6;
  const float* gp = p.g_pre + l * 1024;
  const float* wg = p.w_in + (size_t)l * 1024 * NINSRC + 2560;
  for (int row = blockIdx.x * 4 + wid; row < NTOK; row += gridDim.x * 4) {
    const float* x = xrow(p, l, row);
    float4 v[4]; float ss = 0.f;
#pragma unroll
    for (int i = 0; i < 4; ++i) { v[i] = *(const float4*)(x + i * 256 + lane * 4); ss += v[i].x * v[i].x + v[i].y * v[i].y + v[i].z * v[i].z + v[i].w * v[i].w; }
#pragma unroll
    for (int o = 32; o > 0; o >>= 1) ss += __shfl_xor(ss, o);
    const float rstd = rsqrtf(ss * (1.f / 1024.f) + 1e-6f);
    float d0 = 0, d1 = 0, d2 = 0, d3 = 0, d4 = 0, d5 = 0, d6 = 0, d7 = 0;
#pragma unroll
    for (int i = 0; i < 4; ++i) {
      const int k = i * 256 + lane * 4;
      float4 g = *(const float4*)(gp + k);
      float u0 = v[i].x * rstd * g.x, u1 = v[i].y * rstd * g.y, u2 = v[i].z * rstd * g.z, u3 = v[i].w * rstd * g.w;
      u32x2 pk; pk.x = pack2(u0, u1); pk.y = pack2(u2, u3);
      *(u32x2*)(p.U() + (size_t)row * 1024 + k) = pk;
      float uu[4] = {u0, u1, u2, u3};
#pragma unroll
      for (int e = 0; e < 4; ++e) {
        const float* wp = wg + (size_t)(k + e) * NINSRC;
        float4 w0 = *(const float4*)wp, w1 = *(const float4*)(wp + 4);
        d0 += uu[e] * w0.x; d1 += uu[e] * w0.y; d2 += uu[e] * w0.z; d3 += uu[e] * w0.w;
        d4 += uu[e] * w1.x; d5 += uu[e] * w1.y; d6 += uu[e] * w1.z; d7 += uu[e] * w1.w;
      }
    }
#pragma unroll
    for (int o = 32; o > 0; o >>= 1) {
      d0 += __shfl_xor(d0, o); d1 += __shfl_xor(d1, o); d2 += __shfl_xor(d2, o); d3 += __shfl_xor(d3, o);
      d4 += __shfl_xor(d4, o); d5 += __shfl_xor(d5, o); d6 += __shfl_xor(d6, o); d7 += __shfl_xor(d7, o);
    }
    if (lane < 4) {
      float di = lane == 0 ? d0 : lane == 1 ? d1 : lane == 2 ? d2 : d3;
      float df = lane == 0 ? d4 : lane == 1 ? d5 : lane == 2 ? d6 : d7;
      p.ig()[row * 4 + lane] = di + p.b_i[l * 4 + lane];
      p.lf()[row * 4 + lane] = logsigm(df + p.b_f[l * 4 + lane]);
    }
  }
}

template <typename TA>
__device__ __forceinline__ void gemm_kloop(f32x4 (&acc)[4][4], const TA* Tp, long ldt, const bf16_t* Wp, long ldw, int K, char* smem) {
  bf16_t* sT = (bf16_t*)smem;
  bf16_t* sW = sT + 2 * 9216;
  const int tid = get_tid(), lane = tid & 63, wid = tid >> 6, wr = wid >> 1, wc = wid & 1, fr = lane & 15, fq = lane >> 4;
  u32x4 rt[4], rw[4];
  const int r0 = tid >> 3, c0 = (tid & 7) * 8;
#define GLOAD(k0) _Pragma("unroll") for (int i = 0; i < 4; ++i) { rt[i] = ld8(Tp + (long)(r0 + 32 * i) * ldt + (k0) + c0); rw[i] = ld8(Wp + (long)(r0 + 32 * i) * ldw + (k0) + c0); }
#define SSTORE(buf) _Pragma("unroll") for (int i = 0; i < 4; ++i) { *(u32x4*)(sT + (buf) * 9216 + (r0 + 32 * i) * 72 + c0) = rt[i]; *(u32x4*)(sW + (buf) * 9216 + (r0 + 32 * i) * 72 + c0) = rw[i]; }
  GLOAD(0); SSTORE(0);
  __syncthreads();
  const int nk = K >> 6;
#pragma unroll 1
  for (int kt = 0; kt < nk; ++kt) {
    const int buf = kt & 1;
    if (kt + 1 < nk) { GLOAD((kt + 1) * 64); }
    const bf16_t* aT = sT + buf * 9216 + (wr * 64) * 72;
    const bf16_t* aW = sW + buf * 9216 + (wc * 64) * 72;
    wmma<4, 4, 2>(acc, aW, 72, aT, 72, fr, fq);
    if (kt + 1 < nk) { SSTORE(buf ^ 1); }
    __syncthreads();
  }
#undef GLOAD
#undef SSTORE
}
__device__ __forceinline__ void zero_acc(f32x4 (&acc)[4][4]) {
#pragma unroll
  for (int a = 0; a < 4; ++a)
#pragma unroll
    for (int b = 0; b < 4; ++b) acc[a][b] = (f32x4){0.f, 0.f, 0.f, 0.f};
}

__device__ void inproj_tile(const Params& p, int l, int t, char* smem) {
  const int tm = t / 52, tn = t % 52;
  const int tid = get_tid(), lane = tid & 63, wid = tid >> 6, wr = wid >> 1, wc = wid & 1, fr = lane & 15, fq = lane >> 4;
  f32x4 acc[4][4]; zero_acc(acc);
  gemm_kloop<bf16_t>(acc, p.U() + (size_t)tm * 128 * 1024, 1024, p.wt_in() + (size_t)l * NWT * 1024 + (size_t)tn * 128 * 1024, 1024, 1024, smem);
  const int g = tn >> 2;
  bf16_t* dst = PRG(g);
#pragma unroll
  for (int ni = 0; ni < 4; ++ni) {
    const int row = tm * 128 + wr * 64 + ni * 16 + fr;
    const bool samp = row >= NPROMPT;
    const int rr = samp ? row - NPROMPT : row;
    const int b = samp ? (rr >> 6) : (rr >> 13), tt = samp ? (rr & 63) : (rr & 8191), T = samp ? 64 : 8192, NB = samp ? 8 : 2;
#pragma unroll
    for (int mi = 0; mi < 4; ++mi) {
      const int cg_ = (tn & 3) * 128 + wc * 64 + mi * 16 + fq * 4;
      f32x4 v = acc[mi][ni];
      u32x2 pk; pk.x = pack2(v[0], v[1]); pk.y = pack2(v[2], v[3]);
      *(u32x2*)(dst + (size_t)row * 512 + cg_) = pk;
      if (g == 6 || g == 7) {
        float* o = (g == 6) ? (samp ? p.o_sk() : p.o_pk()) : (samp ? p.o_sv() : p.o_pv());
        const int hh = cg_ >> 7, d = cg_ & 127;
        *(f32x4*)(o + ((size_t)((l * NB + b) * 4 + hh) * T + tt) * 128 + d) = v;
      } else if (g < 2) {
        if (tt >= T - 3) {
          float* o = samp ? p.o_sconv() : p.o_pconv();
          *(f32x4*)(o + ((size_t)(l * NB + b) * 3 + (tt - (T - 3))) * 1024 + g * 512 + cg_) = v;
        }
      }
    }
  }
}

struct UnitInfo { int samp, b, h, c, rowbase, seq; };
__device__ __forceinline__ UnitInfo unit_info(int u) {
  UnitInfo i;
  if (u < 1024) { i.samp = 0; i.seq = u >> 7; i.b = i.seq >> 2; i.h = i.seq & 3; i.c = u & 127; i.rowbase = i.b * 8192 + i.c * 64; }
  else { int sq = u - 1024; i.samp = 1; i.seq = sq; i.b = sq >> 2; i.h = sq & 3; i.c = 0; i.rowbase = NPROMPT + i.b * 64; }
  return i;
}

__device__ void sb_unit(const Params& p, int l, int u, char* smem) {
  bf16_t* Qs = (bf16_t*)smem;
  bf16_t* Ks = Qs + 64 * 136;
  bf16_t* Vt = Ks + 64 * 136;
  bf16_t* Ps = Vt + 128 * 72;
  const int tid = get_tid(), lane = tid & 63, w = tid >> 6, fr = lane & 15, fq = lane >> 4;
  const UnitInfo ui = unit_info(u);
  const int nblk = ui.samp ? 65 : ui.c + 1;
  const int hc = ui.h * 128;
  __syncthreads();
  ld_tile<bf16_t>(Qs, PRG(5) + (size_t)ui.rowbase * 512 + hc, 512, tid);
  f32x4 o[8][1];
#pragma unroll
  for (int mi = 0; mi < 8; ++mi) o[mi][0] = (f32x4){0.f, 0.f, 0.f, 0.f};
  float R = 0.f;
  const int tq = 16 * w + fr;
  for (int i = nblk - 1; i >= 0; --i) {
    if (!ui.samp || i == 64) {
      const size_t krow = ui.samp ? (size_t)ui.rowbase : (size_t)ui.b * 8192 + (size_t)i * 64;
      ld_tile<bf16_t>(Ks, PRG(6) + krow * 512 + hc, 512, tid);
      ld_T<bf16_t, 64, 72>(Vt, PRG(7) + krow * 512 + hc, 512, tid);
    } else {
      const size_t off = ((size_t)((l * 8 + ui.b) * 4 + ui.h) * 4096 + (size_t)i * 64) * 128;
      ld_tile<float>(Ks, p.ck + off, 128, tid);
      ld_T<float, 64, 72>(Vt, p.cv + off, 128, tid);
    }
    __syncthreads();
    f32x4 z[4][1];
#pragma unroll
    for (int mi = 0; mi < 4; ++mi) z[mi][0] = (f32x4){0.f, 0.f, 0.f, 0.f};
    wmma<4, 1, 4>(z, Ks, 136, Qs + 16 * w * 136, 136, fr, fq);
    const bool diag = (i == nblk - 1);
    float L[4][4], lsg[4][4], G[4];
#pragma unroll
    for (int mi = 0; mi < 4; ++mi) {
      G[mi] = 0.f;
#pragma unroll
      for (int j = 0; j < 4; ++j) {
        const int kk = mi * 16 + fq * 4 + j;
        const float zz = z[mi][0][j] * 0.08838834764831845f;
        const float sp = softplus(zz);
        const bool valid = !diag || kk < tq;
        L[mi][j] = valid ? -sp : 0.f;
        lsg[mi][j] = valid ? zz - sp : -1e30f;
        G[mi] += L[mi][j];
      }
    }
    float sufm = 0.f;
#pragma unroll
    for (int mi = 3; mi >= 0; --mi) {
      const float g0 = __shfl(G[mi], fr), g1 = __shfl(G[mi], fr + 16), g2 = __shfl(G[mi], fr + 32), g3 = __shfl(G[mi], fr + 48);
      const float later = (fq < 1 ? g1 : 0.f) + (fq < 2 ? g2 : 0.f) + (fq < 3 ? g3 : 0.f);
      const float s3 = R + sufm + later, s2 = s3 + L[mi][3], s1 = s2 + L[mi][2], s0 = s1 + L[mi][1];
      const float a0 = __expf(lsg[mi][0] + s0), a1 = __expf(lsg[mi][1] + s1), a2 = __expf(lsg[mi][2] + s2), a3 = __expf(lsg[mi][3] + s3);
      u32x2 pk; pk.x = pack2(a0, a1); pk.y = pack2(a2, a3);
      *(u32x2*)(Ps + tq * 72 + mi * 16 + fq * 4) = pk;
      sufm += (g0 + g1) + (g2 + g3);
    }
    R += sufm;
    __syncthreads();
    wmma<8, 1, 2>(o, Vt, 72, Ps + 16 * w * 72, 72, fr, fq);
    if (__syncthreads_and(R < -110.f)) break;
  }
  const size_t row = (size_t)ui.rowbase + tq;
#pragma unroll
  for (int mi = 0; mi < 8; ++mi) {
    const int col = hc + mi * 16 + fq * 4;
    u32x2 zz = *(const u32x2*)(PRG(8) + row * 512 + col);
    f32x4 v = o[mi][0];
    u32x2 pk;
    pk.x = pack2(v[0] * silu(lo2f(zz.x)), v[1] * silu(hi2f(zz.x)));
    pk.y = pack2(v[2] * silu(lo2f(zz.y)), v[3] * silu(hi2f(zz.y)));
    *(u32x2*)(p.H() + (size_t)1 * NTOK * 512 + row * 512 + col) = pk;
  }
}

__device__ void mlstm_local(const Params& p, int l, int u, char* smem) {
  bf16_t* kdT = (bf16_t*)smem;
  bf16_t* vT = kdT + 128 * 72;
  float* dec = (float*)(vT + 128 * 72);
  const int tid = get_tid(), lane = tid & 63, w = tid >> 6, fr = lane & 15, fq = lane >> 4;
  const UnitInfo ui = unit_info(u);
  const int hc = ui.h * 128;
  __syncthreads();
  if (w == 0) {
    const float lfv = p.lf()[(ui.rowbase + lane) * 4 + ui.h], igv = p.ig()[(ui.rowbase + lane) * 4 + ui.h];
    float bs = lfv;
#pragma unroll
    for (int o = 1; o < 64; o <<= 1) { float t = __shfl_up(bs, o); if (lane >= o) bs += t; }
    const float g = igv - bs;
    float gm = g;
#pragma unroll
    for (int o = 32; o > 0; o >>= 1) gm = fmaxf(gm, __shfl_xor(gm, o));
    const float bL = __shfl(bs, 63);
    dec[lane] = __expf(g - gm);
    if (lane == 0) { p.ac()[u] = bL + gm; p.Bc()[u] = bL; }
  }
  ld_T<bf16_t, 64, 72>(vT, PRG(2) + (size_t)ui.rowbase * 512 + hc, 512, tid);
  __syncthreads();
  {
    const int isk = tid >> 7, ch = tid & 127, col = hc + ch;
    const bf16_t* src = PRG(isk) + (size_t)ui.rowbase * 512 + col;
    const float* wc_ = p.w_conv + (size_t)l * 4096 + isk * 512 + col;
    const float w0 = wc_[0], w1 = wc_[1024], w2 = wc_[2048], w3 = wc_[3072];
    float x0 = 0.f, x1 = 0.f, x2 = 0.f;
    if (ui.samp) {
      const float* cs = p.st_conv + (size_t)(l * 8 + ui.b) * 3072 + isk * 512 + col;
      x0 = cs[0]; x1 = cs[1024]; x2 = cs[2048];
    } else if (ui.c > 0) {
      x0 = bf2f(src[-3 * 512]); x1 = bf2f(src[-2 * 512]); x2 = bf2f(src[-1 * 512]);
    }
    bf16_t* dg = (isk ? p.KC() : p.QC()) + (size_t)ui.rowbase * 512 + col;
#pragma unroll 4
    for (int t = 0; t < 64; ++t) {
      const float x3 = bf2f(src[t * 512]);
      float y = silu(w0 * x0 + w1 * x1 + w2 * x2 + w3 * x3);
      if (isk) y *= 0.08838834764831845f;
      const bf16_t yb = f2bf(y);
      dg[t * 512] = yb;
      if (isk) kdT[ch * 72 + t] = f2bf(bf2f(yb) * dec[t]);
      x0 = x1; x1 = x2; x2 = x3;
    }
  }
  __syncthreads();
  if (tid < 128) { float s = 0.f;
#pragma unroll 8
    for (int t = 0; t < 64; ++t) s += bf2f(kdT[tid * 72 + t]); p.nloc()[u * 128 + tid] = s; }
  f32x4 acc[8][2];
#pragma unroll
  for (int a = 0; a < 8; ++a) { acc[a][0] = (f32x4){0.f, 0.f, 0.f, 0.f}; acc[a][1] = (f32x4){0.f, 0.f, 0.f, 0.f}; }
  wmma<8, 2, 2>(acc, vT, 72, kdT + 32 * w * 72, 72, fr, fq);
  bf16_t* sm = p.SM() + (size_t)u * 16384;
#pragma unroll
  for (int mi = 0; mi < 8; ++mi)
#pragma unroll
    for (int ni = 0; ni < 2; ++ni) {
      u32x2 pk; pk.x = pack2(acc[mi][ni][0], acc[mi][ni][1]); pk.y = pack2(acc[mi][ni][2], acc[mi][ni][3]);
      *(u32x2*)(sm + (32 * w + ni * 16 + fr) * 128 + mi * 16 + fq * 4) = pk;
    }
}

__device__ __forceinline__ float hgrn_lb(const Params& p, int l, int ch512) {
  if (l == 0) return 0.f;
  return sigm(p.lb_logits[512 + ch512] - p.lb_logits[ch512]);
}
__device__ __forceinline__ void hgrn_gate(float f, float lb, float& lg, float& kh) {
  const float e = __expf(-fabsf(f));
  const float sp = f >= 0.f ? 1.f / (1.f + e) : e / (1.f + e);
  const float sn = f >= 0.f ? e / (1.f + e) : 1.f / (1.f + e);
  lg = (lb == 0.f) ? (fminf(f, 0.f) - __logf(1.f + e)) : __logf(lb + (1.f - lb) * sp);
  kh = (1.f - lb) * sn;
}

__device__ void hgrn_local(const Params& p, int l, int u, char* smem) {
  bf16_t* kdT = (bf16_t*)smem;
  bf16_t* iT = kdT + 128 * 72;
  float* tot = (float*)(iT + 128 * 72);
  const int tid = get_tid(), lane = tid & 63, w = tid >> 6, fr = lane & 15, fq = lane >> 4;
  const UnitInfo ui = unit_info(u);
  const int hc = ui.h * 128;
  __syncthreads();
  ld_T<bf16_t, 64, 72>(iT, PRG(11) + (size_t)ui.rowbase * 512 + hc, 512, tid);
  const int half = tid >> 7, ch = tid & 127;
  const float lb = hgrn_lb(p, l, hc + ch);
  const bf16_t* src = PRG(10) + (size_t)(ui.rowbase + half * 32) * 512 + hc + ch;
  {
    float run = 0.f;
#pragma unroll 4
    for (int t = 0; t < 32; ++t) { float lg, kh; hgrn_gate(bf2f(src[t * 512]), lb, lg, kh); run += lg; }
    tot[half * 128 + ch] = run;
  }
  __syncthreads();
  {
    const float t0 = tot[ch], t1 = tot[128 + ch];
    const float bcL = t0 + t1;
    float run = half ? t0 : 0.f;
#pragma unroll 4
    for (int t = 0; t < 32; ++t) {
      float lg, kh; hgrn_gate(bf2f(src[t * 512]), lb, lg, kh); run += lg;
      kdT[ch * 72 + half * 32 + t] = f2bf(kh * __expf(bcL - run));
    }
    if (half == 0) p.hbc()[u * 128 + ch] = bcL;
  }
  __syncthreads();
  f32x4 acc[8][2];
#pragma unroll
  for (int a = 0; a < 8; ++a) { acc[a][0] = (f32x4){0.f, 0.f, 0.f, 0.f}; acc[a][1] = (f32x4){0.f, 0.f, 0.f, 0.f}; }
  wmma<8, 2, 2>(acc, iT, 72, kdT + 32 * w * 72, 72, fr, fq);
  bf16_t* sh = p.SH() + (size_t)u * 16384;
#pragma unroll
  for (int mi = 0; mi < 8; ++mi)
#pragma unroll
    for (int ni = 0; ni < 2; ++ni) {
      u32x2 pk; pk.x = pack2(acc[mi][ni][0], acc[mi][ni][1]); pk.y = pack2(acc[mi][ni][2], acc[mi][ni][3]);
      *(u32x2*)(sh + (32 * w + ni * 16 + fr) * 128 + mi * 16 + fq * 4) = pk;
    }
}

__device__ void scan_phase(const Params& p, int l) {
  const int gt = blockIdx.x * 256 + threadIdx.x, nth = gridDim.x * 256;
  for (int it = gt; it < 131072; it += nth) {
    const int kind = it >> 16, seq = (it >> 13) & 7, pr = it & 8191, e = pr * 2;
    if (kind == 0) {
      float m = 0.f, c0 = 0.f, c1 = 0.f;
      for (int c = 0; c < 128; ++c) {
        const int u = seq * 128 + c;
        unsigned* slot = (unsigned*)(p.SM() + (size_t)u * 16384) + pr;
        const unsigned lv = *slot;
        const float a = p.ac()[u], B = p.Bc()[u];
        const float mo = fmaxf(a, B + m), dc = __expf(B + m - mo), wl = __expf(a - mo);
        *slot = pack2(c0, c1);
        if (pr == 0) p.min_()[u] = m;
        c0 = dc * c0 + wl * lo2f(lv); c1 = dc * c1 + wl * hi2f(lv); m = mo;
      }
      float* o = p.o_pC() + (size_t)(l * 8 + seq) * 16384 + e; o[0] = c0; o[1] = c1;
      if (pr == 0) p.o_pm()[l * 8 + seq] = m;
    } else {
      const int row = e >> 7;
      float s0 = 0.f, s1 = 0.f;
      for (int c = 0; c < 128; ++c) {
        const int u = seq * 128 + c;
        unsigned* slot = (unsigned*)(p.SH() + (size_t)u * 16384) + pr;
        const unsigned lv = *slot;
        const float d = __expf(p.hbc()[u * 128 + row]);
        *slot = pack2(s0, s1);
        s0 = d * s0 + lo2f(lv); s1 = d * s1 + hi2f(lv);
      }
      float* o = p.o_pS() + (size_t)(l * 8 + seq) * 16384 + e; o[0] = s0; o[1] = s1;
    }
  }
  for (int it = gt; it < 524288; it += nth) {
    const int kind = it >> 18, sq = (it >> 13) & 31, pr = it & 8191, e = pr * 2, u = 1024 + sq;
    if (kind == 0) {
      const float* c0p = p.st_C + (size_t)(l * 32 + sq) * 16384 + e;
      const float C0 = c0p[0], C1 = c0p[1], m = p.st_m[l * 32 + sq];
      unsigned* slot = (unsigned*)(p.SM() + (size_t)u * 16384) + pr;
      const unsigned lv = *slot;
      const float a = p.ac()[u], B = p.Bc()[u];
      const float mo = fmaxf(a, B + m), dc = __expf(B + m - mo), wl = __expf(a - mo);
      *slot = pack2(C0, C1);
      float* o = p.o_sC() + (size_t)(l * 32 + sq) * 16384 + e; o[0] = dc * C0 + wl * lo2f(lv); o[1] = dc * C1 + wl * hi2f(lv);
      if (pr == 0) { p.min_()[u] = m; p.o_sm()[l * 32 + sq] = mo; }
    } else {
      const int row = e >> 7;
      const float* s0p = p.st_S + (size_t)(l * 32 + sq) * 16384 + e;
      const float S0 = s0p[0], S1 = s0p[1];
      unsigned* slot = (unsigned*)(p.SH() + (size_t)u * 16384) + pr;
      const unsigned lv = *slot;
      const float d = __expf(p.hbc()[u * 128 + row]);
      *slot = pack2(S0, S1);
      float* o = p.o_sS() + (size_t)(l * 32 + sq) * 16384 + e; o[0] = d * S0 + lo2f(lv); o[1] = d * S1 + hi2f(lv);
    }
  }
  for (int it = gt; it < 1024; it += nth) {
    const int seq = it >> 7, d = it & 127;
    float m = 0.f, n = 0.f;
    for (int c = 0; c < 128; ++c) {
      const int u = seq * 128 + c;
      const float a = p.ac()[u], B = p.Bc()[u];
      const float mo = fmaxf(a, B + m), dc = __expf(B + m - mo), wl = __expf(a - mo);
      const float nl = p.nloc()[u * 128 + d];
      p.nloc()[u * 128 + d] = n;
      n = dc * n + wl * nl; m = mo;
    }
    p.o_pn()[(l * 8 + seq) * 128 + d] = n;
  }
  for (int it = gt; it < 4096; it += nth) {
    const int sq = it >> 7, d = it & 127, u = 1024 + sq;
    const float n0 = p.st_n[(l * 32 + sq) * 128 + d], m = p.st_m[l * 32 + sq];
    const float a = p.ac()[u], B = p.Bc()[u];
    const float mo = fmaxf(a, B + m), dc = __expf(B + m - mo), wl = __expf(a - mo);
    const float nl = p.nloc()[u * 128 + d];
    p.nloc()[u * 128 + d] = n0;
    p.o_sn()[(l * 32 + sq) * 128 + d] = dc * n0 + wl * nl;
  }
}

__device__ void mlstm_out(const Params& p, int l, int u, char* smem) {
  bf16_t* Qs = (bf16_t*)smem;
  bf16_t* CT = Qs + 64 * 136;
  bf16_t* Ks = CT;
  bf16_t* Vt = Ks + 64 * 136;
  bf16_t* Ps = Vt + 144 * 72;
  float* misc = (float*)(smem + 17408 + 47360);
  float *bsum = misc, *gs = misc + 64, *mt = misc + 128, *wint = misc + 192;
  const int tid = get_tid(), lane = tid & 63, w = tid >> 6, fr = lane & 15, fq = lane >> 4;
  const UnitInfo ui = unit_info(u);
  const int hc = ui.h * 128;
  __syncthreads();
  if (w == 0) {
    const float lfv = p.lf()[(ui.rowbase + lane) * 4 + ui.h], igv = p.ig()[(ui.rowbase + lane) * 4 + ui.h];
    float bs = lfv;
#pragma unroll
    for (int o = 1; o < 64; o <<= 1) { float t = __shfl_up(bs, o); if (lane >= o) bs += t; }
    const float g = igv - bs;
    float cm = g;
#pragma unroll
    for (int o = 1; o < 64; o <<= 1) { float t = __shfl_up(cm, o); if (lane >= o) cm = fmaxf(cm, t); }
    const float m_in = p.min_()[u];
    const float mtt = bs + fmaxf(cm, m_in);
    bsum[lane] = bs; gs[lane] = g; mt[lane] = mtt; wint[lane] = __expf(bs + m_in - mtt);
  }
  ld_tile<bf16_t>(Qs, p.QC() + (size_t)ui.rowbase * 512 + hc, 512, tid);
  ld_T<bf16_t, 128, 136>(CT, p.SM() + (size_t)u * 16384, 128, tid);
  if (tid < 128) CT[128 * 136 + tid] = f2bf(p.nloc()[u * 128 + tid]);
  for (int i = tid; i < 15 * 128; i += 256) CT[(129 + (i >> 7)) * 136 + (i & 127)] = 0;
  __syncthreads();
  f32x4 acc[9][1];
#pragma unroll
  for (int mi = 0; mi < 9; ++mi) acc[mi][0] = (f32x4){0.f, 0.f, 0.f, 0.f};
  wmma<9, 1, 4>(acc, CT, 136, Qs + 16 * w * 136, 136, fr, fq);
  const int t = 16 * w + fr;
  const float wi = wint[t];
#pragma unroll
  for (int mi = 0; mi < 9; ++mi) acc[mi][0] *= wi;
  __syncthreads();
  ld_tile<bf16_t>(Ks, p.KC() + (size_t)ui.rowbase * 512 + hc, 512, tid);
  ld_T<bf16_t, 64, 72>(Vt, PRG(2) + (size_t)ui.rowbase * 512 + hc, 512, tid);
  if (tid < 64) Vt[128 * 72 + tid] = 0x3F80;
  for (int i = tid; i < 15 * 64; i += 256) Vt[(129 + (i >> 6)) * 72 + (i & 63)] = 0;
  __syncthreads();
  f32x4 st[4][1];
#pragma unroll
  for (int mi = 0; mi < 4; ++mi) st[mi][0] = (f32x4){0.f, 0.f, 0.f, 0.f};
  wmma<4, 1, 4>(st, Ks, 136, Qs + 16 * w * 136, 136, fr, fq);
  const float bt = bsum[t], mtt = mt[t];
#pragma unroll
  for (int mi = 0; mi < 4; ++mi) {
    float a[4];
#pragma unroll
    for (int j = 0; j < 4; ++j) {
      const int s = mi * 16 + fq * 4 + j;
      a[j] = (s <= t) ? st[mi][0][j] * __expf(bt + gs[s] - mtt) : 0.f;
    }
    u32x2 pk; pk.x = pack2(a[0], a[1]); pk.y = pack2(a[2], a[3]);
    *(u32x2*)(Ps + t * 72 + mi * 16 + fq * 4) = pk;
  }
  __syncthreads();
  wmma<9, 1, 2>(acc, Vt, 72, Ps + 16 * w * 72, 72, fr, fq);
  const float den = __shfl(acc[8][0][0], fr);
  const float inv = 1.f / fmaxf(fabsf(den), __expf(-mtt));
  float ss = 0.f;
#pragma unroll
  for (int mi = 0; mi < 8; ++mi) { acc[mi][0] *= inv; ss += acc[mi][0][0] * acc[mi][0][0] + acc[mi][0][1] * acc[mi][0][1] + acc[mi][0][2] * acc[mi][0][2] + acc[mi][0][3] * acc[mi][0][3]; }
  ss += __shfl_xor(ss, 16); ss += __shfl_xor(ss, 32);
  const float rs = rsqrtf(ss * (1.f / 128.f) + 1e-6f);
  const size_t row = (size_t)ui.rowbase + t;
#pragma unroll
  for (int mi = 0; mi < 8; ++mi) {
    const int col = hc + mi * 16 + fq * 4;
    const u32x2 ov = *(const u32x2*)(PRG(3) + row * 512 + col);
    const u32x2 zv = *(const u32x2*)(PRG(4) + row * 512 + col);
    const float4 g = *(const float4*)(p.g_ml + l * 512 + col);
    const f32x4 v = acc[mi][0];
    u32x2 pk;
    pk.x = pack2(v[0] * rs * g.x * sigm(lo2f(ov.x)) * silu(lo2f(zv.x)), v[1] * rs * g.y * sigm(hi2f(ov.x)) * silu(hi2f(zv.x)));
    pk.y = pack2(v[2] * rs * g.z * sigm(lo2f(ov.y)) * silu(lo2f(zv.y)), v[3] * rs * g.w * sigm(hi2f(ov.y)) * silu(hi2f(zv.y)));
    *(u32x2*)(p.H() + row * 512 + col) = pk;
  }
}

__device__ __forceinline__ bf16x8 scale_frag(const bf16_t* src, const float* ea, const float* eb, float sgn, bool clampit) {
  u32x4 raw = *(const u32x4*)src;
  float4 a0 = *(const float4*)ea, a1 = *(const float4*)(ea + 4);
  float4 b0 = {0.f, 0.f, 0.f, 0.f}, b1 = {0.f, 0.f, 0.f, 0.f};
  if (eb) { b0 = *(const float4*)eb; b1 = *(const float4*)(eb + 4); }
  float e[8] = {a0.x - b0.x, a0.y - b0.y, a0.z - b0.z, a0.w - b0.w, a1.x - b1.x, a1.y - b1.y, a1.z - b1.z, a1.w - b1.w};
  float v[8] = {lo2f(raw.x), hi2f(raw.x), lo2f(raw.y), hi2f(raw.y), lo2f(raw.z), hi2f(raw.z), lo2f(raw.w), hi2f(raw.w)};
  unsigned o[4];
#pragma unroll
  for (int i = 0; i < 4; ++i) {
    float x0 = sgn * e[2 * i], x1 = sgn * e[2 * i + 1];
    if (clampit) { x0 = fminf(x0, 80.f); x1 = fminf(x1, 80.f); }
    o[i] = pack2(v[2 * i] * __expf(x0), v[2 * i + 1] * __expf(x1));
  }
  u32x4 r = {o[0], o[1], o[2], o[3]};
  return __builtin_bit_cast(bf16x8, r);
}

__device__ void hgrn_out(const Params& p, int l, int u, char* smem) {
  float* bc = (float*)smem;
  bf16_t* ST = (bf16_t*)smem;
  bf16_t* qs = (bf16_t*)(smem + 34816);
  bf16_t* kh = (bf16_t*)(smem + 34816 + 17408);
  bf16_t* iT = kh;
  bf16_t* Ps = (bf16_t*)(smem + 34816 + 17408 + 18432);
  float* tot = (float*)(smem + 79872);
  const int tid = get_tid(), lane = tid & 63, w = tid >> 6, fr = lane & 15, fq = lane >> 4;
  const UnitInfo ui = unit_info(u);
  const int hc = ui.h * 128;
  __syncthreads();
  ld_tile<bf16_t>(qs, PRG(9) + (size_t)ui.rowbase * 512 + hc, 512, tid);
  {
    const int half = tid >> 7, ch = tid & 127;
    const float lb = hgrn_lb(p, l, hc + ch);
    const bf16_t* src = PRG(10) + (size_t)(ui.rowbase + half * 32) * 512 + hc + ch;
    float run = 0.f;
#pragma unroll 4
    for (int t = 0; t < 32; ++t) { float lg, k; hgrn_gate(bf2f(src[t * 512]), lb, lg, k); run += lg; }
    tot[half * 128 + ch] = run;
    __syncthreads();
    run = half ? tot[ch] : 0.f;
#pragma unroll 4
    for (int t = 0; t < 32; ++t) {
      float lg, k; hgrn_gate(bf2f(src[t * 512]), lb, lg, k); run += lg;
      bc[(half * 32 + t) * 132 + ch] = run;
      kh[(half * 32 + t) * 136 + ch] = f2bf(k);
    }
  }
  __syncthreads();
  {
    const int I = w, t = 16 * I + fr;
    f32x4 a[4];
#pragma unroll
    for (int J = 0; J < 4; ++J) a[J] = (f32x4){0.f, 0.f, 0.f, 0.f};
#pragma unroll
    for (int kk = 0; kk < 4; ++kk) {
      const int c0 = kk * 32 + fq * 8;
      const float* rI = (I > 0) ? bc + (16 * I - 1) * 132 + c0 : nullptr;
      const bf16x8 bq = scale_frag(qs + t * 136 + c0, bc + t * 132 + c0, rI, 1.f, false);
#pragma unroll
      for (int J = 0; J < 4; ++J) {
        if (J <= I) {
          const int s = 16 * J + fr;
          const bf16x8 ak = scale_frag(kh + s * 136 + c0, bc + s * 132 + c0, rI, -1.f, true);
          a[J] = __builtin_amdgcn_mfma_f32_16x16x32_bf16(ak, bq, a[J], 0, 0, 0);
        }
      }
    }
#pragma unroll
    for (int J = 0; J < 4; ++J) {
      float v[4];
#pragma unroll
      for (int j = 0; j < 4; ++j) { const int s = 16 * J + fq * 4 + j; v[j] = (s <= t) ? a[J][j] : 0.f; }
      u32x2 pk; pk.x = pack2(v[0], v[1]); pk.y = pack2(v[2], v[3]);
      *(u32x2*)(Ps + t * 72 + J * 16 + fq * 4) = pk;
    }
  }
  __syncthreads();
#pragma unroll 4
  for (int i = tid; i < 64 * 128; i += 256) { const int t = i >> 7, c = i & 127; qs[t * 136 + c] = f2bf(bf2f(qs[t * 136 + c]) * __expf(bc[t * 132 + c])); }
  __syncthreads();
  ld_T<bf16_t, 64, 72>(iT, PRG(11) + (size_t)ui.rowbase * 512 + hc, 512, tid);
  ld_T<bf16_t, 128, 136>(ST, p.SH() + (size_t)u * 16384, 128, tid);
  __syncthreads();
  f32x4 acc[8][1];
#pragma unroll
  for (int mi = 0; mi < 8; ++mi) acc[mi][0] = (f32x4){0.f, 0.f, 0.f, 0.f};
  wmma<8, 1, 2>(acc, iT, 72, Ps + 16 * w * 72, 72, fr, fq);
  wmma<8, 1, 4>(acc, ST, 136, qs + 16 * w * 136, 136, fr, fq);
  float ss = 0.f;
#pragma unroll
  for (int mi = 0; mi < 8; ++mi) ss += acc[mi][0][0] * acc[mi][0][0] + acc[mi][0][1] * acc[mi][0][1] + acc[mi][0][2] * acc[mi][0][2] + acc[mi][0][3] * acc[mi][0][3];
  ss += __shfl_xor(ss, 16); ss += __shfl_xor(ss, 32);
  const float rs = rsqrtf(ss * (1.f / 128.f) + 1e-6f);
  const size_t row = (size_t)ui.rowbase + 16 * w + fr;
#pragma unroll
  for (int mi = 0; mi < 8; ++mi) {
    const int col = hc + mi * 16 + fq * 4;
    const u32x2 zv = *(const u32x2*)(PRG(12) + row * 512 + col);
    const float4 g = *(const float4*)(p.g_hg + l * 512 + col);
    const f32x4 v = acc[mi][0];
    u32x2 pk;
    pk.x = pack2(v[0] * rs * g.x * silu(lo2f(zv.x)), v[1] * rs * g.y * silu(hi2f(zv.x)));
    pk.y = pack2(v[2] * rs * g.z * silu(lo2f(zv.y)), v[3] * rs * g.w * silu(hi2f(zv.y)));
    *(u32x2*)(p.H() + (size_t)2 * NTOK * 512 + row * 512 + col) = pk;
  }
}

__device__ void merge_tile(const Params& p, int l, int t, char* smem) {
  const int tm = t >> 3, tn = t & 7;
  const int tid = get_tid(), lane = tid & 63, wid = tid >> 6, wr = wid >> 1, wc = wid & 1, fr = lane & 15, fq = lane >> 4;
#pragma unroll 1
  for (int b = 0; b < 3; ++b) {
    f32x4 acc[4][4]; zero_acc(acc);
    gemm_kloop<bf16_t>(acc, p.U() + (size_t)tm * 128 * 1024, 1024, p.wt_in() + (size_t)l * NWT * 1024 + (size_t)(NMAIN + b * 1024 + tn * 128) * 1024, 1024, 1024, smem);
#pragma unroll
    for (int ni = 0; ni < 4; ++ni)
#pragma unroll
      for (int mi = 0; mi < 4; ++mi) {
        f32x4 v; v[0] = sigm(acc[mi][ni][0]); v[1] = sigm(acc[mi][ni][1]); v[2] = sigm(acc[mi][ni][2]); v[3] = sigm(acc[mi][ni][3]);
        *(f32x4*)(p.r() + ((size_t)tm * 128 + wr * 64 + ni * 16 + fr) * 1024 + tn * 128 + wc * 64 + mi * 16 + fq * 4) = v;
      }
    zero_acc(acc);
    gemm_kloop<bf16_t>(acc, p.H() + (size_t)b * NTOK * 512 + (size_t)tm * 128 * 512, 512, p.wt_br() + (size_t)(l * 3 + b) * 1024 * 512 + (size_t)tn * 128 * 512, 512, 512, smem);
#pragma unroll
    for (int ni = 0; ni < 4; ++ni) {
      const size_t row = (size_t)tm * 128 + wr * 64 + ni * 16 + fr;
#pragma unroll
      for (int mi = 0; mi < 4; ++mi) {
        const int col = tn * 128 + wc * 64 + mi * 16 + fq * 4;
        f32x4 v = *(const f32x4*)(p.r() + row * 1024 + col) * acc[mi][ni];
        float* part = p.y() + row * 1024 + col;
        if (b > 0) v += *(const f32x4*)part;
        if (b < 2) *(f32x4*)part = v;
        else { u32x2 pk; pk.x = pack2(v[0], v[1]); pk.y = pack2(v[2], v[3]); *(u32x2*)(p.merged() + row * 1024 + col) = pk; }
      }
    }
  }
}

__device__ void outproj_tile(const Params& p, int l, int t, char* smem) {
  const int tm = t >> 3, tn = t & 7;
  const int tid = get_tid(), lane = tid & 63, wid = tid >> 6, wr = wid >> 1, wc = wid & 1, fr = lane & 15, fq = lane >> 4;
  f32x4 acc[4][4]; zero_acc(acc);
  gemm_kloop<bf16_t>(acc, p.merged() + (size_t)tm * 128 * 1024, 1024, p.wt_out() + (size_t)l * 1048576 + (size_t)tn * 128 * 1024, 1024, 1024, smem);
#pragma unroll
  for (int ni = 0; ni < 4; ++ni) {
    const size_t row = (size_t)tm * 128 + wr * 64 + ni * 16 + fr;
#pragma unroll
    for (int mi = 0; mi < 4; ++mi) *(f32x4*)(p.y() + row * 1024 + tn * 128 + wc * 64 + mi * 16 + fq * 4) = acc[mi][ni];
  }
}

__device__ void postnorm_phase(const Params& p, int l) {
  const int lane = threadIdx.x & 63, wid = threadIdx.x >> 6;
  const float* gp = p.g_post + l * 1024;
  for (int row = blockIdx.x * 4 + wid; row < NTOK; row += gridDim.x * 4) {
    const float* x = xrow(p, l, row);
    const float* y = p.y() + (size_t)row * 1024;
    float4 v[4]; float ss = 0.f;
#pragma unroll
    for (int i = 0; i < 4; ++i) { v[i] = *(const float4*)(y + i * 256 + lane * 4); ss += v[i].x * v[i].x + v[i].y * v[i].y + v[i].z * v[i].z + v[i].w * v[i].w; }
#pragma unroll
    for (int o = 32; o > 0; o >>= 1) ss += __shfl_xor(ss, o);
    const float rstd = rsqrtf(ss * (1.f / 1024.f) + 1e-6f);
#pragma unroll
    for (int i = 0; i < 4; ++i) {
      const int k = i * 256 + lane * 4;
      const float4 g = *(const float4*)(gp + k), xv = *(const float4*)(x + k);
      float4 r; r.x = xv.x + v[i].x * rstd * g.x; r.y = xv.y + v[i].y * rstd * g.y; r.z = xv.z + v[i].z * rstd * g.z; r.w = xv.w + v[i].w * rstd * g.w;
      *(float4*)(p.r() + (size_t)row * 1024 + k) = r;
      u32x2 pk; pk.x = pack2(r.x, r.y); pk.y = pack2(r.z, r.w);
      *(u32x2*)(p.rb() + (size_t)row * 1024 + k) = pk;
    }
  }
}

__device__ void ple_tile(const Params& p, int l, int t, char* smem) {
  const int tm = t >> 3, tn = t & 7;
  const int tid = get_tid(), lane = tid & 63, wid = tid >> 6, wr = wid >> 1, wc = wid & 1, fr = lane & 15, fq = lane >> 4;
  f32x4 acc[4][4]; zero_acc(acc);
  const int row0 = tm * 128;
  const float* pp = row0 < NPROMPT ? p.p_p + ((size_t)l * NPROMPT + row0) * 256 : p.p_s + ((size_t)l * 512 + (row0 - NPROMPT)) * 256;
  gemm_kloop<float>(acc, pp, 256, p.wt_pp() + (size_t)l * 262144 + (size_t)tn * 128 * 256, 256, 256, smem);
  u32x2 pb[4][4];
#pragma unroll
  for (int a = 0; a < 4; ++a)
#pragma unroll
    for (int c = 0; c < 4; ++c) { pb[a][c].x = pack2(acc[a][c][0], acc[a][c][1]); pb[a][c].y = pack2(acc[a][c][2], acc[a][c][3]); }
  zero_acc(acc);
  gemm_kloop<bf16_t>(acc, p.rb() + (size_t)tm * 128 * 1024, 1024, p.wt_pg() + (size_t)l * 1048576 + (size_t)tn * 128 * 1024, 1024, 1024, smem);
#pragma unroll
  for (int ni = 0; ni < 4; ++ni) {
    const size_t row = (size_t)row0 + wr * 64 + ni * 16 + fr;
#pragma unroll
    for (int mi = 0; mi < 4; ++mi) {
      const int col = tn * 128 + wc * 64 + mi * 16 + fq * 4;
      const f32x4 rv = *(const f32x4*)(p.r() + row * 1024 + col);
      f32x4 o;
      o[0] = rv[0] + sigm(acc[mi][ni][0]) * lo2f(pb[mi][ni].x); o[1] = rv[1] + sigm(acc[mi][ni][1]) * hi2f(pb[mi][ni].x);
      o[2] = rv[2] + sigm(acc[mi][ni][2]) * lo2f(pb[mi][ni].y); o[3] = rv[3] + sigm(acc[mi][ni][3]) * hi2f(pb[mi][ni].y);
      *(f32x4*)(p.o_y() + row * 1024 + col) = o;
    }
  }
}

template <int PH>
__device__ __forceinline__ void run_phase(const Params& p, char* smem) {
  const int bid = blockIdx.x, nb = gridDim.x;
  if (PH == 0) { for (int t = bid; t < 6784; t += nb) wconv_tile(p, t, smem); return; }
  constexpr int l = (PH - 1) / 9, s = (PH - 1) % 9;
  if (!((PHMASK >> s) & 1)) return;
  switch (s) {
    case 0: norm_phase(p, l); break;
    case 1: for (int t = bid; t < 132 * 52; t += nb) inproj_tile(p, l, t, smem); break;
    case 2:
      for (int v = bid; v < 3 * NUNIT; v += nb) {
        const int ty = v % 3, u = v / 3;
        if (ty == 0) sb_unit(p, l, u, smem); else if (ty == 1) mlstm_local(p, l, u, smem); else hgrn_local(p, l, u, smem);
      }
      break;
    case 3: scan_phase(p, l); break;
    case 4:
      for (int v = bid; v < 2 * NUNIT; v += nb) { if (v & 1) hgrn_out(p, l, v >> 1, smem); else mlstm_out(p, l, v >> 1, smem); }
      break;
    case 5: for (int t = bid; t < 1056; t += nb) merge_tile(p, l, t, smem); break;
    case 6: for (int t = bid; t < 1056; t += nb) outproj_tile(p, l, t, smem); break;
    case 7: postnorm_phase(p, l); break;
    case 8: for (int t = bid; t < 1056; t += nb) ple_tile(p, l, t, smem); break;
  }
}

template <int PH>
__global__ void __launch_bounds__(256, 2) phase_kernel(Params p) {
  __shared__ __attribute__((aligned(16))) char smem[SMEM_BYTES];
  run_phase<PH>(p, smem);
}

#if FUSED
template <int PH>
__device__ __forceinline__ void run_from(char* smem) {
  {
    typedef const Params __attribute__((address_space(4))) * KP4;
    KP4 kp = (KP4)__builtin_amdgcn_kernarg_segment_ptr();
    asm volatile("" : "+s"(kp));
    const Params q = *(const Params*)kp;
    run_phase<PH>(q, smem);
  }
  if constexpr (PH + 1 < NPHASE) { cg::this_grid().sync(); run_from<PH + 1>(smem); }
}

__global__ void __launch_bounds__(256, 2) mega(Params p_unused) {
  __shared__ __attribute__((aligned(16))) char smem[SMEM_BYTES];
  run_from<0>(smem);
}
#endif

template <int PH>
static void launch_all(const Params& p, int grid, hipStream_t stream) {
  hipLaunchKernelGGL(phase_kernel<PH>, dim3(grid), dim3(256), 0, stream, p);
  if constexpr (PH + 1 < NPHASE) launch_all<PH + 1>(p, grid, stream);
}

extern "C" void kernel_launch(void* const* d_in, const int* in_sizes, int n_in, void* d_out, int out_size, void* d_ws, size_t ws_size, hipStream_t stream) {
  Params p;
  memset(&p, 0, sizeof(p));
  const float* const* in = (const float* const*)d_in;
  p.x_p = in[0]; p.x_s = in[1]; p.p_p = in[2]; p.p_s = in[3]; p.st_C = in[4]; p.st_n = in[5]; p.st_m = in[6]; p.st_conv = in[7];
  p.ck = in[8]; p.cv = in[9]; p.st_S = in[10]; p.g_pre = in[11]; p.w_in = in[12]; p.b_i = in[13]; p.b_f = in[14]; p.w_conv = in[15];
  p.g_ml = in[16]; p.lb_logits = in[17]; p.g_hg = in[18]; p.w_br = in[19]; p.w_out = in[20]; p.g_post = in[21]; p.w_pg = in[22]; p.w_pp = in[23];
  p.out = (float*)d_out; p.ws = (char*)d_ws;
  if (WS_TOTAL > ws_size || (size_t)out_size < O_TOTAL) { fprintf(stderr, "workspace/out too small: need %zu have %zu\n", (size_t)WS_TOTAL, ws_size); return; }
  static int grid_blocks = 0;
  if (!grid_blocks) {
    int dev = 0, cus = 0, per_cu = 0;
    (void)hipGetDevice(&dev);
    (void)hipDeviceGetAttribute(&cus, hipDeviceAttributeMultiprocessorCount, dev);
#if FUSED
    (void)hipOccupancyMaxActiveBlocksPerMultiprocessor(&per_cu, mega, 256, 0);
#else
    per_cu = 2;
#endif
    if (per_cu > 2) per_cu = 2;
    if (per_cu < 1) per_cu = 1;
    grid_blocks = cus * per_cu;
  }
#if FUSED
  void* args[] = {&p};
  hipError_t e = hipLaunchCooperativeKernel((void*)mega, dim3(grid_blocks), dim3(256), args, 0, stream);
  if (e != hipSuccess) fprintf(stderr, "cooperative launch failed: %s (grid %d)\n", hipGetErrorString(e), grid_blocks);
#else
  launch_all<0>(p, grid_blocks, stream);
#endif
}
```

```cpp
#include <hip/hip_runtime.h>
#include <hip/hip_cooperative_groups.h>
#include <stdint.h>
#include <stdio.h>
#include <string.h>
namespace cg = cooperative_groups;

#ifndef FUSED
#define FUSED 1
#endif
#ifndef PHMASK
#define PHMASK 0x3ff
#endif

typedef unsigned short bf16_t;
typedef short bf16x8 __attribute__((ext_vector_type(8)));
typedef float f32x4 __attribute__((ext_vector_type(4)));
typedef unsigned u32x4 __attribute__((ext_vector_type(4)));
typedef unsigned u32x2 __attribute__((ext_vector_type(2)));

constexpr int NTOK = 16896, NPROMPT = 16384, NUNIT = 1056;
constexpr int NINSRC = 9736, NWT = 9728, NMAIN = 6656;
constexpr int SMEM_BYTES = 80896;
constexpr int NPHASE = 19;

constexpr size_t al256(size_t x) { return (x + 255) & ~(size_t)255; }
constexpr size_t WS_WT_IN = 0;
constexpr size_t WS_WT_BR = WS_WT_IN + al256((size_t)2 * NWT * 1024 * 2);
constexpr size_t WS_WT_OUT = WS_WT_BR + al256((size_t)2 * 3 * 1024 * 512 * 2);
constexpr size_t WS_WT_PG = WS_WT_OUT + al256((size_t)2 * 1048576 * 2);
constexpr size_t WS_WT_PP = WS_WT_PG + al256((size_t)2 * 1048576 * 2);
constexpr size_t WS_U = WS_WT_PP + al256((size_t)2 * 262144 * 2);
constexpr size_t WS_PR = WS_U + al256((size_t)NTOK * 1024 * 2);
constexpr size_t WS_QC = WS_PR + al256((size_t)13 * NTOK * 512 * 2);
constexpr size_t WS_KC = WS_QC + al256((size_t)NTOK * 512 * 2);
constexpr size_t WS_SM = WS_KC + al256((size_t)NTOK * 512 * 2);
constexpr size_t WS_SH = WS_SM + al256((size_t)NUNIT * 16384 * 2);
constexpr size_t WS_H = WS_SH + al256((size_t)NUNIT * 16384 * 2);
constexpr size_t WS_IG = WS_H + al256((size_t)3 * NTOK * 512 * 2);
constexpr size_t WS_LF = WS_IG + al256((size_t)NTOK * 16);
constexpr size_t WS_AC = WS_LF + al256((size_t)NTOK * 16);
constexpr size_t WS_BC = WS_AC + al256(NUNIT * 4);
constexpr size_t WS_MIN = WS_BC + al256(NUNIT * 4);
constexpr size_t WS_NLOC = WS_MIN + al256(NUNIT * 4);
constexpr size_t WS_HBC = WS_NLOC + al256((size_t)NUNIT * 512);
constexpr size_t WS_BAR = WS_HBC + al256((size_t)NUNIT * 512);
constexpr size_t WS_TOTAL = WS_BAR + 16384;
constexpr size_t WS_MERGED = WS_PR;
constexpr size_t WS_Y = WS_MERGED + (size_t)NTOK * 1024 * 2;
constexpr size_t WS_R = WS_Y + (size_t)NTOK * 1024 * 4;
constexpr size_t WS_RB = WS_R + (size_t)NTOK * 1024 * 4;
static_assert(WS_RB + (size_t)NTOK * 1024 * 2 <= WS_QC, "alias overflow");
constexpr size_t O_PC = 16777216 + 524288, O_PN = O_PC + 262144, O_PM = O_PN + 2048, O_PCONV = O_PM + 16, O_PK = O_PCONV + 12288, O_PV = O_PK + 16777216,
                 O_PS = O_PV + 16777216, O_SC = O_PS + 262144, O_SN = O_SC + 1048576, O_SM = O_SN + 8192, O_SCONV = O_SM + 64, O_SK = O_SCONV + 49152,
                 O_SV = O_SK + 524288, O_SS = O_SV + 524288, O_TOTAL = O_SS + 1048576;

struct Params {
  const float *x_p, *x_s, *p_p, *p_s, *st_C, *st_n, *st_m, *st_conv, *ck, *cv, *st_S;
  const float *g_pre, *w_in, *b_i, *b_f, *w_conv, *g_ml, *lb_logits, *g_hg, *w_br, *w_out, *g_post, *w_pg, *w_pp;
  float* out; char* ws;
#define WSP(name, T, off) __device__ __forceinline__ T* name() const { return (T*)(ws + (off)); }
#define OUTP(name, off) __device__ __forceinline__ float* name() const { return out + (off); }
  OUTP(o_y, 0) OUTP(o_pC, O_PC) OUTP(o_pn, O_PN) OUTP(o_pm, O_PM) OUTP(o_pconv, O_PCONV) OUTP(o_pk, O_PK) OUTP(o_pv, O_PV) OUTP(o_pS, O_PS)
  OUTP(o_sC, O_SC) OUTP(o_sn, O_SN) OUTP(o_sm, O_SM) OUTP(o_sconv, O_SCONV) OUTP(o_sk, O_SK) OUTP(o_sv, O_SV) OUTP(o_sS, O_SS)
  WSP(wt_in, bf16_t, WS_WT_IN) WSP(wt_br, bf16_t, WS_WT_BR) WSP(wt_out, bf16_t, WS_WT_OUT) WSP(wt_pg, bf16_t, WS_WT_PG) WSP(wt_pp, bf16_t, WS_WT_PP)
  WSP(U, bf16_t, WS_U) WSP(PR, bf16_t, WS_PR) WSP(QC, bf16_t, WS_QC) WSP(KC, bf16_t, WS_KC) WSP(SM, bf16_t, WS_SM) WSP(SH, bf16_t, WS_SH) WSP(H, bf16_t, WS_H)
  WSP(ig, float, WS_IG) WSP(lf, float, WS_LF) WSP(ac, float, WS_AC) WSP(Bc, float, WS_BC) WSP(min_, float, WS_MIN) WSP(nloc, float, WS_NLOC) WSP(hbc, float, WS_HBC)
  WSP(merged, bf16_t, WS_MERGED) WSP(y, float, WS_Y) WSP(r, float, WS_R) WSP(rb, bf16_t, WS_RB)
};

__device__ __forceinline__ int get_tid() { int t = threadIdx.x; asm volatile("" : "+v"(t)); return t; }
__device__ __forceinline__ bf16_t f2bf(float f) { unsigned u = __float_as_uint(f); u += 0x7fffu + ((u >> 16) & 1u); return (bf16_t)(u >> 16); }
__device__ __forceinline__ float bf2f(bf16_t h) { return __uint_as_float(((unsigned)h) << 16); }
__device__ __forceinline__ unsigned pack2(float a, float b) { return (unsigned)f2bf(a) | ((unsigned)f2bf(b) << 16); }
__device__ __forceinline__ float lo2f(unsigned v) { return __uint_as_float(v << 16); }
__device__ __forceinline__ float hi2f(unsigned v) { return __uint_as_float(v & 0xffff0000u); }
__device__ __forceinline__ float sigm(float x) { return 1.f / (1.f + __expf(-x)); }
__device__ __forceinline__ float silu(float x) { return x / (1.f + __expf(-x)); }
__device__ __forceinline__ float softplus(float x) { return fmaxf(x, 0.f) + __logf(1.f + __expf(-fabsf(x))); }
__device__ __forceinline__ float logsigm(float x) { return fminf(x, 0.f) - __logf(1.f + __expf(-fabsf(x))); }

template <int MT, int NT, int KS>
__device__ __forceinline__ void wmma(f32x4 (&acc)[MT][NT], const bf16_t* A, int lda, const bf16_t* B, int ldb, int fr, int fq) {
#pragma unroll
  for (int kk = 0; kk < KS; ++kk) {
    bf16x8 a[MT], b[NT];
#pragma unroll
    for (int mi = 0; mi < MT; ++mi) a[mi] = *(const bf16x8*)(A + (mi * 16 + fr) * lda + kk * 32 + fq * 8);
#pragma unroll
    for (int ni = 0; ni < NT; ++ni) b[ni] = *(const bf16x8*)(B + (ni * 16 + fr) * ldb + kk * 32 + fq * 8);
#pragma unroll
    for (int mi = 0; mi < MT; ++mi)
#pragma unroll
      for (int ni = 0; ni < NT; ++ni) acc[mi][ni] = __builtin_amdgcn_mfma_f32_16x16x32_bf16(a[mi], b[ni], acc[mi][ni], 0, 0, 0);
  }
}

__device__ __forceinline__ u32x4 ld8(const bf16_t* s) { return *(const u32x4*)s; }
__device__ __forceinline__ u32x4 ld8(const float* s) {
  float4 a = *(const float4*)s, b = *(const float4*)(s + 4);
  u32x4 r; r.x = pack2(a.x, a.y); r.y = pack2(a.z, a.w); r.z = pack2(b.x, b.y); r.w = pack2(b.z, b.w); return r;
}
template <typename T>
__device__ __forceinline__ void ld_tile(bf16_t* dst, const T* src, long ld, int tid) {
#pragma unroll
  for (int i = 0; i < 4; ++i) { int id = tid + 256 * i; int r = id >> 4, c = (id & 15) * 8; *(u32x4*)(dst + r * 136 + c) = ld8(src + (long)r * ld + c); }
}
template <typename T, int ROWS, int DLD>
__device__ __forceinline__ void ld_T(bf16_t* dst, const T* src, long ld, int tid) {
#pragma unroll 2
  for (int id = tid; id < ROWS * 16; id += 256) {
    int r = id % ROWS, c = (id / ROWS) * 8;
    u32x4 v = ld8(src + (long)r * ld + c);
    bf16_t* d = dst + c * DLD + r;
    d[0] = (bf16_t)(v.x & 0xffff); d[DLD] = (bf16_t)(v.x >> 16); d[2 * DLD] = (bf16_t)(v.y & 0xffff); d[3 * DLD] = (bf16_t)(v.y >> 16);
    d[4 * DLD] = (bf16_t)(v.z & 0xffff); d[5 * DLD] = (bf16_t)(v.z >> 16); d[6 * DLD] = (bf16_t)(v.w & 0xffff); d[7 * DLD] = (bf16_t)(v.w >> 16);
  }
}

#define PRG(g) (p.PR() + (size_t)(g) * NTOK * 512)

__device__ __forceinline__ const float* xrow(const Params& p, int l, int row) {
  if (l == 0) return row < NPROMPT ? p.x_p + (size_t)row * 1024 : p.x_s + (size_t)(row - NPROMPT) * 1024;
  return p.o_y() + (size_t)row * 1024;
}

__device__ void wconv_tile(const Params& p, int t, char* smem) {
  float* tile = (float*)smem;
  const int tid = get_tid();
  int l = t / 3392, r = t % 3392;
  const float* src; bf16_t* dst; int K, ldsrc, kt, nt, skip = 1 << 30;
  if (r < 2432) { src = p.w_in + (size_t)l * 1024 * NINSRC; dst = p.wt_in() + (size_t)l * NWT * 1024; K = 1024; ldsrc = NINSRC; kt = r % 16; nt = r / 16; skip = 2560; }
  else if (r < 2816) { r -= 2432; int b = r / 128; r %= 128; src = p.w_br + (size_t)(l * 3 + b) * 512 * 1024; dst = p.wt_br() + (size_t)(l * 3 + b) * 1024 * 512; K = 512; ldsrc = 1024; kt = r % 8; nt = r / 8; }
  else if (r < 3072) { r -= 2816; src = p.w_out + (size_t)l * 1048576; dst = p.wt_out() + (size_t)l * 1048576; K = 1024; ldsrc = 1024; kt = r % 16; nt = r / 16; }
  else if (r < 3328) { r -= 3072; src = p.w_pg + (size_t)l * 1048576; dst = p.wt_pg() + (size_t)l * 1048576; K = 1024; ldsrc = 1024; kt = r % 16; nt = r / 16; }
  else { r -= 3328; src = p.w_pp + (size_t)l * 262144; dst = p.wt_pp() + (size_t)l * 262144; K = 256; ldsrc = 1024; kt = r % 4; nt = r / 4; }
  const int n0 = nt * 64, k0 = kt * 64;
#pragma unroll
  for (int i = 0; i < 16; ++i) {
    int k = i * 4 + (tid >> 6), n = tid & 63; int ns = n0 + n; if (ns >= skip) ns += 8;
    tile[k * 65 + n] = src[(size_t)(k0 + k) * ldsrc + ns];
  }
  __syncthreads();
#pragma unroll
  for (int i = 0; i < 8; ++i) {
    int n = i * 8 + (tid >> 5), k = (tid & 31) * 2;
    *(unsigned*)(dst + (size_t)(n0 + n) * K + k0 + k) = pack2(tile[k * 65 + n], tile[(k + 1) * 65 + n]);
  }
  __syncthreads();
}

__device__ void norm_phase(const Params& p, int l) {
  const int lane = threadIdx.x & 63, wid = threadIdx.x >> 6;
  const float* gp = p.g_pre + l * 1024;
  const float* wg = p.w_in + (size_t)l * 1024 * NINSRC + 2560;
  for (int row = blockIdx.x * 4 + wid; row < NTOK; row += gridDim.x * 4) {
    const float* x = xrow(p, l, row);
    float4 v[4]; float ss = 0.f;
#pragma unroll
    for (int i = 0; i < 4; ++i) { v[i] = *(const float4*)(x + i * 256 + lane * 4); ss += v[i].x * v[i].x + v[i].y * v[i].y + v[i].z * v[i].z + v[i].w * v[i].w; }
#pragma unroll
    for (int o = 32; o > 0; o >>= 1) ss += __shfl_xor(ss, o);
    const float rstd = rsqrtf(ss * (1.f / 1024.f) + 1e-6f);
    float d0 = 0, d1 = 0, d2 = 0, d3 = 0, d4 = 0, d5 = 0, d6 = 0, d7 = 0;
#pragma unroll
    for (int i = 0; i < 4; ++i) {
      const int k = i * 256 + lane * 4;
      float4 g = *(const float4*)(gp + k);
      float u0 = v[i].x * rstd * g.x, u1 = v[i].y * rstd * g.y, u2 = v[i].z * rstd * g.z, u3 = v[i].w * rstd * g.w;
      u32x2 pk; pk.x = pack2(u0, u1); pk.y = pack2(u2, u3);
      *(u32x2*)(p.U() + (size_t)row * 1024 + k) = pk;
      float uu[4] = {u0, u1, u2, u3};
#pragma unroll
      for (int e = 0; e < 4; ++e) {
        const float* wp = wg + (size_t)(k + e) * NINSRC;
        float4 w0 = *(const float4*)wp, w1 = *(const float4*)(wp + 4);
        d0 += uu[e] * w0.x; d1 += uu[e] * w0.y; d2 += uu[e] * w0.z; d3 += uu[e] * w0.w;
        d4 += uu[e] * w1.x; d5 += uu[e] * w1.y; d6 += uu[e] * w1.z; d7 += uu[e] * w1.w;
      }
    }
#pragma unroll
    for (int o = 32; o > 0; o >>= 1) {
      d0 += __shfl_xor(d0, o); d1 += __shfl_xor(d1, o); d2 += __shfl_xor(d2, o); d3 += __shfl_xor(d3, o);
      d4 += __shfl_xor(d4, o); d5 += __shfl_xor(d5, o); d6 += __shfl_xor(d6, o); d7 += __shfl_xor(d7, o);
    }
    if (lane < 4) {
      float di = lane == 0 ? d0 : lane == 1 ? d1 : lane == 2 ? d2 : d3;
      float df = lane == 0 ? d4 : lane == 1 ? d5 : lane == 2 ? d6 : d7;
      p.ig()[row * 4 + lane] = di + p.b_i[l * 4 + lane];
      p.lf()[row * 4 + lane] = logsigm(df + p.b_f[l * 4 + lane]);
    }
  }
}

template <typename TA>
__device__ __forceinline__ void gemm_kloop(f32x4 (&acc)[4][4], const TA* Tp, long ldt, const bf16_t* Wp, long ldw, int K, char* smem) {
  bf16_t* sT = (bf16_t*)smem;
  bf16_t* sW = sT + 2 * 9216;
  const int tid = get_tid(), lane = tid & 63, wid = tid >> 6, wr = wid >> 1, wc = wid & 1, fr = lane & 15, fq = lane >> 4;
  u32x4 rt[4], rw[4];
  const int r0 = tid >> 3, c0 = (tid & 7) * 8;
#define GLOAD(k0) _Pragma("unroll") for (int i = 0; i < 4; ++i) { rt[i] = ld8(Tp + (long)(r0 + 32 * i) * ldt + (k0) + c0); rw[i] = ld8(Wp + (long)(r0 + 32 * i) * ldw + (k0) + c0); }
#define SSTORE(buf) _Pragma("unroll") for (int i = 0; i < 4; ++i) { *(u32x4*)(sT + (buf) * 9216 + (r0 + 32 * i) * 72 + c0) = rt[i]; *(u32x4*)(sW + (buf) * 9216 + (r0 + 32 * i) * 72 + c0) = rw[i]; }
  GLOAD(0); SSTORE(0);
  __syncthreads();
  const int nk = K >> 6;
#pragma unroll 1
  for (int kt = 0; kt < nk; ++kt) {
    const int buf = kt & 1;
    if (kt + 1 < nk) { GLOAD((kt + 1) * 64); }
    const bf16_t* aT = sT + buf * 9216 + (wr * 64) * 72;
    const bf16_t* aW = sW + buf * 9216 + (wc * 64) * 72;
    wmma<4, 4, 2>(acc, aW, 72, aT, 72, fr, fq);
    if (kt + 1 < nk) { SSTORE(buf ^ 1); }
    __syncthreads();
  }
#undef GLOAD
#undef SSTORE
}
__device__ __forceinline__ void zero_acc(f32x4 (&acc)[4][4]) {
#pragma unroll
  for (int a = 0; a < 4; ++a)
#pragma unroll
    for (int b = 0; b < 4; ++b) acc[a][b] = (f32x4){0.f, 0.f, 0.f, 0.f};
}

__device__ void inproj_tile(const Params& p, int l, int t, char* smem) {
  const int tm = t / 52, tn = t % 52;
  const int tid = get_tid(), lane = tid & 63, wid = tid >> 6, wr = wid >> 1, wc = wid & 1, fr = lane & 15, fq = lane >> 4;
  f32x4 acc[4][4]; zero_acc(acc);
  gemm_kloop<bf16_t>(acc, p.U() + (size_t)tm * 128 * 1024, 1024, p.wt_in() + (size_t)l * NWT * 1024 + (size_t)tn * 128 * 1024, 1024, 1024, smem);
  const int g = tn >> 2;
  bf16_t* dst = PRG(g);
#pragma unroll
  for (int ni = 0; ni < 4; ++ni) {
    const int row = tm * 128 + wr * 64 + ni * 16 + fr;
    const bool samp = row >= NPROMPT;
    const int rr = samp ? row - NPROMPT : row;
    const int b = samp ? (rr >> 6) : (rr >> 13), tt = samp ? (rr & 63) : (rr & 8191), T = samp ? 64 : 8192, NB = samp ? 8 : 2;
#pragma unroll
    for (int mi = 0; mi < 4; ++mi) {
      const int cg_ = (tn & 3) * 128 + wc * 64 + mi * 16 + fq * 4;
      f32x4 v = acc[mi][ni];
      u32x2 pk; pk.x = pack2(v[0], v[1]); pk.y = pack2(v[2], v[3]);
      *(u32x2*)(dst + (size_t)row * 512 + cg_) = pk;
      if (g == 6 || g == 7) {
        float* o = (g == 6) ? (samp ? p.o_sk() : p.o_pk()) : (samp ? p.o_sv() : p.o_pv());
        const int hh = cg_ >> 7, d = cg_ & 127;
        *(f32x4*)(o + ((size_t)((l * NB + b) * 4 + hh) * T + tt) * 128 + d) = v;
      } else if (g < 2) {
        if (tt >= T - 3) {
          float* o = samp ? p.o_sconv() : p.o_pconv();
          *(f32x4*)(o + ((size_t)(l * NB + b) * 3 + (tt - (T - 3))) * 1024 + g * 512 + cg_) = v;
        }
      }
    }
  }
}

struct UnitInfo { int samp, b, h, c, rowbase, seq; };
__device__ __forceinline__ UnitInfo unit_info(int u) {
  UnitInfo i;
  if (u < 1024) { i.samp = 0; i.seq = u >> 7; i.b = i.seq >> 2; i.h = i.seq & 3; i.c = u & 127; i.rowbase = i.b * 8192 + i.c * 64; }
  else { int sq = u - 1024; i.samp = 1; i.seq = sq; i.b = sq >> 2; i.h = sq & 3; i.c = 0; i.rowbase = NPROMPT + i.b * 64; }
  return i;
}

__device__ void sb_unit(const Params& p, int l, int u, char* smem) {
  bf16_t* Qs = (bf16_t*)smem;
  bf16_t* Ks = Qs + 64 * 136;
  bf16_t* Vt = Ks + 64 * 136;
  bf16_t* Ps = Vt + 128 * 72;
  const int tid = get_tid(), lane = tid & 63, w = tid >> 6, fr = lane & 15, fq = lane >> 4;
  const UnitInfo ui = unit_info(u);
  const int nblk = ui.samp ? 65 : ui.c + 1;
  const int hc = ui.h * 128;
  __syncthreads();
  ld_tile<bf16_t>(Qs, PRG(5) + (size_t)ui.rowbase * 512 + hc, 512, tid);
  f32x4 o[8][1];
#pragma unroll
  for (int mi = 0; mi < 8; ++mi) o[mi][0] = (f32x4){0.f, 0.f, 0.f, 0.f};
  float R = 0.f;
  const int tq = 16 * w + fr;
  for (int i = nblk - 1; i >= 0; --i) {
    if (!ui.samp || i == 64) {
      const size_t krow = ui.samp ? (size_t)ui.rowbase : (size_t)ui.b * 8192 + (size_t)i * 64;
      ld_tile<bf16_t>(Ks, PRG(6) + krow * 512 + hc, 512, tid);
      ld_T<bf16_t, 64, 72>(Vt, PRG(7) + krow * 512 + hc, 512, tid);
    } else {
      const size_t off = ((size_t)((l * 8 + ui.b) * 4 + ui.h) * 4096 + (size_t)i * 64) * 128;
      ld_tile<float>(Ks, p.ck + off, 128, tid);
      ld_T<float, 64, 72>(Vt, p.cv + off, 128, tid);
    }
    __syncthreads();
    f32x4 z[4][1];
#pragma unroll
    for (int mi = 0; mi < 4; ++mi) z[mi][0] = (f32x4){0.f, 0.f, 0.f, 0.f};
    wmma<4, 1, 4>(z, Ks, 136, Qs + 16 * w * 136, 136, fr, fq);
    const bool diag = (i == nblk - 1);
    float L[4][4], lsg[4][4], G[4];
#pragma unroll
    for (int mi = 0; mi < 4; ++mi) {
      G[mi] = 0.f;
#pragma unroll
      for (int j = 0; j < 4; ++j) {
        const int kk = mi * 16 + fq * 4 + j;
        const float zz = z[mi][0][j] * 0.08838834764831845f;
        const float sp = softplus(zz);
        const bool valid = !diag || kk < tq;
        L[mi][j] = valid ? -sp : 0.f;
        lsg[mi][j] = valid ? zz - sp : -1e30f;
        G[mi] += L[mi][j];
      }
    }
    float sufm = 0.f;
#pragma unroll
    for (int mi = 3; mi >= 0; --mi) {
      const float g0 = __shfl(G[mi], fr), g1 = __shfl(G[mi], fr + 16), g2 = __shfl(G[mi], fr + 32), g3 = __shfl(G[mi], fr + 48);
      const float later = (fq < 1 ? g1 : 0.f) + (fq < 2 ? g2 : 0.f) + (fq < 3 ? g3 : 0.f);
      const float s3 = R + sufm + later, s2 = s3 + L[mi][3], s1 = s2 + L[mi][2], s0 = s1 + L[mi][1];
      const float a0 = __expf(lsg[mi][0] + s0), a1 = __expf(lsg[mi][1] + s1), a2 = __expf(lsg[mi][2] + s2), a3 = __expf(lsg[mi][3] + s3);
      u32x2 pk; pk.x = pack2(a0, a1); pk.y = pack2(a2, a3);
      *(u32x2*)(Ps + tq * 72 + mi * 16 + fq * 4) = pk;
      sufm += (g0 + g1) + (g2 + g3);
    }
    R += sufm;
    __syncthreads();
    wmma<8, 1, 2>(o, Vt, 72, Ps + 16 * w * 72, 72, fr, fq);
    if (__syncthreads_and(R < -110.f)) break;
  }
  const size_t row = (size_t)ui.rowbase + tq;
#pragma unroll
  for (int mi = 0; mi < 8; ++mi) {
    const int col = hc + mi * 16 + fq * 4;
    u32x2 zz = *(const u32x2*)(PRG(8) + row * 512 + col);
    f32x4 v = o[mi][0];
    u32x2 pk;
    pk.x = pack2(v[0] * silu(lo2f(zz.x)), v[1] * silu(hi2f(zz.x)));
    pk.y = pack2(v[2] * silu(lo2f(zz.y)), v[3] * silu(hi2f(zz.y)));
    *(u32x2*)(p.H() + (size_t)1 * NTOK * 512 + row * 512 + col) = pk;
  }
}

__device__ void mlstm_local(const Params& p, int l, int u, char* smem) {
  bf16_t* kdT = (bf16_t*)smem;
  bf16_t* vT = kdT + 128 * 72;
  float* dec = (float*)(vT + 128 * 72);
  const int tid = get_tid(), lane = tid & 63, w = tid >> 6, fr = lane & 15, fq = lane >> 4;
  const UnitInfo ui = unit_info(u);
  const int hc = ui.h * 128;
  __syncthreads();
  if (w == 0) {
    const float lfv = p.lf()[(ui.rowbase + lane) * 4 + ui.h], igv = p.ig()[(ui.rowbase + lane) * 4 + ui.h];
    float bs = lfv;
#pragma unroll
    for (int o = 1; o < 64; o <<= 1) { float t = __shfl_up(bs, o); if (lane >= o) bs += t; }
    const float g = igv - bs;
    float gm = g;
#pragma unroll
    for (int o = 32; o > 0; o >>= 1) gm = fmaxf(gm, __shfl_xor(gm, o));
    const float bL = __shfl(bs, 63);
    dec[lane] = __expf(g - gm);
    if (lane == 0) { p.ac()[u] = bL + gm; p.Bc()[u] = bL; }
  }
  ld_T<bf16_t, 64, 72>(vT, PRG(2) + (size_t)ui.rowbase * 512 + hc, 512, tid);
  __syncthreads();
  {
    const int isk = tid >> 7, ch = tid & 127, col = hc + ch;
    const bf16_t* src = PRG(isk) + (size_t)ui.rowbase * 512 + col;
    const float* wc_ = p.w_conv + (size_t)l * 4096 + isk * 512 + col;
    const float w0 = wc_[0], w1 = wc_[1024], w2 = wc_[2048], w3 = wc_[3072];
    float x0 = 0.f, x1 = 0.f, x2 = 0.f;
    if (ui.samp) {
      const float* cs = p.st_conv + (size_t)(l * 8 + ui.b) * 3072 + isk * 512 + col;
      x0 = cs[0]; x1 = cs[1024]; x2 = cs[2048];
    } else if (ui.c > 0) {
      x0 = bf2f(src[-3 * 512]); x1 = bf2f(src[-2 * 512]); x2 = bf2f(src[-1 * 512]);
    }
    bf16_t* dg = (isk ? p.KC() : p.QC()) + (size_t)ui.rowbase * 512 + col;
#pragma unroll 4
    for (int t = 0; t < 64; ++t) {
      const float x3 = bf2f(src[t * 512]);
      float y = silu(w0 * x0 + w1 * x1 + w2 * x2 + w3 * x3);
      if (isk) y *= 0.08838834764831845f;
      const bf16_t yb = f2bf(y);
      dg[t * 512] = yb;
      if (isk) kdT[ch * 72 + t] = f2bf(bf2f(yb) * dec[t]);
      x0 = x1; x1 = x2; x2 = x3;
    }
  }
  __syncthreads();
  if (tid < 128) { float s = 0.f;
#pragma unroll 8
    for (int t = 0; t < 64; ++t) s += bf2f(kdT[tid * 72 + t]); p.nloc()[u * 128 + tid] = s; }
  f32x4 acc[8][2];
#pragma unroll
  for (int a = 0; a < 8; ++a) { acc[a][0] = (f32x4){0.f, 0.f, 0.f, 0.f}; acc[a][1] = (f32x4){0.f, 0.f, 0.f, 0.f}; }
  wmma<8, 2, 2>(acc, vT, 72, kdT + 32 * w * 72, 72, fr, fq);
  bf16_t* sm = p.SM() + (size_t)u * 16384;
#pragma unroll
  for (int mi = 0; mi < 8; ++mi)
#pragma unroll
    for (int ni = 0; ni < 2; ++ni) {
      u32x2 pk; pk.x = pack2(acc[mi][ni][0], acc[mi][ni][1]); pk.y = pack2(acc[mi][ni][2], acc[mi][ni][3]);
      *(u32x2*)(sm + (32 * w + ni * 16 + fr) * 128 + mi * 16 + fq * 4) = pk;
    }
}

__device__ __forceinline__ float hgrn_lb(const Params& p, int l, int ch512) {
  if (l == 0) return 0.f;
  return sigm(p.lb_logits[512 + ch512] - p.lb_logits[ch512]);
}
__device__ __forceinline__ void hgrn_gate(float f, float lb, float& lg, float& kh) {
  const float e = __expf(-fabsf(f));
  const float sp = f >= 0.f ? 1.f / (1.f + e) : e / (1.f + e);
  const float sn = f >= 0.f ? e / (1.f + e) : 1.f / (1.f + e);
  lg = (lb == 0.f) ? (fminf(f, 0.f) - __logf(1.f + e)) : __logf(lb + (1.f - lb) * sp);
  kh = (1.f - lb) * sn;
}

__device__ void hgrn_local(const Params& p, int l, int u, char* smem) {
  bf16_t* kdT = (bf16_t*)smem;
  bf16_t* iT = kdT + 128 * 72;
  float* tot = (float*)(iT + 128 * 72);
  const int tid = get_tid(), lane = tid & 63, w = tid >> 6, fr = lane & 15, fq = lane >> 4;
  const UnitInfo ui = unit_info(u);
  const int hc = ui.h * 128;
  __syncthreads();
  ld_T<bf16_t, 64, 72>(iT, PRG(11) + (size_t)ui.rowbase * 512 + hc, 512, tid);
  const int half = tid >> 7, ch = tid & 127;
  const float lb = hgrn_lb(p, l, hc + ch);
  const bf16_t* src = PRG(10) + (size_t)(ui.rowbase + half * 32) * 512 + hc + ch;
  {
    float run = 0.f;
#pragma unroll 4
    for (int t = 0; t < 32; ++t) { float lg, kh; hgrn_gate(bf2f(src[t * 512]), lb, lg, kh); run += lg; }
    tot[half * 128 + ch] = run;
  }
  __syncthreads();
  {
    const float t0 = tot[ch], t1 = tot[128 + ch];
    const float bcL = t0 + t1;
    float run = half ? t0 : 0.f;
#pragma unroll 4
    for (int t = 0; t < 32; ++t) {
      float lg, kh; hgrn_gate(bf2f(src[t * 512]), lb, lg, kh); run += lg;
      kdT[ch * 72 + half * 32 + t] = f2bf(kh * __expf(bcL - run));
    }
    if (half == 0) p.hbc()[u * 128 + ch] = bcL;
  }
  __syncthreads();
  f32x4 acc[8][2];
#pragma unroll
  for (int a = 0; a < 8; ++a) { acc[a][0] = (f32x4){0.f, 0.f, 0.f, 0.f}; acc[a][1] = (f32x4){0.f, 0.f, 0.f, 0.f}; }
  wmma<8, 2, 2>(acc, iT, 72, kdT + 32 * w * 72, 72, fr, fq);
  bf16_t* sh = p.SH() + (size_t)u * 16384;
#pragma unroll
  for (int mi = 0; mi < 8; ++mi)
#pragma unroll
    for (int ni = 0; ni < 2; ++ni) {
      u32x2 pk; pk.x = pack2(acc[mi][ni][0], acc[mi][ni][1]); pk.y = pack2(acc[mi][ni][2], acc[mi][ni][3]);
      *(u32x2*)(sh + (32 * w + ni * 16 + fr) * 128 + mi * 16 + fq * 4) = pk;
    }
}

__device__ void scan_phase(const Params& p, int l) {
  const int gt = blockIdx.x * 256 + threadIdx.x, nth = gridDim.x * 256;
  for (int it = gt; it < 131072; it += nth) {
    const int kind = it >> 16, seq = (it >> 13) & 7, pr = it & 8191, e = pr * 2;
    if (kind == 0) {
      float m = 0.f, c0 = 0.f, c1 = 0.f;
      for (int c = 0; c < 128; ++c) {
        const int u = seq * 128 + c;
        unsigned* slot = (unsigned*)(p.SM() + (size_t)u * 16384) + pr;
        const unsigned lv = *slot;
        const float a = p.ac()[u], B = p.Bc()[u];
        const float mo = fmaxf(a, B + m), dc = __expf(B + m - mo), wl = __expf(a - mo);
        *slot = pack2(c0, c1);
        if (pr == 0) p.min_()[u] = m;
        c0 = dc * c0 + wl * lo2f(lv); c1 = dc * c1 + wl * hi2f(lv); m = mo;
      }
      float* o = p.o_pC() + (size_t)(l * 8 + seq) * 16384 + e; o[0] = c0; o[1] = c1;
      if (pr == 0) p.o_pm()[l * 8 + seq] = m;
    } else {
      const int row = e >> 7;
      float s0 = 0.f, s1 = 0.f;
      for (int c = 0; c < 128; ++c) {
        const int u = seq * 128 + c;
        unsigned* slot = (unsigned*)(p.SH() + (size_t)u * 16384) + pr;
        const unsigned lv = *slot;
        const float d = __expf(p.hbc()[u * 128 + row]);
        *slot = pack2(s0, s1);
        s0 = d * s0 + lo2f(lv); s1 = d * s1 + hi2f(lv);
      }
      float* o = p.o_pS() + (size_t)(l * 8 + seq) * 16384 + e; o[0] = s0; o[1] = s1;
    }
  }
  for (int it = gt; it < 524288; it += nth) {
    const int kind = it >> 18, sq = (it >> 13) & 31, pr = it & 8191, e = pr * 2, u = 1024 + sq;
    if (kind == 0) {
      const float* c0p = p.st_C + (size_t)(l * 32 + sq) * 16384 + e;
      const float C0 = c0p[0], C1 = c0p[1], m = p.st_m[l * 32 + sq];
      unsigned* slot = (unsigned*)(p.SM() + (size_t)u * 16384) + pr;
      const unsigned lv = *slot;
      const float a = p.ac()[u], B = p.Bc()[u];
      const float mo = fmaxf(a, B + m), dc = __expf(B + m - mo), wl = __expf(a - mo);
      *slot = pack2(C0, C1);
      float* o = p.o_sC() + (size_t)(l * 32 + sq) * 16384 + e; o[0] = dc * C0 + wl * lo2f(lv); o[1] = dc * C1 + wl * hi2f(lv);
      if (pr == 0) { p.min_()[u] = m; p.o_sm()[l * 32 + sq] = mo; }
    } else {
      const int row = e >> 7;
      const float* s0p = p.st_S + (size_t)(l * 32 + sq) * 16384 + e;
      const float S0 = s0p[0], S1 = s0p[1];
      unsigned* slot = (unsigned*)(p.SH() + (size_t)u * 16384) + pr;
      const unsigned lv = *slot;
      const float d = __expf(p.hbc()[u * 128 + row]);
      *slot = pack2(S0, S1);
      float* o = p.o_sS() + (size_t)(l * 32 + sq) * 16384 + e; o[0] = d * S0 + lo2f(lv); o[1] = d * S1 + hi2f(lv);
    }
  }
  for (int it = gt; it < 1024; it += nth) {
    const int seq = it >> 7, d = it & 127;
    float m = 0.f, n = 0.f;
    for (int c = 0; c < 128; ++c) {
      const int u = seq * 128 + c;
      const float a = p.ac()[u], B = p.Bc()[u];
      const float mo = fmaxf(a, B + m), dc = __expf(B + m - mo), wl = __expf(a - mo);
      const float nl = p.nloc()[u * 128 + d];
      p.nloc()[u * 128 + d] = n;
      n = dc * n + wl * nl; m = mo;
    }
    p.o_pn()[(l * 8 + seq) * 128 + d] = n;
  }
  for (int it = gt; it < 4096; it += nth) {
    const int sq = it >> 7, d = it & 127, u = 1024 + sq;
    const float n0 = p.st_n[(l * 32 + sq) * 128 + d], m = p.st_m[l * 32 + sq];
    const float a = p.ac()[u], B = p.Bc()[u];
    const float mo = fmaxf(a, B + m), dc = __expf(B + m - mo), wl = __expf(a - mo);
    const float nl = p.nloc()[u * 128 + d];
    p.nloc()[u * 128 + d] = n0;
    p.o_sn()[(l * 32 + sq) * 128 + d] = dc * n0 + wl * nl;
  }
}

__device__ void mlstm_out(const Params& p, int l, int u, char* smem) {
  bf16_t* Qs = (bf16_t*)smem;
  bf16_t* CT = Qs + 64 * 136;
  bf16_t* Ks = CT;
  bf16_t* Vt = Ks + 64 * 136;
  bf16_t* Ps = Vt + 144 * 72;
  float* misc = (float*)(smem + 17408 + 47360);
  float *bsum = misc, *gs = misc + 64, *mt = misc + 128, *wint = misc + 192;
  const int tid = get_tid(), lane = tid & 63, w = tid >> 6, fr = lane & 15, fq = lane >> 4;
  const UnitInfo ui = unit_info(u);
  const int hc = ui.h * 128;
  __syncthreads();
  if (w == 0) {
    const float lfv = p.lf()[(ui.rowbase + lane) * 4 + ui.h], igv = p.ig()[(ui.rowbase + lane) * 4 + ui.h];
    float bs = lfv;
#pragma unroll
    for (int o = 1; o < 64; o <<= 1) { float t = __shfl_up(bs, o); if (lane >= o) bs += t; }
    const float g = igv - bs;
    float cm = g;
#pragma unroll
    for (int o = 1; o < 64; o <<= 1) { float t = __shfl_up(cm, o); if (lane >= o) cm = fmaxf(cm, t); }
    const float m_in = p.min_()[u];
    const float mtt = bs + fmaxf(cm, m_in);
    bsum[lane] = bs; gs[lane] = g; mt[lane] = mtt; wint[lane] = __expf(bs + m_in - mtt);
  }
  ld_tile<bf16_t>(Qs, p.QC() + (size_t)ui.rowbase * 512 + hc, 512, tid);
  ld_T<bf16_t, 128, 136>(CT, p.SM() + (size_t)u * 16384, 128, tid);
  if (tid < 128) CT[128 * 136 + tid] = f2bf(p.nloc()[u * 128 + tid]);
  for (int i = tid; i < 15 * 128; i += 256) CT[(129 + (i >> 7)) * 136 + (i & 127)] = 0;
  __syncthreads();
  f32x4 acc[9][1];
#pragma unroll
  for (int mi = 0; mi < 9; ++mi) acc[mi][0] = (f32x4){0.f, 0.f, 0.f, 0.f};
  wmma<9, 1, 4>(acc, CT, 136, Qs + 16 * w * 136, 136, fr, fq);
  const int t = 16 * w + fr;
  const float wi = wint[t];
#pragma unroll
  for (int mi = 0; mi < 9; ++mi) acc[mi][0] *= wi;
  __syncthreads();
  ld_tile<bf16_t>(Ks, p.KC() + (size_t)ui.rowbase * 512 + hc, 512, tid);
  ld_T<bf16_t, 64, 72>(Vt, PRG(2) + (size_t)ui.rowbase * 512 + hc, 512, tid);
  if (tid < 64) Vt[128 * 72 + tid] = 0x3F80;
  for (int i = tid; i < 15 * 64; i += 256) Vt[(129 + (i >> 6)) * 72 + (i & 63)] = 0;
  __syncthreads();
  f32x4 st[4][1];
#pragma unroll
  for (int mi = 0; mi < 4; ++mi) st[mi][0] = (f32x4){0.f, 0.f, 0.f, 0.f};
  wmma<4, 1, 4>(st, Ks, 136, Qs + 16 * w * 136, 136, fr, fq);
  const float bt = bsum[t], mtt = mt[t];
#pragma unroll
  for (int mi = 0; mi < 4; ++mi) {
    float a[4];
#pragma unroll
    for (int j = 0; j < 4; ++j) {
      const int s = mi * 16 + fq * 4 + j;
      a[j] = (s <= t) ? st[mi][0][j] * __expf(bt + gs[s] - mtt) : 0.f;
    }
    u32x2 pk; pk.x = pack2(a[0], a[1]); pk.y = pack2(a[2], a[3]);
    *(u32x2*)(Ps + t * 72 + mi * 16 + fq * 4) = pk;
  }
  __syncthreads();
  wmma<9, 1, 2>(acc, Vt, 72, Ps + 16 * w * 72, 72, fr, fq);
  const float den = __shfl(acc[8][0][0], fr);
  const float inv = 1.f / fmaxf(fabsf(den), __expf(-mtt));
  float ss = 0.f;
#pragma unroll
  for (int mi = 0; mi < 8; ++mi) { acc[mi][0] *= inv; ss += acc[mi][0][0] * acc[mi][0][0] + acc[mi][0][1] * acc[mi][0][1] + acc[mi][0][2] * acc[mi][0][2] + acc[mi][0][3] * acc[mi][0][3]; }
  ss += __shfl_xor(ss, 16); ss += __shfl_xor(ss, 32);
  const float rs = rsqrtf(ss * (1.f / 128.f) + 1e-6f);
  const size_t row = (size_t)ui.rowbase + t;
#pragma unroll
  for (int mi = 0; mi < 8; ++mi) {
    const int col = hc + mi * 16 + fq * 4;
    const u32x2 ov = *(const u32x2*)(PRG(3) + row * 512 + col);
    const u32x2 zv = *(const u32x2*)(PRG(4) + row * 512 + col);
    const float4 g = *(const float4*)(p.g_ml + l * 512 + col);
    const f32x4 v = acc[mi][0];
    u32x2 pk;
    pk.x = pack2(v[0] * rs * g.x * sigm(lo2f(ov.x)) * silu(lo2f(zv.x)), v[1] * rs * g.y * sigm(hi2f(ov.x)) * silu(hi2f(zv.x)));
    pk.y = pack2(v[2] * rs * g.z * sigm(lo2f(ov.y)) * silu(lo2f(zv.y)), v[3] * rs * g.w * sigm(hi2f(ov.y)) * silu(hi2f(zv.y)));
    *(u32x2*)(p.H() + row * 512 + col) = pk;
  }
}

__device__ __forceinline__ bf16x8 scale_frag(const bf16_t* src, const float* ea, const float* eb, float sgn, bool clampit) {
  u32x4 raw = *(const u32x4*)src;
  float4 a0 = *(const float4*)ea, a1 = *(const float4*)(ea + 4);
  float4 b0 = {0.f, 0.f, 0.f, 0.f}, b1 = {0.f, 0.f, 0.f, 0.f};
  if (eb) { b0 = *(const float4*)eb; b1 = *(const float4*)(eb + 4); }
  float e[8] = {a0.x - b0.x, a0.y - b0.y, a0.z - b0.z, a0.w - b0.w, a1.x - b1.x, a1.y - b1.y, a1.z - b1.z, a1.w - b1.w};
  float v[8] = {lo2f(raw.x), hi2f(raw.x), lo2f(raw.y), hi2f(raw.y), lo2f(raw.z), hi2f(raw.z), lo2f(raw.w), hi2f(raw.w)};
  unsigned o[4];
#pragma unroll
  for (int i = 0; i < 4; ++i) {
    float x0 = sgn * e[2 * i], x1 = sgn * e[2 * i + 1];
    if (clampit) { x0 = fminf(x0, 80.f); x1 = fminf(x1, 80.f); }
    o[i] = pack2(v[2 * i] * __expf(x0), v[2 * i + 1] * __expf(x1));
  }
  u32x4 r = {o[0], o[1], o[2], o[3]};
  return __builtin_bit_cast(bf16x8, r);
}

__device__ void hgrn_out(const Params& p, int l, int u, char* smem) {
  float* bc = (float*)smem;
  bf16_t* ST = (bf16_t*)smem;
  bf16_t* qs = (bf16_t*)(smem + 34816);
  bf16_t* kh = (bf16_t*)(smem + 34816 + 17408);
  bf16_t* iT = kh;
  bf16_t* Ps = (bf16_t*)(smem + 34816 + 17408 + 18432);
  float* tot = (float*)(smem + 79872);
  const int tid = get_tid(), lane = tid & 63, w = tid >> 6, fr = lane & 15, fq = lane >> 4;
  const UnitInfo ui = unit_info(u);
  const int hc = ui.h * 128;
  __syncthreads();
  ld_tile<bf16_t>(qs, PRG(9) + (size_t)ui.rowbase * 512 + hc, 512, tid);
  {
    const int half = tid >> 7, ch = tid & 127;
    const float lb = hgrn_lb(p, l, hc + ch);
    const bf16_t* src = PRG(10) + (size_t)(ui.rowbase + half * 32) * 512 + hc + ch;
    float run = 0.f;
#pragma unroll 4
    for (int t = 0; t < 32; ++t) { float lg, k; hgrn_gate(bf2f(src[t * 512]), lb, lg, k); run += lg; }
    tot[half * 128 + ch] = run;
    __syncthreads();
    run = half ? tot[ch] : 0.f;
#pragma unroll 4
    for (int t = 0; t < 32; ++t) {
      float lg, k; hgrn_gate(bf2f(src[t * 512]), lb, lg, k); run += lg;
      bc[(half * 32 + t) * 132 + ch] = run;
      kh[(half * 32 + t) * 136 + ch] = f2bf(k);
    }
  }
  __syncthreads();
  {
    const int I = w, t = 16 * I + fr;
    f32x4 a[4];
#pragma unroll
    for (int J = 0; J < 4; ++J) a[J] = (f32x4){0.f, 0.f, 0.f, 0.f};
#pragma unroll
    for (int kk = 0; kk < 4; ++kk) {
      const int c0 = kk * 32 + fq * 8;
      const float* rI = (I > 0) ? bc + (16 * I - 1) * 132 + c0 : nullptr;
      const bf16x8 bq = scale_frag(qs + t * 136 + c0, bc + t * 132 + c0, rI, 1.f, false);
#pragma unroll
      for (int J = 0; J < 4; ++J) {
        if (J <= I) {
          const int s = 16 * J + fr;
          const bf16x8 ak = scale_frag(kh + s * 136 + c0, bc + s * 132 + c0, rI, -1.f, true);
          a[J] = __builtin_amdgcn_mfma_f32_16x16x32_bf16(ak, bq, a[J], 0, 0, 0);
        }
      }
    }
#pragma unroll
    for (int J = 0; J < 4; ++J) {
      float v[4];
#pragma unroll
      for (int j = 0; j < 4; ++j) { const int s = 16 * J + fq * 4 + j; v[j] = (s <= t) ? a[J][j] : 0.f; }
      u32x2 pk; pk.x = pack2(v[0], v[1]); pk.y = pack2(v[2], v[3]);
      *(u32x2*)(Ps + t * 72 + J * 16 + fq * 4) = pk;
    }
  }
  __syncthreads();
#pragma unroll 4
  for (int i = tid; i < 64 * 128; i += 256) { const int t = i >> 7, c = i & 127; qs[t * 136 + c] = f2bf(bf2f(qs[t * 136 + c]) * __expf(bc[t * 132 + c])); }
  __syncthreads();
  ld_T<bf16_t, 64, 72>(iT, PRG(11) + (size_t)ui.rowbase * 512 + hc, 512, tid);
  ld_T<bf16_t, 128, 136>(ST, p.SH() + (size_t)u * 16384, 128, tid);
  __syncthreads();
  f32x4 acc[8][1];
#pragma unroll
  for (int mi = 0; mi < 8; ++mi) acc[mi][0] = (f32x4){0.f, 0.f, 0.f, 0.f};
  wmma<8, 1, 2>(acc, iT, 72, Ps + 16 * w * 72, 72, fr, fq);
  wmma<8, 1, 4>(acc, ST, 136, qs + 16 * w * 136, 136, fr, fq);
  float ss = 0.f;
#pragma unroll
  for (int mi = 0; mi < 8; ++mi) ss += acc[mi][0][0] * acc[mi][0][0] + acc[mi][0][1] * acc[mi][0][1] + acc[mi][0][2] * acc[mi][0][2] + acc[mi][0][3] * acc[mi][0][3];
  ss += __shfl_xor(ss, 16); ss += __shfl_xor(ss, 32);
  const float rs = rsqrtf(ss * (1.f / 128.f) + 1e-6f);
  const size_t row = (size_t)ui.rowbase + 16 * w + fr;
#pragma unroll
  for (int mi = 0; mi < 8; ++mi) {
    const int col = hc + mi * 16 + fq * 4;
    const u32x2 zv = *(const u32x2*)(PRG(12) + row * 512 + col);
    const float4 g = *(const float4*)(p.g_hg + l * 512 + col);
    const f32x4 v = acc[mi][0];
    u32x2 pk;
    pk.x = pack2(v[0] * rs * g.x * silu(lo2f(zv.x)), v[1] * rs * g.y * silu(hi2f(zv.x)));
    pk.y = pack2(v[2] * rs * g.z * silu(lo2f(zv.y)), v[3] * rs * g.w * silu(hi2f(zv.y)));
    *(u32x2*)(p.H() + (size_t)2 * NTOK * 512 + row * 512 + col) = pk;
  }
}

__device__ void merge_tile(const Params& p, int l, int t, char* smem) {
  const int tm = t >> 3, tn = t & 7;
  const int tid = get_tid(), lane = tid & 63, wid = tid >> 6, wr = wid >> 1, wc = wid & 1, fr = lane & 15, fq = lane >> 4;
#pragma unroll 1
  for (int b = 0; b < 3; ++b) {
    f32x4 acc[4][4]; zero_acc(acc);
    gemm_kloop<bf16_t>(acc, p.U() + (size_t)tm * 128 * 1024, 1024, p.wt_in() + (size_t)l * NWT * 1024 + (size_t)(NMAIN + b * 1024 + tn * 128) * 1024, 1024, 1024, smem);
#pragma unroll
    for (int ni = 0; ni < 4; ++ni)
#pragma unroll
      for (int mi = 0; mi < 4; ++mi) {
        f32x4 v; v[0] = sigm(acc[mi][ni][0]); v[1] = sigm(acc[mi][ni][1]); v[2] = sigm(acc[mi][ni][2]); v[3] = sigm(acc[mi][ni][3]);
        *(f32x4*)(p.r() + ((size_t)tm * 128 + wr * 64 + ni * 16 + fr) * 1024 + tn * 128 + wc * 64 + mi * 16 + fq * 4) = v;
      }
    zero_acc(acc);
    gemm_kloop<bf16_t>(acc, p.H() + (size_t)b * NTOK * 512 + (size_t)tm * 128 * 512, 512, p.wt_br() + (size_t)(l * 3 + b) * 1024 * 512 + (size_t)tn * 128 * 512, 512, 512, smem);
#pragma unroll
    for (int ni = 0; ni < 4; ++ni) {
      const size_t row = (size_t)tm * 128 + wr * 64 + ni * 16 + fr;
#pragma unroll
      for (int mi = 0; mi < 4; ++mi) {
        const int col = tn * 128 + wc * 64 + mi * 16 + fq * 4;
        f32x4 v = *(const f32x4*)(p.r() + row * 1024 + col) * acc[mi][ni];
        float* part = p.y() + row * 1024 + col;
        if (b > 0) v += *(const f32x4*)part;
        if (b < 2) *(f32x4*)part = v;
        else { u32x2 pk; pk.x = pack2(v[0], v[1]); pk.y = pack2(v[2], v[3]); *(u32x2*)(p.merged() + row * 1024 + col) = pk; }
      }
    }
  }
}

__device__ void outproj_tile(const Params& p, int l, int t, char* smem) {
  const int tm = t >> 3, tn = t & 7;
  const int tid = get_tid(), lane = tid & 63, wid = tid >> 6, wr = wid >> 1, wc = wid & 1, fr = lane & 15, fq = lane >> 4;
  f32x4 acc[4][4]; zero_acc(acc);
  gemm_kloop<bf16_t>(acc, p.merged() + (size_t)tm * 128 * 1024, 1024, p.wt_out() + (size_t)l * 1048576 + (size_t)tn * 128 * 1024, 1024, 1024, smem);
#pragma unroll
  for (int ni = 0; ni < 4; ++ni) {
    const size_t row = (size_t)tm * 128 + wr * 64 + ni * 16 + fr;
#pragma unroll
    for (int mi = 0; mi < 4; ++mi) *(f32x4*)(p.y() + row * 1024 + tn * 128 + wc * 64 + mi * 16 + fq * 4) = acc[mi][ni];
  }
}

__device__ void postnorm_phase(const Params& p, int l) {
  const int lane = threadIdx.x & 63, wid = threadIdx.x >> 6;
  const float* gp = p.g_post + l * 1024;
  for (int row = blockIdx.x * 4 + wid; row < NTOK; row += gridDim.x * 4) {
    const float* x = xrow(p, l, row);
    const float* y = p.y() + (size_t)row * 1024;
    float4 v[4]; float ss = 0.f;
#pragma unroll
    for (int i = 0; i < 4; ++i) { v[i] = *(const float4*)(y + i * 256 + lane * 4); ss += v[i].x * v[i].x + v[i].y * v[i].y + v[i].z * v[i].z + v[i].w * v[i].w; }
#pragma unroll
    for (int o = 32; o > 0; o >>= 1) ss += __shfl_xor(ss, o);
    const float rstd = rsqrtf(ss * (1.f / 1024.f) + 1e-6f);
#pragma unroll
    for (int i = 0; i < 4; ++i) {
      const int k = i * 256 + lane * 4;
      const float4 g = *(const float4*)(gp + k), xv = *(const float4*)(x + k);
      float4 r; r.x = xv.x + v[i].x * rstd * g.x; r.y = xv.y + v[i].y * rstd * g.y; r.z = xv.z + v[i].z * rstd * g.z; r.w = xv.w + v[i].w * rstd * g.w;
      *(float4*)(p.r() + (size_t)row * 1024 + k) = r;
      u32x2 pk; pk.x = pack2(r.x, r.y); pk.y = pack2(r.z, r.w);
      *(u32x2*)(p.rb() + (size_t)row * 1024 + k) = pk;
    }
  }
}

__device__ void ple_tile(const Params& p, int l, int t, char* smem) {
  const int tm = t >> 3, tn = t & 7;
  const int tid = get_tid(), lane = tid & 63, wid = tid >> 6, wr = wid >> 1, wc = wid & 1, fr = lane & 15, fq = lane >> 4;
  f32x4 acc[4][4]; zero_acc(acc);
  const int row0 = tm * 128;
  const float* pp = row0 < NPROMPT ? p.p_p + ((size_t)l * NPROMPT + row0) * 256 : p.p_s + ((size_t)l * 512 + (row0 - NPROMPT)) * 256;
  gemm_kloop<float>(acc, pp, 256, p.wt_pp() + (size_t)l * 262144 + (size_t)tn * 128 * 256, 256, 256, smem);
  u32x2 pb[4][4];
#pragma unroll
  for (int a = 0; a < 4; ++a)
#pragma unroll
    for (int c = 0; c < 4; ++c) { pb[a][c].x = pack2(acc[a][c][0], acc[a][c][1]); pb[a][c].y = pack2(acc[a][c][2], acc[a][c][3]); }
  zero_acc(acc);
  gemm_kloop<bf16_t>(acc, p.rb() + (size_t)tm * 128 * 1024, 1024, p.wt_pg() + (size_t)l * 1048576 + (size_t)tn * 128 * 1024, 1024, 1024, smem);
#pragma unroll
  for (int ni = 0; ni < 4; ++ni) {
    const size_t row = (size_t)row0 + wr * 64 + ni * 16 + fr;
#pragma unroll
    for (int mi = 0; mi < 4; ++mi) {
      const int col = tn * 128 + wc * 64 + mi * 16 + fq * 4;
      const f32x4 rv = *(const f32x4*)(p.r() + row * 1024 + col);
      f32x4 o;
      o[0] = rv[0] + sigm(acc[mi][ni][0]) * lo2f(pb[mi][ni].x); o[1] = rv[1] + sigm(acc[mi][ni][1]) * hi2f(pb[mi][ni].x);
      o[2] = rv[2] + sigm(acc[mi][ni][2]) * lo2f(pb[mi][ni].y); o[3] = rv[3] + sigm(acc[mi][ni][3]) * hi2f(pb[mi][ni].y);
      *(f32x4*)(p.o_y() + row * 1024 + col) = o;
    }
  }
}


#define XB_TMO      128
#define XB_XCNT(j)  (256  + 64 * (j))
#define XB_XSUB(j)  (1280 + 64 * (j))
#define XB_XGEN(j)  (2304 + 64 * (j))
#define XB_TOP      3328
#define XB_TOPGEN   3392
#define XCD_BAR_WORDS 3456
#define XB_SPIN_CAP (1u << 18)
#define LAS __attribute__((address_space(3)))
__device__ __forceinline__ unsigned xb_ld(unsigned* p)              { return __hip_atomic_load(p, __ATOMIC_RELAXED, __HIP_MEMORY_SCOPE_AGENT); }
__device__ __forceinline__ unsigned xb_add(unsigned* p, unsigned v) { return __hip_atomic_fetch_add(p, v, __ATOMIC_RELAXED, __HIP_MEMORY_SCOPE_AGENT); }
__device__ __forceinline__ unsigned xb_xcc_id() { return (unsigned)__builtin_amdgcn_s_getreg((3 << 11) | 20) & 0xFu; }
#define XB_SPIN(cond, bar) do { unsigned _sp = 0; while (cond) { __builtin_amdgcn_s_sleep(1); \
    if ((++_sp & 255u) == 0u) { if (xb_ld(&(bar)[XB_TMO])) break; if (_sp > XB_SPIN_CAP) { atomicAdd(&(bar)[XB_TMO], 1u); break; } } } } while (0)
__device__ __forceinline__ void xcd_barrier_complete(unsigned* bar, unsigned x, unsigned& nloc, unsigned& nx) {
    const unsigned G = gridDim.x * gridDim.y * gridDim.z;
    unsigned sum, cnt, mine, sp = 0u;
    for (;;) {
        sum = 0u; cnt = 0u; mine = 0u;
#pragma unroll
        for (unsigned j = 0; j < 16; ++j) { const unsigned c = xb_ld(&bar[XB_XCNT(j)]); sum += c; cnt += (c > 0u) ? 1u : 0u; mine = (j == x) ? c : mine; }
        if (sum == G) break;
        __builtin_amdgcn_s_sleep(1);
        if ((++sp & 255u) == 0u) { if (xb_ld(&bar[XB_TMO])) break; if (sp > XB_SPIN_CAP) { atomicAdd(&bar[XB_TMO], 1u); break; } }
    }
    nloc = mine > 0u ? mine : 1u; nx = cnt > 0u ? cnt : 1u;
}
__device__ __forceinline__ void xcd_barrier(unsigned* bar, volatile LAS unsigned* st) {
    asm volatile("s_waitcnt vmcnt(0)" ::: "memory");
    __syncthreads();
    if (threadIdx.x == 0) {
        const unsigned x = xb_xcc_id();
        __builtin_amdgcn_s_waitcnt(0);
        unsigned nloc = st[0], nx = st[1];
        if (nloc == 0u) { xcd_barrier_complete(bar, x, nloc, nx); st[0] = nloc; st[1] = nx; }
        const unsigned old = xb_add(&bar[XB_XSUB(x)], 1u);
        const unsigned gen = old / nloc;
        if (old + 1u == (gen + 1u) * nloc) {
            __builtin_amdgcn_fence(__ATOMIC_RELEASE, "agent");
            asm volatile("s_waitcnt vmcnt(0)" ::: "memory");
            const unsigned og = xb_add(&bar[XB_TOP], 1u);
            const unsigned tg = og / nx;
            if (og + 1u == (tg + 1u) * nx) xb_add(&bar[XB_TOPGEN], 1u);
            else XB_SPIN(xb_ld(&bar[XB_TOPGEN]) == tg, bar);
            __builtin_amdgcn_fence(__ATOMIC_ACQUIRE, "agent");
            xb_add(&bar[XB_XGEN(x)], 1u);
            asm volatile("s_waitcnt vmcnt(0)" ::: "memory");
        } else {
            XB_SPIN(xb_ld(&bar[XB_XGEN(x)]) == gen, bar);
            __builtin_amdgcn_fence(__ATOMIC_ACQUIRE, "agent");
            asm volatile("s_waitcnt vmcnt(0)" ::: "memory");
        }
    }
    __syncthreads();
}

template <int PH>
__device__ __forceinline__ void run_phase(const Params& p, char* smem) {
  const int bid = blockIdx.x, nb = gridDim.x;
  if (PH == 0) { for (int t = bid; t < 6784; t += nb) wconv_tile(p, t, smem); return; }
  constexpr int l = (PH - 1) / 9, s = (PH - 1) % 9;
  if (!((PHMASK >> s) & 1)) return;
  switch (s) {
    case 0: norm_phase(p, l); break;
    case 1: {
      const int per = (132 * 52) / 8, xcd = bid & 7, nloc = (nb + 7 - xcd) >> 3;
      for (int j = bid >> 3; j < per; j += nloc) {
        const int sq = xcd * per + j;
        const int tmg = sq / 416, rem = sq % 416, gm = (tmg == 16) ? 4 : 8;
        const int tng = rem / (gm * 8), rem2 = rem % (gm * 8), wdt = (tng == 6) ? 4 : 8;
        inproj_tile(p, l, (tmg * 8 + rem2 / wdt) * 52 + tng * 8 + rem2 % wdt, smem);
      }
      break;
    }
    case 2:
      for (int v = bid; v < 3 * NUNIT; v += nb) {
        const int ty = v % 3, u = v / 3;
        if (ty == 0) sb_unit(p, l, u, smem); else if (ty == 1) mlstm_local(p, l, u, smem); else hgrn_local(p, l, u, smem);
      }
      break;
    case 3: scan_phase(p, l); break;
    case 4:
      for (int v = bid; v < 2 * NUNIT; v += nb) { if (v & 1) hgrn_out(p, l, v >> 1, smem); else mlstm_out(p, l, v >> 1, smem); }
      break;
    case 5: for (int t = bid; t < 1056; t += nb) merge_tile(p, l, t, smem); break;
    case 6: for (int t = bid; t < 1056; t += nb) outproj_tile(p, l, t, smem); break;
    case 7: postnorm_phase(p, l); break;
    case 8: for (int t = bid; t < 1056; t += nb) ple_tile(p, l, t, smem); break;
  }
}

template <int PH>
__global__ void __launch_bounds__(256, 2) phase_kernel(Params p) {
  __shared__ __attribute__((aligned(16))) char smem[SMEM_BYTES];
  run_phase<PH>(p, smem);
}

#if FUSED
__device__ __forceinline__ void run_phase_rt(const Params& p, int ph, char* smem) {
  const int bid = blockIdx.x, nb = gridDim.x;
  if (ph == 0) { for (int t = bid; t < 6784; t += nb) wconv_tile(p, t, smem); return; }
  const int l = (ph - 1) / 9, s = (ph - 1) % 9;
  switch (s) {
    case 0: norm_phase(p, l); break;
    case 1: {
      const int per = (132 * 52) / 8, xcd = bid & 7, nloc = (nb + 7 - xcd) >> 3;
      for (int j = bid >> 3; j < per; j += nloc) {
        const int sq = xcd * per + j;
        const int tmg = sq / 416, rem = sq % 416, gm = (tmg == 16) ? 4 : 8;
        const int tng = rem / (gm * 8), rem2 = rem % (gm * 8), wdt = (tng == 6) ? 4 : 8;
        inproj_tile(p, l, (tmg * 8 + rem2 / wdt) * 52 + tng * 8 + rem2 % wdt, smem);
      }
      break;
    }
    case 2:
      for (int v = bid; v < 3 * NUNIT; v += nb) {
        const int ty = v % 3, u = v / 3;
        if (ty == 0) sb_unit(p, l, u, smem); else if (ty == 1) mlstm_local(p, l, u, smem); else hgrn_local(p, l, u, smem);
      }
      break;
    case 3: scan_phase(p, l); break;
    case 4:
      for (int v = bid; v < 2 * NUNIT; v += nb) { if (v & 1) hgrn_out(p, l, v >> 1, smem); else mlstm_out(p, l, v >> 1, smem); }
      break;
    case 5: for (int t = bid; t < 1056; t += nb) merge_tile(p, l, t, smem); break;
    case 6: for (int t = bid; t < 1056; t += nb) outproj_tile(p, l, t, smem); break;
    case 7: postnorm_phase(p, l); break;
    case 8: for (int t = bid; t < 1056; t += nb) ple_tile(p, l, t, smem); break;
  }
}

__global__ void __launch_bounds__(256, 2) mega(Params p_unused) {
  __shared__ __attribute__((aligned(16))) char smem[SMEM_BYTES];
  __shared__ uint4 xb_words;
  if (threadIdx.x == 0) {
    typedef const Params __attribute__((address_space(4))) * KP4;
    KP4 kp = (KP4)__builtin_amdgcn_kernarg_segment_ptr();
    asm volatile("" : "+s"(kp));
    char* wsb = ((const Params*)kp)->ws;
    xb_words = make_uint4(0u, 0u, 0u, 0u); (void)xb_add((unsigned*)(wsb + WS_BAR) + XB_XCNT(xb_xcc_id()), 1u);
  }
  __syncthreads();
  typedef const Params __attribute__((address_space(4))) * KP4;
#pragma unroll 1
  for (int ph = 0; ph < NPHASE; ++ph) {
    KP4 kp = (KP4)__builtin_amdgcn_kernarg_segment_ptr();
    asm volatile("" : "+s"(kp));
    const Params q = *(const Params*)kp;
    run_phase_rt(q, ph, smem);
    if (ph == 0) cg::this_grid().sync();
    else if (ph + 1 < NPHASE) xcd_barrier((unsigned*)(q.ws + WS_BAR), (volatile LAS unsigned*)&xb_words);
  }
}
#endif

template <int PH>
static void launch_all(const Params& p, int grid, hipStream_t stream) {
  hipLaunchKernelGGL(phase_kernel<PH>, dim3(grid), dim3(256), 0, stream, p);
  if constexpr (PH + 1 < NPHASE) launch_all<PH + 1>(p, grid, stream);
}

extern "C" void kernel_launch(void* const* d_in, const int* in_sizes, int n_in, void* d_out, int out_size, void* d_ws, size_t ws_size, hipStream_t stream) {
  Params p;
  memset(&p, 0, sizeof(p));
  const float* const* in = (const float* const*)d_in;
  p.x_p = in[0]; p.x_s = in[1]; p.p_p = in[2]; p.p_s = in[3]; p.st_C = in[4]; p.st_n = in[5]; p.st_m = in[6]; p.st_conv = in[7];
  p.ck = in[8]; p.cv = in[9]; p.st_S = in[10]; p.g_pre = in[11]; p.w_in = in[12]; p.b_i = in[13]; p.b_f = in[14]; p.w_conv = in[15];
  p.g_ml = in[16]; p.lb_logits = in[17]; p.g_hg = in[18]; p.w_br = in[19]; p.w_out = in[20]; p.g_post = in[21]; p.w_pg = in[22]; p.w_pp = in[23];
  p.out = (float*)d_out; p.ws = (char*)d_ws;
  if (WS_TOTAL > ws_size || (size_t)out_size < O_TOTAL) { fprintf(stderr, "workspace/out too small: need %zu have %zu\n", (size_t)WS_TOTAL, ws_size); return; }
  static int grid_blocks = 0;
  if (!grid_blocks) {
    int dev = 0, cus = 0, per_cu = 0;
    (void)hipGetDevice(&dev);
    (void)hipDeviceGetAttribute(&cus, hipDeviceAttributeMultiprocessorCount, dev);
#if FUSED
    (void)hipOccupancyMaxActiveBlocksPerMultiprocessor(&per_cu, mega, 256, 0);
#else
    per_cu = 2;
#endif
    if (per_cu > 2) per_cu = 2;
    if (per_cu < 1) per_cu = 1;
    grid_blocks = cus * per_cu;
  }
#if FUSED
  (void)hipMemsetAsync((char*)d_ws + WS_BAR, 0, XCD_BAR_WORDS * 4, stream);
  void* args[] = {&p};
  hipError_t e = hipLaunchCooperativeKernel((void*)mega, dim3(grid_blocks), dim3(256), args, 0, stream);
  if (e != hipSuccess) fprintf(stderr, "cooperative launch failed: %s (grid %d)\n", hipGetErrorString(e), grid_blocks);
#else
  launch_all<0>(p, grid_blocks, stream);
#endif
}
```

```cpp
#include <hip/hip_runtime.h>
#include <hip/hip_cooperative_groups.h>
#include <stdint.h>
#include <stdio.h>
#include <string.h>
namespace cg = cooperative_groups;

#ifndef FUSED
#define FUSED 1
#endif
#ifndef PHMASK
#define PHMASK 0x3ff
#endif

typedef unsigned short bf16_t;
typedef short bf16x8 __attribute__((ext_vector_type(8)));
typedef float f32x4 __attribute__((ext_vector_type(4)));
typedef unsigned u32x4 __attribute__((ext_vector_type(4)));
typedef unsigned u32x2 __attribute__((ext_vector_type(2)));

constexpr int NTOK = 16896, NPROMPT = 16384, NUNIT = 1056;
constexpr int NINSRC = 9736, NWT = 9728, NMAIN = 6656;
constexpr int SMEM_BYTES = 80896;
constexpr int NPL = 10;
constexpr int NPHASE = 1 + 2 * NPL;

constexpr size_t al256(size_t x) { return (x + 255) & ~(size_t)255; }
constexpr size_t WS_WT_IN = 0;
constexpr size_t WS_WT_BR = WS_WT_IN + al256((size_t)2 * NWT * 1024 * 2);
constexpr size_t WS_WT_OUT = WS_WT_BR + al256((size_t)2 * 3 * 1024 * 512 * 2);
constexpr size_t WS_WT_PG = WS_WT_OUT + al256((size_t)2 * 1048576 * 2);
constexpr size_t WS_WT_PP = WS_WT_PG + al256((size_t)2 * 1048576 * 2);
constexpr size_t WS_U = WS_WT_PP + al256((size_t)2 * 262144 * 2);
constexpr size_t WS_PR = WS_U + al256((size_t)NTOK * 1024 * 2);
constexpr size_t WS_QC = WS_PR + al256((size_t)13 * NTOK * 512 * 2);
constexpr size_t WS_KC = WS_QC + al256((size_t)NTOK * 512 * 2);
constexpr size_t WS_SM = WS_KC + al256((size_t)NTOK * 512 * 2);
constexpr size_t WS_SH = WS_SM + al256((size_t)NUNIT * 16384 * 2);
constexpr size_t WS_H = WS_SH + al256((size_t)NUNIT * 16384 * 2);
constexpr size_t WS_IG = WS_H + al256((size_t)3 * NTOK * 512 * 2);
constexpr size_t WS_LF = WS_IG + al256((size_t)NTOK * 16);
constexpr size_t WS_AC = WS_LF + al256((size_t)NTOK * 16);
constexpr size_t WS_BC = WS_AC + al256(NUNIT * 4);
constexpr size_t WS_MIN = WS_BC + al256(NUNIT * 4);
constexpr size_t WS_NLOC = WS_MIN + al256(NUNIT * 4);
constexpr size_t WS_HBC = WS_NLOC + al256((size_t)NUNIT * 512);
constexpr size_t WS_BAR = WS_HBC + al256((size_t)NUNIT * 512);
constexpr size_t WS_WG8 = WS_BAR + 16384;
constexpr size_t WS_TOTAL = WS_WG8 + 65536;
constexpr size_t WS_MERGED = WS_PR;
constexpr size_t WS_Y = WS_MERGED + (size_t)NTOK * 1024 * 2;
constexpr size_t WS_R = WS_Y + (size_t)NTOK * 1024 * 4;
constexpr size_t WS_RB = WS_R + (size_t)NTOK * 1024 * 4;
static_assert(WS_RB + (size_t)NTOK * 1024 * 2 <= WS_QC, "alias overflow");
constexpr size_t O_PC = 16777216 + 524288, O_PN = O_PC + 262144, O_PM = O_PN + 2048, O_PCONV = O_PM + 16, O_PK = O_PCONV + 12288, O_PV = O_PK + 16777216,
                 O_PS = O_PV + 16777216, O_SC = O_PS + 262144, O_SN = O_SC + 1048576, O_SM = O_SN + 8192, O_SCONV = O_SM + 64, O_SK = O_SCONV + 49152,
                 O_SV = O_SK + 524288, O_SS = O_SV + 524288, O_TOTAL = O_SS + 1048576;

struct Params {
  const float *x_p, *x_s, *p_p, *p_s, *st_C, *st_n, *st_m, *st_conv, *ck, *cv, *st_S;
  const float *g_pre, *w_in, *b_i, *b_f, *w_conv, *g_ml, *lb_logits, *g_hg, *w_br, *w_out, *g_post, *w_pg, *w_pp;
  float* out; char* ws;
#define WSP(name, T, off) __device__ __forceinline__ T* name() const { return (T*)(ws + (off)); }
#define OUTP(name, off) __device__ __forceinline__ float* name() const { return out + (off); }
  OUTP(o_y, 0) OUTP(o_pC, O_PC) OUTP(o_pn, O_PN) OUTP(o_pm, O_PM) OUTP(o_pconv, O_PCONV) OUTP(o_pk, O_PK) OUTP(o_pv, O_PV) OUTP(o_pS, O_PS)
  OUTP(o_sC, O_SC) OUTP(o_sn, O_SN) OUTP(o_sm, O_SM) OUTP(o_sconv, O_SCONV) OUTP(o_sk, O_SK) OUTP(o_sv, O_SV) OUTP(o_sS, O_SS)
  WSP(wt_in, bf16_t, WS_WT_IN) WSP(wt_br, bf16_t, WS_WT_BR) WSP(wt_out, bf16_t, WS_WT_OUT) WSP(wt_pg, bf16_t, WS_WT_PG) WSP(wt_pp, bf16_t, WS_WT_PP)
  WSP(U, bf16_t, WS_U) WSP(PR, bf16_t, WS_PR) WSP(QC, bf16_t, WS_QC) WSP(KC, bf16_t, WS_KC) WSP(SM, bf16_t, WS_SM) WSP(SH, bf16_t, WS_SH) WSP(H, bf16_t, WS_H)
  WSP(ig, float, WS_IG) WSP(lf, float, WS_LF) WSP(ac, float, WS_AC) WSP(Bc, float, WS_BC) WSP(min_, float, WS_MIN) WSP(nloc, float, WS_NLOC) WSP(hbc, float, WS_HBC)
  WSP(G, bf16_t, WS_Y) WSP(wg8, float, WS_WG8) WSP(merged, bf16_t, WS_MERGED) WSP(y, float, WS_Y) WSP(r, float, WS_R) WSP(rb, bf16_t, WS_RB)
};

__device__ __forceinline__ int get_tid() { int t = threadIdx.x; asm volatile("" : "+v"(t)); return t; }
__device__ __forceinline__ bf16_t f2bf(float f) { unsigned u = __float_as_uint(f); u += 0x7fffu + ((u >> 16) & 1u); return (bf16_t)(u >> 16); }
__device__ __forceinline__ float bf2f(bf16_t h) { return __uint_as_float(((unsigned)h) << 16); }
__device__ __forceinline__ unsigned pack2(float a, float b) { return (unsigned)f2bf(a) | ((unsigned)f2bf(b) << 16); }
__device__ __forceinline__ float lo2f(unsigned v) { return __uint_as_float(v << 16); }
__device__ __forceinline__ float hi2f(unsigned v) { return __uint_as_float(v & 0xffff0000u); }
__device__ __forceinline__ float sigm(float x) { return 1.f / (1.f + __expf(-x)); }
__device__ __forceinline__ float silu(float x) { return x / (1.f + __expf(-x)); }
__device__ __forceinline__ float softplus(float x) { return fmaxf(x, 0.f) + __logf(1.f + __expf(-fabsf(x))); }
__device__ __forceinline__ float logsigm(float x) { return fminf(x, 0.f) - __logf(1.f + __expf(-fabsf(x))); }

template <int MT, int NT, int KS>
__device__ __forceinline__ void wmma(f32x4 (&acc)[MT][NT], const bf16_t* A, int lda, const bf16_t* B, int ldb, int fr, int fq) {
#pragma unroll
  for (int kk = 0; kk < KS; ++kk) {
    bf16x8 a[MT], b[NT];
#pragma unroll
    for (int mi = 0; mi < MT; ++mi) a[mi] = *(const bf16x8*)(A + (mi * 16 + fr) * lda + kk * 32 + fq * 8);
#pragma unroll
    for (int ni = 0; ni < NT; ++ni) b[ni] = *(const bf16x8*)(B + (ni * 16 + fr) * ldb + kk * 32 + fq * 8);
#pragma unroll
    for (int mi = 0; mi < MT; ++mi)
#pragma unroll
      for (int ni = 0; ni < NT; ++ni) acc[mi][ni] = __builtin_amdgcn_mfma_f32_16x16x32_bf16(a[mi], b[ni], acc[mi][ni], 0, 0, 0);
  }
}

__device__ __forceinline__ u32x4 ld8(const bf16_t* s) { return *(const u32x4*)s; }
__device__ __forceinline__ u32x4 ld8(const float* s) {
  float4 a = *(const float4*)s, b = *(const float4*)(s + 4);
  u32x4 r; r.x = pack2(a.x, a.y); r.y = pack2(a.z, a.w); r.z = pack2(b.x, b.y); r.w = pack2(b.z, b.w); return r;
}
template <typename T>
__device__ __forceinline__ void ld_tile(bf16_t* dst, const T* src, long ld, int tid) {
#pragma unroll
  for (int i = 0; i < 4; ++i) { int id = tid + 256 * i; int r = id >> 4, c = (id & 15) * 8; *(u32x4*)(dst + r * 136 + c) = ld8(src + (long)r * ld + c); }
}
template <typename T>
__device__ __forceinline__ void ld_tile128(bf16_t* dst, const T* src, long ld, int tid) {
#pragma unroll
  for (int i = 0; i < 8; ++i) { int id = tid + 256 * i; int r = id >> 4, c = (id & 15) * 8; *(u32x4*)(dst + r * 136 + c) = ld8(src + (long)r * ld + c); }
}
template <typename T, int ROWS, int DLD>
__device__ __forceinline__ void ld_T(bf16_t* dst, const T* src, long ld, int tid) {
#pragma unroll 2
  for (int id = tid; id < ROWS * 16; id += 256) {
    int r = id % ROWS, c = (id / ROWS) * 8;
    u32x4 v = ld8(src + (long)r * ld + c);
    bf16_t* d = dst + c * DLD + r;
    d[0] = (bf16_t)(v.x & 0xffff); d[DLD] = (bf16_t)(v.x >> 16); d[2 * DLD] = (bf16_t)(v.y & 0xffff); d[3 * DLD] = (bf16_t)(v.y >> 16);
    d[4 * DLD] = (bf16_t)(v.z & 0xffff); d[5 * DLD] = (bf16_t)(v.z >> 16); d[6 * DLD] = (bf16_t)(v.w & 0xffff); d[7 * DLD] = (bf16_t)(v.w >> 16);
  }
}

#define PRG(g) (p.PR() + (size_t)(g) * NTOK * 512)

__device__ __forceinline__ const float* xrow(const Params& p, int l, int row) {
  if (l == 0) return row < NPROMPT ? p.x_p + (size_t)row * 1024 : p.x_s + (size_t)(row - NPROMPT) * 1024;
  return p.o_y() + (size_t)row * 1024;
}

__device__ void wconv_tile(const Params& p, int t, char* smem) {
  float* tile = (float*)smem;
  const int tid = get_tid();
  int l = t / 3392, r = t % 3392;
  const float* src; bf16_t* dst; int K, ldsrc, kt, nt, skip = 1 << 30;
  if (r < 2432) { src = p.w_in + (size_t)l * 1024 * NINSRC; dst = p.wt_in() + (size_t)l * NWT * 1024; K = 1024; ldsrc = NINSRC; kt = r % 16; nt = r / 16; skip = 2560; }
  else if (r < 2816) { r -= 2432; int b = r / 128; r %= 128; src = p.w_br + (size_t)(l * 3 + b) * 512 * 1024; dst = p.wt_br() + (size_t)(l * 3 + b) * 1024 * 512; K = 512; ldsrc = 1024; kt = r % 8; nt = r / 8; }
  else if (r < 3072) { r -= 2816; src = p.w_out + (size_t)l * 1048576; dst = p.wt_out() + (size_t)l * 1048576; K = 1024; ldsrc = 1024; kt = r % 16; nt = r / 16; }
  else if (r < 3328) { r -= 3072; src = p.w_pg + (size_t)l * 1048576; dst = p.wt_pg() + (size_t)l * 1048576; K = 1024; ldsrc = 1024; kt = r % 16; nt = r / 16; }
  else { r -= 3328; src = p.w_pp + (size_t)l * 262144; dst = p.wt_pp() + (size_t)l * 262144; K = 256; ldsrc = 1024; kt = r % 4; nt = r / 4; }
  const int n0 = nt * 64, k0 = kt * 64;
#pragma unroll
  for (int i = 0; i < 16; ++i) {
    int k = i * 4 + (tid >> 6), n = tid & 63; int ns = n0 + n; if (ns >= skip) ns += 8;
    tile[k * 65 + n] = src[(size_t)(k0 + k) * ldsrc + ns];
  }
  __syncthreads();
#pragma unroll
  for (int i = 0; i < 8; ++i) {
    int n = i * 8 + (tid >> 5), k = (tid & 31) * 2;
    *(unsigned*)(dst + (size_t)(n0 + n) * K + k0 + k) = pack2(tile[k * 65 + n], tile[(k + 1) * 65 + n]);
  }
  __syncthreads();
}

__device__ void norm_phase(const Params& p, int l) {
  const int lane = threadIdx.x & 63, wid = threadIdx.x >> 6;
  const float* gp = p.g_pre + l * 1024;
  const float* wg = p.wg8() + l * 8192;
  for (int row = blockIdx.x * 4 + wid; row < NTOK; row += gridDim.x * 4) {
    const float* x = xrow(p, l, row);
    float4 v[4]; float ss = 0.f;
#pragma unroll
    for (int i = 0; i < 4; ++i) { v[i] = *(const float4*)(x + i * 256 + lane * 4); ss += v[i].x * v[i].x + v[i].y * v[i].y + v[i].z * v[i].z + v[i].w * v[i].w; }
#pragma unroll
    for (int o = 32; o > 0; o >>= 1) ss += __shfl_xor(ss, o);
    const float rstd = rsqrtf(ss * (1.f / 1024.f) + 1e-6f);
    float d0 = 0, d1 = 0, d2 = 0, d3 = 0, d4 = 0, d5 = 0, d6 = 0, d7 = 0;
#pragma unroll
    for (int i = 0; i < 4; ++i) {
      const int k = i * 256 + lane * 4;
      float4 g = *(const float4*)(gp + k);
      float u0 = v[i].x * rstd * g.x, u1 = v[i].y * rstd * g.y, u2 = v[i].z * rstd * g.z, u3 = v[i].w * rstd * g.w;
      u32x2 pk; pk.x = pack2(u0, u1); pk.y = pack2(u2, u3);
      *(u32x2*)(p.U() + (size_t)row * 1024 + k) = pk;
      const float* wp = wg + k;
      float4 w;
      w = *(const float4*)(wp);            d0 += u0 * w.x + u1 * w.y + u2 * w.z + u3 * w.w;
      w = *(const float4*)(wp + 1024);     d1 += u0 * w.x + u1 * w.y + u2 * w.z + u3 * w.w;
      w = *(const float4*)(wp + 2 * 1024); d2 += u0 * w.x + u1 * w.y + u2 * w.z + u3 * w.w;
      w = *(const float4*)(wp + 3 * 1024); d3 += u0 * w.x + u1 * w.y + u2 * w.z + u3 * w.w;
      w = *(const float4*)(wp + 4 * 1024); d4 += u0 * w.x + u1 * w.y + u2 * w.z + u3 * w.w;
      w = *(const float4*)(wp + 5 * 1024); d5 += u0 * w.x + u1 * w.y + u2 * w.z + u3 * w.w;
      w = *(const float4*)(wp + 6 * 1024); d6 += u0 * w.x + u1 * w.y + u2 * w.z + u3 * w.w;
      w = *(const float4*)(wp + 7 * 1024); d7 += u0 * w.x + u1 * w.y + u2 * w.z + u3 * w.w;
    }
#pragma unroll
    for (int o = 32; o > 0; o >>= 1) {
      d0 += __shfl_xor(d0, o); d1 += __shfl_xor(d1, o); d2 += __shfl_xor(d2, o); d3 += __shfl_xor(d3, o);
      d4 += __shfl_xor(d4, o); d5 += __shfl_xor(d5, o); d6 += __shfl_xor(d6, o); d7 += __shfl_xor(d7, o);
    }
    if (lane < 4) {
      float di = lane == 0 ? d0 : lane == 1 ? d1 : lane == 2 ? d2 : d3;
      float df = lane == 0 ? d4 : lane == 1 ? d5 : lane == 2 ? d6 : d7;
      p.ig()[row * 4 + lane] = di + p.b_i[l * 4 + lane];
      p.lf()[row * 4 + lane] = logsigm(df + p.b_f[l * 4 + lane]);
    }
  }
}

template <typename TA>
__device__ __forceinline__ void gemm_kloop(f32x4 (&acc)[4][4], const TA* Tp, long ldt, const bf16_t* Wp, long ldw, int K, char* smem) {
  bf16_t* sT = (bf16_t*)smem;
  bf16_t* sW = sT + 2 * 9216;
  const int tid = get_tid(), lane = tid & 63, wid = tid >> 6, wr = wid >> 1, wc = wid & 1, fr = lane & 15, fq = lane >> 4;
  u32x4 rt[4], rw[4];
  const int r0 = tid >> 3, c0 = (tid & 7) * 8;
#define GLOAD(k0) _Pragma("unroll") for (int i = 0; i < 4; ++i) { rt[i] = ld8(Tp + (long)(r0 + 32 * i) * ldt + (k0) + c0); rw[i] = ld8(Wp + (long)(r0 + 32 * i) * ldw + (k0) + c0); }
#define SSTORE(buf) _Pragma("unroll") for (int i = 0; i < 4; ++i) { *(u32x4*)(sT + (buf) * 9216 + (r0 + 32 * i) * 72 + c0) = rt[i]; *(u32x4*)(sW + (buf) * 9216 + (r0 + 32 * i) * 72 + c0) = rw[i]; }
  GLOAD(0); SSTORE(0);
  __syncthreads();
  const int nk = K >> 6;
#pragma unroll 1
  for (int kt = 0; kt < nk; ++kt) {
    const int buf = kt & 1;
    if (kt + 1 < nk) { GLOAD((kt + 1) * 64); }
    const bf16_t* aT = sT + buf * 9216 + (wr * 64) * 72;
    const bf16_t* aW = sW + buf * 9216 + (wc * 64) * 72;
    wmma<4, 4, 2>(acc, aW, 72, aT, 72, fr, fq);
    if (kt + 1 < nk) { SSTORE(buf ^ 1); }
    __syncthreads();
  }
#undef GLOAD
#undef SSTORE
}
__device__ __forceinline__ void zero_acc(f32x4 (&acc)[4][4]) {
#pragma unroll
  for (int a = 0; a < 4; ++a)
#pragma unroll
    for (int b = 0; b < 4; ++b) acc[a][b] = (f32x4){0.f, 0.f, 0.f, 0.f};
}


template <int NT, int NSTAGE>
__device__ __forceinline__ void gemm_glds(f32x4 (&acc)[4][NT], const bf16_t* Tp, long ldt, const bf16_t* Wp, long ldw, int K, char* smem) {
  constexpr int TR = 2 * NT * 16, STAGE_B = (TR + 128) * 64, LT = TR / 64, LPS = LT + 2;
  static_assert(NSTAGE * STAGE_B <= SMEM_BYTES, "ring too large");
  static_assert(NSTAGE == 3 || NSTAGE == 4, "waits below are written for 3 or 4 stages");
  const int tid = get_tid(), lane = tid & 63, wid = tid >> 6, wr = wid >> 1, wc = wid & 1, fr = lane & 15, fq = lane >> 4;
  const int lr = tid >> 2, cp = tid & 3, lc = (cp ^ ((lr >> 2) & 3)) * 8;
  const bf16_t* gT = Tp + (long)lr * ldt + lc;
  const bf16_t* gW = Wp + (long)lr * ldw + lc;
  const int rd_off = fr * 64 + ((fq ^ ((fr >> 2) & 3)) * 16);
#define GL_ISSUE(kt_, slot_) do { char* sb_ = smem + (slot_) * STAGE_B + tid * 16; \
    _Pragma("unroll") for (int i_ = 0; i_ < LT; ++i_) __builtin_amdgcn_global_load_lds((const unsigned*)(gT + (long)i_ * 64 * ldt + (kt_) * 32), (__attribute__((address_space(3))) unsigned*)(sb_ + i_ * 4096), 16, 0, 0); \
    _Pragma("unroll") for (int i_ = 0; i_ < 2; ++i_) __builtin_amdgcn_global_load_lds((const unsigned*)(gW + (long)i_ * 64 * ldw + (kt_) * 32), (__attribute__((address_space(3))) unsigned*)(sb_ + TR * 64 + i_ * 4096), 16, 0, 0); } while (0)
  asm volatile("s_waitcnt vmcnt(0)" ::: "memory");
  __builtin_amdgcn_s_barrier();
  const int nk = K >> 5;
#pragma unroll
  for (int s_ = 0; s_ < NSTAGE - 1; ++s_) if (s_ < nk) GL_ISSUE(s_, s_);
  int slot = 0, islot = NSTAGE - 1;
#pragma unroll 1
  for (int kt = 0; kt < nk; ++kt) {
    const int rem = nk - 1 - kt;
    if (NSTAGE == 4) {
      if (rem >= 2) asm volatile("s_waitcnt vmcnt(%0)" ::"n"(2 * LPS) : "memory");
      else if (rem == 1) asm volatile("s_waitcnt vmcnt(%0)" ::"n"(LPS) : "memory");
      else asm volatile("s_waitcnt vmcnt(0)" ::: "memory");
    } else {
      if (rem >= 1) asm volatile("s_waitcnt vmcnt(%0)" ::"n"(LPS) : "memory");
      else asm volatile("s_waitcnt vmcnt(0)" ::: "memory");
    }
    __builtin_amdgcn_s_barrier();
    if (kt + NSTAGE - 1 < nk) GL_ISSUE(kt + NSTAGE - 1, islot);
    const unsigned aT = (unsigned)(uintptr_t)(smem + slot * STAGE_B + (wr * NT * 16) * 64 + rd_off);
    const unsigned aW = (unsigned)(uintptr_t)(smem + slot * STAGE_B + TR * 64 + (wc * 64) * 64 + rd_off);
    bf16x8 a[4], b[NT];
#pragma unroll
    for (int mi = 0; mi < 4; ++mi) asm volatile("ds_read_b128 %0, %1 offset:%2" : "=v"(a[mi]) : "v"(aW), "n"(mi * 1024));
#pragma unroll
    for (int ni = 0; ni < NT; ++ni) asm volatile("ds_read_b128 %0, %1 offset:%2" : "=v"(b[ni]) : "v"(aT), "n"(ni * 1024));
    if constexpr (NT == 4) asm volatile("s_waitcnt lgkmcnt(0)" : "+v"(a[0]), "+v"(a[1]), "+v"(a[2]), "+v"(a[3]), "+v"(b[0]), "+v"(b[1]), "+v"(b[2]), "+v"(b[3]));
    else asm volatile("s_waitcnt lgkmcnt(0)" : "+v"(a[0]), "+v"(a[1]), "+v"(a[2]), "+v"(a[3]), "+v"(b[0]), "+v"(b[1]), "+v"(b[2]), "+v"(b[3]), "+v"(b[4]), "+v"(b[5]), "+v"(b[6]), "+v"(b[7]));
    __builtin_amdgcn_s_setprio(1);
#pragma unroll
    for (int mi = 0; mi < 4; ++mi)
#pragma unroll
      for (int ni = 0; ni < NT; ++ni) acc[mi][ni] = __builtin_amdgcn_mfma_f32_16x16x32_bf16(a[mi], b[ni], acc[mi][ni], 0, 0, 0);
    __builtin_amdgcn_s_setprio(0);
    slot = (slot + 1 == NSTAGE) ? 0 : slot + 1;
    islot = (islot + 1 == NSTAGE) ? 0 : islot + 1;
  }
#undef GL_ISSUE
  __syncthreads();
}

__device__ void inproj_tile(const Params& p, int l, int t, char* smem) {
  constexpr int NT = 8;
  const int tm = t / 52, tn = t % 52;
  const int tid = get_tid(), lane = tid & 63, wid = tid >> 6, wr = wid >> 1, wc = wid & 1, fr = lane & 15, fq = lane >> 4;
  f32x4 acc[4][NT];
#pragma unroll
  for (int a_ = 0; a_ < 4; ++a_)
#pragma unroll
    for (int b_ = 0; b_ < NT; ++b_) acc[a_][b_] = (f32x4){0.f, 0.f, 0.f, 0.f};
  gemm_glds<NT, 3>(acc, p.U() + (size_t)tm * (NT * 32) * 1024, 1024, p.wt_in() + (size_t)l * NWT * 1024 + (size_t)tn * 128 * 1024, 1024, 1024, smem);
  const int g = tn >> 2;
  bf16_t* dst = PRG(g);
#pragma unroll
  for (int ni = 0; ni < NT; ++ni) {
    const int row = tm * (NT * 32) + wr * (NT * 16) + ni * 16 + fr;
    const bool samp = row >= NPROMPT;
    const int rr = samp ? row - NPROMPT : row;
    const int b = samp ? (rr >> 6) : (rr >> 13), tt = samp ? (rr & 63) : (rr & 8191), T = samp ? 64 : 8192, NB = samp ? 8 : 2;
#pragma unroll
    for (int mi = 0; mi < 4; ++mi) {
      const int cg_ = (tn & 3) * 128 + wc * 64 + mi * 16 + fq * 4;
      f32x4 v = acc[mi][ni];
      u32x2 pk; pk.x = pack2(v[0], v[1]); pk.y = pack2(v[2], v[3]);
      *(u32x2*)(dst + (size_t)row * 512 + cg_) = pk;
      if (g == 6 || g == 7) {
        float* o = (g == 6) ? (samp ? p.o_sk() : p.o_pk()) : (samp ? p.o_sv() : p.o_pv());
        const int hh = cg_ >> 7, d = cg_ & 127;
        *(f32x4*)(o + ((size_t)((l * NB + b) * 4 + hh) * T + tt) * 128 + d) = v;
      } else if (g < 2) {
        if (tt >= T - 3) {
          float* o = samp ? p.o_sconv() : p.o_pconv();
          *(f32x4*)(o + ((size_t)(l * NB + b) * 3 + (tt - (T - 3))) * 1024 + g * 512 + cg_) = v;
        }
      }
    }
  }
}

struct UnitInfo { int samp, b, h, c, rowbase, seq; };
__device__ __forceinline__ UnitInfo unit_info(int u) {
  UnitInfo i;
  if (u < 1024) { i.samp = 0; i.seq = u >> 7; i.b = i.seq >> 2; i.h = i.seq & 3; i.c = u & 127; i.rowbase = i.b * 8192 + i.c * 64; }
  else { int sq = u - 1024; i.samp = 1; i.seq = sq; i.b = sq >> 2; i.h = sq & 3; i.c = 0; i.rowbase = NPROMPT + i.b * 64; }
  return i;
}

__device__ void sb_unit(const Params& p, int l, int u, char* smem) {
  bf16_t* Qs = (bf16_t*)smem;
  bf16_t* Ks = Qs + 64 * 136;
  bf16_t* Vt = Ks + 64 * 136;
  bf16_t* Ps = Vt + 128 * 72;
  const int tid = get_tid(), lane = tid & 63, w = tid >> 6, fr = lane & 15, fq = lane >> 4;
  const UnitInfo ui = unit_info(u);
  const int nblk = ui.samp ? 65 : ui.c + 1;
  const int hc = ui.h * 128;
  __syncthreads();
  ld_tile<bf16_t>(Qs, PRG(5) + (size_t)ui.rowbase * 512 + hc, 512, tid);
  f32x4 o[8][1];
#pragma unroll
  for (int mi = 0; mi < 8; ++mi) o[mi][0] = (f32x4){0.f, 0.f, 0.f, 0.f};
  float R = 0.f;
  const int tq = 16 * w + fr;
  for (int i = nblk - 1; i >= 0; --i) {
    if (!ui.samp || i == 64) {
      const size_t krow = ui.samp ? (size_t)ui.rowbase : (size_t)ui.b * 8192 + (size_t)i * 64;
      ld_tile<bf16_t>(Ks, PRG(6) + krow * 512 + hc, 512, tid);
      ld_T<bf16_t, 64, 72>(Vt, PRG(7) + krow * 512 + hc, 512, tid);
    } else {
      const size_t off = ((size_t)((l * 8 + ui.b) * 4 + ui.h) * 4096 + (size_t)i * 64) * 128;
      ld_tile<float>(Ks, p.ck + off, 128, tid);
      ld_T<float, 64, 72>(Vt, p.cv + off, 128, tid);
    }
    __syncthreads();
    f32x4 z[4][1];
#pragma unroll
    for (int mi = 0; mi < 4; ++mi) z[mi][0] = (f32x4){0.f, 0.f, 0.f, 0.f};
    wmma<4, 1, 4>(z, Ks, 136, Qs + 16 * w * 136, 136, fr, fq);
    const bool diag = (i == nblk - 1);
    float L[4][4], lsg[4][4], G[4];
#pragma unroll
    for (int mi = 0; mi < 4; ++mi) {
      G[mi] = 0.f;
#pragma unroll
      for (int j = 0; j < 4; ++j) {
        const int kk = mi * 16 + fq * 4 + j;
        const float zz = z[mi][0][j] * 0.08838834764831845f;
        const float sp = softplus(zz);
        const bool valid = !diag || kk < tq;
        L[mi][j] = valid ? -sp : 0.f;
        lsg[mi][j] = valid ? zz - sp : -1e30f;
        G[mi] += L[mi][j];
      }
    }
    float sufm = 0.f;
#pragma unroll
    for (int mi = 3; mi >= 0; --mi) {
      const float g0 = __shfl(G[mi], fr), g1 = __shfl(G[mi], fr + 16), g2 = __shfl(G[mi], fr + 32), g3 = __shfl(G[mi], fr + 48);
      const float later = (fq < 1 ? g1 : 0.f) + (fq < 2 ? g2 : 0.f) + (fq < 3 ? g3 : 0.f);
      const float s3 = R + sufm + later, s2 = s3 + L[mi][3], s1 = s2 + L[mi][2], s0 = s1 + L[mi][1];
      const float a0 = __expf(lsg[mi][0] + s0), a1 = __expf(lsg[mi][1] + s1), a2 = __expf(lsg[mi][2] + s2), a3 = __expf(lsg[mi][3] + s3);
      u32x2 pk; pk.x = pack2(a0, a1); pk.y = pack2(a2, a3);
      *(u32x2*)(Ps + tq * 72 + mi * 16 + fq * 4) = pk;
      sufm += (g0 + g1) + (g2 + g3);
    }
    R += sufm;
    __syncthreads();
    wmma<8, 1, 2>(o, Vt, 72, Ps + 16 * w * 72, 72, fr, fq);
    if (__syncthreads_and(R < -110.f)) break;
  }
  const size_t row = (size_t)ui.rowbase + tq;
#pragma unroll
  for (int mi = 0; mi < 8; ++mi) {
    const int col = hc + mi * 16 + fq * 4;
    u32x2 zz = *(const u32x2*)(PRG(8) + row * 512 + col);
    f32x4 v = o[mi][0];
    u32x2 pk;
    pk.x = pack2(v[0] * silu(lo2f(zz.x)), v[1] * silu(hi2f(zz.x)));
    pk.y = pack2(v[2] * silu(lo2f(zz.y)), v[3] * silu(hi2f(zz.y)));
    *(u32x2*)(p.H() + (size_t)1 * NTOK * 512 + row * 512 + col) = pk;
  }
}

__device__ void mlstm_local(const Params& p, int l, int u, char* smem) {
  bf16_t* kdT = (bf16_t*)smem;
  bf16_t* vT = kdT + 128 * 72;
  bf16_t* xq = vT + 128 * 72;
  bf16_t* xk = xq + 67 * 136;
  float* dec = (float*)(xk + 67 * 136);
  const int tid = get_tid(), lane = tid & 63, w = tid >> 6, fr = lane & 15, fq = lane >> 4;
  const UnitInfo ui = unit_info(u);
  const int hc = ui.h * 128;
  __syncthreads();
  if (w == 0) {
    const float lfv = p.lf()[(ui.rowbase + lane) * 4 + ui.h], igv = p.ig()[(ui.rowbase + lane) * 4 + ui.h];
    float bs = lfv;
#pragma unroll
    for (int o = 1; o < 64; o <<= 1) { float t = __shfl_up(bs, o); if (lane >= o) bs += t; }
    const float g = igv - bs;
    float gm = g;
#pragma unroll
    for (int o = 32; o > 0; o >>= 1) gm = fmaxf(gm, __shfl_xor(gm, o));
    const float bL = __shfl(bs, 63);
    dec[lane] = __expf(g - gm);
    if (lane == 0) { p.ac()[u] = bL + gm; p.Bc()[u] = bL; }
  }
  ld_tile<bf16_t>(xq + 3 * 136, PRG(0) + (size_t)ui.rowbase * 512 + hc, 512, tid);
  ld_tile<bf16_t>(xk + 3 * 136, PRG(1) + (size_t)ui.rowbase * 512 + hc, 512, tid);
  ld_T<bf16_t, 64, 72>(vT, PRG(2) + (size_t)ui.rowbase * 512 + hc, 512, tid);
  {
    const int isk = tid >> 7, ch = tid & 127, col = hc + ch;
    bf16_t* xs = isk ? xk : xq;
    if (ui.samp) {
      const float* cs = p.st_conv + (size_t)(l * 8 + ui.b) * 3072 + isk * 512 + col;
      xs[ch] = f2bf(cs[0]); xs[136 + ch] = f2bf(cs[1024]); xs[272 + ch] = f2bf(cs[2048]);
    } else if (ui.c > 0) {
      const bf16_t* src = PRG(isk) + (size_t)ui.rowbase * 512 + col;
      xs[ch] = src[-3 * 512]; xs[136 + ch] = src[-2 * 512]; xs[272 + ch] = src[-1 * 512];
    } else { xs[ch] = 0; xs[136 + ch] = 0; xs[272 + ch] = 0; }
  }
  __syncthreads();
  {
    const int isk = tid >> 7, ch = tid & 127, col = hc + ch;
    bf16_t* xs = isk ? xk : xq;
    const float* wc_ = p.w_conv + (size_t)l * 4096 + isk * 512 + col;
    const float w0 = wc_[0], w1 = wc_[1024], w2 = wc_[2048], w3 = wc_[3072];
    float x0 = bf2f(xs[ch]), x1 = bf2f(xs[136 + ch]), x2 = bf2f(xs[272 + ch]);
#pragma unroll 8
    for (int t = 0; t < 64; ++t) {
      const float x3 = bf2f(xs[(t + 3) * 136 + ch]);
      float y = silu(w0 * x0 + w1 * x1 + w2 * x2 + w3 * x3);
      if (isk) y *= 0.08838834764831845f;
      const bf16_t yb = f2bf(y);
      xs[t * 136 + ch] = yb;
      if (isk) kdT[ch * 72 + t] = f2bf(bf2f(yb) * dec[t]);
      x0 = x1; x1 = x2; x2 = x3;
    }
  }
  __syncthreads();
#pragma unroll
  for (int i = 0; i < 4; ++i) {
    const int id = tid + 256 * i, r = id >> 4, c = (id & 15) * 8;
    *(u32x4*)(p.QC() + (size_t)(ui.rowbase + r) * 512 + hc + c) = *(const u32x4*)(xq + r * 136 + c);
    *(u32x4*)(p.KC() + (size_t)(ui.rowbase + r) * 512 + hc + c) = *(const u32x4*)(xk + r * 136 + c);
  }
  if (tid < 128) { float s_ = 0.f;
#pragma unroll 8
    for (int t = 0; t < 64; ++t) s_ += bf2f(kdT[tid * 72 + t]); p.nloc()[u * 128 + tid] = s_; }
  f32x4 acc[8][2];
#pragma unroll
  for (int a_ = 0; a_ < 8; ++a_) { acc[a_][0] = (f32x4){0.f, 0.f, 0.f, 0.f}; acc[a_][1] = (f32x4){0.f, 0.f, 0.f, 0.f}; }
  wmma<8, 2, 2>(acc, kdT, 72, vT + 32 * w * 72, 72, fr, fq);
  bf16_t* sm = p.SM() + (size_t)u * 16384;
#pragma unroll
  for (int mi = 0; mi < 8; ++mi)
#pragma unroll
    for (int ni = 0; ni < 2; ++ni) {
      u32x2 pk; pk.x = pack2(acc[mi][ni][0], acc[mi][ni][1]); pk.y = pack2(acc[mi][ni][2], acc[mi][ni][3]);
      *(u32x2*)(sm + (32 * w + ni * 16 + fr) * 128 + mi * 16 + fq * 4) = pk;
    }
}

__device__ __forceinline__ float hgrn_lb(const Params& p, int l, int ch512) {
  if (l == 0) return 0.f;
  return sigm(p.lb_logits[512 + ch512] - p.lb_logits[ch512]);
}
__device__ __forceinline__ void hgrn_gate(float f, float lb, float& lg, float& kh) {
  const float e = __expf(-fabsf(f));
  const float sp = f >= 0.f ? 1.f / (1.f + e) : e / (1.f + e);
  const float sn = f >= 0.f ? e / (1.f + e) : 1.f / (1.f + e);
  lg = (lb == 0.f) ? (fminf(f, 0.f) - __logf(1.f + e)) : __logf(lb + (1.f - lb) * sp);
  kh = (1.f - lb) * sn;
}

__device__ void hgrn_local(const Params& p, int l, int u, char* smem) {
  bf16_t* kdT = (bf16_t*)smem;
  bf16_t* iT = kdT + 128 * 72;
  bf16_t* fs = iT + 128 * 72;
  float* tot = (float*)(fs + 64 * 136);
  const int tid = get_tid(), lane = tid & 63, w = tid >> 6, fr = lane & 15, fq = lane >> 4;
  const UnitInfo ui = unit_info(u);
  const int hc = ui.h * 128;
  __syncthreads();
  ld_tile<bf16_t>(fs, PRG(10) + (size_t)ui.rowbase * 512 + hc, 512, tid);
  ld_T<bf16_t, 64, 72>(iT, PRG(11) + (size_t)ui.rowbase * 512 + hc, 512, tid);
  const int half = tid >> 7, ch = tid & 127;
  const float lb = hgrn_lb(p, l, hc + ch);
  __syncthreads();
  const bf16_t* src = fs + (half * 32) * 136 + ch;
  {
    float run = 0.f;
#pragma unroll 8
    for (int t = 0; t < 32; ++t) { float lg, kh; hgrn_gate(bf2f(src[t * 136]), lb, lg, kh); run += lg; }
    tot[half * 128 + ch] = run;
  }
  __syncthreads();
  {
    const float t0 = tot[ch], t1 = tot[128 + ch];
    const float bcL = t0 + t1;
    float run = half ? t0 : 0.f;
#pragma unroll 8
    for (int t = 0; t < 32; ++t) {
      float lg, kh; hgrn_gate(bf2f(src[t * 136]), lb, lg, kh); run += lg;
      kdT[ch * 72 + half * 32 + t] = f2bf(kh * __expf(bcL - run));
    }
    if (half == 0) p.hbc()[u * 128 + ch] = bcL;
  }
  __syncthreads();
  f32x4 acc[8][2];
#pragma unroll
  for (int a_ = 0; a_ < 8; ++a_) { acc[a_][0] = (f32x4){0.f, 0.f, 0.f, 0.f}; acc[a_][1] = (f32x4){0.f, 0.f, 0.f, 0.f}; }
  wmma<8, 2, 2>(acc, kdT, 72, iT + 32 * w * 72, 72, fr, fq);
  bf16_t* sh = p.SH() + (size_t)u * 16384;
#pragma unroll
  for (int mi = 0; mi < 8; ++mi)
#pragma unroll
    for (int ni = 0; ni < 2; ++ni) {
      u32x2 pk; pk.x = pack2(acc[mi][ni][0], acc[mi][ni][1]); pk.y = pack2(acc[mi][ni][2], acc[mi][ni][3]);
      *(u32x2*)(sh + (32 * w + ni * 16 + fr) * 128 + mi * 16 + fq * 4) = pk;
    }
}

__device__ void scan_phase(const Params& p, int l, char* smem) {
  float* cdc = (float*)smem;
  float* cwl = cdc + 128;
  float* cmi = cwl + 128;
  const int tid = get_tid();
  for (int vb = blockIdx.x; vb < 520; vb += gridDim.x) {
    const int kind = vb >> 8;
    const int seq = (kind == 2) ? (vb - 512) : ((vb >> 5) & 7);
    __syncthreads();
    if (kind != 1) {
      if (tid < 128) { cdc[tid] = p.ac()[seq * 128 + tid]; cwl[tid] = p.Bc()[seq * 128 + tid]; }
      __syncthreads();
      if (tid == 0) {
        float m = 0.f;
        for (int c = 0; c < 128; ++c) {
          const float a = cdc[c], B = cwl[c];
          const float mo = fmaxf(a, B + m);
          cdc[c] = __expf(B + m - mo); cwl[c] = __expf(a - mo); cmi[c] = m; m = mo;
        }
        if (kind == 0 && (vb & 31) == 0) p.o_pm()[l * 8 + seq] = m;
      }
      __syncthreads();
      if (kind == 0 && (vb & 31) == 0 && tid < 128) p.min_()[seq * 128 + tid] = cmi[tid];
    }
    if (kind == 2) {
      if (tid < 128) {
        float n = 0.f;
        float* base = p.nloc() + (size_t)seq * 128 * 128 + tid;
        for (int c0 = 0; c0 < 128; c0 += 16) {
          float lv[16];
#pragma unroll
          for (int j = 0; j < 16; ++j) lv[j] = base[(c0 + j) * 128];
#pragma unroll
          for (int j = 0; j < 16; ++j) { const float nl = lv[j]; lv[j] = n; n = cdc[c0 + j] * n + cwl[c0 + j] * nl; }
#pragma unroll
          for (int j = 0; j < 16; ++j) base[(c0 + j) * 128] = lv[j];
        }
        p.o_pn()[(l * 8 + seq) * 128 + tid] = n;
      }
      continue;
    }
    const int pr = (vb & 31) * 256 + tid, e = pr * 2, er = e >> 7, ec = e & 127;
    unsigned* base = (unsigned*)((kind ? p.SH() : p.SM()) + (size_t)seq * 128 * 16384) + pr;
    const float* hb = p.hbc() + (size_t)seq * 128 * 128 + ec;
    float c0v = 0.f, c1v = 0.f;
    unsigned lv[16], nx[16];
    float2 hv[16], hn[16];
#pragma unroll
    for (int j = 0; j < 16; ++j) { nx[j] = base[(size_t)j * 8192]; hn[j] = kind ? *(const float2*)(hb + j * 128) : make_float2(0.f, 0.f); }
    for (int c0 = 0; c0 < 128; c0 += 16) {
#pragma unroll
      for (int j = 0; j < 16; ++j) { lv[j] = nx[j]; hv[j] = hn[j]; }
      if (c0 + 16 < 128) {
#pragma unroll
        for (int j = 0; j < 16; ++j) { nx[j] = base[(size_t)(c0 + 16 + j) * 8192]; if (kind) hn[j] = *(const float2*)(hb + (c0 + 16 + j) * 128); }
      }
#pragma unroll
      for (int j = 0; j < 16; ++j) {
        const unsigned v = lv[j];
        lv[j] = pack2(c0v, c1v);
        const float d0 = kind ? __expf(hv[j].x) : cdc[c0 + j];
        const float d1 = kind ? __expf(hv[j].y) : d0;
        const float wl = kind ? 1.f : cwl[c0 + j];
        c0v = d0 * c0v + wl * lo2f(v); c1v = d1 * c1v + wl * hi2f(v);
      }
#pragma unroll
      for (int j = 0; j < 16; ++j) base[(size_t)(c0 + j) * 8192] = lv[j];
    }
    float* o = (kind ? p.o_pS() : p.o_pC()) + (size_t)(l * 8 + seq) * 16384;
    o[ec * 128 + er] = c0v; o[(ec + 1) * 128 + er] = c1v;
  }
  const int gt = blockIdx.x * 256 + tid, nth = gridDim.x * 256;
  for (int it = gt; it < 524288; it += nth) {
    const int kind = it >> 18, sq = (it >> 13) & 31, pr = it & 8191, e = pr * 2, u = 1024 + sq, er = e >> 7, ec = e & 127;
    if (kind == 0) {
      const float* c0p = p.st_C + (size_t)(l * 32 + sq) * 16384;
      const float C0 = c0p[ec * 128 + er], C1 = c0p[(ec + 1) * 128 + er], m = p.st_m[l * 32 + sq];
      unsigned* slot = (unsigned*)(p.SM() + (size_t)u * 16384) + pr;
      const unsigned lv = *slot;
      const float a = p.ac()[u], B = p.Bc()[u];
      const float mo = fmaxf(a, B + m), dc = __expf(B + m - mo), wl = __expf(a - mo);
      *slot = pack2(C0, C1);
      float* o = p.o_sC() + (size_t)(l * 32 + sq) * 16384;
      o[ec * 128 + er] = dc * C0 + wl * lo2f(lv); o[(ec + 1) * 128 + er] = dc * C1 + wl * hi2f(lv);
      if (pr == 0) { p.min_()[u] = m; p.o_sm()[l * 32 + sq] = mo; }
    } else {
      const float* s0p = p.st_S + (size_t)(l * 32 + sq) * 16384;
      const float S0 = s0p[ec * 128 + er], S1 = s0p[(ec + 1) * 128 + er];
      unsigned* slot = (unsigned*)(p.SH() + (size_t)u * 16384) + pr;
      const unsigned lv = *slot;
      const float d0 = __expf(p.hbc()[u * 128 + ec]), d1 = __expf(p.hbc()[u * 128 + ec + 1]);
      *slot = pack2(S0, S1);
      float* o = p.o_sS() + (size_t)(l * 32 + sq) * 16384;
      o[ec * 128 + er] = d0 * S0 + lo2f(lv); o[(ec + 1) * 128 + er] = d1 * S1 + hi2f(lv);
    }
  }
  for (int it = gt; it < 4096; it += nth) {
    const int sq = it >> 7, d = it & 127, u = 1024 + sq;
    const float n0 = p.st_n[(l * 32 + sq) * 128 + d], m = p.st_m[l * 32 + sq];
    const float a = p.ac()[u], B = p.Bc()[u];
    const float mo = fmaxf(a, B + m), dc = __expf(B + m - mo), wl = __expf(a - mo);
    const float nl = p.nloc()[u * 128 + d];
    p.nloc()[u * 128 + d] = n0;
    p.o_sn()[(l * 32 + sq) * 128 + d] = dc * n0 + wl * nl;
  }
}

__device__ void mlstm_out(const Params& p, int l, int u, char* smem) {
  bf16_t* Qs = (bf16_t*)smem;
  bf16_t* CT = Qs + 64 * 136;
  bf16_t* Ks = CT;
  bf16_t* Vt = Ks + 64 * 136;
  bf16_t* Ps = Vt + 144 * 72;
  float* misc = (float*)(smem + 17408 + 47360);
  float *bsum = misc, *gs = misc + 64, *mt = misc + 128, *wint = misc + 192;
  const int tid = get_tid(), lane = tid & 63, w = tid >> 6, fr = lane & 15, fq = lane >> 4;
  const UnitInfo ui = unit_info(u);
  const int hc = ui.h * 128;
  __syncthreads();
  if (w == 0) {
    const float lfv = p.lf()[(ui.rowbase + lane) * 4 + ui.h], igv = p.ig()[(ui.rowbase + lane) * 4 + ui.h];
    float bs = lfv;
#pragma unroll
    for (int o = 1; o < 64; o <<= 1) { float t = __shfl_up(bs, o); if (lane >= o) bs += t; }
    const float g = igv - bs;
    float cm = g;
#pragma unroll
    for (int o = 1; o < 64; o <<= 1) { float t = __shfl_up(cm, o); if (lane >= o) cm = fmaxf(cm, t); }
    const float m_in = p.min_()[u];
    const float mtt = bs + fmaxf(cm, m_in);
    bsum[lane] = bs; gs[lane] = g; mt[lane] = mtt; wint[lane] = __expf(bs + m_in - mtt);
  }
  ld_tile<bf16_t>(Qs, p.QC() + (size_t)ui.rowbase * 512 + hc, 512, tid);
  ld_tile128<bf16_t>(CT, p.SM() + (size_t)u * 16384, 128, tid);
  if (tid < 128) CT[128 * 136 + tid] = f2bf(p.nloc()[u * 128 + tid]);
  for (int i = tid; i < 15 * 128; i += 256) CT[(129 + (i >> 7)) * 136 + (i & 127)] = 0;
  __syncthreads();
  f32x4 acc[9][1];
#pragma unroll
  for (int mi = 0; mi < 9; ++mi) acc[mi][0] = (f32x4){0.f, 0.f, 0.f, 0.f};
  wmma<9, 1, 4>(acc, CT, 136, Qs + 16 * w * 136, 136, fr, fq);
  const int t = 16 * w + fr;
  const float wi = wint[t];
#pragma unroll
  for (int mi = 0; mi < 9; ++mi) acc[mi][0] *= wi;
  __syncthreads();
  ld_tile<bf16_t>(Ks, p.KC() + (size_t)ui.rowbase * 512 + hc, 512, tid);
  ld_T<bf16_t, 64, 72>(Vt, PRG(2) + (size_t)ui.rowbase * 512 + hc, 512, tid);
  if (tid < 64) Vt[128 * 72 + tid] = 0x3F80;
  for (int i = tid; i < 15 * 64; i += 256) Vt[(129 + (i >> 6)) * 72 + (i & 63)] = 0;
  __syncthreads();
  f32x4 st[4][1];
#pragma unroll
  for (int mi = 0; mi < 4; ++mi) st[mi][0] = (f32x4){0.f, 0.f, 0.f, 0.f};
  wmma<4, 1, 4>(st, Ks, 136, Qs + 16 * w * 136, 136, fr, fq);
  const float bt = bsum[t], mtt = mt[t];
#pragma unroll
  for (int mi = 0; mi < 4; ++mi) {
    float a[4];
#pragma unroll
    for (int j = 0; j < 4; ++j) {
      const int s = mi * 16 + fq * 4 + j;
      a[j] = (s <= t) ? st[mi][0][j] * __expf(bt + gs[s] - mtt) : 0.f;
    }
    u32x2 pk; pk.x = pack2(a[0], a[1]); pk.y = pack2(a[2], a[3]);
    *(u32x2*)(Ps + t * 72 + mi * 16 + fq * 4) = pk;
  }
  __syncthreads();
  wmma<9, 1, 2>(acc, Vt, 72, Ps + 16 * w * 72, 72, fr, fq);
  const float den = __shfl(acc[8][0][0], fr);
  const float inv = 1.f / fmaxf(fabsf(den), __expf(-mtt));
  float ss = 0.f;
#pragma unroll
  for (int mi = 0; mi < 8; ++mi) { acc[mi][0] *= inv; ss += acc[mi][0][0] * acc[mi][0][0] + acc[mi][0][1] * acc[mi][0][1] + acc[mi][0][2] * acc[mi][0][2] + acc[mi][0][3] * acc[mi][0][3]; }
  ss += __shfl_xor(ss, 16); ss += __shfl_xor(ss, 32);
  const float rs = rsqrtf(ss * (1.f / 128.f) + 1e-6f);
  const size_t row = (size_t)ui.rowbase + t;
#pragma unroll
  for (int mi = 0; mi < 8; ++mi) {
    const int col = hc + mi * 16 + fq * 4;
    const u32x2 ov = *(const u32x2*)(PRG(3) + row * 512 + col);
    const u32x2 zv = *(const u32x2*)(PRG(4) + row * 512 + col);
    const float4 g = *(const float4*)(p.g_ml + l * 512 + col);
    const f32x4 v = acc[mi][0];
    u32x2 pk;
    pk.x = pack2(v[0] * rs * g.x * sigm(lo2f(ov.x)) * silu(lo2f(zv.x)), v[1] * rs * g.y * sigm(hi2f(ov.x)) * silu(hi2f(zv.x)));
    pk.y = pack2(v[2] * rs * g.z * sigm(lo2f(ov.y)) * silu(lo2f(zv.y)), v[3] * rs * g.w * sigm(hi2f(ov.y)) * silu(hi2f(zv.y)));
    *(u32x2*)(p.H() + row * 512 + col) = pk;
  }
}

__device__ __forceinline__ bf16x8 scale_frag(const bf16_t* src, const float* ea, const float* eb, float sgn, bool clampit) {
  u32x4 raw = *(const u32x4*)src;
  float4 a0 = *(const float4*)ea, a1 = *(const float4*)(ea + 4);
  float4 b0 = {0.f, 0.f, 0.f, 0.f}, b1 = {0.f, 0.f, 0.f, 0.f};
  if (eb) { b0 = *(const float4*)eb; b1 = *(const float4*)(eb + 4); }
  float e[8] = {a0.x - b0.x, a0.y - b0.y, a0.z - b0.z, a0.w - b0.w, a1.x - b1.x, a1.y - b1.y, a1.z - b1.z, a1.w - b1.w};
  float v[8] = {lo2f(raw.x), hi2f(raw.x), lo2f(raw.y), hi2f(raw.y), lo2f(raw.z), hi2f(raw.z), lo2f(raw.w), hi2f(raw.w)};
  unsigned o[4];
#pragma unroll
  for (int i = 0; i < 4; ++i) {
    float x0 = sgn * e[2 * i], x1 = sgn * e[2 * i + 1];
    if (clampit) { x0 = fminf(x0, 80.f); x1 = fminf(x1, 80.f); }
    o[i] = pack2(v[2 * i] * __expf(x0), v[2 * i + 1] * __expf(x1));
  }
  u32x4 r = {o[0], o[1], o[2], o[3]};
  return __builtin_bit_cast(bf16x8, r);
}

__device__ void hgrn_out(const Params& p, int l, int u, char* smem) {
  float* bc = (float*)smem;
  bf16_t* ST = (bf16_t*)smem;
  bf16_t* qs = (bf16_t*)(smem + 34816);
  bf16_t* kh = (bf16_t*)(smem + 34816 + 17408);
  bf16_t* iT = kh;
  bf16_t* Ps = (bf16_t*)(smem + 34816 + 17408 + 18432);
  float* tot = (float*)(smem + 79872);
  const int tid = get_tid(), lane = tid & 63, w = tid >> 6, fr = lane & 15, fq = lane >> 4;
  const UnitInfo ui = unit_info(u);
  const int hc = ui.h * 128;
  __syncthreads();
  ld_tile<bf16_t>(qs, PRG(9) + (size_t)ui.rowbase * 512 + hc, 512, tid);
  ld_tile<bf16_t>(kh, PRG(10) + (size_t)ui.rowbase * 512 + hc, 512, tid);
  __syncthreads();
  {
    const int half = tid >> 7, ch = tid & 127;
    const float lb = hgrn_lb(p, l, hc + ch);
    bf16_t* src = kh + (half * 32) * 136 + ch;
    float run = 0.f;
#pragma unroll 8
    for (int t = 0; t < 32; ++t) { float lg, k; hgrn_gate(bf2f(src[t * 136]), lb, lg, k); run += lg; }
    tot[half * 128 + ch] = run;
    __syncthreads();
    run = half ? tot[ch] : 0.f;
#pragma unroll 8
    for (int t = 0; t < 32; ++t) {
      float lg, k; hgrn_gate(bf2f(src[t * 136]), lb, lg, k); run += lg;
      bc[(half * 32 + t) * 132 + ch] = run;
      src[t * 136] = f2bf(k);
    }
  }
  __syncthreads();
  {
    const int I = w, t = 16 * I + fr;
    f32x4 a[4];
#pragma unroll
    for (int J = 0; J < 4; ++J) a[J] = (f32x4){0.f, 0.f, 0.f, 0.f};
#pragma unroll
    for (int kk = 0; kk < 4; ++kk) {
      const int c0 = kk * 32 + fq * 8;
      const float* rI = (I > 0) ? bc + (16 * I - 1) * 132 + c0 : nullptr;
      const bf16x8 bq = scale_frag(qs + t * 136 + c0, bc + t * 132 + c0, rI, 1.f, false);
#pragma unroll
      for (int J = 0; J < 4; ++J) {
        if (J <= I) {
          const int s = 16 * J + fr;
          const bf16x8 ak = scale_frag(kh + s * 136 + c0, bc + s * 132 + c0, rI, -1.f, true);
          a[J] = __builtin_amdgcn_mfma_f32_16x16x32_bf16(ak, bq, a[J], 0, 0, 0);
        }
      }
    }
#pragma unroll
    for (int J = 0; J < 4; ++J) {
      float v[4];
#pragma unroll
      for (int j = 0; j < 4; ++j) { const int s = 16 * J + fq * 4 + j; v[j] = (s <= t) ? a[J][j] : 0.f; }
      u32x2 pk; pk.x = pack2(v[0], v[1]); pk.y = pack2(v[2], v[3]);
      *(u32x2*)(Ps + t * 72 + J * 16 + fq * 4) = pk;
    }
  }
  __syncthreads();
#pragma unroll 4
  for (int i = tid; i < 64 * 128; i += 256) { const int t = i >> 7, c = i & 127; qs[t * 136 + c] = f2bf(bf2f(qs[t * 136 + c]) * __expf(bc[t * 132 + c])); }
  __syncthreads();
  ld_T<bf16_t, 64, 72>(iT, PRG(11) + (size_t)ui.rowbase * 512 + hc, 512, tid);
  ld_tile128<bf16_t>(ST, p.SH() + (size_t)u * 16384, 128, tid);
  __syncthreads();
  f32x4 acc[8][1];
#pragma unroll
  for (int mi = 0; mi < 8; ++mi) acc[mi][0] = (f32x4){0.f, 0.f, 0.f, 0.f};
  wmma<8, 1, 2>(acc, iT, 72, Ps + 16 * w * 72, 72, fr, fq);
  wmma<8, 1, 4>(acc, ST, 136, qs + 16 * w * 136, 136, fr, fq);
  float ss = 0.f;
#pragma unroll
  for (int mi = 0; mi < 8; ++mi) ss += acc[mi][0][0] * acc[mi][0][0] + acc[mi][0][1] * acc[mi][0][1] + acc[mi][0][2] * acc[mi][0][2] + acc[mi][0][3] * acc[mi][0][3];
  ss += __shfl_xor(ss, 16); ss += __shfl_xor(ss, 32);
  const float rs = rsqrtf(ss * (1.f / 128.f) + 1e-6f);
  const size_t row = (size_t)ui.rowbase + 16 * w + fr;
#pragma unroll
  for (int mi = 0; mi < 8; ++mi) {
    const int col = hc + mi * 16 + fq * 4;
    const u32x2 zv = *(const u32x2*)(PRG(12) + row * 512 + col);
    const float4 g = *(const float4*)(p.g_hg + l * 512 + col);
    const f32x4 v = acc[mi][0];
    u32x2 pk;
    pk.x = pack2(v[0] * rs * g.x * silu(lo2f(zv.x)), v[1] * rs * g.y * silu(hi2f(zv.x)));
    pk.y = pack2(v[2] * rs * g.z * silu(lo2f(zv.y)), v[3] * rs * g.w * silu(hi2f(zv.y)));
    *(u32x2*)(p.H() + (size_t)2 * NTOK * 512 + row * 512 + col) = pk;
  }
}

__device__ void merge_tile(const Params& p, int l, int t, char* smem) {
  const int tm = t >> 3, tn = t & 7;
  const int tid = get_tid(), lane = tid & 63, wid = tid >> 6, wr = wid >> 1, wc = wid & 1, fr = lane & 15, fq = lane >> 4;
#pragma unroll 1
  for (int b = 0; b < 3; ++b) {
    f32x4 acc[4][4]; zero_acc(acc);
    gemm_kloop<bf16_t>(acc, p.U() + (size_t)tm * 128 * 1024, 1024, p.wt_in() + (size_t)l * NWT * 1024 + (size_t)(NMAIN + b * 1024 + tn * 128) * 1024, 1024, 1024, smem);
#pragma unroll
    for (int ni = 0; ni < 4; ++ni)
#pragma unroll
      for (int mi = 0; mi < 4; ++mi) {
        f32x4 v; v[0] = sigm(acc[mi][ni][0]); v[1] = sigm(acc[mi][ni][1]); v[2] = sigm(acc[mi][ni][2]); v[3] = sigm(acc[mi][ni][3]);
        *(f32x4*)(p.r() + ((size_t)tm * 128 + wr * 64 + ni * 16 + fr) * 1024 + tn * 128 + wc * 64 + mi * 16 + fq * 4) = v;
      }
    zero_acc(acc);
    gemm_kloop<bf16_t>(acc, p.H() + (size_t)b * NTOK * 512 + (size_t)tm * 128 * 512, 512, p.wt_br() + (size_t)(l * 3 + b) * 1024 * 512 + (size_t)tn * 128 * 512, 512, 512, smem);
#pragma unroll
    for (int ni = 0; ni < 4; ++ni) {
      const size_t row = (size_t)tm * 128 + wr * 64 + ni * 16 + fr;
#pragma unroll
      for (int mi = 0; mi < 4; ++mi) {
        const int col = tn * 128 + wc * 64 + mi * 16 + fq * 4;
        f32x4 v = *(const f32x4*)(p.r() + row * 1024 + col) * acc[mi][ni];
        float* part = p.y() + row * 1024 + col;
        if (b > 0) v += *(const f32x4*)part;
        if (b < 2) *(f32x4*)part = v;
        else { u32x2 pk; pk.x = pack2(v[0], v[1]); pk.y = pack2(v[2], v[3]); *(u32x2*)(p.merged() + row * 1024 + col) = pk; }
      }
    }
  }
}

__device__ void outproj_tile(const Params& p, int l, int t, char* smem) {
  const int tm = t >> 3, tn = t & 7;
  const int tid = get_tid(), lane = tid & 63, wid = tid >> 6, wr = wid >> 1, wc = wid & 1, fr = lane & 15, fq = lane >> 4;
  f32x4 acc[4][4]; zero_acc(acc);
  gemm_kloop<bf16_t>(acc, p.merged() + (size_t)tm * 128 * 1024, 1024, p.wt_out() + (size_t)l * 1048576 + (size_t)tn * 128 * 1024, 1024, 1024, smem);
#pragma unroll
  for (int ni = 0; ni < 4; ++ni) {
    const size_t row = (size_t)tm * 128 + wr * 64 + ni * 16 + fr;
#pragma unroll
    for (int mi = 0; mi < 4; ++mi) *(f32x4*)(p.y() + row * 1024 + tn * 128 + wc * 64 + mi * 16 + fq * 4) = acc[mi][ni];
  }
}


__device__ void outproj_tile256(const Params& p, int l, int t, char* smem) {
  constexpr int NT = 8;
  const int tm = t >> 3, tn = t & 7;
  const int tid = get_tid(), lane = tid & 63, wid = tid >> 6, wr = wid >> 1, wc = wid & 1, fr = lane & 15, fq = lane >> 4;
  f32x4 acc[4][NT];
#pragma unroll
  for (int a_ = 0; a_ < 4; ++a_)
#pragma unroll
    for (int b_ = 0; b_ < NT; ++b_) acc[a_][b_] = (f32x4){0.f, 0.f, 0.f, 0.f};
  gemm_glds<NT, 3>(acc, p.merged() + (size_t)tm * 256 * 1024, 1024, p.wt_out() + (size_t)l * 1048576 + (size_t)tn * 128 * 1024, 1024, 1024, smem);
#pragma unroll
  for (int ni = 0; ni < NT; ++ni) {
    const size_t row = (size_t)tm * 256 + wr * 128 + ni * 16 + fr;
#pragma unroll
    for (int mi = 0; mi < 4; ++mi) *(f32x4*)(p.y() + row * 1024 + tn * 128 + wc * 64 + mi * 16 + fq * 4) = acc[mi][ni];
  }
}


__device__ void gate_tile256(const Params& p, int l, int t, char* smem) {
  constexpr int NT = 8;
  const int tm = t / 24, tn = t % 24;
  const int tid = get_tid(), lane = tid & 63, wid = tid >> 6, wr = wid >> 1, wc = wid & 1, fr = lane & 15, fq = lane >> 4;
  f32x4 acc[4][NT];
#pragma unroll
  for (int a_ = 0; a_ < 4; ++a_)
#pragma unroll
    for (int b_ = 0; b_ < NT; ++b_) acc[a_][b_] = (f32x4){0.f, 0.f, 0.f, 0.f};
  gemm_glds<NT, 3>(acc, p.U() + (size_t)tm * 256 * 1024, 1024, p.wt_in() + (size_t)l * NWT * 1024 + (size_t)(NMAIN + tn * 128) * 1024, 1024, 1024, smem);
#pragma unroll
  for (int ni = 0; ni < NT; ++ni) {
    const size_t row = (size_t)tm * 256 + wr * 128 + ni * 16 + fr;
#pragma unroll
    for (int mi = 0; mi < 4; ++mi) {
      u32x2 pk; pk.x = pack2(sigm(acc[mi][ni][0]), sigm(acc[mi][ni][1])); pk.y = pack2(sigm(acc[mi][ni][2]), sigm(acc[mi][ni][3]));
      *(u32x2*)(p.G() + row * 3072 + tn * 128 + wc * 64 + mi * 16 + fq * 4) = pk;
    }
  }
}
__device__ void merge_tile_g(const Params& p, int l, int t, char* smem) {
  const int tm = t >> 3, tn = t & 7;
  const int tid = get_tid(), lane = tid & 63, wid = tid >> 6, wr = wid >> 1, wc = wid & 1, fr = lane & 15, fq = lane >> 4;
  f32x4 macc[4][4]; zero_acc(macc);
#pragma unroll 1
  for (int b = 0; b < 3; ++b) {
    f32x4 acc[4][4]; zero_acc(acc);
    gemm_kloop<bf16_t>(acc, p.H() + (size_t)b * NTOK * 512 + (size_t)tm * 128 * 512, 512, p.wt_br() + (size_t)(l * 3 + b) * 1024 * 512 + (size_t)tn * 128 * 512, 512, 512, smem);
#pragma unroll
    for (int ni = 0; ni < 4; ++ni) {
      const size_t row = (size_t)tm * 128 + wr * 64 + ni * 16 + fr;
#pragma unroll
      for (int mi = 0; mi < 4; ++mi) {
        const u32x2 g = *(const u32x2*)(p.G() + row * 3072 + b * 1024 + tn * 128 + wc * 64 + mi * 16 + fq * 4);
        macc[mi][ni][0] += lo2f(g.x) * acc[mi][ni][0]; macc[mi][ni][1] += hi2f(g.x) * acc[mi][ni][1];
        macc[mi][ni][2] += lo2f(g.y) * acc[mi][ni][2]; macc[mi][ni][3] += hi2f(g.y) * acc[mi][ni][3];
      }
    }
  }
#pragma unroll
  for (int ni = 0; ni < 4; ++ni) {
    const size_t row = (size_t)tm * 128 + wr * 64 + ni * 16 + fr;
#pragma unroll
    for (int mi = 0; mi < 4; ++mi) {
      u32x2 pk; pk.x = pack2(macc[mi][ni][0], macc[mi][ni][1]); pk.y = pack2(macc[mi][ni][2], macc[mi][ni][3]);
      *(u32x2*)(p.merged() + row * 1024 + tn * 128 + wc * 64 + mi * 16 + fq * 4) = pk;
    }
  }
}

__device__ void postnorm_phase(const Params& p, int l) {
  const int lane = threadIdx.x & 63, wid = threadIdx.x >> 6;
  const float* gp = p.g_post + l * 1024;
  for (int row = blockIdx.x * 4 + wid; row < NTOK; row += gridDim.x * 4) {
    const float* x = xrow(p, l, row);
    const float* y = p.y() + (size_t)row * 1024;
    float4 v[4]; float ss = 0.f;
#pragma unroll
    for (int i = 0; i < 4; ++i) { v[i] = *(const float4*)(y + i * 256 + lane * 4); ss += v[i].x * v[i].x + v[i].y * v[i].y + v[i].z * v[i].z + v[i].w * v[i].w; }
#pragma unroll
    for (int o = 32; o > 0; o >>= 1) ss += __shfl_xor(ss, o);
    const float rstd = rsqrtf(ss * (1.f / 1024.f) + 1e-6f);
#pragma unroll
    for (int i = 0; i < 4; ++i) {
      const int k = i * 256 + lane * 4;
      const float4 g = *(const float4*)(gp + k), xv = *(const float4*)(x + k);
      float4 r; r.x = xv.x + v[i].x * rstd * g.x; r.y = xv.y + v[i].y * rstd * g.y; r.z = xv.z + v[i].z * rstd * g.z; r.w = xv.w + v[i].w * rstd * g.w;
      *(float4*)(p.r() + (size_t)row * 1024 + k) = r;
      u32x2 pk; pk.x = pack2(r.x, r.y); pk.y = pack2(r.z, r.w);
      *(u32x2*)(p.rb() + (size_t)row * 1024 + k) = pk;
    }
  }
}

__device__ void ple_tile(const Params& p, int l, int t, char* smem) {
  const int tm = t >> 3, tn = t & 7;
  const int tid = get_tid(), lane = tid & 63, wid = tid >> 6, wr = wid >> 1, wc = wid & 1, fr = lane & 15, fq = lane >> 4;
  f32x4 acc[4][4]; zero_acc(acc);
  const int row0 = tm * 128;
  const float* pp = row0 < NPROMPT ? p.p_p + ((size_t)l * NPROMPT + row0) * 256 : p.p_s + ((size_t)l * 512 + (row0 - NPROMPT)) * 256;
  gemm_kloop<float>(acc, pp, 256, p.wt_pp() + (size_t)l * 262144 + (size_t)tn * 128 * 256, 256, 256, smem);
  u32x2 pb[4][4];
#pragma unroll
  for (int a = 0; a < 4; ++a)
#pragma unroll
    for (int c = 0; c < 4; ++c) { pb[a][c].x = pack2(acc[a][c][0], acc[a][c][1]); pb[a][c].y = pack2(acc[a][c][2], acc[a][c][3]); }
  zero_acc(acc);
  gemm_kloop<bf16_t>(acc, p.rb() + (size_t)tm * 128 * 1024, 1024, p.wt_pg() + (size_t)l * 1048576 + (size_t)tn * 128 * 1024, 1024, 1024, smem);
#pragma unroll
  for (int ni = 0; ni < 4; ++ni) {
    const size_t row = (size_t)row0 + wr * 64 + ni * 16 + fr;
#pragma unroll
    for (int mi = 0; mi < 4; ++mi) {
      const int col = tn * 128 + wc * 64 + mi * 16 + fq * 4;
      const f32x4 rv = *(const f32x4*)(p.r() + row * 1024 + col);
      f32x4 o;
      o[0] = rv[0] + sigm(acc[mi][ni][0]) * lo2f(pb[mi][ni].x); o[1] = rv[1] + sigm(acc[mi][ni][1]) * hi2f(pb[mi][ni].x);
      o[2] = rv[2] + sigm(acc[mi][ni][2]) * lo2f(pb[mi][ni].y); o[3] = rv[3] + sigm(acc[mi][ni][3]) * hi2f(pb[mi][ni].y);
      *(f32x4*)(p.o_y() + row * 1024 + col) = o;
    }
  }
}


template <typename TT>
__device__ __forceinline__ void mini_dot(f32x4& acc, const TT* Trow, const bf16_t* Wrow, int K) {
#pragma unroll 8
  for (int k = 0; k < K; k += 32) {
    const u32x4 tv = ld8(Trow + k), wv = ld8(Wrow + k);
    acc = __builtin_amdgcn_mfma_f32_16x16x32_bf16(__builtin_bit_cast(bf16x8, wv), __builtin_bit_cast(bf16x8, tv), acc, 0, 0, 0);
  }
}
__device__ void merge_mini(const Params& p, int l, int j) {
  const int tid = get_tid(), lane = tid & 63, w = tid >> 6, fr = lane & 15, fq = lane >> 4;
  const size_t row = (size_t)NPROMPT + (j >> 4) * 16 + fr;
  const int cb = (j & 15) * 64 + w * 16;
  f32x4 out = {0.f, 0.f, 0.f, 0.f};
#pragma unroll 1
  for (int b = 0; b < 3; ++b) {
    f32x4 g = {0.f, 0.f, 0.f, 0.f}, h = {0.f, 0.f, 0.f, 0.f};
    mini_dot<bf16_t>(g, p.U() + row * 1024 + fq * 8, p.wt_in() + (size_t)l * NWT * 1024 + (size_t)(NMAIN + b * 1024 + cb + fr) * 1024 + fq * 8, 1024);
    mini_dot<bf16_t>(h, p.H() + (size_t)b * NTOK * 512 + row * 512 + fq * 8, p.wt_br() + (size_t)(l * 3 + b) * 1024 * 512 + (size_t)(cb + fr) * 512 + fq * 8, 512);
    out[0] += sigm(g[0]) * h[0]; out[1] += sigm(g[1]) * h[1]; out[2] += sigm(g[2]) * h[2]; out[3] += sigm(g[3]) * h[3];
  }
  u32x2 pk; pk.x = pack2(out[0], out[1]); pk.y = pack2(out[2], out[3]);
  *(u32x2*)(p.merged() + row * 1024 + cb + fq * 4) = pk;
}
__device__ void outproj_mini(const Params& p, int l, int j) {
  const int tid = get_tid(), lane = tid & 63, w = tid >> 6, fr = lane & 15, fq = lane >> 4;
  const size_t row = (size_t)NPROMPT + (j >> 4) * 16 + fr;
  const int cb = (j & 15) * 64 + w * 16;
  f32x4 y = {0.f, 0.f, 0.f, 0.f};
  mini_dot<bf16_t>(y, p.merged() + row * 1024 + fq * 8, p.wt_out() + (size_t)l * 1048576 + (size_t)(cb + fr) * 1024 + fq * 8, 1024);
  *(f32x4*)(p.y() + row * 1024 + cb + fq * 4) = y;
}
__device__ void ple_mini(const Params& p, int l, int j) {
  const int tid = get_tid(), lane = tid & 63, w = tid >> 6, fr = lane & 15, fq = lane >> 4;
  const int srow = (j >> 4) * 16 + fr;
  const size_t row = (size_t)NPROMPT + srow;
  const int cb = (j & 15) * 64 + w * 16;
  f32x4 g = {0.f, 0.f, 0.f, 0.f}, pa = {0.f, 0.f, 0.f, 0.f};
  mini_dot<float>(pa, p.p_s + ((size_t)l * 512 + srow) * 256 + fq * 8, p.wt_pp() + (size_t)l * 262144 + (size_t)(cb + fr) * 256 + fq * 8, 256);
  mini_dot<bf16_t>(g, p.rb() + row * 1024 + fq * 8, p.wt_pg() + (size_t)l * 1048576 + (size_t)(cb + fr) * 1024 + fq * 8, 1024);
  const f32x4 rv = *(const f32x4*)(p.r() + row * 1024 + cb + fq * 4);
  f32x4 o; o[0] = rv[0] + sigm(g[0]) * pa[0]; o[1] = rv[1] + sigm(g[1]) * pa[1]; o[2] = rv[2] + sigm(g[2]) * pa[2]; o[3] = rv[3] + sigm(g[3]) * pa[3];
  *(f32x4*)(p.o_y() + row * 1024 + cb + fq * 4) = o;
}

#define XB_TMO      128
#define XB_XCNT(j)  (256  + 64 * (j))
#define XB_XSUB(j)  (1280 + 64 * (j))
#define XB_XGEN(j)  (2304 + 64 * (j))
#define XB_TOP      3328
#define XB_TOPGEN   3392
#define XCD_BAR_WORDS 3456
#define XB_SPIN_CAP (1u << 18)
#define LAS __attribute__((address_space(3)))
__device__ __forceinline__ unsigned xb_ld(unsigned* p)              { return __hip_atomic_load(p, __ATOMIC_RELAXED, __HIP_MEMORY_SCOPE_AGENT); }
__device__ __forceinline__ unsigned xb_add(unsigned* p, unsigned v) { return __hip_atomic_fetch_add(p, v, __ATOMIC_RELAXED, __HIP_MEMORY_SCOPE_AGENT); }
__device__ __forceinline__ unsigned xb_xcc_id() { return (unsigned)__builtin_amdgcn_s_getreg((3 << 11) | 20) & 0xFu; }
#define XB_SPIN(cond, bar) do { unsigned _sp = 0; while (cond) { __builtin_amdgcn_s_sleep(1); \
    if ((++_sp & 255u) == 0u) { if (xb_ld(&(bar)[XB_TMO])) break; if (_sp > XB_SPIN_CAP) { atomicAdd(&(bar)[XB_TMO], 1u); break; } } } } while (0)
__device__ __forceinline__ void xcd_barrier_complete(unsigned* bar, unsigned x, unsigned& nloc, unsigned& nx) {
    const unsigned G = gridDim.x * gridDim.y * gridDim.z;
    unsigned sum, cnt, mine, sp = 0u;
    for (;;) {
        sum = 0u; cnt = 0u; mine = 0u;
#pragma unroll
        for (unsigned j = 0; j < 16; ++j) { const unsigned c = xb_ld(&bar[XB_XCNT(j)]); sum += c; cnt += (c > 0u) ? 1u : 0u; mine = (j == x) ? c : mine; }
        if (sum == G) break;
        __builtin_amdgcn_s_sleep(1);
        if ((++sp & 255u) == 0u) { if (xb_ld(&bar[XB_TMO])) break; if (sp > XB_SPIN_CAP) { atomicAdd(&bar[XB_TMO], 1u); break; } }
    }
    nloc = mine > 0u ? mine : 1u; nx = cnt > 0u ? cnt : 1u;
}
__device__ __forceinline__ void xcd_barrier(unsigned* bar, volatile LAS unsigned* st) {
    asm volatile("s_waitcnt vmcnt(0)" ::: "memory");
    __syncthreads();
    if (threadIdx.x == 0) {
        const unsigned x = xb_xcc_id();
        __builtin_amdgcn_s_waitcnt(0);
        unsigned nloc = st[0], nx = st[1];
        if (nloc == 0u) { xcd_barrier_complete(bar, x, nloc, nx); st[0] = nloc; st[1] = nx; }
        const unsigned old = xb_add(&bar[XB_XSUB(x)], 1u);
        const unsigned gen = old / nloc;
        if (old + 1u == (gen + 1u) * nloc) {
            __builtin_amdgcn_fence(__ATOMIC_RELEASE, "agent");
            asm volatile("s_waitcnt vmcnt(0)" ::: "memory");
            const unsigned og = xb_add(&bar[XB_TOP], 1u);
            const unsigned tg = og / nx;
            if (og + 1u == (tg + 1u) * nx) xb_add(&bar[XB_TOPGEN], 1u);
            else XB_SPIN(xb_ld(&bar[XB_TOPGEN]) == tg, bar);
            __builtin_amdgcn_fence(__ATOMIC_ACQUIRE, "agent");
            xb_add(&bar[XB_XGEN(x)], 1u);
            asm volatile("s_waitcnt vmcnt(0)" ::: "memory");
        } else {
            XB_SPIN(xb_ld(&bar[XB_XGEN(x)]) == gen, bar);
            __builtin_amdgcn_fence(__ATOMIC_ACQUIRE, "agent");
            asm volatile("s_waitcnt vmcnt(0)" ::: "memory");
        }
    }
    __syncthreads();
}

template <int PH>
__device__ __forceinline__ void run_phase(const Params& p, char* smem) {
  const int bid = blockIdx.x, nb = gridDim.x;
  if (PH == 0) {
    for (int t = bid; t < 6784; t += nb) wconv_tile(p, t, smem);
    for (int i = bid * 256 + get_tid(); i < 2 * 8 * 1024; i += nb * 256) { const int ll = i >> 13, j = (i >> 10) & 7, k = i & 1023; p.wg8()[i] = p.w_in[((size_t)ll * 1024 + k) * NINSRC + 2560 + j]; }
    return;
  }
  constexpr int l = (PH - 1) / NPL, s0_ = (PH - 1) % NPL, s = s0_ < 5 ? s0_ : s0_ - 1;
  if (s0_ == 5) return;
  if (!((PHMASK >> s) & 1)) return;
  switch (s) {
    case 0: norm_phase(p, l); break;
    case 1: {
      const int per = (66 * 52) / 8, xcd = bid & 7, nloc = (nb + 7 - xcd) >> 3;
      for (int j = bid >> 3; j < per; j += nloc) {
        const int sq = xcd * per + j;
        const int tmg = sq / 416, rem = sq % 416, gm = (tmg == 8) ? 2 : 8;
        const int tng = rem / (gm * 8), rem2 = rem % (gm * 8), wdt = (tng == 6) ? 4 : 8;
        inproj_tile(p, l, (tmg * 8 + rem2 / wdt) * 52 + tng * 8 + rem2 % wdt, smem);
      }
      break;
    }
    case 2:
      for (int v = bid; v < 3 * NUNIT; v += nb) {
        const int ty = v % 3, u = v / 3;
        if (ty == 0) sb_unit(p, l, u, smem); else if (ty == 1) mlstm_local(p, l, u, smem); else hgrn_local(p, l, u, smem);
      }
      break;
    case 3: scan_phase(p, l, smem); break;
    case 4:
      for (int v = bid; v < 2 * NUNIT; v += nb) { if (v & 1) hgrn_out(p, l, v >> 1, smem); else mlstm_out(p, l, v >> 1, smem); }
      break;
    case 5: for (int t = bid; t < 1024; t += nb) merge_tile(p, l, t, smem); for (int j = bid; j < 512; j += nb) merge_mini(p, l, j); break;
    case 6: for (int t = bid; t < 1024; t += nb) outproj_tile(p, l, t, smem); for (int j = bid; j < 512; j += nb) outproj_mini(p, l, j); break;
    case 7: postnorm_phase(p, l); break;
    case 8: for (int t = bid; t < 1024; t += nb) ple_tile(p, l, t, smem); for (int j = bid; j < 512; j += nb) ple_mini(p, l, j); break;
  }
}

template <int PH>
__global__ void __launch_bounds__(256, 2) phase_kernel(Params p) {
  __shared__ __attribute__((aligned(16))) char smem[SMEM_BYTES];
  run_phase<PH>(p, smem);
}

#if FUSED
__device__ __forceinline__ int fetch_work(unsigned* ctr, volatile int* slot) {
  __syncthreads();
  if (threadIdx.x == 0) *slot = (int)__hip_atomic_fetch_add(ctr, 1u, __ATOMIC_RELAXED, __HIP_MEMORY_SCOPE_AGENT);
  __syncthreads();
  return *slot;
}
__device__ __forceinline__ void run_phase_rt(const Params& p, int ph, char* smem, volatile int* wslot) {
  const int bid = blockIdx.x, nb = gridDim.x;
  unsigned* ctr = (unsigned*)(p.ws + WS_BAR + 14336) + ph * 16;
  if (ph == 0) {
    for (int t = bid; t < 6784; t += nb) wconv_tile(p, t, smem);
    for (int i = bid * 256 + get_tid(); i < 2 * 8 * 1024; i += nb * 256) { const int ll = i >> 13, j = (i >> 10) & 7, k = i & 1023; p.wg8()[i] = p.w_in[((size_t)ll * 1024 + k) * NINSRC + 2560 + j]; }
    return;
  }
  const int l = (ph - 1) / NPL, s = (ph - 1) % NPL;
  switch (s) {
    case 0: norm_phase(p, l); break;
    case 1: {
      const int per = (66 * 52) / 8, xcd0 = (int)(xb_xcc_id() & 7u);
      for (int dx = 0; dx < 8; ++dx) {
        const int xcd = (xcd0 + dx) & 7;
        for (;;) {
          const int j = fetch_work(ctr + xcd, wslot);
          if (j >= per) break;
          const int sq = xcd * per + j;
          const int tmg = sq / 416, rem = sq % 416, gm = (tmg == 8) ? 2 : 8;
          const int tng = rem / (gm * 8), rem2 = rem % (gm * 8), wdt = (tng == 6) ? 4 : 8;
          inproj_tile(p, l, (tmg * 8 + rem2 / wdt) * 52 + tng * 8 + rem2 % wdt, smem);
        }
      }
      break;
    }
    case 2:
      for (;;) {
        const int v = fetch_work(ctr, wslot);
        if (v >= 3 * NUNIT) break;
        if (v < NUNIT) sb_unit(p, l, v, smem); else if (v < 2 * NUNIT) mlstm_local(p, l, v - NUNIT, smem); else hgrn_local(p, l, v - 2 * NUNIT, smem);
      }
      break;
    case 3: scan_phase(p, l, smem); break;
    case 4:
      for (;;) {
        const int v = fetch_work(ctr, wslot);
        if (v >= 2 * NUNIT) break;
        if (v < NUNIT) hgrn_out(p, l, v, smem); else mlstm_out(p, l, v - NUNIT, smem);
      }
      break;
    case 5: for (;;) { const int v = fetch_work(ctr, wslot); if (v >= 1536) break; gate_tile256(p, l, v, smem); } break;
    case 6: for (;;) { const int v = fetch_work(ctr, wslot); if (v >= 1536) break; if (v < 1024) merge_tile_g(p, l, v, smem); else merge_mini(p, l, v - 1024); } break;
    case 7: for (;;) { const int v = fetch_work(ctr, wslot); if (v >= 1024) break; if (v < 512) outproj_tile256(p, l, v, smem); else outproj_mini(p, l, v - 512); } break;
    case 8: postnorm_phase(p, l); break;
    case 9: for (;;) { const int v = fetch_work(ctr, wslot); if (v >= 1536) break; if (v < 1024) ple_tile(p, l, v, smem); else ple_mini(p, l, v - 1024); } break;
  }
}

__global__ void __launch_bounds__(256, 2) mega(Params p_unused) {
  __shared__ __attribute__((aligned(16))) char smem[SMEM_BYTES];
  __shared__ uint4 xb_words;
  __shared__ int wslot;
  if (threadIdx.x == 0) {
    typedef const Params __attribute__((address_space(4))) * KP4;
    KP4 kp = (KP4)__builtin_amdgcn_kernarg_segment_ptr();
    asm volatile("" : "+s"(kp));
    char* wsb = ((const Params*)kp)->ws;
    xb_words = make_uint4(0u, 0u, 0u, 0u); (void)xb_add((unsigned*)(wsb + WS_BAR) + XB_XCNT(xb_xcc_id()), 1u);
  }
  __syncthreads();
  typedef const Params __attribute__((address_space(4))) * KP4;
#ifdef PROBE_KIND
  unsigned long long t_acc = 0;
#endif
#pragma unroll 1
  for (int ph = 0; ph < NPHASE; ++ph) {
    KP4 kp = (KP4)__builtin_amdgcn_kernarg_segment_ptr();
    asm volatile("" : "+s"(kp));
    const Params q = *(const Params*)kp;
#ifdef PROBE_KIND
    const unsigned long long tp0 = __builtin_amdgcn_s_memrealtime();
#endif
    run_phase_rt(q, ph, smem, &wslot);
#ifdef PROBE_KIND
    const unsigned long long tp1 = __builtin_amdgcn_s_memrealtime();
    if ((PROBE_KIND == 9 && ph == 0) || (PROBE_KIND < 9 && ph > 0 && (ph - 1) % NPL == PROBE_KIND)) t_acc += tp1 - tp0;
#endif
    if (ph + 1 < NPHASE) xcd_barrier((unsigned*)(q.ws + WS_BAR), (volatile LAS unsigned*)&xb_words);
    if (gridDim.y == 7777u) cg::this_grid().sync();
#ifdef PROBE_KIND
    if (PROBE_KIND == 10 && (PROBE_SEL < 0 || (ph > 0 && (ph - 1) % NPL == PROBE_SEL))) t_acc += __builtin_amdgcn_s_memrealtime() - tp1;
#endif
  }
#ifdef PROBE_KIND
  if (blockIdx.x == PROBE_BLOCK) { const unsigned long long te = __builtin_amdgcn_s_memrealtime(); while (__builtin_amdgcn_s_memrealtime() - te < 4 * t_acc) __builtin_amdgcn_s_sleep(32); }
#endif
}
#endif

template <int PH>
static void launch_all(const Params& p, int grid, hipStream_t stream) {
  hipLaunchKernelGGL(phase_kernel<PH>, dim3(grid), dim3(256), 0, stream, p);
  if constexpr (PH + 1 < NPHASE) launch_all<PH + 1>(p, grid, stream);
}

extern "C" void kernel_launch(void* const* d_in, const int* in_sizes, int n_in, void* d_out, int out_size, void* d_ws, size_t ws_size, hipStream_t stream) {
  Params p;
  memset(&p, 0, sizeof(p));
  const float* const* in = (const float* const*)d_in;
  p.x_p = in[0]; p.x_s = in[1]; p.p_p = in[2]; p.p_s = in[3]; p.st_C = in[4]; p.st_n = in[5]; p.st_m = in[6]; p.st_conv = in[7];
  p.ck = in[8]; p.cv = in[9]; p.st_S = in[10]; p.g_pre = in[11]; p.w_in = in[12]; p.b_i = in[13]; p.b_f = in[14]; p.w_conv = in[15];
  p.g_ml = in[16]; p.lb_logits = in[17]; p.g_hg = in[18]; p.w_br = in[19]; p.w_out = in[20]; p.g_post = in[21]; p.w_pg = in[22]; p.w_pp = in[23];
  p.out = (float*)d_out; p.ws = (char*)d_ws;
  if (WS_TOTAL > ws_size || (size_t)out_size < O_TOTAL) { fprintf(stderr, "workspace/out too small: need %zu have %zu\n", (size_t)WS_TOTAL, ws_size); return; }
  static int grid_blocks = 0;
  if (!grid_blocks) {
    int dev = 0, cus = 0, per_cu = 0;
    (void)hipGetDevice(&dev);
    (void)hipDeviceGetAttribute(&cus, hipDeviceAttributeMultiprocessorCount, dev);
#if FUSED
    (void)hipOccupancyMaxActiveBlocksPerMultiprocessor(&per_cu, mega, 256, 0);
#else
    per_cu = 2;
#endif
    if (per_cu > 2) per_cu = 2;
    if (per_cu < 1) per_cu = 1;
    grid_blocks = cus * per_cu;
  }
#if FUSED
  (void)hipMemsetAsync((char*)d_ws + WS_BAR, 0, 16384, stream);
  void* args[] = {&p};
  hipError_t e = hipLaunchCooperativeKernel((void*)mega, dim3(grid_blocks), dim3(256), args, 0, stream);
  if (e != hipSuccess) fprintf(stderr, "cooperative launch failed: %s (grid %d)\n", hipGetErrorString(e), grid_blocks);
#else
  launch_all<0>(p, grid_blocks, stream);
#endif
}
```

```cpp
#include <hip/hip_runtime.h>
#include <hip/hip_cooperative_groups.h>
#include <stdint.h>
#include <stdio.h>
#include <string.h>
namespace cg = cooperative_groups;

#ifndef FUSED
#define FUSED 1
#endif
#ifndef PHMASK
#define PHMASK 0x3ff
#endif

typedef unsigned short bf16_t;
typedef short bf16x8 __attribute__((ext_vector_type(8)));
typedef float f32x4 __attribute__((ext_vector_type(4)));
typedef unsigned u32x4 __attribute__((ext_vector_type(4)));
typedef unsigned u32x2 __attribute__((ext_vector_type(2)));

constexpr int NTOK = 16896, NPROMPT = 16384, NUNIT = 1056;
constexpr int NINSRC = 9736, NWT = 9728, NMAIN = 6656;
constexpr int SMEM_BYTES = 80896;
constexpr int NPL = 10;
constexpr int NPHASE = 1 + 2 * NPL;

constexpr size_t al256(size_t x) { return (x + 255) & ~(size_t)255; }
constexpr size_t WS_WT_IN = 0;
constexpr size_t WS_WT_BR = WS_WT_IN + al256((size_t)2 * NWT * 1024 * 2);
constexpr size_t WS_WT_OUT = WS_WT_BR + al256((size_t)2 * 3 * 1024 * 512 * 2);
constexpr size_t WS_WT_PG = WS_WT_OUT + al256((size_t)2 * 1048576 * 2);
constexpr size_t WS_WT_PP = WS_WT_PG + al256((size_t)2 * 1048576 * 2);
constexpr size_t WS_U = WS_WT_PP + al256((size_t)2 * 262144 * 2);
constexpr size_t WS_PR = WS_U + al256((size_t)NTOK * 1024 * 2);
constexpr size_t WS_QC = WS_PR + al256((size_t)13 * NTOK * 512 * 2);
constexpr size_t WS_KC = WS_QC + al256((size_t)NTOK * 512 * 2);
constexpr size_t WS_SM = WS_KC + al256((size_t)NTOK * 512 * 2);
constexpr size_t WS_SH = WS_SM + al256((size_t)NUNIT * 16384 * 2);
constexpr size_t WS_H = WS_SH + al256((size_t)NUNIT * 16384 * 2);
constexpr size_t WS_IG = WS_H + al256((size_t)3 * NTOK * 512 * 2);
constexpr size_t WS_LF = WS_IG + al256((size_t)NTOK * 16);
constexpr size_t WS_AC = WS_LF + al256((size_t)NTOK * 16);
constexpr size_t WS_BC = WS_AC + al256(NUNIT * 4);
constexpr size_t WS_MIN = WS_BC + al256(NUNIT * 4);
constexpr size_t WS_NLOC = WS_MIN + al256(NUNIT * 4);
constexpr size_t WS_HBC = WS_NLOC + al256((size_t)NUNIT * 512);
constexpr size_t WS_BAR = WS_HBC + al256((size_t)NUNIT * 512);
constexpr size_t WS_WG8 = WS_BAR + 16384;
constexpr size_t WS_TOTAL = WS_WG8 + 65536;
constexpr size_t WS_MERGED = WS_PR;
constexpr size_t WS_Y = WS_MERGED + (size_t)NTOK * 1024 * 2;
constexpr size_t WS_R = WS_Y + (size_t)NTOK * 1024 * 4;
constexpr size_t WS_RB = WS_R + (size_t)NTOK * 1024 * 4;
static_assert(WS_RB + (size_t)NTOK * 1024 * 2 <= WS_QC, "alias overflow");
constexpr size_t O_PC = 16777216 + 524288, O_PN = O_PC + 262144, O_PM = O_PN + 2048, O_PCONV = O_PM + 16, O_PK = O_PCONV + 12288, O_PV = O_PK + 16777216,
                 O_PS = O_PV + 16777216, O_SC = O_PS + 262144, O_SN = O_SC + 1048576, O_SM = O_SN + 8192, O_SCONV = O_SM + 64, O_SK = O_SCONV + 49152,
                 O_SV = O_SK + 524288, O_SS = O_SV + 524288, O_TOTAL = O_SS + 1048576;

struct Params {
  const float *x_p, *x_s, *p_p, *p_s, *st_C, *st_n, *st_m, *st_conv, *ck, *cv, *st_S;
  const float *g_pre, *w_in, *b_i, *b_f, *w_conv, *g_ml, *lb_logits, *g_hg, *w_br, *w_out, *g_post, *w_pg, *w_pp;
  float* out; char* ws;
#define WSP(name, T, off) __device__ __forceinline__ T* name() const { return (T*)(ws + (off)); }
#define OUTP(name, off) __device__ __forceinline__ float* name() const { return out + (off); }
  OUTP(o_y, 0) OUTP(o_pC, O_PC) OUTP(o_pn, O_PN) OUTP(o_pm, O_PM) OUTP(o_pconv, O_PCONV) OUTP(o_pk, O_PK) OUTP(o_pv, O_PV) OUTP(o_pS, O_PS)
  OUTP(o_sC, O_SC) OUTP(o_sn, O_SN) OUTP(o_sm, O_SM) OUTP(o_sconv, O_SCONV) OUTP(o_sk, O_SK) OUTP(o_sv, O_SV) OUTP(o_sS, O_SS)
  WSP(wt_in, bf16_t, WS_WT_IN) WSP(wt_br, bf16_t, WS_WT_BR) WSP(wt_out, bf16_t, WS_WT_OUT) WSP(wt_pg, bf16_t, WS_WT_PG) WSP(wt_pp, bf16_t, WS_WT_PP)
  WSP(U, bf16_t, WS_U) WSP(PR, bf16_t, WS_PR) WSP(QC, bf16_t, WS_QC) WSP(KC, bf16_t, WS_KC) WSP(SM, bf16_t, WS_SM) WSP(SH, bf16_t, WS_SH) WSP(H, bf16_t, WS_H)
  WSP(ig, float, WS_IG) WSP(lf, float, WS_LF) WSP(ac, float, WS_AC) WSP(Bc, float, WS_BC) WSP(min_, float, WS_MIN) WSP(nloc, float, WS_NLOC) WSP(hbc, float, WS_HBC)
  WSP(G, bf16_t, WS_Y) WSP(wg8, float, WS_WG8) WSP(merged, bf16_t, WS_MERGED) WSP(y, float, WS_Y) WSP(r, float, WS_R) WSP(rb, bf16_t, WS_RB)
};

__device__ __forceinline__ int get_tid() { int t = threadIdx.x; asm volatile("" : "+v"(t)); return t; }
__device__ __forceinline__ bf16_t f2bf(float f) { unsigned u = __float_as_uint(f); u += 0x7fffu + ((u >> 16) & 1u); return (bf16_t)(u >> 16); }
__device__ __forceinline__ float bf2f(bf16_t h) { return __uint_as_float(((unsigned)h) << 16); }
__device__ __forceinline__ unsigned pack2(float a, float b) { return (unsigned)f2bf(a) | ((unsigned)f2bf(b) << 16); }
__device__ __forceinline__ float lo2f(unsigned v) { return __uint_as_float(v << 16); }
__device__ __forceinline__ float hi2f(unsigned v) { return __uint_as_float(v & 0xffff0000u); }
__device__ __forceinline__ float sigm(float x) { return 1.f / (1.f + __expf(-x)); }
__device__ __forceinline__ float silu(float x) { return x / (1.f + __expf(-x)); }
__device__ __forceinline__ float softplus(float x) { return fmaxf(x, 0.f) + __logf(1.f + __expf(-fabsf(x))); }
__device__ __forceinline__ float logsigm(float x) { return fminf(x, 0.f) - __logf(1.f + __expf(-fabsf(x))); }

template <int MT, int NT, int KS>
__device__ __forceinline__ void wmma(f32x4 (&acc)[MT][NT], const bf16_t* A, int lda, const bf16_t* B, int ldb, int fr, int fq) {
#pragma unroll
  for (int kk = 0; kk < KS; ++kk) {
    bf16x8 a[MT], b[NT];
#pragma unroll
    for (int mi = 0; mi < MT; ++mi) a[mi] = *(const bf16x8*)(A + (mi * 16 + fr) * lda + kk * 32 + fq * 8);
#pragma unroll
    for (int ni = 0; ni < NT; ++ni) b[ni] = *(const bf16x8*)(B + (ni * 16 + fr) * ldb + kk * 32 + fq * 8);
#pragma unroll
    for (int mi = 0; mi < MT; ++mi)
#pragma unroll
      for (int ni = 0; ni < NT; ++ni) acc[mi][ni] = __builtin_amdgcn_mfma_f32_16x16x32_bf16(a[mi], b[ni], acc[mi][ni], 0, 0, 0);
  }
}

__device__ __forceinline__ u32x4 ld8(const bf16_t* s) { return *(const u32x4*)s; }
__device__ __forceinline__ u32x4 ld8(const float* s) {
  float4 a = *(const float4*)s, b = *(const float4*)(s + 4);
  u32x4 r; r.x = pack2(a.x, a.y); r.y = pack2(a.z, a.w); r.z = pack2(b.x, b.y); r.w = pack2(b.z, b.w); return r;
}
template <typename T>
__device__ __forceinline__ void ld_tile(bf16_t* dst, const T* src, long ld, int tid) {
#pragma unroll
  for (int i = 0; i < 4; ++i) { int id = tid + 256 * i; int r = id >> 4, c = (id & 15) * 8; *(u32x4*)(dst + r * 136 + c) = ld8(src + (long)r * ld + c); }
}
template <typename T>
__device__ __forceinline__ void ld_tile128(bf16_t* dst, const T* src, long ld, int tid) {
#pragma unroll
  for (int i = 0; i < 8; ++i) { int id = tid + 256 * i; int r = id >> 4, c = (id & 15) * 8; *(u32x4*)(dst + r * 136 + c) = ld8(src + (long)r * ld + c); }
}
template <typename T, int ROWS, int DLD>
__device__ __forceinline__ void ld_T(bf16_t* dst, const T* src, long ld, int tid) {
#pragma unroll 2
  for (int id = tid; id < ROWS * 16; id += 256) {
    int r = id % ROWS, c = (id / ROWS) * 8;
    u32x4 v = ld8(src + (long)r * ld + c);
    bf16_t* d = dst + c * DLD + r;
    d[0] = (bf16_t)(v.x & 0xffff); d[DLD] = (bf16_t)(v.x >> 16); d[2 * DLD] = (bf16_t)(v.y & 0xffff); d[3 * DLD] = (bf16_t)(v.y >> 16);
    d[4 * DLD] = (bf16_t)(v.z & 0xffff); d[5 * DLD] = (bf16_t)(v.z >> 16); d[6 * DLD] = (bf16_t)(v.w & 0xffff); d[7 * DLD] = (bf16_t)(v.w >> 16);
  }
}

#define PRG(g) (p.PR() + (size_t)(g) * NTOK * 512)

__device__ __forceinline__ const float* xrow(const Params& p, int l, int row) {
  if (l == 0) return row < NPROMPT ? p.x_p + (size_t)row * 1024 : p.x_s + (size_t)(row - NPROMPT) * 1024;
  return p.o_y() + (size_t)row * 1024;
}

__device__ void wconv_tile(const Params& p, int t, char* smem) {
  float* tile = (float*)smem;
  const int tid = get_tid();
  int l = t / 3392, r = t % 3392;
  const float* src; bf16_t* dst; int K, ldsrc, kt, nt, skip = 1 << 30;
  if (r < 2432) { src = p.w_in + (size_t)l * 1024 * NINSRC; dst = p.wt_in() + (size_t)l * NWT * 1024; K = 1024; ldsrc = NINSRC; kt = r % 16; nt = r / 16; skip = 2560; }
  else if (r < 2816) { r -= 2432; int b = r / 128; r %= 128; src = p.w_br + (size_t)(l * 3 + b) * 512 * 1024; dst = p.wt_br() + (size_t)(l * 3 + b) * 1024 * 512; K = 512; ldsrc = 1024; kt = r % 8; nt = r / 8; }
  else if (r < 3072) { r -= 2816; src = p.w_out + (size_t)l * 1048576; dst = p.wt_out() + (size_t)l * 1048576; K = 1024; ldsrc = 1024; kt = r % 16; nt = r / 16; }
  else if (r < 3328) { r -= 3072; src = p.w_pg + (size_t)l * 1048576; dst = p.wt_pg() + (size_t)l * 1048576; K = 1024; ldsrc = 1024; kt = r % 16; nt = r / 16; }
  else { r -= 3328; src = p.w_pp + (size_t)l * 262144; dst = p.wt_pp() + (size_t)l * 262144; K = 256; ldsrc = 1024; kt = r % 4; nt = r / 4; }
  const int n0 = nt * 64, k0 = kt * 64;
#pragma unroll
  for (int i = 0; i < 16; ++i) {
    int k = i * 4 + (tid >> 6), n = tid & 63; int ns = n0 + n; if (ns >= skip) ns += 8;
    tile[k * 65 + n] = src[(size_t)(k0 + k) * ldsrc + ns];
  }
  __syncthreads();
#pragma unroll
  for (int i = 0; i < 8; ++i) {
    int n = i * 8 + (tid >> 5), k = (tid & 31) * 2;
    *(unsigned*)(dst + (size_t)(n0 + n) * K + k0 + k) = pack2(tile[k * 65 + n], tile[(k + 1) * 65 + n]);
  }
  __syncthreads();
}

__device__ void norm_phase(const Params& p, int l) {
  const int lane = threadIdx.x & 63, wid = threadIdx.x >> 6;
  const float* gp = p.g_pre + l * 1024;
  const float* wg = p.wg8() + l * 8192;
  for (int row = blockIdx.x * 4 + wid; row < NTOK; row += gridDim.x * 4) {
    const float* x = xrow(p, l, row);
    float4 v[4]; float ss = 0.f;
#pragma unroll
    for (int i = 0; i < 4; ++i) { v[i] = *(const float4*)(x + i * 256 + lane * 4); ss += v[i].x * v[i].x + v[i].y * v[i].y + v[i].z * v[i].z + v[i].w * v[i].w; }
#pragma unroll
    for (int o = 32; o > 0; o >>= 1) ss += __shfl_xor(ss, o);
    const float rstd = rsqrtf(ss * (1.f / 1024.f) + 1e-6f);
    float d0 = 0, d1 = 0, d2 = 0, d3 = 0, d4 = 0, d5 = 0, d6 = 0, d7 = 0;
#pragma unroll
    for (int i = 0; i < 4; ++i) {
      const int k = i * 256 + lane * 4;
      float4 g = *(const float4*)(gp + k);
      float u0 = v[i].x * rstd * g.x, u1 = v[i].y * rstd * g.y, u2 = v[i].z * rstd * g.z, u3 = v[i].w * rstd * g.w;
      u32x2 pk; pk.x = pack2(u0, u1); pk.y = pack2(u2, u3);
      *(u32x2*)(p.U() + (size_t)row * 1024 + k) = pk;
      const float* wp = wg + k;
      float4 w;
      w = *(const float4*)(wp);            d0 += u0 * w.x + u1 * w.y + u2 * w.z + u3 * w.w;
      w = *(const float4*)(wp + 1024);     d1 += u0 * w.x + u1 * w.y + u2 * w.z + u3 * w.w;
      w = *(const float4*)(wp + 2 * 1024); d2 += u0 * w.x + u1 * w.y + u2 * w.z + u3 * w.w;
      w = *(const float4*)(wp + 3 * 1024); d3 += u0 * w.x + u1 * w.y + u2 * w.z + u3 * w.w;
      w = *(const float4*)(wp + 4 * 1024); d4 += u0 * w.x + u1 * w.y + u2 * w.z + u3 * w.w;
      w = *(const float4*)(wp + 5 * 1024); d5 += u0 * w.x + u1 * w.y + u2 * w.z + u3 * w.w;
      w = *(const float4*)(wp + 6 * 1024); d6 += u0 * w.x + u1 * w.y + u2 * w.z + u3 * w.w;
      w = *(const float4*)(wp + 7 * 1024); d7 += u0 * w.x + u1 * w.y + u2 * w.z + u3 * w.w;
    }
#pragma unroll
    for (int o = 32; o > 0; o >>= 1) {
      d0 += __shfl_xor(d0, o); d1 += __shfl_xor(d1, o); d2 += __shfl_xor(d2, o); d3 += __shfl_xor(d3, o);
      d4 += __shfl_xor(d4, o); d5 += __shfl_xor(d5, o); d6 += __shfl_xor(d6, o); d7 += __shfl_xor(d7, o);
    }
    if (lane < 4) {
      float di = lane == 0 ? d0 : lane == 1 ? d1 : lane == 2 ? d2 : d3;
      float df = lane == 0 ? d4 : lane == 1 ? d5 : lane == 2 ? d6 : d7;
      p.ig()[row * 4 + lane] = di + p.b_i[l * 4 + lane];
      p.lf()[row * 4 + lane] = logsigm(df + p.b_f[l * 4 + lane]);
    }
  }
}

template <typename TA>
__device__ __forceinline__ void gemm_kloop(f32x4 (&acc)[4][4], const TA* Tp, long ldt, const bf16_t* Wp, long ldw, int K, char* smem) {
  bf16_t* sT = (bf16_t*)smem;
  bf16_t* sW = sT + 2 * 9216;
  const int tid = get_tid(), lane = tid & 63, wid = tid >> 6, wr = wid >> 1, wc = wid & 1, fr = lane & 15, fq = lane >> 4;
  u32x4 rt[4], rw[4];
  const int r0 = tid >> 3, c0 = (tid & 7) * 8;
#define GLOAD(k0) _Pragma("unroll") for (int i = 0; i < 4; ++i) { rt[i] = ld8(Tp + (long)(r0 + 32 * i) * ldt + (k0) + c0); rw[i] = ld8(Wp + (long)(r0 + 32 * i) * ldw + (k0) + c0); }
#define SSTORE(buf) _Pragma("unroll") for (int i = 0; i < 4; ++i) { *(u32x4*)(sT + (buf) * 9216 + (r0 + 32 * i) * 72 + c0) = rt[i]; *(u32x4*)(sW + (buf) * 9216 + (r0 + 32 * i) * 72 + c0) = rw[i]; }
  GLOAD(0); SSTORE(0);
  __syncthreads();
  const int nk = K >> 6;
#pragma unroll 1
  for (int kt = 0; kt < nk; ++kt) {
    const int buf = kt & 1;
    if (kt + 1 < nk) { GLOAD((kt + 1) * 64); }
    const bf16_t* aT = sT + buf * 9216 + (wr * 64) * 72;
    const bf16_t* aW = sW + buf * 9216 + (wc * 64) * 72;
    wmma<4, 4, 2>(acc, aW, 72, aT, 72, fr, fq);
    if (kt + 1 < nk) { SSTORE(buf ^ 1); }
    __syncthreads();
  }
#undef GLOAD
#undef SSTORE
}
__device__ __forceinline__ void zero_acc(f32x4 (&acc)[4][4]) {
#pragma unroll
  for (int a = 0; a < 4; ++a)
#pragma unroll
    for (int b = 0; b < 4; ++b) acc[a][b] = (f32x4){0.f, 0.f, 0.f, 0.f};
}


template <int NT, int NSTAGE>
__device__ __forceinline__ void gemm_glds(f32x4 (&acc)[4][NT], const bf16_t* Tp, long ldt, const bf16_t* Wp, long ldw, int K, char* smem) {
  constexpr int TR = 2 * NT * 16, STAGE_B = (TR + 128) * 64, LT = TR / 64, LPS = LT + 2;
  static_assert(NSTAGE * STAGE_B <= SMEM_BYTES, "ring too large");
  static_assert(NSTAGE == 3 || NSTAGE == 4, "waits below are written for 3 or 4 stages");
  const int tid = get_tid(), lane = tid & 63, wid = tid >> 6, wr = wid >> 1, wc = wid & 1, fr = lane & 15, fq = lane >> 4;
  const int lr = tid >> 2, cp = tid & 3, lc = (cp ^ ((lr >> 2) & 3)) * 8;
  const bf16_t* gT = Tp + (long)lr * ldt + lc;
  const int plr = ((lr >> 5) & 1) * 32 + ((lr >> 2) & 3) * 8 + ((lr >> 4) & 1) * 4 + (lr & 3);
  const bf16_t* gW = Wp + (long)plr * ldw + lc;
  const int rd_off = fr * 64 + ((fq ^ ((fr >> 2) & 3)) * 16);
#define GL_ISSUE(kt_, slot_) do { char* sb_ = smem + (slot_) * STAGE_B + tid * 16; \
    _Pragma("unroll") for (int i_ = 0; i_ < LT; ++i_) __builtin_amdgcn_global_load_lds((const unsigned*)(gT + (long)i_ * 64 * ldt + (kt_) * 32), (__attribute__((address_space(3))) unsigned*)(sb_ + i_ * 4096), 16, 0, 0); \
    _Pragma("unroll") for (int i_ = 0; i_ < 2; ++i_) __builtin_amdgcn_global_load_lds((const unsigned*)(gW + (long)i_ * 64 * ldw + (kt_) * 32), (__attribute__((address_space(3))) unsigned*)(sb_ + TR * 64 + i_ * 4096), 16, 0, 0); } while (0)
  asm volatile("s_waitcnt vmcnt(0)" ::: "memory");
  __builtin_amdgcn_s_barrier();
  const int nk = K >> 5;
#pragma unroll
  for (int s_ = 0; s_ < NSTAGE - 1; ++s_) if (s_ < nk) GL_ISSUE(s_, s_);
  int slot = 0, islot = NSTAGE - 1;
#pragma unroll 1
  for (int kt = 0; kt < nk; ++kt) {
    const int rem = nk - 1 - kt;
    if (NSTAGE == 4) {
      if (rem >= 2) asm volatile("s_waitcnt vmcnt(%0)" ::"n"(2 * LPS) : "memory");
      else if (rem == 1) asm volatile("s_waitcnt vmcnt(%0)" ::"n"(LPS) : "memory");
      else asm volatile("s_waitcnt vmcnt(0)" ::: "memory");
    } else {
      if (rem >= 1) asm volatile("s_waitcnt vmcnt(%0)" ::"n"(LPS) : "memory");
      else asm volatile("s_waitcnt vmcnt(0)" ::: "memory");
    }
    __builtin_amdgcn_s_barrier();
    const unsigned aT = (unsigned)(uintptr_t)(smem + slot * STAGE_B + (wr * NT * 16) * 64 + rd_off);
    const unsigned aW = (unsigned)(uintptr_t)(smem + slot * STAGE_B + TR * 64 + (wc * 64) * 64 + rd_off);
    bf16x8 a[4], b[NT];
#pragma unroll
    for (int mi = 0; mi < 4; ++mi) asm volatile("ds_read_b128 %0, %1 offset:%2" : "=v"(a[mi]) : "v"(aW), "n"(mi * 1024));
#pragma unroll
    for (int ni = 0; ni < NT; ++ni) asm volatile("ds_read_b128 %0, %1 offset:%2" : "=v"(b[ni]) : "v"(aT), "n"(ni * 1024));
    if constexpr (NT == 4) asm volatile("s_waitcnt lgkmcnt(0)" : "+v"(a[0]), "+v"(a[1]), "+v"(a[2]), "+v"(a[3]), "+v"(b[0]), "+v"(b[1]), "+v"(b[2]), "+v"(b[3]));
    else asm volatile("s_waitcnt lgkmcnt(0)" : "+v"(a[0]), "+v"(a[1]), "+v"(a[2]), "+v"(a[3]), "+v"(b[0]), "+v"(b[1]), "+v"(b[2]), "+v"(b[3]), "+v"(b[4]), "+v"(b[5]), "+v"(b[6]), "+v"(b[7]));
    const bool doiss = (kt + NSTAGE - 1 < nk);
    const int ktn = kt + NSTAGE - 1;
    char* sbi = smem + islot * STAGE_B + tid * 16;
#pragma unroll
    for (int mi = 0; mi < 4; ++mi) {
#pragma unroll
      for (int ni = 0; ni < NT; ++ni) acc[mi][ni] = __builtin_amdgcn_mfma_f32_16x16x32_bf16(a[mi], b[ni], acc[mi][ni], 0, 0, 0);
      __builtin_amdgcn_sched_barrier(0);
      if (doiss) {
#pragma unroll
        for (int q = 0; q < 2; ++q) {
          const int idx = mi * 2 + q;
          if (idx < LT) __builtin_amdgcn_global_load_lds((const unsigned*)(gT + (long)idx * 64 * ldt + ktn * 32), (__attribute__((address_space(3))) unsigned*)(sbi + idx * 4096), 16, 0, 0);
          else if (idx < LPS) __builtin_amdgcn_global_load_lds((const unsigned*)(gW + (long)(idx - LT) * 64 * ldw + ktn * 32), (__attribute__((address_space(3))) unsigned*)(sbi + TR * 64 + (idx - LT) * 4096), 16, 0, 0);
        }
      }
      __builtin_amdgcn_sched_barrier(0);
    }
    slot = (slot + 1 == NSTAGE) ? 0 : slot + 1;
    islot = (islot + 1 == NSTAGE) ? 0 : islot + 1;
  }
#undef GL_ISSUE
  __syncthreads();
}

__device__ void inproj_tile(const Params& p, int l, int t, char* smem) {
  constexpr int NT = 8;
  const int tm = t / 52, tn = t % 52;
  const int tid = get_tid(), lane = tid & 63, wid = tid >> 6, wr = wid >> 1, wc = wid & 1, fr = lane & 15, fq = lane >> 4;
  f32x4 acc[4][NT];
#pragma unroll
  for (int a_ = 0; a_ < 4; ++a_)
#pragma unroll
    for (int b_ = 0; b_ < NT; ++b_) acc[a_][b_] = (f32x4){0.f, 0.f, 0.f, 0.f};
  gemm_glds<NT, 3>(acc, p.U() + (size_t)tm * (NT * 32) * 1024, 1024, p.wt_in() + (size_t)l * NWT * 1024 + (size_t)tn * 128 * 1024, 1024, 1024, smem);
  const int g = tn >> 2;
  bf16_t* dst = PRG(g);
#pragma unroll
  for (int ni = 0; ni < NT; ++ni) {
    const int row = tm * (NT * 32) + wr * (NT * 16) + ni * 16 + fr;
    const bool samp = row >= NPROMPT;
    const int rr = samp ? row - NPROMPT : row;
    const int b = samp ? (rr >> 6) : (rr >> 13), tt = samp ? (rr & 63) : (rr & 8191), T = samp ? 64 : 8192, NB = samp ? 8 : 2;
#pragma unroll
    for (int m = 0; m < 2; ++m) {
      const int cg_ = (tn & 3) * 128 + wc * 64 + m * 32 + fq * 8;
      const f32x4 v0 = acc[2 * m][ni], v1 = acc[2 * m + 1][ni];
      u32x4 pk; pk.x = pack2(v0[0], v0[1]); pk.y = pack2(v0[2], v0[3]); pk.z = pack2(v1[0], v1[1]); pk.w = pack2(v1[2], v1[3]);
      *(u32x4*)(dst + (size_t)row * 512 + cg_) = pk;
      if (g == 6 || g == 7) {
        float* o = (g == 6) ? (samp ? p.o_sk() : p.o_pk()) : (samp ? p.o_sv() : p.o_pv());
        const int hh = cg_ >> 7, d = cg_ & 127;
        float* op = o + ((size_t)((l * NB + b) * 4 + hh) * T + tt) * 128 + d;
        *(f32x4*)op = v0; *(f32x4*)(op + 4) = v1;
      } else if (g < 2) {
        if (tt >= T - 3) {
          float* o = samp ? p.o_sconv() : p.o_pconv();
          float* op = o + ((size_t)(l * NB + b) * 3 + (tt - (T - 3))) * 1024 + g * 512 + cg_;
          *(f32x4*)op = v0; *(f32x4*)(op + 4) = v1;
        }
      }
    }
  }
}

struct UnitInfo { int samp, b, h, c, rowbase, seq; };
__device__ __forceinline__ UnitInfo unit_info(int u) {
  UnitInfo i;
  if (u < 1024) { i.samp = 0; i.seq = u >> 7; i.b = i.seq >> 2; i.h = i.seq & 3; i.c = u & 127; i.rowbase = i.b * 8192 + i.c * 64; }
  else { int sq = u - 1024; i.samp = 1; i.seq = sq; i.b = sq >> 2; i.h = sq & 3; i.c = 0; i.rowbase = NPROMPT + i.b * 64; }
  return i;
}

__device__ void sb_unit(const Params& p, int l, int u, char* smem) {
  bf16_t* Qs = (bf16_t*)smem;
  bf16_t* Ks = Qs + 64 * 136;
  bf16_t* Vt = Ks + 64 * 136;
  bf16_t* Ps = Vt + 128 * 72;
  const int tid = get_tid(), lane = tid & 63, w = tid >> 6, fr = lane & 15, fq = lane >> 4;
  const UnitInfo ui = unit_info(u);
  const int nblk = ui.samp ? 65 : ui.c + 1;
  const int hc = ui.h * 128;
  __syncthreads();
  ld_tile<bf16_t>(Qs, PRG(5) + (size_t)ui.rowbase * 512 + hc, 512, tid);
  f32x4 o[8][1];
#pragma unroll
  for (int mi = 0; mi < 8; ++mi) o[mi][0] = (f32x4){0.f, 0.f, 0.f, 0.f};
  float R = 0.f;
  const int tq = 16 * w + fr;
  for (int i = nblk - 1; i >= 0; --i) {
    if (!ui.samp || i == 64) {
      const size_t krow = ui.samp ? (size_t)ui.rowbase : (size_t)ui.b * 8192 + (size_t)i * 64;
      ld_tile<bf16_t>(Ks, PRG(6) + krow * 512 + hc, 512, tid);
      ld_T<bf16_t, 64, 72>(Vt, PRG(7) + krow * 512 + hc, 512, tid);
    } else {
      const size_t off = ((size_t)((l * 8 + ui.b) * 4 + ui.h) * 4096 + (size_t)i * 64) * 128;
      ld_tile<float>(Ks, p.ck + off, 128, tid);
      ld_T<float, 64, 72>(Vt, p.cv + off, 128, tid);
    }
    __syncthreads();
    f32x4 z[4][1];
#pragma unroll
    for (int mi = 0; mi < 4; ++mi) z[mi][0] = (f32x4){0.f, 0.f, 0.f, 0.f};
    wmma<4, 1, 4>(z, Ks, 136, Qs + 16 * w * 136, 136, fr, fq);
    const bool diag = (i == nblk - 1);
    float L[4][4], lsg[4][4], G[4];
#pragma unroll
    for (int mi = 0; mi < 4; ++mi) {
      G[mi] = 0.f;
#pragma unroll
      for (int j = 0; j < 4; ++j) {
        const int kk = mi * 16 + fq * 4 + j;
        const float zz = z[mi][0][j] * 0.08838834764831845f;
        const float sp = softplus(zz);
        const bool valid = !diag || kk < tq;
        L[mi][j] = valid ? -sp : 0.f;
        lsg[mi][j] = valid ? zz - sp : -1e30f;
        G[mi] += L[mi][j];
      }
    }
    float sufm = 0.f;
#pragma unroll
    for (int mi = 3; mi >= 0; --mi) {
      const float g0 = __shfl(G[mi], fr), g1 = __shfl(G[mi], fr + 16), g2 = __shfl(G[mi], fr + 32), g3 = __shfl(G[mi], fr + 48);
      const float later = (fq < 1 ? g1 : 0.f) + (fq < 2 ? g2 : 0.f) + (fq < 3 ? g3 : 0.f);
      const float s3 = R + sufm + later, s2 = s3 + L[mi][3], s1 = s2 + L[mi][2], s0 = s1 + L[mi][1];
      const float a0 = __expf(lsg[mi][0] + s0), a1 = __expf(lsg[mi][1] + s1), a2 = __expf(lsg[mi][2] + s2), a3 = __expf(lsg[mi][3] + s3);
      u32x2 pk; pk.x = pack2(a0, a1); pk.y = pack2(a2, a3);
      *(u32x2*)(Ps + tq * 72 + mi * 16 + fq * 4) = pk;
      sufm += (g0 + g1) + (g2 + g3);
    }
    R += sufm;
    __syncthreads();
    wmma<8, 1, 2>(o, Vt, 72, Ps + 16 * w * 72, 72, fr, fq);
    if (__syncthreads_and(R < -110.f)) break;
  }
  const size_t row = (size_t)ui.rowbase + tq;
#pragma unroll
  for (int mi = 0; mi < 8; ++mi) {
    const int col = hc + mi * 16 + fq * 4;
    u32x2 zz = *(const u32x2*)(PRG(8) + row * 512 + col);
    f32x4 v = o[mi][0];
    u32x2 pk;
    pk.x = pack2(v[0] * silu(lo2f(zz.x)), v[1] * silu(hi2f(zz.x)));
    pk.y = pack2(v[2] * silu(lo2f(zz.y)), v[3] * silu(hi2f(zz.y)));
    *(u32x2*)(p.H() + (size_t)1 * NTOK * 512 + row * 512 + col) = pk;
  }
}

__device__ void mlstm_local(const Params& p, int l, int u, char* smem) {
  bf16_t* kdT = (bf16_t*)smem;
  bf16_t* vT = kdT + 128 * 72;
  bf16_t* xq = vT + 128 * 72;
  bf16_t* xk = xq + 67 * 136;
  float* dec = (float*)(xk + 67 * 136);
  const int tid = get_tid(), lane = tid & 63, w = tid >> 6, fr = lane & 15, fq = lane >> 4;
  const UnitInfo ui = unit_info(u);
  const int hc = ui.h * 128;
  __syncthreads();
  if (w == 0) {
    const float lfv = p.lf()[(ui.rowbase + lane) * 4 + ui.h], igv = p.ig()[(ui.rowbase + lane) * 4 + ui.h];
    float bs = lfv;
#pragma unroll
    for (int o = 1; o < 64; o <<= 1) { float t = __shfl_up(bs, o); if (lane >= o) bs += t; }
    const float g = igv - bs;
    float gm = g;
#pragma unroll
    for (int o = 32; o > 0; o >>= 1) gm = fmaxf(gm, __shfl_xor(gm, o));
    const float bL = __shfl(bs, 63);
    dec[lane] = __expf(g - gm);
    if (lane == 0) { p.ac()[u] = bL + gm; p.Bc()[u] = bL; }
  }
  ld_tile<bf16_t>(xq + 3 * 136, PRG(0) + (size_t)ui.rowbase * 512 + hc, 512, tid);
  ld_tile<bf16_t>(xk + 3 * 136, PRG(1) + (size_t)ui.rowbase * 512 + hc, 512, tid);
  ld_T<bf16_t, 64, 72>(vT, PRG(2) + (size_t)ui.rowbase * 512 + hc, 512, tid);
  {
    const int isk = tid >> 7, ch = tid & 127, col = hc + ch;
    bf16_t* xs = isk ? xk : xq;
    if (ui.samp) {
      const float* cs = p.st_conv + (size_t)(l * 8 + ui.b) * 3072 + isk * 512 + col;
      xs[ch] = f2bf(cs[0]); xs[136 + ch] = f2bf(cs[1024]); xs[272 + ch] = f2bf(cs[2048]);
    } else if (ui.c > 0) {
      const bf16_t* src = PRG(isk) + (size_t)ui.rowbase * 512 + col;
      xs[ch] = src[-3 * 512]; xs[136 + ch] = src[-2 * 512]; xs[272 + ch] = src[-1 * 512];
    } else { xs[ch] = 0; xs[136 + ch] = 0; xs[272 + ch] = 0; }
  }
  __syncthreads();
  {
    const int isk = tid >> 7, ch = tid & 127, col = hc + ch;
    bf16_t* xs = isk ? xk : xq;
    const float* wc_ = p.w_conv + (size_t)l * 4096 + isk * 512 + col;
    const float w0 = wc_[0], w1 = wc_[1024], w2 = wc_[2048], w3 = wc_[3072];
    float x0 = bf2f(xs[ch]), x1 = bf2f(xs[136 + ch]), x2 = bf2f(xs[272 + ch]);
#pragma unroll 8
    for (int t = 0; t < 64; ++t) {
      const float x3 = bf2f(xs[(t + 3) * 136 + ch]);
      float y = silu(w0 * x0 + w1 * x1 + w2 * x2 + w3 * x3);
      if (isk) y *= 0.08838834764831845f;
      const bf16_t yb = f2bf(y);
      xs[t * 136 + ch] = yb;
      if (isk) kdT[ch * 72 + t] = f2bf(bf2f(yb) * dec[t]);
      x0 = x1; x1 = x2; x2 = x3;
    }
  }
  __syncthreads();
#pragma unroll
  for (int i = 0; i < 4; ++i) {
    const int id = tid + 256 * i, r = id >> 4, c = (id & 15) * 8;
    *(u32x4*)(p.QC() + (size_t)(ui.rowbase + r) * 512 + hc + c) = *(const u32x4*)(xq + r * 136 + c);
    *(u32x4*)(p.KC() + (size_t)(ui.rowbase + r) * 512 + hc + c) = *(const u32x4*)(xk + r * 136 + c);
  }
  if (tid < 128) { float s_ = 0.f;
#pragma unroll 8
    for (int t = 0; t < 64; ++t) s_ += bf2f(kdT[tid * 72 + t]); p.nloc()[u * 128 + tid] = s_; }
  f32x4 acc[8][2];
#pragma unroll
  for (int a_ = 0; a_ < 8; ++a_) { acc[a_][0] = (f32x4){0.f, 0.f, 0.f, 0.f}; acc[a_][1] = (f32x4){0.f, 0.f, 0.f, 0.f}; }
  wmma<8, 2, 2>(acc, kdT, 72, vT + 32 * w * 72, 72, fr, fq);
  bf16_t* sm = p.SM() + (size_t)u * 16384;
#pragma unroll
  for (int mi = 0; mi < 8; ++mi)
#pragma unroll
    for (int ni = 0; ni < 2; ++ni) {
      u32x2 pk; pk.x = pack2(acc[mi][ni][0], acc[mi][ni][1]); pk.y = pack2(acc[mi][ni][2], acc[mi][ni][3]);
      *(u32x2*)(sm + (32 * w + ni * 16 + fr) * 128 + mi * 16 + fq * 4) = pk;
    }
}

__device__ __forceinline__ float hgrn_lb(const Params& p, int l, int ch512) {
  if (l == 0) return 0.f;
  return sigm(p.lb_logits[512 + ch512] - p.lb_logits[ch512]);
}
__device__ __forceinline__ void hgrn_gate(float f, float lb, float& lg, float& kh) {
  const float e = __expf(-fabsf(f));
  const float sp = f >= 0.f ? 1.f / (1.f + e) : e / (1.f + e);
  const float sn = f >= 0.f ? e / (1.f + e) : 1.f / (1.f + e);
  lg = (lb == 0.f) ? (fminf(f, 0.f) - __logf(1.f + e)) : __logf(lb + (1.f - lb) * sp);
  kh = (1.f - lb) * sn;
}

__device__ void hgrn_local(const Params& p, int l, int u, char* smem) {
  bf16_t* kdT = (bf16_t*)smem;
  bf16_t* iT = kdT + 128 * 72;
  bf16_t* fs = iT + 128 * 72;
  float* tot = (float*)(fs + 64 * 136);
  const int tid = get_tid(), lane = tid & 63, w = tid >> 6, fr = lane & 15, fq = lane >> 4;
  const UnitInfo ui = unit_info(u);
  const int hc = ui.h * 128;
  __syncthreads();
  ld_tile<bf16_t>(fs, PRG(10) + (size_t)ui.rowbase * 512 + hc, 512, tid);
  ld_T<bf16_t, 64, 72>(iT, PRG(11) + (size_t)ui.rowbase * 512 + hc, 512, tid);
  const int half = tid >> 7, ch = tid & 127;
  const float lb = hgrn_lb(p, l, hc + ch);
  __syncthreads();
  const bf16_t* src = fs + (half * 32) * 136 + ch;
  {
    float run = 0.f;
#pragma unroll 8
    for (int t = 0; t < 32; ++t) { float lg, kh; hgrn_gate(bf2f(src[t * 136]), lb, lg, kh); run += lg; }
    tot[half * 128 + ch] = run;
  }
  __syncthreads();
  {
    const float t0 = tot[ch], t1 = tot[128 + ch];
    const float bcL = t0 + t1;
    float run = half ? t0 : 0.f;
#pragma unroll 8
    for (int t = 0; t < 32; ++t) {
      float lg, kh; hgrn_gate(bf2f(src[t * 136]), lb, lg, kh); run += lg;
      kdT[ch * 72 + half * 32 + t] = f2bf(kh * __expf(bcL - run));
    }
    if (half == 0) p.hbc()[u * 128 + ch] = bcL;
  }
  __syncthreads();
  f32x4 acc[8][2];
#pragma unroll
  for (int a_ = 0; a_ < 8; ++a_) { acc[a_][0] = (f32x4){0.f, 0.f, 0.f, 0.f}; acc[a_][1] = (f32x4){0.f, 0.f, 0.f, 0.f}; }
  wmma<8, 2, 2>(acc, kdT, 72, iT + 32 * w * 72, 72, fr, fq);
  bf16_t* sh = p.SH() + (size_t)u * 16384;
#pragma unroll
  for (int mi = 0; mi < 8; ++mi)
#pragma unroll
    for (int ni = 0; ni < 2; ++ni) {
      u32x2 pk; pk.x = pack2(acc[mi][ni][0], acc[mi][ni][1]); pk.y = pack2(acc[mi][ni][2], acc[mi][ni][3]);
      *(u32x2*)(sh + (32 * w + ni * 16 + fr) * 128 + mi * 16 + fq * 4) = pk;
    }
}

__device__ void scan_phase(const Params& p, int l, char* smem) {
  float* cdc = (float*)smem;
  float* cwl = cdc + 128;
  float* cmi = cwl + 128;
  const int tid = get_tid();
  for (int vb = blockIdx.x; vb < 520; vb += gridDim.x) {
    const int kind = vb >> 8;
    const int seq = (kind == 2) ? (vb - 512) : ((vb >> 5) & 7);
    __syncthreads();
    if (kind != 1) {
      if (tid < 128) { cdc[tid] = p.ac()[seq * 128 + tid]; cwl[tid] = p.Bc()[seq * 128 + tid]; }
      __syncthreads();
      if (tid == 0) {
        float m = 0.f;
        for (int c = 0; c < 128; ++c) {
          const float a = cdc[c], B = cwl[c];
          const float mo = fmaxf(a, B + m);
          cdc[c] = __expf(B + m - mo); cwl[c] = __expf(a - mo); cmi[c] = m; m = mo;
        }
        if (kind == 0 && (vb & 31) == 0) p.o_pm()[l * 8 + seq] = m;
      }
      __syncthreads();
      if (kind == 0 && (vb & 31) == 0 && tid < 128) p.min_()[seq * 128 + tid] = cmi[tid];
    }
    if (kind == 2) {
      if (tid < 128) {
        float n = 0.f;
        float* base = p.nloc() + (size_t)seq * 128 * 128 + tid;
        for (int c0 = 0; c0 < 128; c0 += 16) {
          float lv[16];
#pragma unroll
          for (int j = 0; j < 16; ++j) lv[j] = base[(c0 + j) * 128];
#pragma unroll
          for (int j = 0; j < 16; ++j) { const float nl = lv[j]; lv[j] = n; n = cdc[c0 + j] * n + cwl[c0 + j] * nl; }
#pragma unroll
          for (int j = 0; j < 16; ++j) base[(c0 + j) * 128] = lv[j];
        }
        p.o_pn()[(l * 8 + seq) * 128 + tid] = n;
      }
      continue;
    }
    const int pr = (vb & 31) * 256 + tid, e = pr * 2, er = e >> 7, ec = e & 127;
    unsigned* base = (unsigned*)((kind ? p.SH() : p.SM()) + (size_t)seq * 128 * 16384) + pr;
    const float* hb = p.hbc() + (size_t)seq * 128 * 128 + ec;
    float c0v = 0.f, c1v = 0.f;
    unsigned lv[16], nx[16];
    float2 hv[16], hn[16];
#pragma unroll
    for (int j = 0; j < 16; ++j) { nx[j] = base[(size_t)j * 8192]; hn[j] = kind ? *(const float2*)(hb + j * 128) : make_float2(0.f, 0.f); }
    for (int c0 = 0; c0 < 128; c0 += 16) {
#pragma unroll
      for (int j = 0; j < 16; ++j) { lv[j] = nx[j]; hv[j] = hn[j]; }
      if (c0 + 16 < 128) {
#pragma unroll
        for (int j = 0; j < 16; ++j) { nx[j] = base[(size_t)(c0 + 16 + j) * 8192]; if (kind) hn[j] = *(const float2*)(hb + (c0 + 16 + j) * 128); }
      }
#pragma unroll
      for (int j = 0; j < 16; ++j) {
        const unsigned v = lv[j];
        lv[j] = pack2(c0v, c1v);
        const float d0 = kind ? __expf(hv[j].x) : cdc[c0 + j];
        const float d1 = kind ? __expf(hv[j].y) : d0;
        const float wl = kind ? 1.f : cwl[c0 + j];
        c0v = d0 * c0v + wl * lo2f(v); c1v = d1 * c1v + wl * hi2f(v);
      }
#pragma unroll
      for (int j = 0; j < 16; ++j) base[(size_t)(c0 + j) * 8192] = lv[j];
    }
    float* o = (kind ? p.o_pS() : p.o_pC()) + (size_t)(l * 8 + seq) * 16384;
    o[ec * 128 + er] = c0v; o[(ec + 1) * 128 + er] = c1v;
  }
  const int gt = blockIdx.x * 256 + tid, nth = gridDim.x * 256;
  for (int it = gt; it < 524288; it += nth) {
    const int kind = it >> 18, sq = (it >> 13) & 31, pr = it & 8191, e = pr * 2, u = 1024 + sq, er = e >> 7, ec = e & 127;
    if (kind == 0) {
      const float* c0p = p.st_C + (size_t)(l * 32 + sq) * 16384;
      const float C0 = c0p[ec * 128 + er], C1 = c0p[(ec + 1) * 128 + er], m = p.st_m[l * 32 + sq];
      unsigned* slot = (unsigned*)(p.SM() + (size_t)u * 16384) + pr;
      const unsigned lv = *slot;
      const float a = p.ac()[u], B = p.Bc()[u];
      const float mo = fmaxf(a, B + m), dc = __expf(B + m - mo), wl = __expf(a - mo);
      *slot = pack2(C0, C1);
      float* o = p.o_sC() + (size_t)(l * 32 + sq) * 16384;
      o[ec * 128 + er] = dc * C0 + wl * lo2f(lv); o[(ec + 1) * 128 + er] = dc * C1 + wl * hi2f(lv);
      if (pr == 0) { p.min_()[u] = m; p.o_sm()[l * 32 + sq] = mo; }
    } else {
      const float* s0p = p.st_S + (size_t)(l * 32 + sq) * 16384;
      const float S0 = s0p[ec * 128 + er], S1 = s0p[(ec + 1) * 128 + er];
      unsigned* slot = (unsigned*)(p.SH() + (size_t)u * 16384) + pr;
      const unsigned lv = *slot;
      const float d0 = __expf(p.hbc()[u * 128 + ec]), d1 = __expf(p.hbc()[u * 128 + ec + 1]);
      *slot = pack2(S0, S1);
      float* o = p.o_sS() + (size_t)(l * 32 + sq) * 16384;
      o[ec * 128 + er] = d0 * S0 + lo2f(lv); o[(ec + 1) * 128 + er] = d1 * S1 + hi2f(lv);
    }
  }
  for (int it = gt; it < 4096; it += nth) {
    const int sq = it >> 7, d = it & 127, u = 1024 + sq;
    const float n0 = p.st_n[(l * 32 + sq) * 128 + d], m = p.st_m[l * 32 + sq];
    const float a = p.ac()[u], B = p.Bc()[u];
    const float mo = fmaxf(a, B + m), dc = __expf(B + m - mo), wl = __expf(a - mo);
    const float nl = p.nloc()[u * 128 + d];
    p.nloc()[u * 128 + d] = n0;
    p.o_sn()[(l * 32 + sq) * 128 + d] = dc * n0 + wl * nl;
  }
}

__device__ void mlstm_out(const Params& p, int l, int u, char* smem) {
  bf16_t* Qs = (bf16_t*)smem;
  bf16_t* CT = Qs + 64 * 136;
  bf16_t* Ks = CT;
  bf16_t* Vt = Ks + 64 * 136;
  bf16_t* Ps = Vt + 144 * 72;
  float* misc = (float*)(smem + 17408 + 47360);
  float *bsum = misc, *gs = misc + 64, *mt = misc + 128, *wint = misc + 192;
  const int tid = get_tid(), lane = tid & 63, w = tid >> 6, fr = lane & 15, fq = lane >> 4;
  const UnitInfo ui = unit_info(u);
  const int hc = ui.h * 128;
  __syncthreads();
  if (w == 0) {
    const float lfv = p.lf()[(ui.rowbase + lane) * 4 + ui.h], igv = p.ig()[(ui.rowbase + lane) * 4 + ui.h];
    float bs = lfv;
#pragma unroll
    for (int o = 1; o < 64; o <<= 1) { float t = __shfl_up(bs, o); if (lane >= o) bs += t; }
    const float g = igv - bs;
    float cm = g;
#pragma unroll
    for (int o = 1; o < 64; o <<= 1) { float t = __shfl_up(cm, o); if (lane >= o) cm = fmaxf(cm, t); }
    const float m_in = p.min_()[u];
    const float mtt = bs + fmaxf(cm, m_in);
    bsum[lane] = bs; gs[lane] = g; mt[lane] = mtt; wint[lane] = __expf(bs + m_in - mtt);
  }
  ld_tile<bf16_t>(Qs, p.QC() + (size_t)ui.rowbase * 512 + hc, 512, tid);
  ld_tile128<bf16_t>(CT, p.SM() + (size_t)u * 16384, 128, tid);
  if (tid < 128) CT[128 * 136 + tid] = f2bf(p.nloc()[u * 128 + tid]);
  for (int i = tid; i < 15 * 128; i += 256) CT[(129 + (i >> 7)) * 136 + (i & 127)] = 0;
  __syncthreads();
  f32x4 acc[9][1];
#pragma unroll
  for (int mi = 0; mi < 9; ++mi) acc[mi][0] = (f32x4){0.f, 0.f, 0.f, 0.f};
  wmma<9, 1, 4>(acc, CT, 136, Qs + 16 * w * 136, 136, fr, fq);
  const int t = 16 * w + fr;
  const float wi = wint[t];
#pragma unroll
  for (int mi = 0; mi < 9; ++mi) acc[mi][0] *= wi;
  __syncthreads();
  ld_tile<bf16_t>(Ks, p.KC() + (size_t)ui.rowbase * 512 + hc, 512, tid);
  ld_T<bf16_t, 64, 72>(Vt, PRG(2) + (size_t)ui.rowbase * 512 + hc, 512, tid);
  if (tid < 64) Vt[128 * 72 + tid] = 0x3F80;
  for (int i = tid; i < 15 * 64; i += 256) Vt[(129 + (i >> 6)) * 72 + (i & 63)] = 0;
  __syncthreads();
  f32x4 st[4][1];
#pragma unroll
  for (int mi = 0; mi < 4; ++mi) st[mi][0] = (f32x4){0.f, 0.f, 0.f, 0.f};
  wmma<4, 1, 4>(st, Ks, 136, Qs + 16 * w * 136, 136, fr, fq);
  const float bt = bsum[t], mtt = mt[t];
#pragma unroll
  for (int mi = 0; mi < 4; ++mi) {
    float a[4];
#pragma unroll
    for (int j = 0; j < 4; ++j) {
      const int s = mi * 16 + fq * 4 + j;
      a[j] = (s <= t) ? st[mi][0][j] * __expf(bt + gs[s] - mtt) : 0.f;
    }
    u32x2 pk; pk.x = pack2(a[0], a[1]); pk.y = pack2(a[2], a[3]);
    *(u32x2*)(Ps + t * 72 + mi * 16 + fq * 4) = pk;
  }
  __syncthreads();
  wmma<9, 1, 2>(acc, Vt, 72, Ps + 16 * w * 72, 72, fr, fq);
  const float den = __shfl(acc[8][0][0], fr);
  const float inv = 1.f / fmaxf(fabsf(den), __expf(-mtt));
  float ss = 0.f;
#pragma unroll
  for (int mi = 0; mi < 8; ++mi) { acc[mi][0] *= inv; ss += acc[mi][0][0] * acc[mi][0][0] + acc[mi][0][1] * acc[mi][0][1] + acc[mi][0][2] * acc[mi][0][2] + acc[mi][0][3] * acc[mi][0][3]; }
  ss += __shfl_xor(ss, 16); ss += __shfl_xor(ss, 32);
  const float rs = rsqrtf(ss * (1.f / 128.f) + 1e-6f);
  const size_t row = (size_t)ui.rowbase + t;
#pragma unroll
  for (int mi = 0; mi < 8; ++mi) {
    const int col = hc + mi * 16 + fq * 4;
    const u32x2 ov = *(const u32x2*)(PRG(3) + row * 512 + col);
    const u32x2 zv = *(const u32x2*)(PRG(4) + row * 512 + col);
    const float4 g = *(const float4*)(p.g_ml + l * 512 + col);
    const f32x4 v = acc[mi][0];
    u32x2 pk;
    pk.x = pack2(v[0] * rs * g.x * sigm(lo2f(ov.x)) * silu(lo2f(zv.x)), v[1] * rs * g.y * sigm(hi2f(ov.x)) * silu(hi2f(zv.x)));
    pk.y = pack2(v[2] * rs * g.z * sigm(lo2f(ov.y)) * silu(lo2f(zv.y)), v[3] * rs * g.w * sigm(hi2f(ov.y)) * silu(hi2f(zv.y)));
    *(u32x2*)(p.H() + row * 512 + col) = pk;
  }
}

__device__ __forceinline__ bf16x8 scale_frag(const bf16_t* src, const float* ea, const float* eb, float sgn, bool clampit) {
  u32x4 raw = *(const u32x4*)src;
  float4 a0 = *(const float4*)ea, a1 = *(const float4*)(ea + 4);
  float4 b0 = {0.f, 0.f, 0.f, 0.f}, b1 = {0.f, 0.f, 0.f, 0.f};
  if (eb) { b0 = *(const float4*)eb; b1 = *(const float4*)(eb + 4); }
  float e[8] = {a0.x - b0.x, a0.y - b0.y, a0.z - b0.z, a0.w - b0.w, a1.x - b1.x, a1.y - b1.y, a1.z - b1.z, a1.w - b1.w};
  float v[8] = {lo2f(raw.x), hi2f(raw.x), lo2f(raw.y), hi2f(raw.y), lo2f(raw.z), hi2f(raw.z), lo2f(raw.w), hi2f(raw.w)};
  unsigned o[4];
#pragma unroll
  for (int i = 0; i < 4; ++i) {
    float x0 = sgn * e[2 * i], x1 = sgn * e[2 * i + 1];
    if (clampit) { x0 = fminf(x0, 80.f); x1 = fminf(x1, 80.f); }
    o[i] = pack2(v[2 * i] * __expf(x0), v[2 * i + 1] * __expf(x1));
  }
  u32x4 r = {o[0], o[1], o[2], o[3]};
  return __builtin_bit_cast(bf16x8, r);
}

__device__ void hgrn_out(const Params& p, int l, int u, char* smem) {
  float* bc = (float*)smem;
  bf16_t* ST = (bf16_t*)smem;
  bf16_t* qs = (bf16_t*)(smem + 34816);
  bf16_t* kh = (bf16_t*)(smem + 34816 + 17408);
  bf16_t* iT = kh;
  bf16_t* Ps = (bf16_t*)(smem + 34816 + 17408 + 18432);
  float* tot = (float*)(smem + 79872);
  const int tid = get_tid(), lane = tid & 63, w = tid >> 6, fr = lane & 15, fq = lane >> 4;
  const UnitInfo ui = unit_info(u);
  const int hc = ui.h * 128;
  __syncthreads();
  ld_tile<bf16_t>(qs, PRG(9) + (size_t)ui.rowbase * 512 + hc, 512, tid);
  ld_tile<bf16_t>(kh, PRG(10) + (size_t)ui.rowbase * 512 + hc, 512, tid);
  __syncthreads();
  {
    const int half = tid >> 7, ch = tid & 127;
    const float lb = hgrn_lb(p, l, hc + ch);
    bf16_t* src = kh + (half * 32) * 136 + ch;
    float run = 0.f;
#pragma unroll 8
    for (int t = 0; t < 32; ++t) { float lg, k; hgrn_gate(bf2f(src[t * 136]), lb, lg, k); run += lg; }
    tot[half * 128 + ch] = run;
    __syncthreads();
    run = half ? tot[ch] : 0.f;
#pragma unroll 8
    for (int t = 0; t < 32; ++t) {
      float lg, k; hgrn_gate(bf2f(src[t * 136]), lb, lg, k); run += lg;
      bc[(half * 32 + t) * 132 + ch] = run;
      src[t * 136] = f2bf(k);
    }
  }
  __syncthreads();
  {
    const int I = w, t = 16 * I + fr;
    f32x4 a[4];
#pragma unroll
    for (int J = 0; J < 4; ++J) a[J] = (f32x4){0.f, 0.f, 0.f, 0.f};
#pragma unroll
    for (int kk = 0; kk < 4; ++kk) {
      const int c0 = kk * 32 + fq * 8;
      const float* rI = (I > 0) ? bc + (16 * I - 1) * 132 + c0 : nullptr;
      const bf16x8 bq = scale_frag(qs + t * 136 + c0, bc + t * 132 + c0, rI, 1.f, false);
#pragma unroll
      for (int J = 0; J < 4; ++J) {
        if (J <= I) {
          const int s = 16 * J + fr;
          const bf16x8 ak = scale_frag(kh + s * 136 + c0, bc + s * 132 + c0, rI, -1.f, true);
          a[J] = __builtin_amdgcn_mfma_f32_16x16x32_bf16(ak, bq, a[J], 0, 0, 0);
        }
      }
    }
#pragma unroll
    for (int J = 0; J < 4; ++J) {
      float v[4];
#pragma unroll
      for (int j = 0; j < 4; ++j) { const int s = 16 * J + fq * 4 + j; v[j] = (s <= t) ? a[J][j] : 0.f; }
      u32x2 pk; pk.x = pack2(v[0], v[1]); pk.y = pack2(v[2], v[3]);
      *(u32x2*)(Ps + t * 72 + J * 16 + fq * 4) = pk;
    }
  }
  __syncthreads();
#pragma unroll 4
  for (int i = tid; i < 64 * 128; i += 256) { const int t = i >> 7, c = i & 127; qs[t * 136 + c] = f2bf(bf2f(qs[t * 136 + c]) * __expf(bc[t * 132 + c])); }
  __syncthreads();
  ld_T<bf16_t, 64, 72>(iT, PRG(11) + (size_t)ui.rowbase * 512 + hc, 512, tid);
  ld_tile128<bf16_t>(ST, p.SH() + (size_t)u * 16384, 128, tid);
  __syncthreads();
  f32x4 acc[8][1];
#pragma unroll
  for (int mi = 0; mi < 8; ++mi) acc[mi][0] = (f32x4){0.f, 0.f, 0.f, 0.f};
  wmma<8, 1, 2>(acc, iT, 72, Ps + 16 * w * 72, 72, fr, fq);
  wmma<8, 1, 4>(acc, ST, 136, qs + 16 * w * 136, 136, fr, fq);
  float ss = 0.f;
#pragma unroll
  for (int mi = 0; mi < 8; ++mi) ss += acc[mi][0][0] * acc[mi][0][0] + acc[mi][0][1] * acc[mi][0][1] + acc[mi][0][2] * acc[mi][0][2] + acc[mi][0][3] * acc[mi][0][3];
  ss += __shfl_xor(ss, 16); ss += __shfl_xor(ss, 32);
  const float rs = rsqrtf(ss * (1.f / 128.f) + 1e-6f);
  const size_t row = (size_t)ui.rowbase + 16 * w + fr;
#pragma unroll
  for (int mi = 0; mi < 8; ++mi) {
    const int col = hc + mi * 16 + fq * 4;
    const u32x2 zv = *(const u32x2*)(PRG(12) + row * 512 + col);
    const float4 g = *(const float4*)(p.g_hg + l * 512 + col);
    const f32x4 v = acc[mi][0];
    u32x2 pk;
    pk.x = pack2(v[0] * rs * g.x * silu(lo2f(zv.x)), v[1] * rs * g.y * silu(hi2f(zv.x)));
    pk.y = pack2(v[2] * rs * g.z * silu(lo2f(zv.y)), v[3] * rs * g.w * silu(hi2f(zv.y)));
    *(u32x2*)(p.H() + (size_t)2 * NTOK * 512 + row * 512 + col) = pk;
  }
}

__device__ void merge_tile(const Params& p, int l, int t, char* smem) {
  const int tm = t >> 3, tn = t & 7;
  const int tid = get_tid(), lane = tid & 63, wid = tid >> 6, wr = wid >> 1, wc = wid & 1, fr = lane & 15, fq = lane >> 4;
#pragma unroll 1
  for (int b = 0; b < 3; ++b) {
    f32x4 acc[4][4]; zero_acc(acc);
    gemm_kloop<bf16_t>(acc, p.U() + (size_t)tm * 128 * 1024, 1024, p.wt_in() + (size_t)l * NWT * 1024 + (size_t)(NMAIN + b * 1024 + tn * 128) * 1024, 1024, 1024, smem);
#pragma unroll
    for (int ni = 0; ni < 4; ++ni)
#pragma unroll
      for (int mi = 0; mi < 4; ++mi) {
        f32x4 v; v[0] = sigm(acc[mi][ni][0]); v[1] = sigm(acc[mi][ni][1]); v[2] = sigm(acc[mi][ni][2]); v[3] = sigm(acc[mi][ni][3]);
        *(f32x4*)(p.r() + ((size_t)tm * 128 + wr * 64 + ni * 16 + fr) * 1024 + tn * 128 + wc * 64 + mi * 16 + fq * 4) = v;
      }
    zero_acc(acc);
    gemm_kloop<bf16_t>(acc, p.H() + (size_t)b * NTOK * 512 + (size_t)tm * 128 * 512, 512, p.wt_br() + (size_t)(l * 3 + b) * 1024 * 512 + (size_t)tn * 128 * 512, 512, 512, smem);
#pragma unroll
    for (int ni = 0; ni < 4; ++ni) {
      const size_t row = (size_t)tm * 128 + wr * 64 + ni * 16 + fr;
#pragma unroll
      for (int mi = 0; mi < 4; ++mi) {
        const int col = tn * 128 + wc * 64 + mi * 16 + fq * 4;
        f32x4 v = *(const f32x4*)(p.r() + row * 1024 + col) * acc[mi][ni];
        float* part = p.y() + row * 1024 + col;
        if (b > 0) v += *(const f32x4*)part;
        if (b < 2) *(f32x4*)part = v;
        else { u32x2 pk; pk.x = pack2(v[0], v[1]); pk.y = pack2(v[2], v[3]); *(u32x2*)(p.merged() + row * 1024 + col) = pk; }
      }
    }
  }
}

__device__ void outproj_tile(const Params& p, int l, int t, char* smem) {
  const int tm = t >> 3, tn = t & 7;
  const int tid = get_tid(), lane = tid & 63, wid = tid >> 6, wr = wid >> 1, wc = wid & 1, fr = lane & 15, fq = lane >> 4;
  f32x4 acc[4][4]; zero_acc(acc);
  gemm_kloop<bf16_t>(acc, p.merged() + (size_t)tm * 128 * 1024, 1024, p.wt_out() + (size_t)l * 1048576 + (size_t)tn * 128 * 1024, 1024, 1024, smem);
#pragma unroll
  for (int ni = 0; ni < 4; ++ni) {
    const size_t row = (size_t)tm * 128 + wr * 64 + ni * 16 + fr;
#pragma unroll
    for (int mi = 0; mi < 4; ++mi) *(f32x4*)(p.y() + row * 1024 + tn * 128 + wc * 64 + mi * 16 + fq * 4) = acc[mi][ni];
  }
}


__device__ void outproj_tile256(const Params& p, int l, int t, char* smem) {
  constexpr int NT = 8;
  const int tm = t >> 3, tn = t & 7;
  const int tid = get_tid(), lane = tid & 63, wid = tid >> 6, wr = wid >> 1, wc = wid & 1, fr = lane & 15, fq = lane >> 4;
  f32x4 acc[4][NT];
#pragma unroll
  for (int a_ = 0; a_ < 4; ++a_)
#pragma unroll
    for (int b_ = 0; b_ < NT; ++b_) acc[a_][b_] = (f32x4){0.f, 0.f, 0.f, 0.f};
  gemm_glds<NT, 3>(acc, p.merged() + (size_t)tm * 256 * 1024, 1024, p.wt_out() + (size_t)l * 1048576 + (size_t)tn * 128 * 1024, 1024, 1024, smem);
#pragma unroll
  for (int ni = 0; ni < NT; ++ni) {
    const size_t row = (size_t)tm * 256 + wr * 128 + ni * 16 + fr;
#pragma unroll
    for (int m = 0; m < 2; ++m) {
      float* op = p.y() + row * 1024 + tn * 128 + wc * 64 + m * 32 + fq * 8;
      *(f32x4*)op = acc[2 * m][ni]; *(f32x4*)(op + 4) = acc[2 * m + 1][ni];
    }
  }
}


__device__ void gate_tile256(const Params& p, int l, int t, char* smem) {
  constexpr int NT = 8;
  const int tm = t / 24, tn = t % 24;
  const int tid = get_tid(), lane = tid & 63, wid = tid >> 6, wr = wid >> 1, wc = wid & 1, fr = lane & 15, fq = lane >> 4;
  f32x4 acc[4][NT];
#pragma unroll
  for (int a_ = 0; a_ < 4; ++a_)
#pragma unroll
    for (int b_ = 0; b_ < NT; ++b_) acc[a_][b_] = (f32x4){0.f, 0.f, 0.f, 0.f};
  gemm_glds<NT, 3>(acc, p.U() + (size_t)tm * 256 * 1024, 1024, p.wt_in() + (size_t)l * NWT * 1024 + (size_t)(NMAIN + tn * 128) * 1024, 1024, 1024, smem);
#pragma unroll
  for (int ni = 0; ni < NT; ++ni) {
    const size_t row = (size_t)tm * 256 + wr * 128 + ni * 16 + fr;
#pragma unroll
    for (int m = 0; m < 2; ++m) {
      const f32x4 v0 = acc[2 * m][ni], v1 = acc[2 * m + 1][ni];
      u32x4 pk; pk.x = pack2(sigm(v0[0]), sigm(v0[1])); pk.y = pack2(sigm(v0[2]), sigm(v0[3])); pk.z = pack2(sigm(v1[0]), sigm(v1[1])); pk.w = pack2(sigm(v1[2]), sigm(v1[3]));
      *(u32x4*)(p.G() + row * 3072 + tn * 128 + wc * 64 + m * 32 + fq * 8) = pk;
    }
  }
}
__device__ void merge_tile_g(const Params& p, int l, int t, char* smem) {
  const int tm = t >> 3, tn = t & 7;
  const int tid = get_tid(), lane = tid & 63, wid = tid >> 6, wr = wid >> 1, wc = wid & 1, fr = lane & 15, fq = lane >> 4;
  f32x4 macc[4][4]; zero_acc(macc);
#pragma unroll 1
  for (int b = 0; b < 3; ++b) {
    f32x4 acc[4][4]; zero_acc(acc);
    gemm_kloop<bf16_t>(acc, p.H() + (size_t)b * NTOK * 512 + (size_t)tm * 128 * 512, 512, p.wt_br() + (size_t)(l * 3 + b) * 1024 * 512 + (size_t)tn * 128 * 512, 512, 512, smem);
#pragma unroll
    for (int ni = 0; ni < 4; ++ni) {
      const size_t row = (size_t)tm * 128 + wr * 64 + ni * 16 + fr;
#pragma unroll
      for (int mi = 0; mi < 4; ++mi) {
        const u32x2 g = *(const u32x2*)(p.G() + row * 3072 + b * 1024 + tn * 128 + wc * 64 + mi * 16 + fq * 4);
        macc[mi][ni][0] += lo2f(g.x) * acc[mi][ni][0]; macc[mi][ni][1] += hi2f(g.x) * acc[mi][ni][1];
        macc[mi][ni][2] += lo2f(g.y) * acc[mi][ni][2]; macc[mi][ni][3] += hi2f(g.y) * acc[mi][ni][3];
      }
    }
  }
#pragma unroll
  for (int ni = 0; ni < 4; ++ni) {
    const size_t row = (size_t)tm * 128 + wr * 64 + ni * 16 + fr;
#pragma unroll
    for (int mi = 0; mi < 4; ++mi) {
      u32x2 pk; pk.x = pack2(macc[mi][ni][0], macc[mi][ni][1]); pk.y = pack2(macc[mi][ni][2], macc[mi][ni][3]);
      *(u32x2*)(p.merged() + row * 1024 + tn * 128 + wc * 64 + mi * 16 + fq * 4) = pk;
    }
  }
}

__device__ void postnorm_phase(const Params& p, int l) {
  const int lane = threadIdx.x & 63, wid = threadIdx.x >> 6;
  const float* gp = p.g_post + l * 1024;
  for (int row = blockIdx.x * 4 + wid; row < NTOK; row += gridDim.x * 4) {
    const float* x = xrow(p, l, row);
    const float* y = p.y() + (size_t)row * 1024;
    float4 v[4]; float ss = 0.f;
#pragma unroll
    for (int i = 0; i < 4; ++i) { v[i] = *(const float4*)(y + i * 256 + lane * 4); ss += v[i].x * v[i].x + v[i].y * v[i].y + v[i].z * v[i].z + v[i].w * v[i].w; }
#pragma unroll
    for (int o = 32; o > 0; o >>= 1) ss += __shfl_xor(ss, o);
    const float rstd = rsqrtf(ss * (1.f / 1024.f) + 1e-6f);
#pragma unroll
    for (int i = 0; i < 4; ++i) {
      const int k = i * 256 + lane * 4;
      const float4 g = *(const float4*)(gp + k), xv = *(const float4*)(x + k);
      float4 r; r.x = xv.x + v[i].x * rstd * g.x; r.y = xv.y + v[i].y * rstd * g.y; r.z = xv.z + v[i].z * rstd * g.z; r.w = xv.w + v[i].w * rstd * g.w;
      *(float4*)(p.r() + (size_t)row * 1024 + k) = r;
      u32x2 pk; pk.x = pack2(r.x, r.y); pk.y = pack2(r.z, r.w);
      *(u32x2*)(p.rb() + (size_t)row * 1024 + k) = pk;
    }
  }
}

__device__ void ple_tile(const Params& p, int l, int t, char* smem) {
  const int tm = t >> 3, tn = t & 7;
  const int tid = get_tid(), lane = tid & 63, wid = tid >> 6, wr = wid >> 1, wc = wid & 1, fr = lane & 15, fq = lane >> 4;
  f32x4 acc[4][4]; zero_acc(acc);
  const int row0 = tm * 128;
  const float* pp = row0 < NPROMPT ? p.p_p + ((size_t)l * NPROMPT + row0) * 256 : p.p_s + ((size_t)l * 512 + (row0 - NPROMPT)) * 256;
  gemm_kloop<float>(acc, pp, 256, p.wt_pp() + (size_t)l * 262144 + (size_t)tn * 128 * 256, 256, 256, smem);
  u32x2 pb[4][4];
#pragma unroll
  for (int a = 0; a < 4; ++a)
#pragma unroll
    for (int c = 0; c < 4; ++c) { pb[a][c].x = pack2(acc[a][c][0], acc[a][c][1]); pb[a][c].y = pack2(acc[a][c][2], acc[a][c][3]); }
  zero_acc(acc);
  gemm_kloop<bf16_t>(acc, p.rb() + (size_t)tm * 128 * 1024, 1024, p.wt_pg() + (size_t)l * 1048576 + (size_t)tn * 128 * 1024, 1024, 1024, smem);
#pragma unroll
  for (int ni = 0; ni < 4; ++ni) {
    const size_t row = (size_t)row0 + wr * 64 + ni * 16 + fr;
#pragma unroll
    for (int mi = 0; mi < 4; ++mi) {
      const int col = tn * 128 + wc * 64 + mi * 16 + fq * 4;
      const f32x4 rv = *(const f32x4*)(p.r() + row * 1024 + col);
      f32x4 o;
      o[0] = rv[0] + sigm(acc[mi][ni][0]) * lo2f(pb[mi][ni].x); o[1] = rv[1] + sigm(acc[mi][ni][1]) * hi2f(pb[mi][ni].x);
      o[2] = rv[2] + sigm(acc[mi][ni][2]) * lo2f(pb[mi][ni].y); o[3] = rv[3] + sigm(acc[mi][ni][3]) * hi2f(pb[mi][ni].y);
      *(f32x4*)(p.o_y() + row * 1024 + col) = o;
    }
  }
}


template <typename TT>
__device__ __forceinline__ void mini_dot(f32x4& acc, const TT* Trow, const bf16_t* Wrow, int K) {
#pragma unroll 8
  for (int k = 0; k < K; k += 32) {
    const u32x4 tv = ld8(Trow + k), wv = ld8(Wrow + k);
    acc = __builtin_amdgcn_mfma_f32_16x16x32_bf16(__builtin_bit_cast(bf16x8, wv), __builtin_bit_cast(bf16x8, tv), acc, 0, 0, 0);
  }
}
__device__ void merge_mini(const Params& p, int l, int j) {
  const int tid = get_tid(), lane = tid & 63, w = tid >> 6, fr = lane & 15, fq = lane >> 4;
  const size_t row = (size_t)NPROMPT + (j >> 4) * 16 + fr;
  const int cb = (j & 15) * 64 + w * 16;
  f32x4 out = {0.f, 0.f, 0.f, 0.f};
#pragma unroll 1
  for (int b = 0; b < 3; ++b) {
    f32x4 g = {0.f, 0.f, 0.f, 0.f}, h = {0.f, 0.f, 0.f, 0.f};
    mini_dot<bf16_t>(g, p.U() + row * 1024 + fq * 8, p.wt_in() + (size_t)l * NWT * 1024 + (size_t)(NMAIN + b * 1024 + cb + fr) * 1024 + fq * 8, 1024);
    mini_dot<bf16_t>(h, p.H() + (size_t)b * NTOK * 512 + row * 512 + fq * 8, p.wt_br() + (size_t)(l * 3 + b) * 1024 * 512 + (size_t)(cb + fr) * 512 + fq * 8, 512);
    out[0] += sigm(g[0]) * h[0]; out[1] += sigm(g[1]) * h[1]; out[2] += sigm(g[2]) * h[2]; out[3] += sigm(g[3]) * h[3];
  }
  u32x2 pk; pk.x = pack2(out[0], out[1]); pk.y = pack2(out[2], out[3]);
  *(u32x2*)(p.merged() + row * 1024 + cb + fq * 4) = pk;
}
__device__ void outproj_mini(const Params& p, int l, int j) {
  const int tid = get_tid(), lane = tid & 63, w = tid >> 6, fr = lane & 15, fq = lane >> 4;
  const size_t row = (size_t)NPROMPT + (j >> 4) * 16 + fr;
  const int cb = (j & 15) * 64 + w * 16;
  f32x4 y = {0.f, 0.f, 0.f, 0.f};
  mini_dot<bf16_t>(y, p.merged() + row * 1024 + fq * 8, p.wt_out() + (size_t)l * 1048576 + (size_t)(cb + fr) * 1024 + fq * 8, 1024);
  *(f32x4*)(p.y() + row * 1024 + cb + fq * 4) = y;
}
__device__ void ple_mini(const Params& p, int l, int j) {
  const int tid = get_tid(), lane = tid & 63, w = tid >> 6, fr = lane & 15, fq = lane >> 4;
  const int srow = (j >> 4) * 16 + fr;
  const size_t row = (size_t)NPROMPT + srow;
  const int cb = (j & 15) * 64 + w * 16;
  f32x4 g = {0.f, 0.f, 0.f, 0.f}, pa = {0.f, 0.f, 0.f, 0.f};
  mini_dot<float>(pa, p.p_s + ((size_t)l * 512 + srow) * 256 + fq * 8, p.wt_pp() + (size_t)l * 262144 + (size_t)(cb + fr) * 256 + fq * 8, 256);
  mini_dot<bf16_t>(g, p.rb() + row * 1024 + fq * 8, p.wt_pg() + (size_t)l * 1048576 + (size_t)(cb + fr) * 1024 + fq * 8, 1024);
  const f32x4 rv = *(const f32x4*)(p.r() + row * 1024 + cb + fq * 4);
  f32x4 o; o[0] = rv[0] + sigm(g[0]) * pa[0]; o[1] = rv[1] + sigm(g[1]) * pa[1]; o[2] = rv[2] + sigm(g[2]) * pa[2]; o[3] = rv[3] + sigm(g[3]) * pa[3];
  *(f32x4*)(p.o_y() + row * 1024 + cb + fq * 4) = o;
}

#define XB_TMO      128
#define XB_XCNT(j)  (256  + 64 * (j))
#define XB_XSUB(j)  (1280 + 64 * (j))
#define XB_XGEN(j)  (2304 + 64 * (j))
#define XB_TOP      3328
#define XB_TOPGEN   3392
#define XCD_BAR_WORDS 3456
#define XB_SPIN_CAP (1u << 18)
#define LAS __attribute__((address_space(3)))
__device__ __forceinline__ unsigned xb_ld(unsigned* p)              { return __hip_atomic_load(p, __ATOMIC_RELAXED, __HIP_MEMORY_SCOPE_AGENT); }
__device__ __forceinline__ unsigned xb_add(unsigned* p, unsigned v) { return __hip_atomic_fetch_add(p, v, __ATOMIC_RELAXED, __HIP_MEMORY_SCOPE_AGENT); }
__device__ __forceinline__ unsigned xb_xcc_id() { return (unsigned)__builtin_amdgcn_s_getreg((3 << 11) | 20) & 0xFu; }
#define XB_SPIN(cond, bar) do { unsigned _sp = 0; while (cond) { __builtin_amdgcn_s_sleep(1); \
    if ((++_sp & 255u) == 0u) { if (xb_ld(&(bar)[XB_TMO])) break; if (_sp > XB_SPIN_CAP) { atomicAdd(&(bar)[XB_TMO], 1u); break; } } } } while (0)
__device__ __forceinline__ void xcd_barrier_complete(unsigned* bar, unsigned x, unsigned& nloc, unsigned& nx) {
    const unsigned G = gridDim.x * gridDim.y * gridDim.z;
    unsigned sum, cnt, mine, sp = 0u;
    for (;;) {
        sum = 0u; cnt = 0u; mine = 0u;
#pragma unroll
        for (unsigned j = 0; j < 16; ++j) { const unsigned c = xb_ld(&bar[XB_XCNT(j)]); sum += c; cnt += (c > 0u) ? 1u : 0u; mine = (j == x) ? c : mine; }
        if (sum == G) break;
        __builtin_amdgcn_s_sleep(1);
        if ((++sp & 255u) == 0u) { if (xb_ld(&bar[XB_TMO])) break; if (sp > XB_SPIN_CAP) { atomicAdd(&bar[XB_TMO], 1u); break; } }
    }
    nloc = mine > 0u ? mine : 1u; nx = cnt > 0u ? cnt : 1u;
}
__device__ __forceinline__ void xcd_barrier(unsigned* bar, volatile LAS unsigned* st) {
    asm volatile("s_waitcnt vmcnt(0)" ::: "memory");
    __syncthreads();
    if (threadIdx.x == 0) {
        const unsigned x = xb_xcc_id();
        __builtin_amdgcn_s_waitcnt(0);
        unsigned nloc = st[0], nx = st[1];
        if (nloc == 0u) { xcd_barrier_complete(bar, x, nloc, nx); st[0] = nloc; st[1] = nx; }
        const unsigned old = xb_add(&bar[XB_XSUB(x)], 1u);
        const unsigned gen = old / nloc;
        if (old + 1u == (gen + 1u) * nloc) {
            __builtin_amdgcn_fence(__ATOMIC_RELEASE, "agent");
            asm volatile("s_waitcnt vmcnt(0)" ::: "memory");
            const unsigned og = xb_add(&bar[XB_TOP], 1u);
            const unsigned tg = og / nx;
            if (og + 1u == (tg + 1u) * nx) xb_add(&bar[XB_TOPGEN], 1u);
            else XB_SPIN(xb_ld(&bar[XB_TOPGEN]) == tg, bar);
            __builtin_amdgcn_fence(__ATOMIC_ACQUIRE, "agent");
            xb_add(&bar[XB_XGEN(x)], 1u);
            asm volatile("s_waitcnt vmcnt(0)" ::: "memory");
        } else {
            XB_SPIN(xb_ld(&bar[XB_XGEN(x)]) == gen, bar);
            __builtin_amdgcn_fence(__ATOMIC_ACQUIRE, "agent");
            asm volatile("s_waitcnt vmcnt(0)" ::: "memory");
        }
    }
    __syncthreads();
}

template <int PH>
__device__ __forceinline__ void run_phase(const Params& p, char* smem) {
  const int bid = blockIdx.x, nb = gridDim.x;
  if (PH == 0) {
    for (int t = bid; t < 6784; t += nb) wconv_tile(p, t, smem);
    for (int i = bid * 256 + get_tid(); i < 2 * 8 * 1024; i += nb * 256) { const int ll = i >> 13, j = (i >> 10) & 7, k = i & 1023; p.wg8()[i] = p.w_in[((size_t)ll * 1024 + k) * NINSRC + 2560 + j]; }
    return;
  }
  constexpr int l = (PH - 1) / NPL, s0_ = (PH - 1) % NPL, s = s0_ < 5 ? s0_ : s0_ - 1;
  if (s0_ == 5) return;
  if (!((PHMASK >> s) & 1)) return;
  switch (s) {
    case 0: norm_phase(p, l); break;
    case 1: {
      const int per = (66 * 52) / 8, xcd = bid & 7, nloc = (nb + 7 - xcd) >> 3;
      for (int j = bid >> 3; j < per; j += nloc) {
        const int sq = xcd * per + j;
        const int tmg = sq / 416, rem = sq % 416, gm = (tmg == 8) ? 2 : 8;
        const int tng = rem / (gm * 8), rem2 = rem % (gm * 8), wdt = (tng == 6) ? 4 : 8;
        inproj_tile(p, l, (tmg * 8 + rem2 / wdt) * 52 + tng * 8 + rem2 % wdt, smem);
      }
      break;
    }
    case 2:
      for (int v = bid; v < 3 * NUNIT; v += nb) {
        const int ty = v % 3, u = v / 3;
        if (ty == 0) sb_unit(p, l, u, smem); else if (ty == 1) mlstm_local(p, l, u, smem); else hgrn_local(p, l, u, smem);
      }
      break;
    case 3: scan_phase(p, l, smem); break;
    case 4:
      for (int v = bid; v < 2 * NUNIT; v += nb) { if (v & 1) hgrn_out(p, l, v >> 1, smem); else mlstm_out(p, l, v >> 1, smem); }
      break;
    case 5: for (int t = bid; t < 1024; t += nb) merge_tile(p, l, t, smem); for (int j = bid; j < 512; j += nb) merge_mini(p, l, j); break;
    case 6: for (int t = bid; t < 1024; t += nb) outproj_tile(p, l, t, smem); for (int j = bid; j < 512; j += nb) outproj_mini(p, l, j); break;
    case 7: postnorm_phase(p, l); break;
    case 8: for (int t = bid; t < 1024; t += nb) ple_tile(p, l, t, smem); for (int j = bid; j < 512; j += nb) ple_mini(p, l, j); break;
  }
}

template <int PH>
__global__ void __launch_bounds__(256, 2) phase_kernel(Params p) {
  __shared__ __attribute__((aligned(16))) char smem[SMEM_BYTES];
  run_phase<PH>(p, smem);
}

#if FUSED
__device__ __forceinline__ int fetch_work(unsigned* ctr, volatile int* slot) {
  __syncthreads();
  if (threadIdx.x == 0) *slot = (int)__hip_atomic_fetch_add(ctr, 1u, __ATOMIC_RELAXED, __HIP_MEMORY_SCOPE_AGENT);
  __syncthreads();
  return *slot;
}
__device__ __forceinline__ void run_phase_rt(const Params& p, int ph, char* smem, volatile int* wslot) {
  const int bid = blockIdx.x, nb = gridDim.x;
  unsigned* ctr = (unsigned*)(p.ws + WS_BAR + 14336) + ph * 16;
  if (ph == 0) {
    for (int t = bid; t < 6784; t += nb) wconv_tile(p, t, smem);
    for (int i = bid * 256 + get_tid(); i < 2 * 8 * 1024; i += nb * 256) { const int ll = i >> 13, j = (i >> 10) & 7, k = i & 1023; p.wg8()[i] = p.w_in[((size_t)ll * 1024 + k) * NINSRC + 2560 + j]; }
    return;
  }
  const int l = (ph - 1) / NPL, s = (ph - 1) % NPL;
  switch (s) {
    case 0: norm_phase(p, l); break;
    case 1: {
      const int per = (66 * 52) / 8, xcd0 = (int)(xb_xcc_id() & 7u);
      for (int dx = 0; dx < 8; ++dx) {
        const int xcd = (xcd0 + dx) & 7;
        for (;;) {
          const int j = fetch_work(ctr + xcd, wslot);
          if (j >= per) break;
          const int sq = xcd * per + j;
          const int tmg = sq / 416, rem = sq % 416, gm = (tmg == 8) ? 2 : 8;
          const int tng = rem / (gm * 8), rem2 = rem % (gm * 8), wdt = (tng == 6) ? 4 : 8;
          inproj_tile(p, l, (tmg * 8 + rem2 / wdt) * 52 + tng * 8 + rem2 % wdt, smem);
        }
      }
      break;
    }
    case 2:
      for (;;) {
        const int v = fetch_work(ctr, wslot);
        if (v >= 3 * NUNIT) break;
        if (v < NUNIT) sb_unit(p, l, v, smem); else if (v < 2 * NUNIT) mlstm_local(p, l, v - NUNIT, smem); else hgrn_local(p, l, v - 2 * NUNIT, smem);
      }
      break;
    case 3: scan_phase(p, l, smem); break;
    case 4:
      for (;;) {
        const int v = fetch_work(ctr, wslot);
        if (v >= 2 * NUNIT) break;
        if (v < NUNIT) hgrn_out(p, l, v, smem); else mlstm_out(p, l, v - NUNIT, smem);
      }
      break;
    case 5: for (;;) { const int v = fetch_work(ctr, wslot); if (v >= 1536) break; gate_tile256(p, l, v, smem); } break;
    case 6: for (;;) { const int v = fetch_work(ctr, wslot); if (v >= 1536) break; if (v < 1024) merge_tile_g(p, l, v, smem); else merge_mini(p, l, v - 1024); } break;
    case 7: for (;;) { const int v = fetch_work(ctr, wslot); if (v >= 1024) break; if (v < 512) outproj_tile256(p, l, v, smem); else outproj_mini(p, l, v - 512); } break;
    case 8: postnorm_phase(p, l); break;
    case 9: for (;;) { const int v = fetch_work(ctr, wslot); if (v >= 1536) break; if (v < 1024) ple_tile(p, l, v, smem); else ple_mini(p, l, v - 1024); } break;
  }
}

__global__ void __launch_bounds__(256, 2) mega(Params p_unused) {
  __shared__ __attribute__((aligned(16))) char smem[SMEM_BYTES];
  __shared__ uint4 xb_words;
  __shared__ int wslot;
  if (threadIdx.x == 0) {
    typedef const Params __attribute__((address_space(4))) * KP4;
    KP4 kp = (KP4)__builtin_amdgcn_kernarg_segment_ptr();
    asm volatile("" : "+s"(kp));
    char* wsb = ((const Params*)kp)->ws;
    xb_words = make_uint4(0u, 0u, 0u, 0u); (void)xb_add((unsigned*)(wsb + WS_BAR) + XB_XCNT(xb_xcc_id()), 1u);
  }
  __syncthreads();
  typedef const Params __attribute__((address_space(4))) * KP4;
#ifdef PROBE_KIND
  unsigned long long t_acc = 0;
#endif
#pragma unroll 1
  for (int ph = 0; ph < NPHASE; ++ph) {
    KP4 kp = (KP4)__builtin_amdgcn_kernarg_segment_ptr();
    asm volatile("" : "+s"(kp));
    const Params q = *(const Params*)kp;
#ifdef PROBE_KIND
    const unsigned long long tp0 = __builtin_amdgcn_s_memrealtime();
#endif
    run_phase_rt(q, ph, smem, &wslot);
#ifdef PROBE_KIND
    const unsigned long long tp1 = __builtin_amdgcn_s_memrealtime();
    if ((PROBE_KIND == 9 && ph == 0) || (PROBE_KIND < 9 && ph > 0 && (ph - 1) % NPL == PROBE_KIND)) t_acc += tp1 - tp0;
#endif
    if (ph + 1 < NPHASE) xcd_barrier((unsigned*)(q.ws + WS_BAR), (volatile LAS unsigned*)&xb_words);
    if (gridDim.y == 7777u) cg::this_grid().sync();
#ifdef PROBE_KIND
    if (PROBE_KIND == 10 && (PROBE_SEL < 0 || (ph > 0 && (ph - 1) % NPL == PROBE_SEL))) t_acc += __builtin_amdgcn_s_memrealtime() - tp1;
#endif
  }
#ifdef PROBE_GEMM
  {
    KP4 kp = (KP4)__builtin_amdgcn_kernarg_segment_ptr();
    asm volatile("" : "+s"(kp));
    const Params q = *(const Params*)kp;
    xcd_barrier((unsigned*)(q.ws + WS_BAR), (volatile LAS unsigned*)&xb_words);
    const unsigned long long tg0 = __builtin_amdgcn_s_memrealtime();
    f32x4 acc[4][8];
#pragma unroll
    for (int a_ = 0; a_ < 4; ++a_)
#pragma unroll
      for (int b_ = 0; b_ < 8; ++b_) acc[a_][b_] = (f32x4){0.f, 0.f, 0.f, 0.f};
    const int bid = blockIdx.x;
#pragma unroll 1
    for (int it = 0; it < 8; ++it) {
      int tm, tn;
      if (PROBE_GEMM == 0) { tm = 0; tn = 0; }
      else if (PROBE_GEMM == 1) { tm = bid & 63; tn = ((bid >> 6) * 6 + it) % 52; }
      else { const int xcd = bid & 7, idx = bid >> 3; tm = xcd * 8 + (idx & 7); tn = ((idx >> 3) + 8 * it) % 52; }
      gemm_glds<8, 3>(acc, q.U() + (size_t)tm * 256 * 1024, 1024, q.wt_in() + (size_t)tn * 128 * 1024, 1024, 1024, smem);
    }
    float sum = 0.f;
#pragma unroll
    for (int a_ = 0; a_ < 4; ++a_)
#pragma unroll
      for (int b_ = 0; b_ < 8; ++b_) sum += acc[a_][b_][0] + acc[a_][b_][1] + acc[a_][b_][2] + acc[a_][b_][3];
    if (sum == 123456.789f) q.hbc()[0] = sum;
    const unsigned long long tg1 = __builtin_amdgcn_s_memrealtime();
    if (blockIdx.x == 0) { while (__builtin_amdgcn_s_memrealtime() - tg1 < 4 * (tg1 - tg0)) __builtin_amdgcn_s_sleep(32); }
  }
#endif
#ifdef PROBE_KIND
  if (blockIdx.x == PROBE_BLOCK) { const unsigned long long te = __builtin_amdgcn_s_memrealtime(); while (__builtin_amdgcn_s_memrealtime() - te < 4 * t_acc) __builtin_amdgcn_s_sleep(32); }
#endif
}
#endif

template <int PH>
static void launch_all(const Params& p, int grid, hipStream_t stream) {
  hipLaunchKernelGGL(phase_kernel<PH>, dim3(grid), dim3(256), 0, stream, p);
  if constexpr (PH + 1 < NPHASE) launch_all<PH + 1>(p, grid, stream);
}

extern "C" void kernel_launch(void* const* d_in, const int* in_sizes, int n_in, void* d_out, int out_size, void* d_ws, size_t ws_size, hipStream_t stream) {
  Params p;
  memset(&p, 0, sizeof(p));
  const float* const* in = (const float* const*)d_in;
  p.x_p = in[0]; p.x_s = in[1]; p.p_p = in[2]; p.p_s = in[3]; p.st_C = in[4]; p.st_n = in[5]; p.st_m = in[6]; p.st_conv = in[7];
  p.ck = in[8]; p.cv = in[9]; p.st_S = in[10]; p.g_pre = in[11]; p.w_in = in[12]; p.b_i = in[13]; p.b_f = in[14]; p.w_conv = in[15];
  p.g_ml = in[16]; p.lb_logits = in[17]; p.g_hg = in[18]; p.w_br = in[19]; p.w_out = in[20]; p.g_post = in[21]; p.w_pg = in[22]; p.w_pp = in[23];
  p.out = (float*)d_out; p.ws = (char*)d_ws;
  if (WS_TOTAL > ws_size || (size_t)out_size < O_TOTAL) { fprintf(stderr, "workspace/out too small: need %zu have %zu\n", (size_t)WS_TOTAL, ws_size); return; }
  static int grid_blocks = 0;
  if (!grid_blocks) {
    int dev = 0, cus = 0, per_cu = 0;
    (void)hipGetDevice(&dev);
    (void)hipDeviceGetAttribute(&cus, hipDeviceAttributeMultiprocessorCount, dev);
#if FUSED
    (void)hipOccupancyMaxActiveBlocksPerMultiprocessor(&per_cu, mega, 256, 0);
#else
    per_cu = 2;
#endif
    if (per_cu > 2) per_cu = 2;
    if (per_cu < 1) per_cu = 1;
    grid_blocks = cus * per_cu;
  }
#if FUSED
  (void)hipMemsetAsync((char*)d_ws + WS_BAR, 0, 16384, stream);
  void* args[] = {&p};
  hipError_t e = hipLaunchCooperativeKernel((void*)mega, dim3(grid_blocks), dim3(256), args, 0, stream);
  if (e != hipSuccess) fprintf(stderr, "cooperative launch failed: %s (grid %d)\n", hipGetErrorString(e), grid_blocks);
#else
  launch_all<0>(p, grid_blocks, stream);
#endif
}
```

```cpp
#include <hip/hip_runtime.h>
#include <hip/hip_cooperative_groups.h>
#include <stdint.h>
#include <stdio.h>
#include <string.h>
namespace cg = cooperative_groups;

#ifndef FUSED
#define FUSED 1
#endif
#ifndef PHMASK
#define PHMASK 0x3ff
#endif

typedef unsigned short bf16_t;
typedef short bf16x8 __attribute__((ext_vector_type(8)));
typedef float f32x4 __attribute__((ext_vector_type(4)));
typedef unsigned u32x4 __attribute__((ext_vector_type(4)));
typedef unsigned u32x2 __attribute__((ext_vector_type(2)));

constexpr int NTOK = 16896, NPROMPT = 16384, NUNIT = 1056;
constexpr int NINSRC = 9736, NWT = 9728, NMAIN = 6656;
constexpr int SMEM_BYTES = 80896;
constexpr int NPL = 10;
constexpr int NPHASE = 1 + 2 * NPL;

constexpr size_t al256(size_t x) { return (x + 255) & ~(size_t)255; }
constexpr size_t WS_WT_IN = 0;
constexpr size_t WS_WT_BR = WS_WT_IN + al256((size_t)2 * NWT * 1024 * 2);
constexpr size_t WS_WT_OUT = WS_WT_BR + al256((size_t)2 * 3 * 1024 * 512 * 2);
constexpr size_t WS_WT_PG = WS_WT_OUT + al256((size_t)2 * 1048576 * 2);
constexpr size_t WS_WT_PP = WS_WT_PG + al256((size_t)2 * 1048576 * 2);
constexpr size_t WS_U = WS_WT_PP + al256((size_t)2 * 262144 * 2);
constexpr size_t WS_PR = WS_U + al256((size_t)NTOK * 1024 * 2);
constexpr size_t WS_QC = WS_PR + al256((size_t)13 * NTOK * 512 * 2);
constexpr size_t WS_KC = WS_QC + al256((size_t)NTOK * 512 * 2);
constexpr size_t WS_SM = WS_KC + al256((size_t)NTOK * 512 * 2);
constexpr size_t WS_SH = WS_SM + al256((size_t)NUNIT * 16384 * 2);
constexpr size_t WS_H = WS_SH + al256((size_t)NUNIT * 16384 * 2);
constexpr size_t WS_IG = WS_H + al256((size_t)3 * NTOK * 512 * 2);
constexpr size_t WS_LF = WS_IG + al256((size_t)NTOK * 16);
constexpr size_t WS_AC = WS_LF + al256((size_t)NTOK * 16);
constexpr size_t WS_BC = WS_AC + al256(NUNIT * 4);
constexpr size_t WS_MIN = WS_BC + al256(NUNIT * 4);
constexpr size_t WS_NLOC = WS_MIN + al256(NUNIT * 4);
constexpr size_t WS_HBC = WS_NLOC + al256((size_t)NUNIT * 512);
constexpr size_t WS_BAR = WS_HBC + al256((size_t)NUNIT * 512);
constexpr size_t WS_WG8 = WS_BAR + 16384;
constexpr size_t WS_TOTAL = WS_WG8 + 65536;
constexpr size_t WS_MERGED = WS_PR;
constexpr size_t WS_Y = WS_MERGED + (size_t)NTOK * 1024 * 2;
constexpr size_t WS_R = WS_Y + (size_t)NTOK * 1024 * 4;
constexpr size_t WS_RB = WS_R + (size_t)NTOK * 1024 * 4;
static_assert(WS_RB + (size_t)NTOK * 1024 * 2 <= WS_QC, "alias overflow");
constexpr size_t O_PC = 16777216 + 524288, O_PN = O_PC + 262144, O_PM = O_PN + 2048, O_PCONV = O_PM + 16, O_PK = O_PCONV + 12288, O_PV = O_PK + 16777216,
                 O_PS = O_PV + 16777216, O_SC = O_PS + 262144, O_SN = O_SC + 1048576, O_SM = O_SN + 8192, O_SCONV = O_SM + 64, O_SK = O_SCONV + 49152,
                 O_SV = O_SK + 524288, O_SS = O_SV + 524288, O_TOTAL = O_SS + 1048576;

struct Params {
  const float *x_p, *x_s, *p_p, *p_s, *st_C, *st_n, *st_m, *st_conv, *ck, *cv, *st_S;
  const float *g_pre, *w_in, *b_i, *b_f, *w_conv, *g_ml, *lb_logits, *g_hg, *w_br, *w_out, *g_post, *w_pg, *w_pp;
  float* out; char* ws;
#define WSP(name, T, off) __device__ __forceinline__ T* name() const { return (T*)(ws + (off)); }
#define OUTP(name, off) __device__ __forceinline__ float* name() const { return out + (off); }
  OUTP(o_y, 0) OUTP(o_pC, O_PC) OUTP(o_pn, O_PN) OUTP(o_pm, O_PM) OUTP(o_pconv, O_PCONV) OUTP(o_pk, O_PK) OUTP(o_pv, O_PV) OUTP(o_pS, O_PS)
  OUTP(o_sC, O_SC) OUTP(o_sn, O_SN) OUTP(o_sm, O_SM) OUTP(o_sconv, O_SCONV) OUTP(o_sk, O_SK) OUTP(o_sv, O_SV) OUTP(o_sS, O_SS)
  WSP(wt_in, bf16_t, WS_WT_IN) WSP(wt_br, bf16_t, WS_WT_BR) WSP(wt_out, bf16_t, WS_WT_OUT) WSP(wt_pg, bf16_t, WS_WT_PG) WSP(wt_pp, bf16_t, WS_WT_PP)
  WSP(U, bf16_t, WS_U) WSP(PR, bf16_t, WS_PR) WSP(QC, bf16_t, WS_QC) WSP(KC, bf16_t, WS_KC) WSP(SM, bf16_t, WS_SM) WSP(SH, bf16_t, WS_SH) WSP(H, bf16_t, WS_H)
  WSP(ig, float, WS_IG) WSP(lf, float, WS_LF) WSP(ac, float, WS_AC) WSP(Bc, float, WS_BC) WSP(min_, float, WS_MIN) WSP(nloc, float, WS_NLOC) WSP(hbc, float, WS_HBC)
  WSP(G, bf16_t, WS_Y) WSP(wg8, float, WS_WG8) WSP(merged, bf16_t, WS_MERGED) WSP(y, float, WS_Y) WSP(r, float, WS_R) WSP(rb, bf16_t, WS_RB)
};

__device__ __forceinline__ int get_tid() { int t = threadIdx.x; asm volatile("" : "+v"(t)); return t; }
__device__ __forceinline__ bf16_t f2bf(float f) { unsigned u = __float_as_uint(f); u += 0x7fffu + ((u >> 16) & 1u); return (bf16_t)(u >> 16); }
__device__ __forceinline__ float bf2f(bf16_t h) { return __uint_as_float(((unsigned)h) << 16); }
__device__ __forceinline__ unsigned pack2(float a, float b) { return (unsigned)f2bf(a) | ((unsigned)f2bf(b) << 16); }
__device__ __forceinline__ float lo2f(unsigned v) { return __uint_as_float(v << 16); }
__device__ __forceinline__ float hi2f(unsigned v) { return __uint_as_float(v & 0xffff0000u); }
__device__ __forceinline__ float sigm(float x) { return 1.f / (1.f + __expf(-x)); }
__device__ __forceinline__ float silu(float x) { return x / (1.f + __expf(-x)); }
__device__ __forceinline__ float softplus(float x) { return fmaxf(x, 0.f) + __logf(1.f + __expf(-fabsf(x))); }
__device__ __forceinline__ float logsigm(float x) { return fminf(x, 0.f) - __logf(1.f + __expf(-fabsf(x))); }

template <int MT, int NT, int KS>
__device__ __forceinline__ void wmma(f32x4 (&acc)[MT][NT], const bf16_t* A, int lda, const bf16_t* B, int ldb, int fr, int fq) {
#pragma unroll
  for (int kk = 0; kk < KS; ++kk) {
    bf16x8 a[MT], b[NT];
#pragma unroll
    for (int mi = 0; mi < MT; ++mi) a[mi] = *(const bf16x8*)(A + (mi * 16 + fr) * lda + kk * 32 + fq * 8);
#pragma unroll
    for (int ni = 0; ni < NT; ++ni) b[ni] = *(const bf16x8*)(B + (ni * 16 + fr) * ldb + kk * 32 + fq * 8);
#pragma unroll
    for (int mi = 0; mi < MT; ++mi)
#pragma unroll
      for (int ni = 0; ni < NT; ++ni) acc[mi][ni] = __builtin_amdgcn_mfma_f32_16x16x32_bf16(a[mi], b[ni], acc[mi][ni], 0, 0, 0);
  }
}

__device__ __forceinline__ u32x4 ld8(const bf16_t* s) { return *(const u32x4*)s; }
__device__ __forceinline__ u32x4 ld8(const float* s) {
  float4 a = *(const float4*)s, b = *(const float4*)(s + 4);
  u32x4 r; r.x = pack2(a.x, a.y); r.y = pack2(a.z, a.w); r.z = pack2(b.x, b.y); r.w = pack2(b.z, b.w); return r;
}
template <typename T>
__device__ __forceinline__ void ld_tile(bf16_t* dst, const T* src, long ld, int tid) {
#pragma unroll
  for (int i = 0; i < 4; ++i) { int id = tid + 256 * i; int r = id >> 4, c = (id & 15) * 8; *(u32x4*)(dst + r * 136 + c) = ld8(src + (long)r * ld + c); }
}
template <typename T>
__device__ __forceinline__ void ld_tile128(bf16_t* dst, const T* src, long ld, int tid) {
#pragma unroll
  for (int i = 0; i < 8; ++i) { int id = tid + 256 * i; int r = id >> 4, c = (id & 15) * 8; *(u32x4*)(dst + r * 136 + c) = ld8(src + (long)r * ld + c); }
}
template <typename T, int ROWS, int DLD>
__device__ __forceinline__ void ld_T(bf16_t* dst, const T* src, long ld, int tid) {
#pragma unroll 2
  for (int id = tid; id < ROWS * 16; id += 256) {
    int r = id % ROWS, c = (id / ROWS) * 8;
    u32x4 v = ld8(src + (long)r * ld + c);
    bf16_t* d = dst + c * DLD + r;
    d[0] = (bf16_t)(v.x & 0xffff); d[DLD] = (bf16_t)(v.x >> 16); d[2 * DLD] = (bf16_t)(v.y & 0xffff); d[3 * DLD] = (bf16_t)(v.y >> 16);
    d[4 * DLD] = (bf16_t)(v.z & 0xffff); d[5 * DLD] = (bf16_t)(v.z >> 16); d[6 * DLD] = (bf16_t)(v.w & 0xffff); d[7 * DLD] = (bf16_t)(v.w >> 16);
  }
}

#define PRG(g) (p.PR() + (size_t)(g) * NTOK * 512)

__device__ __forceinline__ const float* xrow(const Params& p, int l, int row) {
  if (l == 0) return row < NPROMPT ? p.x_p + (size_t)row * 1024 : p.x_s + (size_t)(row - NPROMPT) * 1024;
  return p.o_y() + (size_t)row * 1024;
}

__device__ void wconv_tile(const Params& p, int t, char* smem) {
  float* tile = (float*)smem;
  const int tid = get_tid();
  int l = t / 848, r = t % 848;
  const float* src; bf16_t* dst; int K, ldsrc, kt, nt, skip = 1 << 30;
  if (r < 608) { src = p.w_in + (size_t)l * 1024 * NINSRC; dst = p.wt_in() + (size_t)l * NWT * 1024; K = 1024; ldsrc = NINSRC; kt = r % 16; nt = r / 16; skip = 2560; }
  else if (r < 704) { r -= 608; int b = r / 32; r %= 32; src = p.w_br + (size_t)(l * 3 + b) * 512 * 1024; dst = p.wt_br() + (size_t)(l * 3 + b) * 1024 * 512; K = 512; ldsrc = 1024; kt = r % 8; nt = r / 8; }
  else if (r < 768) { r -= 704; src = p.w_out + (size_t)l * 1048576; dst = p.wt_out() + (size_t)l * 1048576; K = 1024; ldsrc = 1024; kt = r % 16; nt = r / 16; }
  else if (r < 832) { r -= 768; src = p.w_pg + (size_t)l * 1048576; dst = p.wt_pg() + (size_t)l * 1048576; K = 1024; ldsrc = 1024; kt = r % 16; nt = r / 16; }
  else { r -= 832; src = p.w_pp + (size_t)l * 262144; dst = p.wt_pp() + (size_t)l * 262144; K = 256; ldsrc = 1024; kt = r % 4; nt = r / 4; }
  const int n0 = nt * 256, k0 = kt * 64;
  __syncthreads();
#pragma unroll
  for (int i = 0; i < 16; ++i) {
    const int k = i * 4 + (tid >> 6), n4 = (tid & 63) * 4;
    int ns = n0 + n4; if (ns >= skip) ns += 8;
    *(float4*)(tile + k * 260 + n4) = *(const float4*)(src + (size_t)(k0 + k) * ldsrc + ns);
  }
  __syncthreads();
  bf16_t* drow = dst + (size_t)(n0 + tid) * K + k0;
#pragma unroll
  for (int c = 0; c < 8; ++c) {
    u32x4 pk;
    pk.x = pack2(tile[(c * 8 + 0) * 260 + tid], tile[(c * 8 + 1) * 260 + tid]);
    pk.y = pack2(tile[(c * 8 + 2) * 260 + tid], tile[(c * 8 + 3) * 260 + tid]);
    pk.z = pack2(tile[(c * 8 + 4) * 260 + tid], tile[(c * 8 + 5) * 260 + tid]);
    pk.w = pack2(tile[(c * 8 + 6) * 260 + tid], tile[(c * 8 + 7) * 260 + tid]);
    *(u32x4*)(drow + c * 8) = pk;
  }
}

__device__ void norm_phase(const Params& p, int l) {
  const int lane = threadIdx.x & 63, wid = threadIdx.x >> 6;
  const float* gp = p.g_pre + l * 1024;
  const float* wg = p.wg8() + l * 8192;
  for (int row = blockIdx.x * 4 + wid; row < NTOK; row += gridDim.x * 4) {
    const float* x = xrow(p, l, row);
    float4 v[4]; float ss = 0.f;
#pragma unroll
    for (int i = 0; i < 4; ++i) { v[i] = *(const float4*)(x + i * 256 + lane * 4); ss += v[i].x * v[i].x + v[i].y * v[i].y + v[i].z * v[i].z + v[i].w * v[i].w; }
#pragma unroll
    for (int o = 32; o > 0; o >>= 1) ss += __shfl_xor(ss, o);
    const float rstd = rsqrtf(ss * (1.f / 1024.f) + 1e-6f);
    float d0 = 0, d1 = 0, d2 = 0, d3 = 0, d4 = 0, d5 = 0, d6 = 0, d7 = 0;
#pragma unroll
    for (int i = 0; i < 4; ++i) {
      const int k = i * 256 + lane * 4;
      float4 g = *(const float4*)(gp + k);
      float u0 = v[i].x * rstd * g.x, u1 = v[i].y * rstd * g.y, u2 = v[i].z * rstd * g.z, u3 = v[i].w * rstd * g.w;
      u32x2 pk; pk.x = pack2(u0, u1); pk.y = pack2(u2, u3);
      *(u32x2*)(p.U() + (size_t)row * 1024 + k) = pk;
      const float* wp = wg + k;
      float4 w;
      w = *(const float4*)(wp);            d0 += u0 * w.x + u1 * w.y + u2 * w.z + u3 * w.w;
      w = *(const float4*)(wp + 1024);     d1 += u0 * w.x + u1 * w.y + u2 * w.z + u3 * w.w;
      w = *(const float4*)(wp + 2 * 1024); d2 += u0 * w.x + u1 * w.y + u2 * w.z + u3 * w.w;
      w = *(const float4*)(wp + 3 * 1024); d3 += u0 * w.x + u1 * w.y + u2 * w.z + u3 * w.w;
      w = *(const float4*)(wp + 4 * 1024); d4 += u0 * w.x + u1 * w.y + u2 * w.z + u3 * w.w;
      w = *(const float4*)(wp + 5 * 1024); d5 += u0 * w.x + u1 * w.y + u2 * w.z + u3 * w.w;
      w = *(const float4*)(wp + 6 * 1024); d6 += u0 * w.x + u1 * w.y + u2 * w.z + u3 * w.w;
      w = *(const float4*)(wp + 7 * 1024); d7 += u0 * w.x + u1 * w.y + u2 * w.z + u3 * w.w;
    }
#pragma unroll
    for (int o = 32; o > 0; o >>= 1) {
      d0 += __shfl_xor(d0, o); d1 += __shfl_xor(d1, o); d2 += __shfl_xor(d2, o); d3 += __shfl_xor(d3, o);
      d4 += __shfl_xor(d4, o); d5 += __shfl_xor(d5, o); d6 += __shfl_xor(d6, o); d7 += __shfl_xor(d7, o);
    }
    if (lane < 4) {
      float di = lane == 0 ? d0 : lane == 1 ? d1 : lane == 2 ? d2 : d3;
      float df = lane == 0 ? d4 : lane == 1 ? d5 : lane == 2 ? d6 : d7;
      p.ig()[row * 4 + lane] = di + p.b_i[l * 4 + lane];
      p.lf()[row * 4 + lane] = logsigm(df + p.b_f[l * 4 + lane]);
    }
  }
}

template <typename TA>
__device__ __forceinline__ void gemm_kloop(f32x4 (&acc)[4][4], const TA* Tp, long ldt, const bf16_t* Wp, long ldw, int K, char* smem) {
  bf16_t* sT = (bf16_t*)smem;
  bf16_t* sW = sT + 2 * 9216;
  const int tid = get_tid(), lane = tid & 63, wid = tid >> 6, wr = wid >> 1, wc = wid & 1, fr = lane & 15, fq = lane >> 4;
  u32x4 rt[4], rw[4];
  const int r0 = tid >> 3, c0 = (tid & 7) * 8;
#define GLOAD(k0) _Pragma("unroll") for (int i = 0; i < 4; ++i) { rt[i] = ld8(Tp + (long)(r0 + 32 * i) * ldt + (k0) + c0); rw[i] = ld8(Wp + (long)(r0 + 32 * i) * ldw + (k0) + c0); }
#define SSTORE(buf) _Pragma("unroll") for (int i = 0; i < 4; ++i) { *(u32x4*)(sT + (buf) * 9216 + (r0 + 32 * i) * 72 + c0) = rt[i]; *(u32x4*)(sW + (buf) * 9216 + (r0 + 32 * i) * 72 + c0) = rw[i]; }
  GLOAD(0); SSTORE(0);
  __syncthreads();
  const int nk = K >> 6;
#pragma unroll 1
  for (int kt = 0; kt < nk; ++kt) {
    const int buf = kt & 1;
    if (kt + 1 < nk) { GLOAD((kt + 1) * 64); }
    const bf16_t* aT = sT + buf * 9216 + (wr * 64) * 72;
    const bf16_t* aW = sW + buf * 9216 + (wc * 64) * 72;
    wmma<4, 4, 2>(acc, aW, 72, aT, 72, fr, fq);
    if (kt + 1 < nk) { SSTORE(buf ^ 1); }
    __syncthreads();
  }
#undef GLOAD
#undef SSTORE
}
__device__ __forceinline__ void zero_acc(f32x4 (&acc)[4][4]) {
#pragma unroll
  for (int a = 0; a < 4; ++a)
#pragma unroll
    for (int b = 0; b < 4; ++b) acc[a][b] = (f32x4){0.f, 0.f, 0.f, 0.f};
}


template <int NT, int NSTAGE>
__device__ __forceinline__ void gemm_glds(f32x4 (&acc)[4][NT], const bf16_t* Tp, long ldt, const bf16_t* Wp, long ldw, int K, char* smem) {
  constexpr int TR = 2 * NT * 16, STAGE_B = (TR + 128) * 64, LT = TR / 64, LPS = LT + 2;
  static_assert(NSTAGE * STAGE_B <= SMEM_BYTES, "ring too large");
  static_assert(NSTAGE == 3 || NSTAGE == 4, "waits below are written for 3 or 4 stages");
  const int tid = get_tid(), lane = tid & 63, wid = tid >> 6, wr = wid >> 1, wc = wid & 1, fr = lane & 15, fq = lane >> 4;
  const int lr = tid >> 2, cp = tid & 3, lc = (cp ^ ((lr >> 2) & 3)) * 8;
  const bf16_t* gT = Tp + (long)lr * ldt + lc;
  const int plr = ((lr >> 5) & 1) * 32 + ((lr >> 2) & 3) * 8 + ((lr >> 4) & 1) * 4 + (lr & 3);
  const bf16_t* gW = Wp + (long)plr * ldw + lc;
  const int rd_off = fr * 64 + ((fq ^ ((fr >> 2) & 3)) * 16);
#define GL_ISSUE(kt_, slot_) do { char* sb_ = smem + (slot_) * STAGE_B + tid * 16; \
    _Pragma("unroll") for (int i_ = 0; i_ < LT; ++i_) __builtin_amdgcn_global_load_lds((const unsigned*)(gT + (long)i_ * 64 * ldt + (kt_) * 32), (__attribute__((address_space(3))) unsigned*)(sb_ + i_ * 4096), 16, 0, 0); \
    _Pragma("unroll") for (int i_ = 0; i_ < 2; ++i_) __builtin_amdgcn_global_load_lds((const unsigned*)(gW + (long)i_ * 64 * ldw + (kt_) * 32), (__attribute__((address_space(3))) unsigned*)(sb_ + TR * 64 + i_ * 4096), 16, 0, 0); } while (0)
  asm volatile("s_waitcnt vmcnt(0)" ::: "memory");
  __builtin_amdgcn_s_barrier();
  const int nk = K >> 5;
#pragma unroll
  for (int s_ = 0; s_ < NSTAGE - 1; ++s_) if (s_ < nk) GL_ISSUE(s_, s_);
  int slot = 0, islot = NSTAGE - 1;
#pragma unroll 1
  for (int kt = 0; kt < nk; ++kt) {
    const int rem = nk - 1 - kt;
    if (NSTAGE == 4) {
      if (rem >= 2) asm volatile("s_waitcnt vmcnt(%0)" ::"n"(2 * LPS) : "memory");
      else if (rem == 1) asm volatile("s_waitcnt vmcnt(%0)" ::"n"(LPS) : "memory");
      else asm volatile("s_waitcnt vmcnt(0)" ::: "memory");
    } else {
      if (rem >= 1) asm volatile("s_waitcnt vmcnt(%0)" ::"n"(LPS) : "memory");
      else asm volatile("s_waitcnt vmcnt(0)" ::: "memory");
    }
    __builtin_amdgcn_s_barrier();
    const unsigned aT = (unsigned)(uintptr_t)(smem + slot * STAGE_B + (wr * NT * 16) * 64 + rd_off);
    const unsigned aW = (unsigned)(uintptr_t)(smem + slot * STAGE_B + TR * 64 + (wc * 64) * 64 + rd_off);
    bf16x8 a[4], b[NT];
#pragma unroll
    for (int mi = 0; mi < 4; ++mi) asm volatile("ds_read_b128 %0, %1 offset:%2" : "=v"(a[mi]) : "v"(aW), "n"(mi * 1024));
#pragma unroll
    for (int ni = 0; ni < NT; ++ni) asm volatile("ds_read_b128 %0, %1 offset:%2" : "=v"(b[ni]) : "v"(aT), "n"(ni * 1024));
    if constexpr (NT == 4) asm volatile("s_waitcnt lgkmcnt(0)" : "+v"(a[0]), "+v"(a[1]), "+v"(a[2]), "+v"(a[3]), "+v"(b[0]), "+v"(b[1]), "+v"(b[2]), "+v"(b[3]));
    else asm volatile("s_waitcnt lgkmcnt(0)" : "+v"(a[0]), "+v"(a[1]), "+v"(a[2]), "+v"(a[3]), "+v"(b[0]), "+v"(b[1]), "+v"(b[2]), "+v"(b[3]), "+v"(b[4]), "+v"(b[5]), "+v"(b[6]), "+v"(b[7]));
    const bool doiss = (kt + NSTAGE - 1 < nk);
    const int ktn = kt + NSTAGE - 1;
    char* sbi = smem + islot * STAGE_B + tid * 16;
#pragma unroll
    for (int mi = 0; mi < 4; ++mi) {
#pragma unroll
      for (int ni = 0; ni < NT; ++ni) acc[mi][ni] = __builtin_amdgcn_mfma_f32_16x16x32_bf16(a[mi], b[ni], acc[mi][ni], 0, 0, 0);
      __builtin_amdgcn_sched_barrier(0);
      if (doiss) {
#pragma unroll
        for (int q = 0; q < 2; ++q) {
          const int idx = mi * 2 + q;
          if (idx < LT) __builtin_amdgcn_global_load_lds((const unsigned*)(gT + (long)idx * 64 * ldt + ktn * 32), (__attribute__((address_space(3))) unsigned*)(sbi + idx * 4096), 16, 0, 0);
          else if (idx < LPS) __builtin_amdgcn_global_load_lds((const unsigned*)(gW + (long)(idx - LT) * 64 * ldw + ktn * 32), (__attribute__((address_space(3))) unsigned*)(sbi + TR * 64 + (idx - LT) * 4096), 16, 0, 0);
        }
      }
      __builtin_amdgcn_sched_barrier(0);
    }
    slot = (slot + 1 == NSTAGE) ? 0 : slot + 1;
    islot = (islot + 1 == NSTAGE) ? 0 : islot + 1;
  }
#undef GL_ISSUE
  __syncthreads();
}

__device__ void inproj_tile(const Params& p, int l, int t, char* smem) {
  constexpr int NT = 8;
  const int tm = t / 52, tn = t % 52;
  const int tid = get_tid(), lane = tid & 63, wid = tid >> 6, wr = wid >> 1, wc = wid & 1, fr = lane & 15, fq = lane >> 4;
  f32x4 acc[4][NT];
#pragma unroll
  for (int a_ = 0; a_ < 4; ++a_)
#pragma unroll
    for (int b_ = 0; b_ < NT; ++b_) acc[a_][b_] = (f32x4){0.f, 0.f, 0.f, 0.f};
  gemm_glds<NT, 3>(acc, p.U() + (size_t)tm * (NT * 32) * 1024, 1024, p.wt_in() + (size_t)l * NWT * 1024 + (size_t)tn * 128 * 1024, 1024, 1024, smem);
  const int g = tn >> 2;
  bf16_t* dst = PRG(g);
#pragma unroll
  for (int ni = 0; ni < NT; ++ni) {
    const int row = tm * (NT * 32) + wr * (NT * 16) + ni * 16 + fr;
    const bool samp = row >= NPROMPT;
    const int rr = samp ? row - NPROMPT : row;
    const int b = samp ? (rr >> 6) : (rr >> 13), tt = samp ? (rr & 63) : (rr & 8191), T = samp ? 64 : 8192, NB = samp ? 8 : 2;
#pragma unroll
    for (int m = 0; m < 2; ++m) {
      const int cg_ = (tn & 3) * 128 + wc * 64 + m * 32 + fq * 8;
      const f32x4 v0 = acc[2 * m][ni], v1 = acc[2 * m + 1][ni];
      u32x4 pk; pk.x = pack2(v0[0], v0[1]); pk.y = pack2(v0[2], v0[3]); pk.z = pack2(v1[0], v1[1]); pk.w = pack2(v1[2], v1[3]);
      *(u32x4*)(dst + (size_t)row * 512 + cg_) = pk;
      if (g == 6 || g == 7) {
        float* o = (g == 6) ? (samp ? p.o_sk() : p.o_pk()) : (samp ? p.o_sv() : p.o_pv());
        const int hh = cg_ >> 7, d = cg_ & 127;
        float* op = o + ((size_t)((l * NB + b) * 4 + hh) * T + tt) * 128 + d;
        *(f32x4*)op = v0; *(f32x4*)(op + 4) = v1;
      } else if (g < 2) {
        if (tt >= T - 3) {
          float* o = samp ? p.o_sconv() : p.o_pconv();
          float* op = o + ((size_t)(l * NB + b) * 3 + (tt - (T - 3))) * 1024 + g * 512 + cg_;
          *(f32x4*)op = v0; *(f32x4*)(op + 4) = v1;
        }
      }
    }
  }
}

struct UnitInfo { int samp, b, h, c, rowbase, seq; };
__device__ __forceinline__ UnitInfo unit_info(int u) {
  UnitInfo i;
  if (u < 1024) { i.samp = 0; i.seq = u >> 7; i.b = i.seq >> 2; i.h = i.seq & 3; i.c = u & 127; i.rowbase = i.b * 8192 + i.c * 64; }
  else { int sq = u - 1024; i.samp = 1; i.seq = sq; i.b = sq >> 2; i.h = sq & 3; i.c = 0; i.rowbase = NPROMPT + i.b * 64; }
  return i;
}

__device__ void sb_unit(const Params& p, int l, int u, char* smem) {
  bf16_t* Qs = (bf16_t*)smem;
  bf16_t* Ks = Qs + 64 * 136;
  bf16_t* Vt = Ks + 64 * 136;
  bf16_t* Ps = Vt + 128 * 72;
  const int tid = get_tid(), lane = tid & 63, w = tid >> 6, fr = lane & 15, fq = lane >> 4;
  const UnitInfo ui = unit_info(u);
  const int nblk = ui.samp ? 65 : ui.c + 1;
  const int hc = ui.h * 128;
  __syncthreads();
  ld_tile<bf16_t>(Qs, PRG(5) + (size_t)ui.rowbase * 512 + hc, 512, tid);
  f32x4 o[8][1];
#pragma unroll
  for (int mi = 0; mi < 8; ++mi) o[mi][0] = (f32x4){0.f, 0.f, 0.f, 0.f};
  float R = 0.f;
  const int tq = 16 * w + fr;
  for (int i = nblk - 1; i >= 0; --i) {
    if (!ui.samp || i == 64) {
      const size_t krow = ui.samp ? (size_t)ui.rowbase : (size_t)ui.b * 8192 + (size_t)i * 64;
      ld_tile<bf16_t>(Ks, PRG(6) + krow * 512 + hc, 512, tid);
      ld_T<bf16_t, 64, 72>(Vt, PRG(7) + krow * 512 + hc, 512, tid);
    } else {
      const size_t off = ((size_t)((l * 8 + ui.b) * 4 + ui.h) * 4096 + (size_t)i * 64) * 128;
      ld_tile<float>(Ks, p.ck + off, 128, tid);
      ld_T<float, 64, 72>(Vt, p.cv + off, 128, tid);
    }
    __syncthreads();
    f32x4 z[4][1];
#pragma unroll
    for (int mi = 0; mi < 4; ++mi) z[mi][0] = (f32x4){0.f, 0.f, 0.f, 0.f};
    wmma<4, 1, 4>(z, Ks, 136, Qs + 16 * w * 136, 136, fr, fq);
    const bool diag = (i == nblk - 1);
    float L[4][4], lsg[4][4], G[4];
#pragma unroll
    for (int mi = 0; mi < 4; ++mi) {
      G[mi] = 0.f;
#pragma unroll
      for (int j = 0; j < 4; ++j) {
        const int kk = mi * 16 + fq * 4 + j;
        const float zz = z[mi][0][j] * 0.08838834764831845f;
        const float sp = softplus(zz);
        const bool valid = !diag || kk < tq;
        L[mi][j] = valid ? -sp : 0.f;
        lsg[mi][j] = valid ? zz - sp : -1e30f;
        G[mi] += L[mi][j];
      }
    }
    float sufm = 0.f;
#pragma unroll
    for (int mi = 3; mi >= 0; --mi) {
      const float g0 = __shfl(G[mi], fr), g1 = __shfl(G[mi], fr + 16), g2 = __shfl(G[mi], fr + 32), g3 = __shfl(G[mi], fr + 48);
      const float later = (fq < 1 ? g1 : 0.f) + (fq < 2 ? g2 : 0.f) + (fq < 3 ? g3 : 0.f);
      const float s3 = R + sufm + later, s2 = s3 + L[mi][3], s1 = s2 + L[mi][2], s0 = s1 + L[mi][1];
      const float a0 = __expf(lsg[mi][0] + s0), a1 = __expf(lsg[mi][1] + s1), a2 = __expf(lsg[mi][2] + s2), a3 = __expf(lsg[mi][3] + s3);
      u32x2 pk; pk.x = pack2(a0, a1); pk.y = pack2(a2, a3);
      *(u32x2*)(Ps + tq * 72 + mi * 16 + fq * 4) = pk;
      sufm += (g0 + g1) + (g2 + g3);
    }
    R += sufm;
    __syncthreads();
    wmma<8, 1, 2>(o, Vt, 72, Ps + 16 * w * 72, 72, fr, fq);
    if (__syncthreads_and(R < -110.f)) break;
  }
  const size_t row = (size_t)ui.rowbase + tq;
#pragma unroll
  for (int mi = 0; mi < 8; ++mi) {
    const int col = hc + mi * 16 + fq * 4;
    u32x2 zz = *(const u32x2*)(PRG(8) + row * 512 + col);
    f32x4 v = o[mi][0];
    u32x2 pk;
    pk.x = pack2(v[0] * silu(lo2f(zz.x)), v[1] * silu(hi2f(zz.x)));
    pk.y = pack2(v[2] * silu(lo2f(zz.y)), v[3] * silu(hi2f(zz.y)));
    *(u32x2*)(p.H() + (size_t)1 * NTOK * 512 + row * 512 + col) = pk;
  }
}

__device__ void mlstm_local(const Params& p, int l, int u, char* smem) {
  bf16_t* kdT = (bf16_t*)smem;
  bf16_t* vT = kdT + 128 * 72;
  bf16_t* xq = vT + 128 * 72;
  bf16_t* xk = xq + 67 * 136;
  float* dec = (float*)(xk + 67 * 136);
  const int tid = get_tid(), lane = tid & 63, w = tid >> 6, fr = lane & 15, fq = lane >> 4;
  const UnitInfo ui = unit_info(u);
  const int hc = ui.h * 128;
  __syncthreads();
  if (w == 0) {
    const float lfv = p.lf()[(ui.rowbase + lane) * 4 + ui.h], igv = p.ig()[(ui.rowbase + lane) * 4 + ui.h];
    float bs = lfv;
#pragma unroll
    for (int o = 1; o < 64; o <<= 1) { float t = __shfl_up(bs, o); if (lane >= o) bs += t; }
    const float g = igv - bs;
    float gm = g;
#pragma unroll
    for (int o = 32; o > 0; o >>= 1) gm = fmaxf(gm, __shfl_xor(gm, o));
    const float bL = __shfl(bs, 63);
    dec[lane] = __expf(g - gm);
    if (lane == 0) { p.ac()[u] = bL + gm; p.Bc()[u] = bL; }
  }
  ld_tile<bf16_t>(xq + 3 * 136, PRG(0) + (size_t)ui.rowbase * 512 + hc, 512, tid);
  ld_tile<bf16_t>(xk + 3 * 136, PRG(1) + (size_t)ui.rowbase * 512 + hc, 512, tid);
  ld_T<bf16_t, 64, 72>(vT, PRG(2) + (size_t)ui.rowbase * 512 + hc, 512, tid);
  {
    const int isk = tid >> 7, ch = tid & 127, col = hc + ch;
    bf16_t* xs = isk ? xk : xq;
    if (ui.samp) {
      const float* cs = p.st_conv + (size_t)(l * 8 + ui.b) * 3072 + isk * 512 + col;
      xs[ch] = f2bf(cs[0]); xs[136 + ch] = f2bf(cs[1024]); xs[272 + ch] = f2bf(cs[2048]);
    } else if (ui.c > 0) {
      const bf16_t* src = PRG(isk) + (size_t)ui.rowbase * 512 + col;
      xs[ch] = src[-3 * 512]; xs[136 + ch] = src[-2 * 512]; xs[272 + ch] = src[-1 * 512];
    } else { xs[ch] = 0; xs[136 + ch] = 0; xs[272 + ch] = 0; }
  }
  __syncthreads();
  {
    const int isk = tid >> 7, ch = tid & 127, col = hc + ch;
    bf16_t* xs = isk ? xk : xq;
    const float* wc_ = p.w_conv + (size_t)l * 4096 + isk * 512 + col;
    const float w0 = wc_[0], w1 = wc_[1024], w2 = wc_[2048], w3 = wc_[3072];
    float x0 = bf2f(xs[ch]), x1 = bf2f(xs[136 + ch]), x2 = bf2f(xs[272 + ch]);
#pragma unroll 8
    for (int t = 0; t < 64; ++t) {
      const float x3 = bf2f(xs[(t + 3) * 136 + ch]);
      float y = silu(w0 * x0 + w1 * x1 + w2 * x2 + w3 * x3);
      if (isk) y *= 0.08838834764831845f;
      const bf16_t yb = f2bf(y);
      xs[t * 136 + ch] = yb;
      if (isk) kdT[ch * 72 + t] = f2bf(bf2f(yb) * dec[t]);
      x0 = x1; x1 = x2; x2 = x3;
    }
  }
  __syncthreads();
#pragma unroll
  for (int i = 0; i < 4; ++i) {
    const int id = tid + 256 * i, r = id >> 4, c = (id & 15) * 8;
    *(u32x4*)(p.QC() + (size_t)(ui.rowbase + r) * 512 + hc + c) = *(const u32x4*)(xq + r * 136 + c);
    *(u32x4*)(p.KC() + (size_t)(ui.rowbase + r) * 512 + hc + c) = *(const u32x4*)(xk + r * 136 + c);
  }
  if (tid < 128) { float s_ = 0.f;
#pragma unroll 8
    for (int t = 0; t < 64; ++t) s_ += bf2f(kdT[tid * 72 + t]); p.nloc()[u * 128 + tid] = s_; }
  f32x4 acc[8][2];
#pragma unroll
  for (int a_ = 0; a_ < 8; ++a_) { acc[a_][0] = (f32x4){0.f, 0.f, 0.f, 0.f}; acc[a_][1] = (f32x4){0.f, 0.f, 0.f, 0.f}; }
  wmma<8, 2, 2>(acc, kdT, 72, vT + 32 * w * 72, 72, fr, fq);
  bf16_t* sm = p.SM() + (size_t)u * 16384;
#pragma unroll
  for (int mi = 0; mi < 8; ++mi)
#pragma unroll
    for (int ni = 0; ni < 2; ++ni) {
      u32x2 pk; pk.x = pack2(acc[mi][ni][0], acc[mi][ni][1]); pk.y = pack2(acc[mi][ni][2], acc[mi][ni][3]);
      *(u32x2*)(sm + (32 * w + ni * 16 + fr) * 128 + mi * 16 + fq * 4) = pk;
    }
}

__device__ __forceinline__ float hgrn_lb(const Params& p, int l, int ch512) {
  if (l == 0) return 0.f;
  return sigm(p.lb_logits[512 + ch512] - p.lb_logits[ch512]);
}
__device__ __forceinline__ void hgrn_gate(float f, float lb, float& lg, float& kh) {
  const float e = __expf(-fabsf(f));
  const float sp = f >= 0.f ? 1.f / (1.f + e) : e / (1.f + e);
  const float sn = f >= 0.f ? e / (1.f + e) : 1.f / (1.f + e);
  lg = (lb == 0.f) ? (fminf(f, 0.f) - __logf(1.f + e)) : __logf(lb + (1.f - lb) * sp);
  kh = (1.f - lb) * sn;
}

__device__ void hgrn_local(const Params& p, int l, int u, char* smem) {
  bf16_t* kdT = (bf16_t*)smem;
  bf16_t* iT = kdT + 128 * 72;
  bf16_t* fs = iT + 128 * 72;
  float* tot = (float*)(fs + 64 * 136);
  const int tid = get_tid(), lane = tid & 63, w = tid >> 6, fr = lane & 15, fq = lane >> 4;
  const UnitInfo ui = unit_info(u);
  const int hc = ui.h * 128;
  __syncthreads();
  ld_tile<bf16_t>(fs, PRG(10) + (size_t)ui.rowbase * 512 + hc, 512, tid);
  ld_T<bf16_t, 64, 72>(iT, PRG(11) + (size_t)ui.rowbase * 512 + hc, 512, tid);
  const int half = tid >> 7, ch = tid & 127;
  const float lb = hgrn_lb(p, l, hc + ch);
  __syncthreads();
  const bf16_t* src = fs + (half * 32) * 136 + ch;
  {
    float run = 0.f;
#pragma unroll 8
    for (int t = 0; t < 32; ++t) { float lg, kh; hgrn_gate(bf2f(src[t * 136]), lb, lg, kh); run += lg; }
    tot[half * 128 + ch] = run;
  }
  __syncthreads();
  {
    const float t0 = tot[ch], t1 = tot[128 + ch];
    const float bcL = t0 + t1;
    float run = half ? t0 : 0.f;
#pragma unroll 8
    for (int t = 0; t < 32; ++t) {
      float lg, kh; hgrn_gate(bf2f(src[t * 136]), lb, lg, kh); run += lg;
      kdT[ch * 72 + half * 32 + t] = f2bf(kh * __expf(bcL - run));
    }
    if (half == 0) p.hbc()[u * 128 + ch] = bcL;
  }
  __syncthreads();
  f32x4 acc[8][2];
#pragma unroll
  for (int a_ = 0; a_ < 8; ++a_) { acc[a_][0] = (f32x4){0.f, 0.f, 0.f, 0.f}; acc[a_][1] = (f32x4){0.f, 0.f, 0.f, 0.f}; }
  wmma<8, 2, 2>(acc, kdT, 72, iT + 32 * w * 72, 72, fr, fq);
  bf16_t* sh = p.SH() + (size_t)u * 16384;
#pragma unroll
  for (int mi = 0; mi < 8; ++mi)
#pragma unroll
    for (int ni = 0; ni < 2; ++ni) {
      u32x2 pk; pk.x = pack2(acc[mi][ni][0], acc[mi][ni][1]); pk.y = pack2(acc[mi][ni][2], acc[mi][ni][3]);
      *(u32x2*)(sh + (32 * w + ni * 16 + fr) * 128 + mi * 16 + fq * 4) = pk;
    }
}

__device__ void scan_phase(const Params& p, int l, char* smem) {
  float* cdc = (float*)smem;
  float* cwl = cdc + 128;
  float* cmi = cwl + 128;
  const int tid = get_tid();
  for (int vb = blockIdx.x; vb < 520; vb += gridDim.x) {
    const int kind = vb >> 8;
    const int seq = (kind == 2) ? (vb - 512) : ((vb >> 5) & 7);
    __syncthreads();
    if (kind != 1) {
      if (tid < 128) { cdc[tid] = p.ac()[seq * 128 + tid]; cwl[tid] = p.Bc()[seq * 128 + tid]; }
      __syncthreads();
      if (tid == 0) {
        float m = 0.f;
        for (int c = 0; c < 128; ++c) {
          const float a = cdc[c], B = cwl[c];
          const float mo = fmaxf(a, B + m);
          cdc[c] = __expf(B + m - mo); cwl[c] = __expf(a - mo); cmi[c] = m; m = mo;
        }
        if (kind == 0 && (vb & 31) == 0) p.o_pm()[l * 8 + seq] = m;
      }
      __syncthreads();
      if (kind == 0 && (vb & 31) == 0 && tid < 128) p.min_()[seq * 128 + tid] = cmi[tid];
    }
    if (kind == 2) {
      if (tid < 128) {
        float n = 0.f;
        float* base = p.nloc() + (size_t)seq * 128 * 128 + tid;
        for (int c0 = 0; c0 < 128; c0 += 16) {
          float lv[16];
#pragma unroll
          for (int j = 0; j < 16; ++j) lv[j] = base[(c0 + j) * 128];
#pragma unroll
          for (int j = 0; j < 16; ++j) { const float nl = lv[j]; lv[j] = n; n = cdc[c0 + j] * n + cwl[c0 + j] * nl; }
#pragma unroll
          for (int j = 0; j < 16; ++j) base[(c0 + j) * 128] = lv[j];
        }
        p.o_pn()[(l * 8 + seq) * 128 + tid] = n;
      }
      continue;
    }
    const int pr = (vb & 31) * 256 + tid, e = pr * 2, er = e >> 7, ec = e & 127;
    unsigned* base = (unsigned*)((kind ? p.SH() : p.SM()) + (size_t)seq * 128 * 16384) + pr;
    const float* hb = p.hbc() + (size_t)seq * 128 * 128 + ec;
    float c0v = 0.f, c1v = 0.f;
    unsigned lv[16], nx[16];
    float2 hv[16], hn[16];
#pragma unroll
    for (int j = 0; j < 16; ++j) { nx[j] = base[(size_t)j * 8192]; hn[j] = kind ? *(const float2*)(hb + j * 128) : make_float2(0.f, 0.f); }
    for (int c0 = 0; c0 < 128; c0 += 16) {
#pragma unroll
      for (int j = 0; j < 16; ++j) { lv[j] = nx[j]; hv[j] = hn[j]; }
      if (c0 + 16 < 128) {
#pragma unroll
        for (int j = 0; j < 16; ++j) { nx[j] = base[(size_t)(c0 + 16 + j) * 8192]; if (kind) hn[j] = *(const float2*)(hb + (c0 + 16 + j) * 128); }
      }
#pragma unroll
      for (int j = 0; j < 16; ++j) {
        const unsigned v = lv[j];
        lv[j] = pack2(c0v, c1v);
        const float d0 = kind ? __expf(hv[j].x) : cdc[c0 + j];
        const float d1 = kind ? __expf(hv[j].y) : d0;
        const float wl = kind ? 1.f : cwl[c0 + j];
        c0v = d0 * c0v + wl * lo2f(v); c1v = d1 * c1v + wl * hi2f(v);
      }
#pragma unroll
      for (int j = 0; j < 16; ++j) base[(size_t)(c0 + j) * 8192] = lv[j];
    }
    float* o = (kind ? p.o_pS() : p.o_pC()) + (size_t)(l * 8 + seq) * 16384;
    o[ec * 128 + er] = c0v; o[(ec + 1) * 128 + er] = c1v;
  }
  const int gt = blockIdx.x * 256 + tid, nth = gridDim.x * 256;
  for (int it = gt; it < 524288; it += nth) {
    const int kind = it >> 18, sq = (it >> 13) & 31, pr = it & 8191, e = pr * 2, u = 1024 + sq, er = e >> 7, ec = e & 127;
    if (kind == 0) {
      const float* c0p = p.st_C + (size_t)(l * 32 + sq) * 16384;
      const float C0 = c0p[ec * 128 + er], C1 = c0p[(ec + 1) * 128 + er], m = p.st_m[l * 32 + sq];
      unsigned* slot = (unsigned*)(p.SM() + (size_t)u * 16384) + pr;
      const unsigned lv = *slot;
      const float a = p.ac()[u], B = p.Bc()[u];
      const float mo = fmaxf(a, B + m), dc = __expf(B + m - mo), wl = __expf(a - mo);
      *slot = pack2(C0, C1);
      float* o = p.o_sC() + (size_t)(l * 32 + sq) * 16384;
      o[ec * 128 + er] = dc * C0 + wl * lo2f(lv); o[(ec + 1) * 128 + er] = dc * C1 + wl * hi2f(lv);
      if (pr == 0) { p.min_()[u] = m; p.o_sm()[l * 32 + sq] = mo; }
    } else {
      const float* s0p = p.st_S + (size_t)(l * 32 + sq) * 16384;
      const float S0 = s0p[ec * 128 + er], S1 = s0p[(ec + 1) * 128 + er];
      unsigned* slot = (unsigned*)(p.SH() + (size_t)u * 16384) + pr;
      const unsigned lv = *slot;
      const float d0 = __expf(p.hbc()[u * 128 + ec]), d1 = __expf(p.hbc()[u * 128 + ec + 1]);
      *slot = pack2(S0, S1);
      float* o = p.o_sS() + (size_t)(l * 32 + sq) * 16384;
      o[ec * 128 + er] = d0 * S0 + lo2f(lv); o[(ec + 1) * 128 + er] = d1 * S1 + hi2f(lv);
    }
  }
  for (int it = gt; it < 4096; it += nth) {
    const int sq = it >> 7, d = it & 127, u = 1024 + sq;
    const float n0 = p.st_n[(l * 32 + sq) * 128 + d], m = p.st_m[l * 32 + sq];
    const float a = p.ac()[u], B = p.Bc()[u];
    const float mo = fmaxf(a, B + m), dc = __expf(B + m - mo), wl = __expf(a - mo);
    const float nl = p.nloc()[u * 128 + d];
    p.nloc()[u * 128 + d] = n0;
    p.o_sn()[(l * 32 + sq) * 128 + d] = dc * n0 + wl * nl;
  }
}

__device__ void mlstm_out(const Params& p, int l, int u, char* smem) {
  bf16_t* Qs = (bf16_t*)smem;
  bf16_t* CT = Qs + 64 * 136;
  bf16_t* Ks = CT;
  bf16_t* Vt = Ks + 64 * 136;
  bf16_t* Ps = Vt + 144 * 72;
  float* misc = (float*)(smem + 17408 + 47360);
  float *bsum = misc, *gs = misc + 64, *mt = misc + 128, *wint = misc + 192;
  const int tid = get_tid(), lane = tid & 63, w = tid >> 6, fr = lane & 15, fq = lane >> 4;
  const UnitInfo ui = unit_info(u);
  const int hc = ui.h * 128;
  __syncthreads();
  if (w == 0) {
    const float lfv = p.lf()[(ui.rowbase + lane) * 4 + ui.h], igv = p.ig()[(ui.rowbase + lane) * 4 + ui.h];
    float bs = lfv;
#pragma unroll
    for (int o = 1; o < 64; o <<= 1) { float t = __shfl_up(bs, o); if (lane >= o) bs += t; }
    const float g = igv - bs;
    float cm = g;
#pragma unroll
    for (int o = 1; o < 64; o <<= 1) { float t = __shfl_up(cm, o); if (lane >= o) cm = fmaxf(cm, t); }
    const float m_in = p.min_()[u];
    const float mtt = bs + fmaxf(cm, m_in);
    bsum[lane] = bs; gs[lane] = g; mt[lane] = mtt; wint[lane] = __expf(bs + m_in - mtt);
  }
  ld_tile<bf16_t>(Qs, p.QC() + (size_t)ui.rowbase * 512 + hc, 512, tid);
  ld_tile128<bf16_t>(CT, p.SM() + (size_t)u * 16384, 128, tid);
  if (tid < 128) CT[128 * 136 + tid] = f2bf(p.nloc()[u * 128 + tid]);
  for (int i = tid; i < 15 * 128; i += 256) CT[(129 + (i >> 7)) * 136 + (i & 127)] = 0;
  __syncthreads();
  f32x4 acc[9][1];
#pragma unroll
  for (int mi = 0; mi < 9; ++mi) acc[mi][0] = (f32x4){0.f, 0.f, 0.f, 0.f};
  wmma<9, 1, 4>(acc, CT, 136, Qs + 16 * w * 136, 136, fr, fq);
  const int t = 16 * w + fr;
  const float wi = wint[t];
#pragma unroll
  for (int mi = 0; mi < 9; ++mi) acc[mi][0] *= wi;
  __syncthreads();
  ld_tile<bf16_t>(Ks, p.KC() + (size_t)ui.rowbase * 512 + hc, 512, tid);
  ld_T<bf16_t, 64, 72>(Vt, PRG(2) + (size_t)ui.rowbase * 512 + hc, 512, tid);
  if (tid < 64) Vt[128 * 72 + tid] = 0x3F80;
  for (int i = tid; i < 15 * 64; i += 256) Vt[(129 + (i >> 6)) * 72 + (i & 63)] = 0;
  __syncthreads();
  f32x4 st[4][1];
#pragma unroll
  for (int mi = 0; mi < 4; ++mi) st[mi][0] = (f32x4){0.f, 0.f, 0.f, 0.f};
  wmma<4, 1, 4>(st, Ks, 136, Qs + 16 * w * 136, 136, fr, fq);
  const float bt = bsum[t], mtt = mt[t];
#pragma unroll
  for (int mi = 0; mi < 4; ++mi) {
    float a[4];
#pragma unroll
    for (int j = 0; j < 4; ++j) {
      const int s = mi * 16 + fq * 4 + j;
      a[j] = (s <= t) ? st[mi][0][j] * __expf(bt + gs[s] - mtt) : 0.f;
    }
    u32x2 pk; pk.x = pack2(a[0], a[1]); pk.y = pack2(a[2], a[3]);
    *(u32x2*)(Ps + t * 72 + mi * 16 + fq * 4) = pk;
  }
  __syncthreads();
  wmma<9, 1, 2>(acc, Vt, 72, Ps + 16 * w * 72, 72, fr, fq);
  const float den = __shfl(acc[8][0][0], fr);
  const float inv = 1.f / fmaxf(fabsf(den), __expf(-mtt));
  float ss = 0.f;
#pragma unroll
  for (int mi = 0; mi < 8; ++mi) { acc[mi][0] *= inv; ss += acc[mi][0][0] * acc[mi][0][0] + acc[mi][0][1] * acc[mi][0][1] + acc[mi][0][2] * acc[mi][0][2] + acc[mi][0][3] * acc[mi][0][3]; }
  ss += __shfl_xor(ss, 16); ss += __shfl_xor(ss, 32);
  const float rs = rsqrtf(ss * (1.f / 128.f) + 1e-6f);
  const size_t row = (size_t)ui.rowbase + t;
#pragma unroll
  for (int mi = 0; mi < 8; ++mi) {
    const int col = hc + mi * 16 + fq * 4;
    const u32x2 ov = *(const u32x2*)(PRG(3) + row * 512 + col);
    const u32x2 zv = *(const u32x2*)(PRG(4) + row * 512 + col);
    const float4 g = *(const float4*)(p.g_ml + l * 512 + col);
    const f32x4 v = acc[mi][0];
    u32x2 pk;
    pk.x = pack2(v[0] * rs * g.x * sigm(lo2f(ov.x)) * silu(lo2f(zv.x)), v[1] * rs * g.y * sigm(hi2f(ov.x)) * silu(hi2f(zv.x)));
    pk.y = pack2(v[2] * rs * g.z * sigm(lo2f(ov.y)) * silu(lo2f(zv.y)), v[3] * rs * g.w * sigm(hi2f(ov.y)) * silu(hi2f(zv.y)));
    *(u32x2*)(p.H() + row * 512 + col) = pk;
  }
}

__device__ __forceinline__ bf16x8 scale_frag(const bf16_t* src, const float* ea, const float* eb, float sgn, bool clampit) {
  u32x4 raw = *(const u32x4*)src;
  float4 a0 = *(const float4*)ea, a1 = *(const float4*)(ea + 4);
  float4 b0 = {0.f, 0.f, 0.f, 0.f}, b1 = {0.f, 0.f, 0.f, 0.f};
  if (eb) { b0 = *(const float4*)eb; b1 = *(const float4*)(eb + 4); }
  float e[8] = {a0.x - b0.x, a0.y - b0.y, a0.z - b0.z, a0.w - b0.w, a1.x - b1.x, a1.y - b1.y, a1.z - b1.z, a1.w - b1.w};
  float v[8] = {lo2f(raw.x), hi2f(raw.x), lo2f(raw.y), hi2f(raw.y), lo2f(raw.z), hi2f(raw.z), lo2f(raw.w), hi2f(raw.w)};
  unsigned o[4];
#pragma unroll
  for (int i = 0; i < 4; ++i) {
    float x0 = sgn * e[2 * i], x1 = sgn * e[2 * i + 1];
    if (clampit) { x0 = fminf(x0, 80.f); x1 = fminf(x1, 80.f); }
    o[i] = pack2(v[2 * i] * __expf(x0), v[2 * i + 1] * __expf(x1));
  }
  u32x4 r = {o[0], o[1], o[2], o[3]};
  return __builtin_bit_cast(bf16x8, r);
}

__device__ void hgrn_out(const Params& p, int l, int u, char* smem) {
  float* bc = (float*)smem;
  bf16_t* ST = (bf16_t*)smem;
  bf16_t* qs = (bf16_t*)(smem + 34816);
  bf16_t* kh = (bf16_t*)(smem + 34816 + 17408);
  bf16_t* iT = kh;
  bf16_t* Ps = (bf16_t*)(smem + 34816 + 17408 + 18432);
  float* tot = (float*)(smem + 79872);
  const int tid = get_tid(), lane = tid & 63, w = tid >> 6, fr = lane & 15, fq = lane >> 4;
  const UnitInfo ui = unit_info(u);
  const int hc = ui.h * 128;
  __syncthreads();
  ld_tile<bf16_t>(qs, PRG(9) + (size_t)ui.rowbase * 512 + hc, 512, tid);
  ld_tile<bf16_t>(kh, PRG(10) + (size_t)ui.rowbase * 512 + hc, 512, tid);
  __syncthreads();
  {
    const int half = tid >> 7, ch = tid & 127;
    const float lb = hgrn_lb(p, l, hc + ch);
    bf16_t* src = kh + (half * 32) * 136 + ch;
    float run = 0.f;
#pragma unroll 8
    for (int t = 0; t < 32; ++t) { float lg, k; hgrn_gate(bf2f(src[t * 136]), lb, lg, k); run += lg; }
    tot[half * 128 + ch] = run;
    __syncthreads();
    run = half ? tot[ch] : 0.f;
#pragma unroll 8
    for (int t = 0; t < 32; ++t) {
      float lg, k; hgrn_gate(bf2f(src[t * 136]), lb, lg, k); run += lg;
      bc[(half * 32 + t) * 132 + ch] = run;
      src[t * 136] = f2bf(k);
    }
  }
  __syncthreads();
  {
    const int I = w, t = 16 * I + fr;
    f32x4 a[4];
#pragma unroll
    for (int J = 0; J < 4; ++J) a[J] = (f32x4){0.f, 0.f, 0.f, 0.f};
#pragma unroll
    for (int kk = 0; kk < 4; ++kk) {
      const int c0 = kk * 32 + fq * 8;
      const float* rI = (I > 0) ? bc + (16 * I - 1) * 132 + c0 : nullptr;
      const bf16x8 bq = scale_frag(qs + t * 136 + c0, bc + t * 132 + c0, rI, 1.f, false);
#pragma unroll
      for (int J = 0; J < 4; ++J) {
        if (J <= I) {
          const int s = 16 * J + fr;
          const bf16x8 ak = scale_frag(kh + s * 136 + c0, bc + s * 132 + c0, rI, -1.f, true);
          a[J] = __builtin_amdgcn_mfma_f32_16x16x32_bf16(ak, bq, a[J], 0, 0, 0);
        }
      }
    }
#pragma unroll
    for (int J = 0; J < 4; ++J) {
      float v[4];
#pragma unroll
      for (int j = 0; j < 4; ++j) { const int s = 16 * J + fq * 4 + j; v[j] = (s <= t) ? a[J][j] : 0.f; }
      u32x2 pk; pk.x = pack2(v[0], v[1]); pk.y = pack2(v[2], v[3]);
      *(u32x2*)(Ps + t * 72 + J * 16 + fq * 4) = pk;
    }
  }
  __syncthreads();
#pragma unroll 4
  for (int i = tid; i < 64 * 128; i += 256) { const int t = i >> 7, c = i & 127; qs[t * 136 + c] = f2bf(bf2f(qs[t * 136 + c]) * __expf(bc[t * 132 + c])); }
  __syncthreads();
  ld_T<bf16_t, 64, 72>(iT, PRG(11) + (size_t)ui.rowbase * 512 + hc, 512, tid);
  ld_tile128<bf16_t>(ST, p.SH() + (size_t)u * 16384, 128, tid);
  __syncthreads();
  f32x4 acc[8][1];
#pragma unroll
  for (int mi = 0; mi < 8; ++mi) acc[mi][0] = (f32x4){0.f, 0.f, 0.f, 0.f};
  wmma<8, 1, 2>(acc, iT, 72, Ps + 16 * w * 72, 72, fr, fq);
  wmma<8, 1, 4>(acc, ST, 136, qs + 16 * w * 136, 136, fr, fq);
  float ss = 0.f;
#pragma unroll
  for (int mi = 0; mi < 8; ++mi) ss += acc[mi][0][0] * acc[mi][0][0] + acc[mi][0][1] * acc[mi][0][1] + acc[mi][0][2] * acc[mi][0][2] + acc[mi][0][3] * acc[mi][0][3];
  ss += __shfl_xor(ss, 16); ss += __shfl_xor(ss, 32);
  const float rs = rsqrtf(ss * (1.f / 128.f) + 1e-6f);
  const size_t row = (size_t)ui.rowbase + 16 * w + fr;
#pragma unroll
  for (int mi = 0; mi < 8; ++mi) {
    const int col = hc + mi * 16 + fq * 4;
    const u32x2 zv = *(const u32x2*)(PRG(12) + row * 512 + col);
    const float4 g = *(const float4*)(p.g_hg + l * 512 + col);
    const f32x4 v = acc[mi][0];
    u32x2 pk;
    pk.x = pack2(v[0] * rs * g.x * silu(lo2f(zv.x)), v[1] * rs * g.y * silu(hi2f(zv.x)));
    pk.y = pack2(v[2] * rs * g.z * silu(lo2f(zv.y)), v[3] * rs * g.w * silu(hi2f(zv.y)));
    *(u32x2*)(p.H() + (size_t)2 * NTOK * 512 + row * 512 + col) = pk;
  }
}

__device__ void merge_tile(const Params& p, int l, int t, char* smem) {
  const int tm = t >> 3, tn = t & 7;
  const int tid = get_tid(), lane = tid & 63, wid = tid >> 6, wr = wid >> 1, wc = wid & 1, fr = lane & 15, fq = lane >> 4;
#pragma unroll 1
  for (int b = 0; b < 3; ++b) {
    f32x4 acc[4][4]; zero_acc(acc);
    gemm_kloop<bf16_t>(acc, p.U() + (size_t)tm * 128 * 1024, 1024, p.wt_in() + (size_t)l * NWT * 1024 + (size_t)(NMAIN + b * 1024 + tn * 128) * 1024, 1024, 1024, smem);
#pragma unroll
    for (int ni = 0; ni < 4; ++ni)
#pragma unroll
      for (int mi = 0; mi < 4; ++mi) {
        f32x4 v; v[0] = sigm(acc[mi][ni][0]); v[1] = sigm(acc[mi][ni][1]); v[2] = sigm(acc[mi][ni][2]); v[3] = sigm(acc[mi][ni][3]);
        *(f32x4*)(p.r() + ((size_t)tm * 128 + wr * 64 + ni * 16 + fr) * 1024 + tn * 128 + wc * 64 + mi * 16 + fq * 4) = v;
      }
    zero_acc(acc);
    gemm_kloop<bf16_t>(acc, p.H() + (size_t)b * NTOK * 512 + (size_t)tm * 128 * 512, 512, p.wt_br() + (size_t)(l * 3 + b) * 1024 * 512 + (size_t)tn * 128 * 512, 512, 512, smem);
#pragma unroll
    for (int ni = 0; ni < 4; ++ni) {
      const size_t row = (size_t)tm * 128 + wr * 64 + ni * 16 + fr;
#pragma unroll
      for (int mi = 0; mi < 4; ++mi) {
        const int col = tn * 128 + wc * 64 + mi * 16 + fq * 4;
        f32x4 v = *(const f32x4*)(p.r() + row * 1024 + col) * acc[mi][ni];
        float* part = p.y() + row * 1024 + col;
        if (b > 0) v += *(const f32x4*)part;
        if (b < 2) *(f32x4*)part = v;
        else { u32x2 pk; pk.x = pack2(v[0], v[1]); pk.y = pack2(v[2], v[3]); *(u32x2*)(p.merged() + row * 1024 + col) = pk; }
      }
    }
  }
}

__device__ void outproj_tile(const Params& p, int l, int t, char* smem) {
  const int tm = t >> 3, tn = t & 7;
  const int tid = get_tid(), lane = tid & 63, wid = tid >> 6, wr = wid >> 1, wc = wid & 1, fr = lane & 15, fq = lane >> 4;
  f32x4 acc[4][4]; zero_acc(acc);
  gemm_kloop<bf16_t>(acc, p.merged() + (size_t)tm * 128 * 1024, 1024, p.wt_out() + (size_t)l * 1048576 + (size_t)tn * 128 * 1024, 1024, 1024, smem);
#pragma unroll
  for (int ni = 0; ni < 4; ++ni) {
    const size_t row = (size_t)tm * 128 + wr * 64 + ni * 16 + fr;
#pragma unroll
    for (int mi = 0; mi < 4; ++mi) *(f32x4*)(p.y() + row * 1024 + tn * 128 + wc * 64 + mi * 16 + fq * 4) = acc[mi][ni];
  }
}


__device__ void outproj_tile256(const Params& p, int l, int t, char* smem) {
  constexpr int NT = 8;
  const int tm = t >> 3, tn = t & 7;
  const int tid = get_tid(), lane = tid & 63, wid = tid >> 6, wr = wid >> 1, wc = wid & 1, fr = lane & 15, fq = lane >> 4;
  f32x4 acc[4][NT];
#pragma unroll
  for (int a_ = 0; a_ < 4; ++a_)
#pragma unroll
    for (int b_ = 0; b_ < NT; ++b_) acc[a_][b_] = (f32x4){0.f, 0.f, 0.f, 0.f};
  gemm_glds<NT, 3>(acc, p.merged() + (size_t)tm * 256 * 1024, 1024, p.wt_out() + (size_t)l * 1048576 + (size_t)tn * 128 * 1024, 1024, 1024, smem);
#pragma unroll
  for (int ni = 0; ni < NT; ++ni) {
    const size_t row = (size_t)tm * 256 + wr * 128 + ni * 16 + fr;
#pragma unroll
    for (int m = 0; m < 2; ++m) {
      float* op = p.y() + row * 1024 + tn * 128 + wc * 64 + m * 32 + fq * 8;
      *(f32x4*)op = acc[2 * m][ni]; *(f32x4*)(op + 4) = acc[2 * m + 1][ni];
    }
  }
}


__device__ void gate_tile256(const Params& p, int l, int t, char* smem) {
  constexpr int NT = 8;
  const int tm = t / 24, tn = t % 24;
  const int tid = get_tid(), lane = tid & 63, wid = tid >> 6, wr = wid >> 1, wc = wid & 1, fr = lane & 15, fq = lane >> 4;
  f32x4 acc[4][NT];
#pragma unroll
  for (int a_ = 0; a_ < 4; ++a_)
#pragma unroll
    for (int b_ = 0; b_ < NT; ++b_) acc[a_][b_] = (f32x4){0.f, 0.f, 0.f, 0.f};
  gemm_glds<NT, 3>(acc, p.U() + (size_t)tm * 256 * 1024, 1024, p.wt_in() + (size_t)l * NWT * 1024 + (size_t)(NMAIN + tn * 128) * 1024, 1024, 1024, smem);
#pragma unroll
  for (int ni = 0; ni < NT; ++ni) {
    const size_t row = (size_t)tm * 256 + wr * 128 + ni * 16 + fr;
#pragma unroll
    for (int m = 0; m < 2; ++m) {
      const f32x4 v0 = acc[2 * m][ni], v1 = acc[2 * m + 1][ni];
      u32x4 pk; pk.x = pack2(sigm(v0[0]), sigm(v0[1])); pk.y = pack2(sigm(v0[2]), sigm(v0[3])); pk.z = pack2(sigm(v1[0]), sigm(v1[1])); pk.w = pack2(sigm(v1[2]), sigm(v1[3]));
      *(u32x4*)(p.G() + row * 3072 + tn * 128 + wc * 64 + m * 32 + fq * 8) = pk;
    }
  }
}
__device__ void merge_tile_g(const Params& p, int l, int t, char* smem) {
  const int tm = t >> 3, tn = t & 7;
  const int tid = get_tid(), lane = tid & 63, wid = tid >> 6, wr = wid >> 1, wc = wid & 1, fr = lane & 15, fq = lane >> 4;
  f32x4 macc[4][4]; zero_acc(macc);
#pragma unroll 1
  for (int b = 0; b < 3; ++b) {
    f32x4 acc[4][4]; zero_acc(acc);
    gemm_kloop<bf16_t>(acc, p.H() + (size_t)b * NTOK * 512 + (size_t)tm * 128 * 512, 512, p.wt_br() + (size_t)(l * 3 + b) * 1024 * 512 + (size_t)tn * 128 * 512, 512, 512, smem);
#pragma unroll
    for (int ni = 0; ni < 4; ++ni) {
      const size_t row = (size_t)tm * 128 + wr * 64 + ni * 16 + fr;
#pragma unroll
      for (int mi = 0; mi < 4; ++mi) {
        const u32x2 g = *(const u32x2*)(p.G() + row * 3072 + b * 1024 + tn * 128 + wc * 64 + mi * 16 + fq * 4);
        macc[mi][ni][0] += lo2f(g.x) * acc[mi][ni][0]; macc[mi][ni][1] += hi2f(g.x) * acc[mi][ni][1];
        macc[mi][ni][2] += lo2f(g.y) * acc[mi][ni][2]; macc[mi][ni][3] += hi2f(g.y) * acc[mi][ni][3];
      }
    }
  }
#pragma unroll
  for (int ni = 0; ni < 4; ++ni) {
    const size_t row = (size_t)tm * 128 + wr * 64 + ni * 16 + fr;
#pragma unroll
    for (int mi = 0; mi < 4; ++mi) {
      u32x2 pk; pk.x = pack2(macc[mi][ni][0], macc[mi][ni][1]); pk.y = pack2(macc[mi][ni][2], macc[mi][ni][3]);
      *(u32x2*)(p.merged() + row * 1024 + tn * 128 + wc * 64 + mi * 16 + fq * 4) = pk;
    }
  }
}

__device__ void postnorm_phase(const Params& p, int l) {
  const int lane = threadIdx.x & 63, wid = threadIdx.x >> 6;
  const float* gp = p.g_post + l * 1024;
  for (int row = blockIdx.x * 4 + wid; row < NTOK; row += gridDim.x * 4) {
    const float* x = xrow(p, l, row);
    const float* y = p.y() + (size_t)row * 1024;
    float4 v[4]; float ss = 0.f;
#pragma unroll
    for (int i = 0; i < 4; ++i) { v[i] = *(const float4*)(y + i * 256 + lane * 4); ss += v[i].x * v[i].x + v[i].y * v[i].y + v[i].z * v[i].z + v[i].w * v[i].w; }
#pragma unroll
    for (int o = 32; o > 0; o >>= 1) ss += __shfl_xor(ss, o);
    const float rstd = rsqrtf(ss * (1.f / 1024.f) + 1e-6f);
#pragma unroll
    for (int i = 0; i < 4; ++i) {
      const int k = i * 256 + lane * 4;
      const float4 g = *(const float4*)(gp + k), xv = *(const float4*)(x + k);
      float4 r; r.x = xv.x + v[i].x * rstd * g.x; r.y = xv.y + v[i].y * rstd * g.y; r.z = xv.z + v[i].z * rstd * g.z; r.w = xv.w + v[i].w * rstd * g.w;
      *(float4*)(p.r() + (size_t)row * 1024 + k) = r;
      u32x2 pk; pk.x = pack2(r.x, r.y); pk.y = pack2(r.z, r.w);
      *(u32x2*)(p.rb() + (size_t)row * 1024 + k) = pk;
    }
  }
}

__device__ void ple_tile(const Params& p, int l, int t, char* smem) {
  const int tm = t >> 3, tn = t & 7;
  const int tid = get_tid(), lane = tid & 63, wid = tid >> 6, wr = wid >> 1, wc = wid & 1, fr = lane & 15, fq = lane >> 4;
  f32x4 acc[4][4]; zero_acc(acc);
  const int row0 = tm * 128;
  const float* pp = row0 < NPROMPT ? p.p_p + ((size_t)l * NPROMPT + row0) * 256 : p.p_s + ((size_t)l * 512 + (row0 - NPROMPT)) * 256;
  gemm_kloop<float>(acc, pp, 256, p.wt_pp() + (size_t)l * 262144 + (size_t)tn * 128 * 256, 256, 256, smem);
  u32x2 pb[4][4];
#pragma unroll
  for (int a = 0; a < 4; ++a)
#pragma unroll
    for (int c = 0; c < 4; ++c) { pb[a][c].x = pack2(acc[a][c][0], acc[a][c][1]); pb[a][c].y = pack2(acc[a][c][2], acc[a][c][3]); }
  zero_acc(acc);
  gemm_kloop<bf16_t>(acc, p.rb() + (size_t)tm * 128 * 1024, 1024, p.wt_pg() + (size_t)l * 1048576 + (size_t)tn * 128 * 1024, 1024, 1024, smem);
#pragma unroll
  for (int ni = 0; ni < 4; ++ni) {
    const size_t row = (size_t)row0 + wr * 64 + ni * 16 + fr;
#pragma unroll
    for (int mi = 0; mi < 4; ++mi) {
      const int col = tn * 128 + wc * 64 + mi * 16 + fq * 4;
      const f32x4 rv = *(const f32x4*)(p.r() + row * 1024 + col);
      f32x4 o;
      o[0] = rv[0] + sigm(acc[mi][ni][0]) * lo2f(pb[mi][ni].x); o[1] = rv[1] + sigm(acc[mi][ni][1]) * hi2f(pb[mi][ni].x);
      o[2] = rv[2] + sigm(acc[mi][ni][2]) * lo2f(pb[mi][ni].y); o[3] = rv[3] + sigm(acc[mi][ni][3]) * hi2f(pb[mi][ni].y);
      *(f32x4*)(p.o_y() + row * 1024 + col) = o;
    }
  }
}


template <typename TT>
__device__ __forceinline__ void mini_dot(f32x4& acc, const TT* Trow, const bf16_t* Wrow, int K) {
#pragma unroll 8
  for (int k = 0; k < K; k += 32) {
    const u32x4 tv = ld8(Trow + k), wv = ld8(Wrow + k);
    acc = __builtin_amdgcn_mfma_f32_16x16x32_bf16(__builtin_bit_cast(bf16x8, wv), __builtin_bit_cast(bf16x8, tv), acc, 0, 0, 0);
  }
}
__device__ void merge_mini(const Params& p, int l, int j) {
  const int tid = get_tid(), lane = tid & 63, w = tid >> 6, fr = lane & 15, fq = lane >> 4;
  const size_t row = (size_t)NPROMPT + (j >> 4) * 16 + fr;
  const int cb = (j & 15) * 64 + w * 16;
  f32x4 out = {0.f, 0.f, 0.f, 0.f};
#pragma unroll 1
  for (int b = 0; b < 3; ++b) {
    f32x4 g = {0.f, 0.f, 0.f, 0.f}, h = {0.f, 0.f, 0.f, 0.f};
    mini_dot<bf16_t>(g, p.U() + row * 1024 + fq * 8, p.wt_in() + (size_t)l * NWT * 1024 + (size_t)(NMAIN + b * 1024 + cb + fr) * 1024 + fq * 8, 1024);
    mini_dot<bf16_t>(h, p.H() + (size_t)b * NTOK * 512 + row * 512 + fq * 8, p.wt_br() + (size_t)(l * 3 + b) * 1024 * 512 + (size_t)(cb + fr) * 512 + fq * 8, 512);
    out[0] += sigm(g[0]) * h[0]; out[1] += sigm(g[1]) * h[1]; out[2] += sigm(g[2]) * h[2]; out[3] += sigm(g[3]) * h[3];
  }
  u32x2 pk; pk.x = pack2(out[0], out[1]); pk.y = pack2(out[2], out[3]);
  *(u32x2*)(p.merged() + row * 1024 + cb + fq * 4) = pk;
}
__device__ void outproj_mini(const Params& p, int l, int j) {
  const int tid = get_tid(), lane = tid & 63, w = tid >> 6, fr = lane & 15, fq = lane >> 4;
  const size_t row = (size_t)NPROMPT + (j >> 4) * 16 + fr;
  const int cb = (j & 15) * 64 + w * 16;
  f32x4 y = {0.f, 0.f, 0.f, 0.f};
  mini_dot<bf16_t>(y, p.merged() + row * 1024 + fq * 8, p.wt_out() + (size_t)l * 1048576 + (size_t)(cb + fr) * 1024 + fq * 8, 1024);
  *(f32x4*)(p.y() + row * 1024 + cb + fq * 4) = y;
}
__device__ void ple_mini(const Params& p, int l, int j) {
  const int tid = get_tid(), lane = tid & 63, w = tid >> 6, fr = lane & 15, fq = lane >> 4;
  const int srow = (j >> 4) * 16 + fr;
  const size_t row = (size_t)NPROMPT + srow;
  const int cb = (j & 15) * 64 + w * 16;
  f32x4 g = {0.f, 0.f, 0.f, 0.f}, pa = {0.f, 0.f, 0.f, 0.f};
  mini_dot<float>(pa, p.p_s + ((size_t)l * 512 + srow) * 256 + fq * 8, p.wt_pp() + (size_t)l * 262144 + (size_t)(cb + fr) * 256 + fq * 8, 256);
  mini_dot<bf16_t>(g, p.rb() + row * 1024 + fq * 8, p.wt_pg() + (size_t)l * 1048576 + (size_t)(cb + fr) * 1024 + fq * 8, 1024);
  const f32x4 rv = *(const f32x4*)(p.r() + row * 1024 + cb + fq * 4);
  f32x4 o; o[0] = rv[0] + sigm(g[0]) * pa[0]; o[1] = rv[1] + sigm(g[1]) * pa[1]; o[2] = rv[2] + sigm(g[2]) * pa[2]; o[3] = rv[3] + sigm(g[3]) * pa[3];
  *(f32x4*)(p.o_y() + row * 1024 + cb + fq * 4) = o;
}

#define XB_TMO      128
#define XB_XCNT(j)  (256  + 64 * (j))
#define XB_XSUB(j)  (1280 + 64 * (j))
#define XB_XGEN(j)  (2304 + 64 * (j))
#define XB_TOP      3328
#define XB_TOPGEN   3392
#define XCD_BAR_WORDS 3456
#define XB_SPIN_CAP (1u << 18)
#define LAS __attribute__((address_space(3)))
__device__ __forceinline__ unsigned xb_ld(unsigned* p)              { return __hip_atomic_load(p, __ATOMIC_RELAXED, __HIP_MEMORY_SCOPE_AGENT); }
__device__ __forceinline__ unsigned xb_add(unsigned* p, unsigned v) { return __hip_atomic_fetch_add(p, v, __ATOMIC_RELAXED, __HIP_MEMORY_SCOPE_AGENT); }
__device__ __forceinline__ unsigned xb_xcc_id() { return (unsigned)__builtin_amdgcn_s_getreg((3 << 11) | 20) & 0xFu; }
#define XB_SPIN(cond, bar) do { unsigned _sp = 0; while (cond) { __builtin_amdgcn_s_sleep(1); \
    if ((++_sp & 255u) == 0u) { if (xb_ld(&(bar)[XB_TMO])) break; if (_sp > XB_SPIN_CAP) { atomicAdd(&(bar)[XB_TMO], 1u); break; } } } } while (0)
__device__ __forceinline__ void xcd_barrier_complete(unsigned* bar, unsigned x, unsigned& nloc, unsigned& nx) {
    const unsigned G = gridDim.x * gridDim.y * gridDim.z;
    unsigned sum, cnt, mine, sp = 0u;
    for (;;) {
        sum = 0u; cnt = 0u; mine = 0u;
#pragma unroll
        for (unsigned j = 0; j < 16; ++j) { const unsigned c = xb_ld(&bar[XB_XCNT(j)]); sum += c; cnt += (c > 0u) ? 1u : 0u; mine = (j == x) ? c : mine; }
        if (sum == G) break;
        __builtin_amdgcn_s_sleep(1);
        if ((++sp & 255u) == 0u) { if (xb_ld(&bar[XB_TMO])) break; if (sp > XB_SPIN_CAP) { atomicAdd(&bar[XB_TMO], 1u); break; } }
    }
    nloc = mine > 0u ? mine : 1u; nx = cnt > 0u ? cnt : 1u;
}
__device__ __forceinline__ void xcd_barrier(unsigned* bar, volatile LAS unsigned* st) {
    asm volatile("s_waitcnt vmcnt(0)" ::: "memory");
    __syncthreads();
    if (threadIdx.x == 0) {
        const unsigned x = xb_xcc_id();
        __builtin_amdgcn_s_waitcnt(0);
        unsigned nloc = st[0], nx = st[1];
        if (nloc == 0u) { xcd_barrier_complete(bar, x, nloc, nx); st[0] = nloc; st[1] = nx; }
        const unsigned old = xb_add(&bar[XB_XSUB(x)], 1u);
        const unsigned gen = old / nloc;
        if (old + 1u == (gen + 1u) * nloc) {
            __builtin_amdgcn_fence(__ATOMIC_RELEASE, "agent");
            asm volatile("s_waitcnt vmcnt(0)" ::: "memory");
            const unsigned og = xb_add(&bar[XB_TOP], 1u);
            const unsigned tg = og / nx;
            if (og + 1u == (tg + 1u) * nx) xb_add(&bar[XB_TOPGEN], 1u);
            else XB_SPIN(xb_ld(&bar[XB_TOPGEN]) == tg, bar);
            __builtin_amdgcn_fence(__ATOMIC_ACQUIRE, "agent");
            xb_add(&bar[XB_XGEN(x)], 1u);
            asm volatile("s_waitcnt vmcnt(0)" ::: "memory");
        } else {
            XB_SPIN(xb_ld(&bar[XB_XGEN(x)]) == gen, bar);
            __builtin_amdgcn_fence(__ATOMIC_ACQUIRE, "agent");
            asm volatile("s_waitcnt vmcnt(0)" ::: "memory");
        }
    }
    __syncthreads();
}

template <int PH>
__device__ __forceinline__ void run_phase(const Params& p, char* smem) {
  const int bid = blockIdx.x, nb = gridDim.x;
  if (PH == 0) {
    for (int t = bid; t < 1696; t += nb) wconv_tile(p, t, smem);
    for (int i = bid * 256 + get_tid(); i < 2 * 8 * 1024; i += nb * 256) { const int ll = i >> 13, j = (i >> 10) & 7, k = i & 1023; p.wg8()[i] = p.w_in[((size_t)ll * 1024 + k) * NINSRC + 2560 + j]; }
    return;
  }
  constexpr int l = (PH - 1) / NPL, s0_ = (PH - 1) % NPL, s = s0_ < 5 ? s0_ : s0_ - 1;
  if (s0_ == 5) return;
  if (!((PHMASK >> s) & 1)) return;
  switch (s) {
    case 0: norm_phase(p, l); break;
    case 1: {
      const int per = (66 * 52) / 8, xcd = bid & 7, nloc = (nb + 7 - xcd) >> 3;
      for (int j = bid >> 3; j < per; j += nloc) {
        const int sq = xcd * per + j;
        const int tmg = sq / 416, rem = sq % 416, gm = (tmg == 8) ? 2 : 8;
        const int tng = rem / (gm * 8), rem2 = rem % (gm * 8), wdt = (tng == 6) ? 4 : 8;
        inproj_tile(p, l, (tmg * 8 + rem2 / wdt) * 52 + tng * 8 + rem2 % wdt, smem);
      }
      break;
    }
    case 2:
      for (int v = bid; v < 3 * NUNIT; v += nb) {
        const int ty = v % 3, u = v / 3;
        if (ty == 0) sb_unit(p, l, u, smem); else if (ty == 1) mlstm_local(p, l, u, smem); else hgrn_local(p, l, u, smem);
      }
      break;
    case 3: scan_phase(p, l, smem); break;
    case 4:
      for (int v = bid; v < 2 * NUNIT; v += nb) { if (v & 1) hgrn_out(p, l, v >> 1, smem); else mlstm_out(p, l, v >> 1, smem); }
      break;
    case 5: for (int t = bid; t < 1024; t += nb) merge_tile(p, l, t, smem); for (int j = bid; j < 512; j += nb) merge_mini(p, l, j); break;
    case 6: for (int t = bid; t < 1024; t += nb) outproj_tile(p, l, t, smem); for (int j = bid; j < 512; j += nb) outproj_mini(p, l, j); break;
    case 7: postnorm_phase(p, l); break;
    case 8: for (int t = bid; t < 1024; t += nb) ple_tile(p, l, t, smem); for (int j = bid; j < 512; j += nb) ple_mini(p, l, j); break;
  }
}

template <int PH>
__global__ void __launch_bounds__(256, 2) phase_kernel(Params p) {
  __shared__ __attribute__((aligned(16))) char smem[SMEM_BYTES];
  run_phase<PH>(p, smem);
}

#if FUSED
__device__ __forceinline__ int fetch_work(unsigned* ctr, volatile int* slot) {
  __syncthreads();
  if (threadIdx.x == 0) *slot = (int)__hip_atomic_fetch_add(ctr, 1u, __ATOMIC_RELAXED, __HIP_MEMORY_SCOPE_AGENT);
  __syncthreads();
  return *slot;
}
__device__ __forceinline__ void run_phase_rt(const Params& p, int ph, char* smem, volatile int* wslot) {
  const int bid = blockIdx.x, nb = gridDim.x;
  unsigned* ctr = (unsigned*)(p.ws + WS_BAR + 14336) + ph * 16;
  if (ph == 0) {
    for (int t = bid; t < 1696; t += nb) wconv_tile(p, t, smem);
    for (int i = bid * 256 + get_tid(); i < 2 * 8 * 1024; i += nb * 256) { const int ll = i >> 13, j = (i >> 10) & 7, k = i & 1023; p.wg8()[i] = p.w_in[((size_t)ll * 1024 + k) * NINSRC + 2560 + j]; }
    return;
  }
  const int l = (ph - 1) / NPL, s = (ph - 1) % NPL;
  switch (s) {
    case 0: norm_phase(p, l); break;
    case 1: {
      const int per = (66 * 52) / 8, xcd0 = (int)(xb_xcc_id() & 7u);
      for (int dx = 0; dx < 8; ++dx) {
        const int xcd = (xcd0 + dx) & 7;
        for (;;) {
          const int j = fetch_work(ctr + xcd, wslot);
          if (j >= per) break;
          const int sq = xcd * per + j;
          const int tmg = sq / 416, rem = sq % 416, gm = (tmg == 8) ? 2 : 8;
          const int tng = rem / (gm * 8), rem2 = rem % (gm * 8), wdt = (tng == 6) ? 4 : 8;
          inproj_tile(p, l, (tmg * 8 + rem2 / wdt) * 52 + tng * 8 + rem2 % wdt, smem);
        }
      }
      break;
    }
    case 2:
      for (;;) {
        const int v = fetch_work(ctr, wslot);
        if (v >= 3 * NUNIT) break;
        if (v < NUNIT) sb_unit(p, l, v, smem); else if (v < 2 * NUNIT) mlstm_local(p, l, v - NUNIT, smem); else hgrn_local(p, l, v - 2 * NUNIT, smem);
      }
      break;
    case 3: scan_phase(p, l, smem); break;
    case 4:
      for (;;) {
        const int v = fetch_work(ctr, wslot);
        if (v >= 2 * NUNIT) break;
        if (v < NUNIT) hgrn_out(p, l, v, smem); else mlstm_out(p, l, v - NUNIT, smem);
      }
      break;
    case 5: for (;;) { const int v = fetch_work(ctr, wslot); if (v >= 1536) break; gate_tile256(p, l, v, smem); } break;
    case 6: for (;;) { const int v = fetch_work(ctr, wslot); if (v >= 1536) break; if (v < 1024) merge_tile_g(p, l, v, smem); else merge_mini(p, l, v - 1024); } break;
    case 7: for (;;) { const int v = fetch_work(ctr, wslot); if (v >= 1024) break; if (v < 512) outproj_tile256(p, l, v, smem); else outproj_mini(p, l, v - 512); } break;
    case 8: postnorm_phase(p, l); break;
    case 9: for (;;) { const int v = fetch_work(ctr, wslot); if (v >= 1536) break; if (v < 1024) ple_tile(p, l, v, smem); else ple_mini(p, l, v - 1024); } break;
  }
}

__global__ void __launch_bounds__(256, 2) mega(Params p_unused) {
  __shared__ __attribute__((aligned(16))) char smem[SMEM_BYTES];
  __shared__ uint4 xb_words;
  __shared__ int wslot;
  if (threadIdx.x == 0) {
    typedef const Params __attribute__((address_space(4))) * KP4;
    KP4 kp = (KP4)__builtin_amdgcn_kernarg_segment_ptr();
    asm volatile("" : "+s"(kp));
    char* wsb = ((const Params*)kp)->ws;
    xb_words = make_uint4(0u, 0u, 0u, 0u); (void)xb_add((unsigned*)(wsb + WS_BAR) + XB_XCNT(xb_xcc_id()), 1u);
  }
  __syncthreads();
  typedef const Params __attribute__((address_space(4))) * KP4;
#ifdef PROBE_KIND
  unsigned long long t_acc = 0;
#endif
#pragma unroll 1
  for (int ph = 0; ph < NPHASE; ++ph) {
    KP4 kp = (KP4)__builtin_amdgcn_kernarg_segment_ptr();
    asm volatile("" : "+s"(kp));
    const Params q = *(const Params*)kp;
#ifdef PROBE_KIND
    const unsigned long long tp0 = __builtin_amdgcn_s_memrealtime();
#endif
    run_phase_rt(q, ph, smem, &wslot);
#ifdef PROBE_KIND
    const unsigned long long tp1 = __builtin_amdgcn_s_memrealtime();
    if ((PROBE_KIND == 9 && ph == 0) || (PROBE_KIND < 9 && ph > 0 && (ph - 1) % NPL == PROBE_KIND)) t_acc += tp1 - tp0;
#endif
    if (ph + 1 < NPHASE) xcd_barrier((unsigned*)(q.ws + WS_BAR), (volatile LAS unsigned*)&xb_words);
    if (gridDim.y == 7777u) cg::this_grid().sync();
#ifdef PROBE_KIND
    if (PROBE_KIND == 10 && (PROBE_SEL < 0 || (ph > 0 && (ph - 1) % NPL == PROBE_SEL))) t_acc += __builtin_amdgcn_s_memrealtime() - tp1;
#endif
  }
#ifdef PROBE_GEMM
  {
    KP4 kp = (KP4)__builtin_amdgcn_kernarg_segment_ptr();
    asm volatile("" : "+s"(kp));
    const Params q = *(const Params*)kp;
    xcd_barrier((unsigned*)(q.ws + WS_BAR), (volatile LAS unsigned*)&xb_words);
    const unsigned long long tg0 = __builtin_amdgcn_s_memrealtime();
    f32x4 acc[4][8];
#pragma unroll
    for (int a_ = 0; a_ < 4; ++a_)
#pragma unroll
      for (int b_ = 0; b_ < 8; ++b_) acc[a_][b_] = (f32x4){0.f, 0.f, 0.f, 0.f};
    const int bid = blockIdx.x;
#pragma unroll 1
    for (int it = 0; it < 8; ++it) {
      int tm, tn;
      if (PROBE_GEMM == 0) { tm = 0; tn = 0; }
      else if (PROBE_GEMM == 1) { tm = bid & 63; tn = ((bid >> 6) * 6 + it) % 52; }
      else { const int xcd = bid & 7, idx = bid >> 3; tm = xcd * 8 + (idx & 7); tn = ((idx >> 3) + 8 * it) % 52; }
      gemm_glds<8, 3>(acc, q.U() + (size_t)tm * 256 * 1024, 1024, q.wt_in() + (size_t)tn * 128 * 1024, 1024, 1024, smem);
    }
    float sum = 0.f;
#pragma unroll
    for (int a_ = 0; a_ < 4; ++a_)
#pragma unroll
      for (int b_ = 0; b_ < 8; ++b_) sum += acc[a_][b_][0] + acc[a_][b_][1] + acc[a_][b_][2] + acc[a_][b_][3];
    if (sum == 123456.789f) q.hbc()[0] = sum;
    const unsigned long long tg1 = __builtin_amdgcn_s_memrealtime();
    if (blockIdx.x == 0) { while (__builtin_amdgcn_s_memrealtime() - tg1 < 4 * (tg1 - tg0)) __builtin_amdgcn_s_sleep(32); }
  }
#endif
#ifdef PROBE_KIND
  if (blockIdx.x == PROBE_BLOCK) { const unsigned long long te = __builtin_amdgcn_s_memrealtime(); while (__builtin_amdgcn_s_memrealtime() - te < 4 * t_acc) __builtin_amdgcn_s_sleep(32); }
#endif
}
#endif

template <int PH>
static void launch_all(const Params& p, int grid, hipStream_t stream) {
  hipLaunchKernelGGL(phase_kernel<PH>, dim3(grid), dim3(256), 0, stream, p);
  if constexpr (PH + 1 < NPHASE) launch_all<PH + 1>(p, grid, stream);
}

extern "C" void kernel_launch(void* const* d_in, const int* in_sizes, int n_in, void* d_out, int out_size, void* d_ws, size_t ws_size, hipStream_t stream) {
  Params p;
  memset(&p, 0, sizeof(p));
  const float* const* in = (const float* const*)d_in;
  p.x_p = in[0]; p.x_s = in[1]; p.p_p = in[2]; p.p_s = in[3]; p.st_C = in[4]; p.st_n = in[5]; p.st_m = in[6]; p.st_conv = in[7];
  p.ck = in[8]; p.cv = in[9]; p.st_S = in[10]; p.g_pre = in[11]; p.w_in = in[12]; p.b_i = in[13]; p.b_f = in[14]; p.w_conv = in[15];
  p.g_ml = in[16]; p.lb_logits = in[17]; p.g_hg = in[18]; p.w_br = in[19]; p.w_out = in[20]; p.g_post = in[21]; p.w_pg = in[22]; p.w_pp = in[23];
  p.out = (float*)d_out; p.ws = (char*)d_ws;
  if (WS_TOTAL > ws_size || (size_t)out_size < O_TOTAL) { fprintf(stderr, "workspace/out too small: need %zu have %zu\n", (size_t)WS_TOTAL, ws_size); return; }
  static int grid_blocks = 0;
  if (!grid_blocks) {
    int dev = 0, cus = 0, per_cu = 0;
    (void)hipGetDevice(&dev);
    (void)hipDeviceGetAttribute(&cus, hipDeviceAttributeMultiprocessorCount, dev);
#if FUSED
    (void)hipOccupancyMaxActiveBlocksPerMultiprocessor(&per_cu, mega, 256, 0);
#else
    per_cu = 2;
#endif
    if (per_cu > 2) per_cu = 2;
    if (per_cu < 1) per_cu = 1;
    grid_blocks = cus * per_cu;
  }
#if FUSED
  (void)hipMemsetAsync((char*)d_ws + WS_BAR, 0, 16384, stream);
  void* args[] = {&p};
  hipError_t e = hipLaunchCooperativeKernel((void*)mega, dim3(grid_blocks), dim3(256), args, 0, stream);
  if (e != hipSuccess) fprintf(stderr, "cooperative launch failed: %s (grid %d)\n", hipGetErrorString(e), grid_blocks);
#else
  launch_all<0>(p, grid_blocks, stream);
#endif
}
```

```cpp
#include <hip/hip_runtime.h>
#include <hip/hip_cooperative_groups.h>
#include <stdint.h>
#include <stdio.h>
#include <string.h>
namespace cg = cooperative_groups;

#ifndef FUSED
#define FUSED 1
#endif
#ifndef PHMASK
#define PHMASK 0x3ff
#endif

typedef unsigned short bf16_t;
typedef short bf16x8 __attribute__((ext_vector_type(8)));
typedef float f32x4 __attribute__((ext_vector_type(4)));
typedef unsigned u32x4 __attribute__((ext_vector_type(4)));
typedef unsigned u32x2 __attribute__((ext_vector_type(2)));

constexpr int NTOK = 16896, NPROMPT = 16384, NUNIT = 1056;
constexpr int NINSRC = 9736, NWT = 9728, NMAIN = 6656;
constexpr int SMEM_BYTES = 80896;
constexpr int NPL = 9;
constexpr int NPHASE = 1 + 2 * NPL;

constexpr size_t al256(size_t x) { return (x + 255) & ~(size_t)255; }
constexpr size_t WS_WT_IN = 0;
constexpr size_t WS_WT_BR = WS_WT_IN + al256((size_t)2 * NWT * 1024 * 2);
constexpr size_t WS_WT_OUT = WS_WT_BR + al256((size_t)2 * 3 * 1024 * 512 * 2);
constexpr size_t WS_WT_PG = WS_WT_OUT + al256((size_t)2 * 1048576 * 2);
constexpr size_t WS_WT_PP = WS_WT_PG + al256((size_t)2 * 1048576 * 2);
constexpr size_t WS_U = WS_WT_PP + al256((size_t)2 * 262144 * 2);
constexpr size_t WS_PR = WS_U + al256((size_t)NTOK * 1024 * 2);
constexpr size_t WS_QC = WS_PR + al256((size_t)13 * NTOK * 512 * 2);
constexpr size_t WS_KC = WS_QC + al256((size_t)NTOK * 512 * 2);
constexpr size_t WS_SM = WS_KC + al256((size_t)NTOK * 512 * 2);
constexpr size_t WS_SH = WS_SM + al256((size_t)NUNIT * 16384 * 2);
constexpr size_t WS_H = WS_SH + al256((size_t)NUNIT * 16384 * 2);
constexpr size_t WS_IG = WS_H + al256((size_t)3 * NTOK * 512 * 2);
constexpr size_t WS_LF = WS_IG + al256((size_t)NTOK * 16);
constexpr size_t WS_AC = WS_LF + al256((size_t)NTOK * 16);
constexpr size_t WS_BC = WS_AC + al256(NUNIT * 4);
constexpr size_t WS_MIN = WS_BC + al256(NUNIT * 4);
constexpr size_t WS_NLOC = WS_MIN + al256(NUNIT * 4);
constexpr size_t WS_HBC = WS_NLOC + al256((size_t)NUNIT * 512);
constexpr size_t WS_BAR = WS_HBC + al256((size_t)NUNIT * 512);
constexpr size_t WS_WG8 = WS_BAR + 16384;
constexpr size_t WS_TOTAL = WS_WG8 + 65536;
constexpr size_t GRP = (size_t)NTOK * 512 * 2;
constexpr size_t WS_G0 = WS_PR + 0 * GRP, WS_G1 = WS_PR + 5 * GRP, WS_G2 = WS_PR + 7 * GRP;
constexpr size_t WS_MERGED = WS_PR + 2 * GRP;
constexpr size_t WS_Y = WS_PR + 9 * GRP;
constexpr size_t WS_RB = WS_PR + 0 * GRP;
constexpr size_t WS_R = WS_PR + 5 * GRP;
static_assert(WS_Y + (size_t)NTOK * 1024 * 4 <= WS_QC, "alias overflow");
constexpr size_t O_PC = 16777216 + 524288, O_PN = O_PC + 262144, O_PM = O_PN + 2048, O_PCONV = O_PM + 16, O_PK = O_PCONV + 12288, O_PV = O_PK + 16777216,
                 O_PS = O_PV + 16777216, O_SC = O_PS + 262144, O_SN = O_SC + 1048576, O_SM = O_SN + 8192, O_SCONV = O_SM + 64, O_SK = O_SCONV + 49152,
                 O_SV = O_SK + 524288, O_SS = O_SV + 524288, O_TOTAL = O_SS + 1048576;

struct Params {
  const float *x_p, *x_s, *p_p, *p_s, *st_C, *st_n, *st_m, *st_conv, *ck, *cv, *st_S;
  const float *g_pre, *w_in, *b_i, *b_f, *w_conv, *g_ml, *lb_logits, *g_hg, *w_br, *w_out, *g_post, *w_pg, *w_pp;
  float* out; char* ws;
#define WSP(name, T, off) __device__ __forceinline__ T* name() const { return (T*)(ws + (off)); }
#define OUTP(name, off) __device__ __forceinline__ float* name() const { return out + (off); }
  OUTP(o_y, 0) OUTP(o_pC, O_PC) OUTP(o_pn, O_PN) OUTP(o_pm, O_PM) OUTP(o_pconv, O_PCONV) OUTP(o_pk, O_PK) OUTP(o_pv, O_PV) OUTP(o_pS, O_PS)
  OUTP(o_sC, O_SC) OUTP(o_sn, O_SN) OUTP(o_sm, O_SM) OUTP(o_sconv, O_SCONV) OUTP(o_sk, O_SK) OUTP(o_sv, O_SV) OUTP(o_sS, O_SS)
  WSP(wt_in, bf16_t, WS_WT_IN) WSP(wt_br, bf16_t, WS_WT_BR) WSP(wt_out, bf16_t, WS_WT_OUT) WSP(wt_pg, bf16_t, WS_WT_PG) WSP(wt_pp, bf16_t, WS_WT_PP)
  WSP(U, bf16_t, WS_U) WSP(PR, bf16_t, WS_PR) WSP(QC, bf16_t, WS_QC) WSP(KC, bf16_t, WS_KC) WSP(SM, bf16_t, WS_SM) WSP(SH, bf16_t, WS_SH) WSP(H, bf16_t, WS_H)
  WSP(ig, float, WS_IG) WSP(lf, float, WS_LF) WSP(ac, float, WS_AC) WSP(Bc, float, WS_BC) WSP(min_, float, WS_MIN) WSP(nloc, float, WS_NLOC) WSP(hbc, float, WS_HBC)
  __device__ __forceinline__ bf16_t* Gb(int b) const { return (bf16_t*)(ws + (b == 0 ? WS_G0 : b == 1 ? WS_G1 : WS_G2)); }
  WSP(wg8, float, WS_WG8) WSP(merged, bf16_t, WS_MERGED) WSP(y, float, WS_Y) WSP(r, float, WS_R) WSP(rb, bf16_t, WS_RB)
};

__device__ __forceinline__ int get_tid() { int t = threadIdx.x; asm volatile("" : "+v"(t)); return t; }
__device__ __forceinline__ bf16_t f2bf(float f) { unsigned u = __float_as_uint(f); u += 0x7fffu + ((u >> 16) & 1u); return (bf16_t)(u >> 16); }
__device__ __forceinline__ float bf2f(bf16_t h) { return __uint_as_float(((unsigned)h) << 16); }
__device__ __forceinline__ unsigned pack2(float a, float b) { return (unsigned)f2bf(a) | ((unsigned)f2bf(b) << 16); }
__device__ __forceinline__ float lo2f(unsigned v) { return __uint_as_float(v << 16); }
__device__ __forceinline__ float hi2f(unsigned v) { return __uint_as_float(v & 0xffff0000u); }
__device__ __forceinline__ float sigm(float x) { return 1.f / (1.f + __expf(-x)); }
__device__ __forceinline__ float silu(float x) { return x / (1.f + __expf(-x)); }
__device__ __forceinline__ float softplus(float x) { return fmaxf(x, 0.f) + __logf(1.f + __expf(-fabsf(x))); }
__device__ __forceinline__ float logsigm(float x) { return fminf(x, 0.f) - __logf(1.f + __expf(-fabsf(x))); }

template <int MT, int NT, int KS>
__device__ __forceinline__ void wmma(f32x4 (&acc)[MT][NT], const bf16_t* A, int lda, const bf16_t* B, int ldb, int fr, int fq) {
#pragma unroll
  for (int kk = 0; kk < KS; ++kk) {
    bf16x8 a[MT], b[NT];
#pragma unroll
    for (int mi = 0; mi < MT; ++mi) a[mi] = *(const bf16x8*)(A + (mi * 16 + fr) * lda + kk * 32 + fq * 8);
#pragma unroll
    for (int ni = 0; ni < NT; ++ni) b[ni] = *(const bf16x8*)(B + (ni * 16 + fr) * ldb + kk * 32 + fq * 8);
#pragma unroll
    for (int mi = 0; mi < MT; ++mi)
#pragma unroll
      for (int ni = 0; ni < NT; ++ni) acc[mi][ni] = __builtin_amdgcn_mfma_f32_16x16x32_bf16(a[mi], b[ni], acc[mi][ni], 0, 0, 0);
  }
}

__device__ __forceinline__ u32x4 ld8(const bf16_t* s) { return *(const u32x4*)s; }
__device__ __forceinline__ u32x4 ld8(const float* s) {
  float4 a = *(const float4*)s, b = *(const float4*)(s + 4);
  u32x4 r; r.x = pack2(a.x, a.y); r.y = pack2(a.z, a.w); r.z = pack2(b.x, b.y); r.w = pack2(b.z, b.w); return r;
}
template <typename T>
__device__ __forceinline__ void ld_tile(bf16_t* dst, const T* src, long ld, int tid) {
#pragma unroll
  for (int i = 0; i < 4; ++i) { int id = tid + 256 * i; int r = id >> 4, c = (id & 15) * 8; *(u32x4*)(dst + r * 136 + c) = ld8(src + (long)r * ld + c); }
}
template <typename T>
__device__ __forceinline__ void ld_tile128(bf16_t* dst, const T* src, long ld, int tid) {
#pragma unroll
  for (int i = 0; i < 8; ++i) { int id = tid + 256 * i; int r = id >> 4, c = (id & 15) * 8; *(u32x4*)(dst + r * 136 + c) = ld8(src + (long)r * ld + c); }
}
template <typename T, int ROWS, int DLD>
__device__ __forceinline__ void ld_T(bf16_t* dst, const T* src, long ld, int tid) {
#pragma unroll 2
  for (int id = tid; id < ROWS * 16; id += 256) {
    int r = id % ROWS, c = (id / ROWS) * 8;
    u32x4 v = ld8(src + (long)r * ld + c);
    bf16_t* d = dst + c * DLD + r;
    d[0] = (bf16_t)(v.x & 0xffff); d[DLD] = (bf16_t)(v.x >> 16); d[2 * DLD] = (bf16_t)(v.y & 0xffff); d[3 * DLD] = (bf16_t)(v.y >> 16);
    d[4 * DLD] = (bf16_t)(v.z & 0xffff); d[5 * DLD] = (bf16_t)(v.z >> 16); d[6 * DLD] = (bf16_t)(v.w & 0xffff); d[7 * DLD] = (bf16_t)(v.w >> 16);
  }
}

#define PRG(g) (p.PR() + (size_t)(g) * NTOK * 512)

__device__ __forceinline__ const float* xrow(const Params& p, int l, int row) {
  if (l == 0) return row < NPROMPT ? p.x_p + (size_t)row * 1024 : p.x_s + (size_t)(row - NPROMPT) * 1024;
  return p.o_y() + (size_t)row * 1024;
}

__device__ void wconv_tile(const Params& p, int t, char* smem) {
  float* tile = (float*)smem;
  const int tid = get_tid();
  int l = t / 848, r = t % 848;
  const float* src; bf16_t* dst; int K, ldsrc, kt, nt, skip = 1 << 30;
  if (r < 608) { src = p.w_in + (size_t)l * 1024 * NINSRC; dst = p.wt_in() + (size_t)l * NWT * 1024; K = 1024; ldsrc = NINSRC; kt = r % 16; nt = r / 16; skip = 2560; }
  else if (r < 704) { r -= 608; int b = r / 32; r %= 32; src = p.w_br + (size_t)(l * 3 + b) * 512 * 1024; dst = p.wt_br() + (size_t)(l * 3 + b) * 1024 * 512; K = 512; ldsrc = 1024; kt = r % 8; nt = r / 8; }
  else if (r < 768) { r -= 704; src = p.w_out + (size_t)l * 1048576; dst = p.wt_out() + (size_t)l * 1048576; K = 1024; ldsrc = 1024; kt = r % 16; nt = r / 16; }
  else if (r < 832) { r -= 768; src = p.w_pg + (size_t)l * 1048576; dst = p.wt_pg() + (size_t)l * 1048576; K = 1024; ldsrc = 1024; kt = r % 16; nt = r / 16; }
  else { r -= 832; src = p.w_pp + (size_t)l * 262144; dst = p.wt_pp() + (size_t)l * 262144; K = 256; ldsrc = 1024; kt = r % 4; nt = r / 4; }
  const int n0 = nt * 256, k0 = kt * 64;
  __syncthreads();
#pragma unroll
  for (int i = 0; i < 16; ++i) {
    const int k = i * 4 + (tid >> 6), n4 = (tid & 63) * 4;
    int ns = n0 + n4; if (ns >= skip) ns += 8;
    *(float4*)(tile + k * 260 + n4) = *(const float4*)(src + (size_t)(k0 + k) * ldsrc + ns);
  }
  __syncthreads();
  bf16_t* drow = dst + (size_t)(n0 + tid) * K + k0;
#pragma unroll
  for (int c = 0; c < 8; ++c) {
    u32x4 pk;
    pk.x = pack2(tile[(c * 8 + 0) * 260 + tid], tile[(c * 8 + 1) * 260 + tid]);
    pk.y = pack2(tile[(c * 8 + 2) * 260 + tid], tile[(c * 8 + 3) * 260 + tid]);
    pk.z = pack2(tile[(c * 8 + 4) * 260 + tid], tile[(c * 8 + 5) * 260 + tid]);
    pk.w = pack2(tile[(c * 8 + 6) * 260 + tid], tile[(c * 8 + 7) * 260 + tid]);
    *(u32x4*)(drow + c * 8) = pk;
  }
}

__device__ void norm_phase(const Params& p, int l) {
  const int lane = threadIdx.x & 63, wid = threadIdx.x >> 6;
  const float* gp = p.g_pre + l * 1024;
  const float* wg = p.wg8() + l * 8192;
  for (int row = blockIdx.x * 4 + wid; row < NTOK; row += gridDim.x * 4) {
    const float* x = xrow(p, l, row);
    float4 v[4]; float ss = 0.f;
#pragma unroll
    for (int i = 0; i < 4; ++i) { v[i] = *(const float4*)(x + i * 256 + lane * 4); ss += v[i].x * v[i].x + v[i].y * v[i].y + v[i].z * v[i].z + v[i].w * v[i].w; }
#pragma unroll
    for (int o = 32; o > 0; o >>= 1) ss += __shfl_xor(ss, o);
    const float rstd = rsqrtf(ss * (1.f / 1024.f) + 1e-6f);
    float d0 = 0, d1 = 0, d2 = 0, d3 = 0, d4 = 0, d5 = 0, d6 = 0, d7 = 0;
#pragma unroll
    for (int i = 0; i < 4; ++i) {
      const int k = i * 256 + lane * 4;
      float4 g = *(const float4*)(gp + k);
      float u0 = v[i].x * rstd * g.x, u1 = v[i].y * rstd * g.y, u2 = v[i].z * rstd * g.z, u3 = v[i].w * rstd * g.w;
      u32x2 pk; pk.x = pack2(u0, u1); pk.y = pack2(u2, u3);
      *(u32x2*)(p.U() + (size_t)row * 1024 + k) = pk;
      const float* wp = wg + k;
      float4 w;
      w = *(const float4*)(wp);            d0 += u0 * w.x + u1 * w.y + u2 * w.z + u3 * w.w;
      w = *(const float4*)(wp + 1024);     d1 += u0 * w.x + u1 * w.y + u2 * w.z + u3 * w.w;
      w = *(const float4*)(wp + 2 * 1024); d2 += u0 * w.x + u1 * w.y + u2 * w.z + u3 * w.w;
      w = *(const float4*)(wp + 3 * 1024); d3 += u0 * w.x + u1 * w.y + u2 * w.z + u3 * w.w;
      w = *(const float4*)(wp + 4 * 1024); d4 += u0 * w.x + u1 * w.y + u2 * w.z + u3 * w.w;
      w = *(const float4*)(wp + 5 * 1024); d5 += u0 * w.x + u1 * w.y + u2 * w.z + u3 * w.w;
      w = *(const float4*)(wp + 6 * 1024); d6 += u0 * w.x + u1 * w.y + u2 * w.z + u3 * w.w;
      w = *(const float4*)(wp + 7 * 1024); d7 += u0 * w.x + u1 * w.y + u2 * w.z + u3 * w.w;
    }
#pragma unroll
    for (int o = 32; o > 0; o >>= 1) {
      d0 += __shfl_xor(d0, o); d1 += __shfl_xor(d1, o); d2 += __shfl_xor(d2, o); d3 += __shfl_xor(d3, o);
      d4 += __shfl_xor(d4, o); d5 += __shfl_xor(d5, o); d6 += __shfl_xor(d6, o); d7 += __shfl_xor(d7, o);
    }
    if (lane < 4) {
      float di = lane == 0 ? d0 : lane == 1 ? d1 : lane == 2 ? d2 : d3;
      float df = lane == 0 ? d4 : lane == 1 ? d5 : lane == 2 ? d6 : d7;
      p.ig()[row * 4 + lane] = di + p.b_i[l * 4 + lane];
      p.lf()[row * 4 + lane] = logsigm(df + p.b_f[l * 4 + lane]);
    }
  }
}

template <typename TA>
__device__ __forceinline__ void gemm_kloop(f32x4 (&acc)[4][4], const TA* Tp, long ldt, const bf16_t* Wp, long ldw, int K, char* smem) {
  bf16_t* sT = (bf16_t*)smem;
  bf16_t* sW = sT + 2 * 9216;
  const int tid = get_tid(), lane = tid & 63, wid = tid >> 6, wr = wid >> 1, wc = wid & 1, fr = lane & 15, fq = lane >> 4;
  u32x4 rt[4], rw[4];
  const int r0 = tid >> 3, c0 = (tid & 7) * 8;
#define GLOAD(k0) _Pragma("unroll") for (int i = 0; i < 4; ++i) { rt[i] = ld8(Tp + (long)(r0 + 32 * i) * ldt + (k0) + c0); rw[i] = ld8(Wp + (long)(r0 + 32 * i) * ldw + (k0) + c0); }
#define SSTORE(buf) _Pragma("unroll") for (int i = 0; i < 4; ++i) { *(u32x4*)(sT + (buf) * 9216 + (r0 + 32 * i) * 72 + c0) = rt[i]; *(u32x4*)(sW + (buf) * 9216 + (r0 + 32 * i) * 72 + c0) = rw[i]; }
  GLOAD(0); SSTORE(0);
  __syncthreads();
  const int nk = K >> 6;
#pragma unroll 1
  for (int kt = 0; kt < nk; ++kt) {
    const int buf = kt & 1;
    if (kt + 1 < nk) { GLOAD((kt + 1) * 64); }
    const bf16_t* aT = sT + buf * 9216 + (wr * 64) * 72;
    const bf16_t* aW = sW + buf * 9216 + (wc * 64) * 72;
    wmma<4, 4, 2>(acc, aW, 72, aT, 72, fr, fq);
    if (kt + 1 < nk) { SSTORE(buf ^ 1); }
    __syncthreads();
  }
#undef GLOAD
#undef SSTORE
}
__device__ __forceinline__ void zero_acc(f32x4 (&acc)[4][4]) {
#pragma unroll
  for (int a = 0; a < 4; ++a)
#pragma unroll
    for (int b = 0; b < 4; ++b) acc[a][b] = (f32x4){0.f, 0.f, 0.f, 0.f};
}


template <int NT, int NSTAGE>
__device__ __forceinline__ void gemm_glds(f32x4 (&acc)[4][NT], const bf16_t* Tp, long ldt, const bf16_t* Wp, long ldw, int K, char* smem) {
  constexpr int TR = 2 * NT * 16, STAGE_B = (TR + 128) * 64, LT = TR / 64, LPS = LT + 2;
  static_assert(NSTAGE * STAGE_B <= SMEM_BYTES, "ring too large");
  static_assert(NSTAGE == 3 || NSTAGE == 4, "waits below are written for 3 or 4 stages");
  const int tid = get_tid(), lane = tid & 63, wid = tid >> 6, wr = wid >> 1, wc = wid & 1, fr = lane & 15, fq = lane >> 4;
  const int lr = tid >> 2, cp = tid & 3, lc = (cp ^ ((lr >> 2) & 3)) * 8;
  const bf16_t* gT = Tp + (long)lr * ldt + lc;
  const int plr = ((lr >> 5) & 1) * 32 + ((lr >> 2) & 3) * 8 + ((lr >> 4) & 1) * 4 + (lr & 3);
  const bf16_t* gW = Wp + (long)plr * ldw + lc;
  const int rd_off = fr * 64 + ((fq ^ ((fr >> 2) & 3)) * 16);
#define GL_ISSUE(kt_, slot_) do { char* sb_ = smem + (slot_) * STAGE_B + tid * 16; \
    _Pragma("unroll") for (int i_ = 0; i_ < LT; ++i_) __builtin_amdgcn_global_load_lds((const unsigned*)(gT + (long)i_ * 64 * ldt + (kt_) * 32), (__attribute__((address_space(3))) unsigned*)(sb_ + i_ * 4096), 16, 0, 0); \
    _Pragma("unroll") for (int i_ = 0; i_ < 2; ++i_) __builtin_amdgcn_global_load_lds((const unsigned*)(gW + (long)i_ * 64 * ldw + (kt_) * 32), (__attribute__((address_space(3))) unsigned*)(sb_ + TR * 64 + i_ * 4096), 16, 0, 0); } while (0)
  asm volatile("s_waitcnt vmcnt(0)" ::: "memory");
  __builtin_amdgcn_s_barrier();
  const int nk = K >> 5;
#pragma unroll
  for (int s_ = 0; s_ < NSTAGE - 1; ++s_) if (s_ < nk) GL_ISSUE(s_, s_);
  int slot = 0, islot = NSTAGE - 1;
#pragma unroll 1
  for (int kt = 0; kt < nk; ++kt) {
    const int rem = nk - 1 - kt;
    if (NSTAGE == 4) {
      if (rem >= 2) asm volatile("s_waitcnt vmcnt(%0)" ::"n"(2 * LPS) : "memory");
      else if (rem == 1) asm volatile("s_waitcnt vmcnt(%0)" ::"n"(LPS) : "memory");
      else asm volatile("s_waitcnt vmcnt(0)" ::: "memory");
    } else {
      if (rem >= 1) asm volatile("s_waitcnt vmcnt(%0)" ::"n"(LPS) : "memory");
      else asm volatile("s_waitcnt vmcnt(0)" ::: "memory");
    }
    __builtin_amdgcn_s_barrier();
    const unsigned aT = (unsigned)(uintptr_t)(smem + slot * STAGE_B + (wr * NT * 16) * 64 + rd_off);
    const unsigned aW = (unsigned)(uintptr_t)(smem + slot * STAGE_B + TR * 64 + (wc * 64) * 64 + rd_off);
    bf16x8 a[4], b[NT];
#pragma unroll
    for (int mi = 0; mi < 4; ++mi) asm volatile("ds_read_b128 %0, %1 offset:%2" : "=v"(a[mi]) : "v"(aW), "n"(mi * 1024));
#pragma unroll
    for (int ni = 0; ni < NT; ++ni) asm volatile("ds_read_b128 %0, %1 offset:%2" : "=v"(b[ni]) : "v"(aT), "n"(ni * 1024));
    if constexpr (NT == 4) asm volatile("s_waitcnt lgkmcnt(0)" : "+v"(a[0]), "+v"(a[1]), "+v"(a[2]), "+v"(a[3]), "+v"(b[0]), "+v"(b[1]), "+v"(b[2]), "+v"(b[3]));
    else asm volatile("s_waitcnt lgkmcnt(0)" : "+v"(a[0]), "+v"(a[1]), "+v"(a[2]), "+v"(a[3]), "+v"(b[0]), "+v"(b[1]), "+v"(b[2]), "+v"(b[3]), "+v"(b[4]), "+v"(b[5]), "+v"(b[6]), "+v"(b[7]));
    const bool doiss = (kt + NSTAGE - 1 < nk);
    const int ktn = kt + NSTAGE - 1;
    char* sbi = smem + islot * STAGE_B + tid * 16;
#pragma unroll
    for (int mi = 0; mi < 4; ++mi) {
#pragma unroll
      for (int ni = 0; ni < NT; ++ni) acc[mi][ni] = __builtin_amdgcn_mfma_f32_16x16x32_bf16(a[mi], b[ni], acc[mi][ni], 0, 0, 0);
      __builtin_amdgcn_sched_barrier(0);
      if (doiss) {
#pragma unroll
        for (int q = 0; q < 2; ++q) {
          const int idx = mi * 2 + q;
          if (idx < LT) __builtin_amdgcn_global_load_lds((const unsigned*)(gT + (long)idx * 64 * ldt + ktn * 32), (__attribute__((address_space(3))) unsigned*)(sbi + idx * 4096), 16, 0, 0);
          else if (idx < LPS) __builtin_amdgcn_global_load_lds((const unsigned*)(gW + (long)(idx - LT) * 64 * ldw + ktn * 32), (__attribute__((address_space(3))) unsigned*)(sbi + TR * 64 + (idx - LT) * 4096), 16, 0, 0);
        }
      }
      __builtin_amdgcn_sched_barrier(0);
    }
    slot = (slot + 1 == NSTAGE) ? 0 : slot + 1;
    islot = (islot + 1 == NSTAGE) ? 0 : islot + 1;
  }
#undef GL_ISSUE
  __syncthreads();
}

__device__ void inproj_tile(const Params& p, int l, int t, char* smem) {
  constexpr int NT = 8;
  const int tm = t / 52, tn = t % 52;
  const int tid = get_tid(), lane = tid & 63, wid = tid >> 6, wr = wid >> 1, wc = wid & 1, fr = lane & 15, fq = lane >> 4;
  f32x4 acc[4][NT];
#pragma unroll
  for (int a_ = 0; a_ < 4; ++a_)
#pragma unroll
    for (int b_ = 0; b_ < NT; ++b_) acc[a_][b_] = (f32x4){0.f, 0.f, 0.f, 0.f};
  gemm_glds<NT, 3>(acc, p.U() + (size_t)tm * (NT * 32) * 1024, 1024, p.wt_in() + (size_t)l * NWT * 1024 + (size_t)tn * 128 * 1024, 1024, 1024, smem);
  const int g = tn >> 2;
  bf16_t* dst = PRG(g);
#pragma unroll
  for (int ni = 0; ni < NT; ++ni) {
    const int row = tm * (NT * 32) + wr * (NT * 16) + ni * 16 + fr;
    const bool samp = row >= NPROMPT;
    const int rr = samp ? row - NPROMPT : row;
    const int b = samp ? (rr >> 6) : (rr >> 13), tt = samp ? (rr & 63) : (rr & 8191), T = samp ? 64 : 8192, NB = samp ? 8 : 2;
#pragma unroll
    for (int m = 0; m < 2; ++m) {
      const int cg_ = (tn & 3) * 128 + wc * 64 + m * 32 + fq * 8;
      const f32x4 v0 = acc[2 * m][ni], v1 = acc[2 * m + 1][ni];
      u32x4 pk; pk.x = pack2(v0[0], v0[1]); pk.y = pack2(v0[2], v0[3]); pk.z = pack2(v1[0], v1[1]); pk.w = pack2(v1[2], v1[3]);
      *(u32x4*)(dst + (size_t)row * 512 + cg_) = pk;
      if (g == 6 || g == 7) {
        float* o = (g == 6) ? (samp ? p.o_sk() : p.o_pk()) : (samp ? p.o_sv() : p.o_pv());
        const int hh = cg_ >> 7, d = cg_ & 127;
        float* op = o + ((size_t)((l * NB + b) * 4 + hh) * T + tt) * 128 + d;
        *(f32x4*)op = v0; *(f32x4*)(op + 4) = v1;
      } else if (g < 2) {
        if (tt >= T - 3) {
          float* o = samp ? p.o_sconv() : p.o_pconv();
          float* op = o + ((size_t)(l * NB + b) * 3 + (tt - (T - 3))) * 1024 + g * 512 + cg_;
          *(f32x4*)op = v0; *(f32x4*)(op + 4) = v1;
        }
      }
    }
  }
}

struct UnitInfo { int samp, b, h, c, rowbase, seq; };
__device__ __forceinline__ UnitInfo unit_info(int u) {
  UnitInfo i;
  if (u < 1024) { i.samp = 0; i.seq = u >> 7; i.b = i.seq >> 2; i.h = i.seq & 3; i.c = u & 127; i.rowbase = i.b * 8192 + i.c * 64; }
  else { int sq = u - 1024; i.samp = 1; i.seq = sq; i.b = sq >> 2; i.h = sq & 3; i.c = 0; i.rowbase = NPROMPT + i.b * 64; }
  return i;
}

__device__ void sb_unit(const Params& p, int l, int u, char* smem) {
  bf16_t* Qs = (bf16_t*)smem;
  bf16_t* Ks = Qs + 64 * 136;
  bf16_t* Vt = Ks + 64 * 136;
  bf16_t* Ps = Vt + 128 * 72;
  const int tid = get_tid(), lane = tid & 63, w = tid >> 6, fr = lane & 15, fq = lane >> 4;
  const UnitInfo ui = unit_info(u);
  const int nblk = ui.samp ? 65 : ui.c + 1;
  const int hc = ui.h * 128;
  __syncthreads();
  ld_tile<bf16_t>(Qs, PRG(5) + (size_t)ui.rowbase * 512 + hc, 512, tid);
  f32x4 o[8][1];
#pragma unroll
  for (int mi = 0; mi < 8; ++mi) o[mi][0] = (f32x4){0.f, 0.f, 0.f, 0.f};
  float R = 0.f;
  const int tq = 16 * w + fr;
  for (int i = nblk - 1; i >= 0; --i) {
    if (!ui.samp || i == 64) {
      const size_t krow = ui.samp ? (size_t)ui.rowbase : (size_t)ui.b * 8192 + (size_t)i * 64;
      ld_tile<bf16_t>(Ks, PRG(6) + krow * 512 + hc, 512, tid);
      ld_T<bf16_t, 64, 72>(Vt, PRG(7) + krow * 512 + hc, 512, tid);
    } else {
      const size_t off = ((size_t)((l * 8 + ui.b) * 4 + ui.h) * 4096 + (size_t)i * 64) * 128;
      ld_tile<float>(Ks, p.ck + off, 128, tid);
      ld_T<float, 64, 72>(Vt, p.cv + off, 128, tid);
    }
    __syncthreads();
    f32x4 z[4][1];
#pragma unroll
    for (int mi = 0; mi < 4; ++mi) z[mi][0] = (f32x4){0.f, 0.f, 0.f, 0.f};
    wmma<4, 1, 4>(z, Ks, 136, Qs + 16 * w * 136, 136, fr, fq);
    const bool diag = (i == nblk - 1);
    float L[4][4], lsg[4][4], G[4];
#pragma unroll
    for (int mi = 0; mi < 4; ++mi) {
      G[mi] = 0.f;
#pragma unroll
      for (int j = 0; j < 4; ++j) {
        const int kk = mi * 16 + fq * 4 + j;
        const float zz = z[mi][0][j] * 0.08838834764831845f;
        const float sp = softplus(zz);
        const bool valid = !diag || kk < tq;
        L[mi][j] = valid ? -sp : 0.f;
        lsg[mi][j] = valid ? zz - sp : -1e30f;
        G[mi] += L[mi][j];
      }
    }
    float sufm = 0.f;
#pragma unroll
    for (int mi = 3; mi >= 0; --mi) {
      const float g0 = __shfl(G[mi], fr), g1 = __shfl(G[mi], fr + 16), g2 = __shfl(G[mi], fr + 32), g3 = __shfl(G[mi], fr + 48);
      const float later = (fq < 1 ? g1 : 0.f) + (fq < 2 ? g2 : 0.f) + (fq < 3 ? g3 : 0.f);
      const float s3 = R + sufm + later, s2 = s3 + L[mi][3], s1 = s2 + L[mi][2], s0 = s1 + L[mi][1];
      const float a0 = __expf(lsg[mi][0] + s0), a1 = __expf(lsg[mi][1] + s1), a2 = __expf(lsg[mi][2] + s2), a3 = __expf(lsg[mi][3] + s3);
      u32x2 pk; pk.x = pack2(a0, a1); pk.y = pack2(a2, a3);
      *(u32x2*)(Ps + tq * 72 + mi * 16 + fq * 4) = pk;
      sufm += (g0 + g1) + (g2 + g3);
    }
    R += sufm;
    __syncthreads();
    wmma<8, 1, 2>(o, Vt, 72, Ps + 16 * w * 72, 72, fr, fq);
    if (__syncthreads_and(R < -110.f)) break;
  }
  const size_t row = (size_t)ui.rowbase + tq;
#pragma unroll
  for (int mi = 0; mi < 8; ++mi) {
    const int col = hc + mi * 16 + fq * 4;
    u32x2 zz = *(const u32x2*)(PRG(8) + row * 512 + col);
    f32x4 v = o[mi][0];
    u32x2 pk;
    pk.x = pack2(v[0] * silu(lo2f(zz.x)), v[1] * silu(hi2f(zz.x)));
    pk.y = pack2(v[2] * silu(lo2f(zz.y)), v[3] * silu(hi2f(zz.y)));
    *(u32x2*)(p.H() + (size_t)1 * NTOK * 512 + row * 512 + col) = pk;
  }
}

__device__ void mlstm_local(const Params& p, int l, int u, char* smem) {
  bf16_t* kdT = (bf16_t*)smem;
  bf16_t* vT = kdT + 128 * 72;
  bf16_t* xq = vT + 128 * 72;
  bf16_t* xk = xq + 67 * 136;
  float* dec = (float*)(xk + 67 * 136);
  const int tid = get_tid(), lane = tid & 63, w = tid >> 6, fr = lane & 15, fq = lane >> 4;
  const UnitInfo ui = unit_info(u);
  const int hc = ui.h * 128;
  __syncthreads();
  if (w == 0) {
    const float lfv = p.lf()[(ui.rowbase + lane) * 4 + ui.h], igv = p.ig()[(ui.rowbase + lane) * 4 + ui.h];
    float bs = lfv;
#pragma unroll
    for (int o = 1; o < 64; o <<= 1) { float t = __shfl_up(bs, o); if (lane >= o) bs += t; }
    const float g = igv - bs;
    float gm = g;
#pragma unroll
    for (int o = 32; o > 0; o >>= 1) gm = fmaxf(gm, __shfl_xor(gm, o));
    const float bL = __shfl(bs, 63);
    dec[lane] = __expf(g - gm);
    if (lane == 0) { p.ac()[u] = bL + gm; p.Bc()[u] = bL; }
  }
  ld_tile<bf16_t>(xq + 3 * 136, PRG(0) + (size_t)ui.rowbase * 512 + hc, 512, tid);
  ld_tile<bf16_t>(xk + 3 * 136, PRG(1) + (size_t)ui.rowbase * 512 + hc, 512, tid);
  ld_T<bf16_t, 64, 72>(vT, PRG(2) + (size_t)ui.rowbase * 512 + hc, 512, tid);
  {
    const int isk = tid >> 7, ch = tid & 127, col = hc + ch;
    bf16_t* xs = isk ? xk : xq;
    if (ui.samp) {
      const float* cs = p.st_conv + (size_t)(l * 8 + ui.b) * 3072 + isk * 512 + col;
      xs[ch] = f2bf(cs[0]); xs[136 + ch] = f2bf(cs[1024]); xs[272 + ch] = f2bf(cs[2048]);
    } else if (ui.c > 0) {
      const bf16_t* src = PRG(isk) + (size_t)ui.rowbase * 512 + col;
      xs[ch] = src[-3 * 512]; xs[136 + ch] = src[-2 * 512]; xs[272 + ch] = src[-1 * 512];
    } else { xs[ch] = 0; xs[136 + ch] = 0; xs[272 + ch] = 0; }
  }
  __syncthreads();
  {
    const int isk = tid >> 7, ch = tid & 127, col = hc + ch;
    bf16_t* xs = isk ? xk : xq;
    const float* wc_ = p.w_conv + (size_t)l * 4096 + isk * 512 + col;
    const float w0 = wc_[0], w1 = wc_[1024], w2 = wc_[2048], w3 = wc_[3072];
    float x0 = bf2f(xs[ch]), x1 = bf2f(xs[136 + ch]), x2 = bf2f(xs[272 + ch]);
#pragma unroll 8
    for (int t = 0; t < 64; ++t) {
      const float x3 = bf2f(xs[(t + 3) * 136 + ch]);
      float y = silu(w0 * x0 + w1 * x1 + w2 * x2 + w3 * x3);
      if (isk) y *= 0.08838834764831845f;
      const bf16_t yb = f2bf(y);
      xs[t * 136 + ch] = yb;
      if (isk) kdT[ch * 72 + t] = f2bf(bf2f(yb) * dec[t]);
      x0 = x1; x1 = x2; x2 = x3;
    }
  }
  __syncthreads();
#pragma unroll
  for (int i = 0; i < 4; ++i) {
    const int id = tid + 256 * i, r = id >> 4, c = (id & 15) * 8;
    *(u32x4*)(p.QC() + (size_t)(ui.rowbase + r) * 512 + hc + c) = *(const u32x4*)(xq + r * 136 + c);
    *(u32x4*)(p.KC() + (size_t)(ui.rowbase + r) * 512 + hc + c) = *(const u32x4*)(xk + r * 136 + c);
  }
  if (tid < 128) { float s_ = 0.f;
#pragma unroll 8
    for (int t = 0; t < 64; ++t) s_ += bf2f(kdT[tid * 72 + t]); p.nloc()[u * 128 + tid] = s_; }
  f32x4 acc[8][2];
#pragma unroll
  for (int a_ = 0; a_ < 8; ++a_) { acc[a_][0] = (f32x4){0.f, 0.f, 0.f, 0.f}; acc[a_][1] = (f32x4){0.f, 0.f, 0.f, 0.f}; }
  wmma<8, 2, 2>(acc, kdT, 72, vT + 32 * w * 72, 72, fr, fq);
  bf16_t* sm = p.SM() + (size_t)u * 16384;
#pragma unroll
  for (int mi = 0; mi < 8; ++mi)
#pragma unroll
    for (int ni = 0; ni < 2; ++ni) {
      u32x2 pk; pk.x = pack2(acc[mi][ni][0], acc[mi][ni][1]); pk.y = pack2(acc[mi][ni][2], acc[mi][ni][3]);
      *(u32x2*)(sm + (32 * w + ni * 16 + fr) * 128 + mi * 16 + fq * 4) = pk;
    }
}

__device__ __forceinline__ float hgrn_lb(const Params& p, int l, int ch512) {
  if (l == 0) return 0.f;
  return sigm(p.lb_logits[512 + ch512] - p.lb_logits[ch512]);
}
__device__ __forceinline__ void hgrn_gate(float f, float lb, float& lg, float& kh) {
  const float e = __expf(-fabsf(f));
  const float sp = f >= 0.f ? 1.f / (1.f + e) : e / (1.f + e);
  const float sn = f >= 0.f ? e / (1.f + e) : 1.f / (1.f + e);
  lg = (lb == 0.f) ? (fminf(f, 0.f) - __logf(1.f + e)) : __logf(lb + (1.f - lb) * sp);
  kh = (1.f - lb) * sn;
}

__device__ void hgrn_local(const Params& p, int l, int u, char* smem) {
  bf16_t* kdT = (bf16_t*)smem;
  bf16_t* iT = kdT + 128 * 72;
  bf16_t* fs = iT + 128 * 72;
  float* tot = (float*)(fs + 64 * 136);
  const int tid = get_tid(), lane = tid & 63, w = tid >> 6, fr = lane & 15, fq = lane >> 4;
  const UnitInfo ui = unit_info(u);
  const int hc = ui.h * 128;
  __syncthreads();
  ld_tile<bf16_t>(fs, PRG(10) + (size_t)ui.rowbase * 512 + hc, 512, tid);
  ld_T<bf16_t, 64, 72>(iT, PRG(11) + (size_t)ui.rowbase * 512 + hc, 512, tid);
  const int half = tid >> 7, ch = tid & 127;
  const float lb = hgrn_lb(p, l, hc + ch);
  __syncthreads();
  const bf16_t* src = fs + (half * 32) * 136 + ch;
  {
    float run = 0.f;
#pragma unroll 8
    for (int t = 0; t < 32; ++t) { float lg, kh; hgrn_gate(bf2f(src[t * 136]), lb, lg, kh); run += lg; }
    tot[half * 128 + ch] = run;
  }
  __syncthreads();
  {
    const float t0 = tot[ch], t1 = tot[128 + ch];
    const float bcL = t0 + t1;
    float run = half ? t0 : 0.f;
#pragma unroll 8
    for (int t = 0; t < 32; ++t) {
      float lg, kh; hgrn_gate(bf2f(src[t * 136]), lb, lg, kh); run += lg;
      kdT[ch * 72 + half * 32 + t] = f2bf(kh * __expf(bcL - run));
    }
    if (half == 0) p.hbc()[u * 128 + ch] = bcL;
  }
  __syncthreads();
  f32x4 acc[8][2];
#pragma unroll
  for (int a_ = 0; a_ < 8; ++a_) { acc[a_][0] = (f32x4){0.f, 0.f, 0.f, 0.f}; acc[a_][1] = (f32x4){0.f, 0.f, 0.f, 0.f}; }
  wmma<8, 2, 2>(acc, kdT, 72, iT + 32 * w * 72, 72, fr, fq);
  bf16_t* sh = p.SH() + (size_t)u * 16384;
#pragma unroll
  for (int mi = 0; mi < 8; ++mi)
#pragma unroll
    for (int ni = 0; ni < 2; ++ni) {
      u32x2 pk; pk.x = pack2(acc[mi][ni][0], acc[mi][ni][1]); pk.y = pack2(acc[mi][ni][2], acc[mi][ni][3]);
      *(u32x2*)(sh + (32 * w + ni * 16 + fr) * 128 + mi * 16 + fq * 4) = pk;
    }
}

__device__ void scan_phase(const Params& p, int l, char* smem) {
  float* cdc = (float*)smem;
  float* cwl = cdc + 128;
  float* cmi = cwl + 128;
  const int tid = get_tid();
  for (int vb = blockIdx.x; vb < 520; vb += gridDim.x) {
    const int kind = vb >> 8;
    const int seq = (kind == 2) ? (vb - 512) : ((vb >> 5) & 7);
    __syncthreads();
    if (kind != 1) {
      if (tid < 128) { cdc[tid] = p.ac()[seq * 128 + tid]; cwl[tid] = p.Bc()[seq * 128 + tid]; }
      __syncthreads();
      if (tid == 0) {
        float m = 0.f;
        for (int c = 0; c < 128; ++c) {
          const float a = cdc[c], B = cwl[c];
          const float mo = fmaxf(a, B + m);
          cdc[c] = __expf(B + m - mo); cwl[c] = __expf(a - mo); cmi[c] = m; m = mo;
        }
        if (kind == 0 && (vb & 31) == 0) p.o_pm()[l * 8 + seq] = m;
      }
      __syncthreads();
      if (kind == 0 && (vb & 31) == 0 && tid < 128) p.min_()[seq * 128 + tid] = cmi[tid];
    }
    if (kind == 2) {
      if (tid < 128) {
        float n = 0.f;
        float* base = p.nloc() + (size_t)seq * 128 * 128 + tid;
        for (int c0 = 0; c0 < 128; c0 += 16) {
          float lv[16];
#pragma unroll
          for (int j = 0; j < 16; ++j) lv[j] = base[(c0 + j) * 128];
#pragma unroll
          for (int j = 0; j < 16; ++j) { const float nl = lv[j]; lv[j] = n; n = cdc[c0 + j] * n + cwl[c0 + j] * nl; }
#pragma unroll
          for (int j = 0; j < 16; ++j) base[(c0 + j) * 128] = lv[j];
        }
        p.o_pn()[(l * 8 + seq) * 128 + tid] = n;
      }
      continue;
    }
    const int pr = (vb & 31) * 256 + tid, e = pr * 2, er = e >> 7, ec = e & 127;
    unsigned* base = (unsigned*)((kind ? p.SH() : p.SM()) + (size_t)seq * 128 * 16384) + pr;
    const float* hb = p.hbc() + (size_t)seq * 128 * 128 + ec;
    float c0v = 0.f, c1v = 0.f;
    unsigned lv[16], nx[16];
    float2 hv[16], hn[16];
#pragma unroll
    for (int j = 0; j < 16; ++j) { nx[j] = base[(size_t)j * 8192]; hn[j] = kind ? *(const float2*)(hb + j * 128) : make_float2(0.f, 0.f); }
    for (int c0 = 0; c0 < 128; c0 += 16) {
#pragma unroll
      for (int j = 0; j < 16; ++j) { lv[j] = nx[j]; hv[j] = hn[j]; }
      if (c0 + 16 < 128) {
#pragma unroll
        for (int j = 0; j < 16; ++j) { nx[j] = base[(size_t)(c0 + 16 + j) * 8192]; if (kind) hn[j] = *(const float2*)(hb + (c0 + 16 + j) * 128); }
      }
#pragma unroll
      for (int j = 0; j < 16; ++j) {
        const unsigned v = lv[j];
        lv[j] = pack2(c0v, c1v);
        const float d0 = kind ? __expf(hv[j].x) : cdc[c0 + j];
        const float d1 = kind ? __expf(hv[j].y) : d0;
        const float wl = kind ? 1.f : cwl[c0 + j];
        c0v = d0 * c0v + wl * lo2f(v); c1v = d1 * c1v + wl * hi2f(v);
      }
#pragma unroll
      for (int j = 0; j < 16; ++j) base[(size_t)(c0 + j) * 8192] = lv[j];
    }
    float* o = (kind ? p.o_pS() : p.o_pC()) + (size_t)(l * 8 + seq) * 16384;
    o[ec * 128 + er] = c0v; o[(ec + 1) * 128 + er] = c1v;
  }
  const int gt = blockIdx.x * 256 + tid, nth = gridDim.x * 256;
  for (int it = gt; it < 524288; it += nth) {
    const int kind = it >> 18, sq = (it >> 13) & 31, pr = it & 8191, e = pr * 2, u = 1024 + sq, er = e >> 7, ec = e & 127;
    if (kind == 0) {
      const float* c0p = p.st_C + (size_t)(l * 32 + sq) * 16384;
      const float C0 = c0p[ec * 128 + er], C1 = c0p[(ec + 1) * 128 + er], m = p.st_m[l * 32 + sq];
      unsigned* slot = (unsigned*)(p.SM() + (size_t)u * 16384) + pr;
      const unsigned lv = *slot;
      const float a = p.ac()[u], B = p.Bc()[u];
      const float mo = fmaxf(a, B + m), dc = __expf(B + m - mo), wl = __expf(a - mo);
      *slot = pack2(C0, C1);
      float* o = p.o_sC() + (size_t)(l * 32 + sq) * 16384;
      o[ec * 128 + er] = dc * C0 + wl * lo2f(lv); o[(ec + 1) * 128 + er] = dc * C1 + wl * hi2f(lv);
      if (pr == 0) { p.min_()[u] = m; p.o_sm()[l * 32 + sq] = mo; }
    } else {
      const float* s0p = p.st_S + (size_t)(l * 32 + sq) * 16384;
      const float S0 = s0p[ec * 128 + er], S1 = s0p[(ec + 1) * 128 + er];
      unsigned* slot = (unsigned*)(p.SH() + (size_t)u * 16384) + pr;
      const unsigned lv = *slot;
      const float d0 = __expf(p.hbc()[u * 128 + ec]), d1 = __expf(p.hbc()[u * 128 + ec + 1]);
      *slot = pack2(S0, S1);
      float* o = p.o_sS() + (size_t)(l * 32 + sq) * 16384;
      o[ec * 128 + er] = d0 * S0 + lo2f(lv); o[(ec + 1) * 128 + er] = d1 * S1 + hi2f(lv);
    }
  }
  for (int it = gt; it < 4096; it += nth) {
    const int sq = it >> 7, d = it & 127, u = 1024 + sq;
    const float n0 = p.st_n[(l * 32 + sq) * 128 + d], m = p.st_m[l * 32 + sq];
    const float a = p.ac()[u], B = p.Bc()[u];
    const float mo = fmaxf(a, B + m), dc = __expf(B + m - mo), wl = __expf(a - mo);
    const float nl = p.nloc()[u * 128 + d];
    p.nloc()[u * 128 + d] = n0;
    p.o_sn()[(l * 32 + sq) * 128 + d] = dc * n0 + wl * nl;
  }
}

__device__ void mlstm_out(const Params& p, int l, int u, char* smem) {
  bf16_t* Qs = (bf16_t*)smem;
  bf16_t* CT = Qs + 64 * 136;
  bf16_t* Ks = CT;
  bf16_t* Vt = Ks + 64 * 136;
  bf16_t* Ps = Vt + 144 * 72;
  float* misc = (float*)(smem + 17408 + 47360);
  float *bsum = misc, *gs = misc + 64, *mt = misc + 128, *wint = misc + 192;
  const int tid = get_tid(), lane = tid & 63, w = tid >> 6, fr = lane & 15, fq = lane >> 4;
  const UnitInfo ui = unit_info(u);
  const int hc = ui.h * 128;
  __syncthreads();
  if (w == 0) {
    const float lfv = p.lf()[(ui.rowbase + lane) * 4 + ui.h], igv = p.ig()[(ui.rowbase + lane) * 4 + ui.h];
    float bs = lfv;
#pragma unroll
    for (int o = 1; o < 64; o <<= 1) { float t = __shfl_up(bs, o); if (lane >= o) bs += t; }
    const float g = igv - bs;
    float cm = g;
#pragma unroll
    for (int o = 1; o < 64; o <<= 1) { float t = __shfl_up(cm, o); if (lane >= o) cm = fmaxf(cm, t); }
    const float m_in = p.min_()[u];
    const float mtt = bs + fmaxf(cm, m_in);
    bsum[lane] = bs; gs[lane] = g; mt[lane] = mtt; wint[lane] = __expf(bs + m_in - mtt);
  }
  ld_tile<bf16_t>(Qs, p.QC() + (size_t)ui.rowbase * 512 + hc, 512, tid);
  ld_tile128<bf16_t>(CT, p.SM() + (size_t)u * 16384, 128, tid);
  if (tid < 128) CT[128 * 136 + tid] = f2bf(p.nloc()[u * 128 + tid]);
  for (int i = tid; i < 15 * 128; i += 256) CT[(129 + (i >> 7)) * 136 + (i & 127)] = 0;
  __syncthreads();
  f32x4 acc[9][1];
#pragma unroll
  for (int mi = 0; mi < 9; ++mi) acc[mi][0] = (f32x4){0.f, 0.f, 0.f, 0.f};
  wmma<9, 1, 4>(acc, CT, 136, Qs + 16 * w * 136, 136, fr, fq);
  const int t = 16 * w + fr;
  const float wi = wint[t];
#pragma unroll
  for (int mi = 0; mi < 9; ++mi) acc[mi][0] *= wi;
  __syncthreads();
  ld_tile<bf16_t>(Ks, p.KC() + (size_t)ui.rowbase * 512 + hc, 512, tid);
  ld_T<bf16_t, 64, 72>(Vt, PRG(2) + (size_t)ui.rowbase * 512 + hc, 512, tid);
  if (tid < 64) Vt[128 * 72 + tid] = 0x3F80;
  for (int i = tid; i < 15 * 64; i += 256) Vt[(129 + (i >> 6)) * 72 + (i & 63)] = 0;
  __syncthreads();
  f32x4 st[4][1];
#pragma unroll
  for (int mi = 0; mi < 4; ++mi) st[mi][0] = (f32x4){0.f, 0.f, 0.f, 0.f};
  wmma<4, 1, 4>(st, Ks, 136, Qs + 16 * w * 136, 136, fr, fq);
  const float bt = bsum[t], mtt = mt[t];
#pragma unroll
  for (int mi = 0; mi < 4; ++mi) {
    float a[4];
#pragma unroll
    for (int j = 0; j < 4; ++j) {
      const int s = mi * 16 + fq * 4 + j;
      a[j] = (s <= t) ? st[mi][0][j] * __expf(bt + gs[s] - mtt) : 0.f;
    }
    u32x2 pk; pk.x = pack2(a[0], a[1]); pk.y = pack2(a[2], a[3]);
    *(u32x2*)(Ps + t * 72 + mi * 16 + fq * 4) = pk;
  }
  __syncthreads();
  wmma<9, 1, 2>(acc, Vt, 72, Ps + 16 * w * 72, 72, fr, fq);
  const float den = __shfl(acc[8][0][0], fr);
  const float inv = 1.f / fmaxf(fabsf(den), __expf(-mtt));
  float ss = 0.f;
#pragma unroll
  for (int mi = 0; mi < 8; ++mi) { acc[mi][0] *= inv; ss += acc[mi][0][0] * acc[mi][0][0] + acc[mi][0][1] * acc[mi][0][1] + acc[mi][0][2] * acc[mi][0][2] + acc[mi][0][3] * acc[mi][0][3]; }
  ss += __shfl_xor(ss, 16); ss += __shfl_xor(ss, 32);
  const float rs = rsqrtf(ss * (1.f / 128.f) + 1e-6f);
  const size_t row = (size_t)ui.rowbase + t;
#pragma unroll
  for (int mi = 0; mi < 8; ++mi) {
    const int col = hc + mi * 16 + fq * 4;
    const u32x2 ov = *(const u32x2*)(PRG(3) + row * 512 + col);
    const u32x2 zv = *(const u32x2*)(PRG(4) + row * 512 + col);
    const float4 g = *(const float4*)(p.g_ml + l * 512 + col);
    const f32x4 v = acc[mi][0];
    u32x2 pk;
    pk.x = pack2(v[0] * rs * g.x * sigm(lo2f(ov.x)) * silu(lo2f(zv.x)), v[1] * rs * g.y * sigm(hi2f(ov.x)) * silu(hi2f(zv.x)));
    pk.y = pack2(v[2] * rs * g.z * sigm(lo2f(ov.y)) * silu(lo2f(zv.y)), v[3] * rs * g.w * sigm(hi2f(ov.y)) * silu(hi2f(zv.y)));
    *(u32x2*)(p.H() + row * 512 + col) = pk;
  }
}

__device__ __forceinline__ bf16x8 scale_frag(const bf16_t* src, const float* ea, const float* eb, float sgn, bool clampit) {
  u32x4 raw = *(const u32x4*)src;
  float4 a0 = *(const float4*)ea, a1 = *(const float4*)(ea + 4);
  float4 b0 = {0.f, 0.f, 0.f, 0.f}, b1 = {0.f, 0.f, 0.f, 0.f};
  if (eb) { b0 = *(const float4*)eb; b1 = *(const float4*)(eb + 4); }
  float e[8] = {a0.x - b0.x, a0.y - b0.y, a0.z - b0.z, a0.w - b0.w, a1.x - b1.x, a1.y - b1.y, a1.z - b1.z, a1.w - b1.w};
  float v[8] = {lo2f(raw.x), hi2f(raw.x), lo2f(raw.y), hi2f(raw.y), lo2f(raw.z), hi2f(raw.z), lo2f(raw.w), hi2f(raw.w)};
  unsigned o[4];
#pragma unroll
  for (int i = 0; i < 4; ++i) {
    float x0 = sgn * e[2 * i], x1 = sgn * e[2 * i + 1];
    if (clampit) { x0 = fminf(x0, 80.f); x1 = fminf(x1, 80.f); }
    o[i] = pack2(v[2 * i] * __expf(x0), v[2 * i + 1] * __expf(x1));
  }
  u32x4 r = {o[0], o[1], o[2], o[3]};
  return __builtin_bit_cast(bf16x8, r);
}

__device__ void hgrn_out(const Params& p, int l, int u, char* smem) {
  float* bc = (float*)smem;
  bf16_t* ST = (bf16_t*)smem;
  bf16_t* qs = (bf16_t*)(smem + 34816);
  bf16_t* kh = (bf16_t*)(smem + 34816 + 17408);
  bf16_t* iT = kh;
  bf16_t* Ps = (bf16_t*)(smem + 34816 + 17408 + 18432);
  float* tot = (float*)(smem + 79872);
  const int tid = get_tid(), lane = tid & 63, w = tid >> 6, fr = lane & 15, fq = lane >> 4;
  const UnitInfo ui = unit_info(u);
  const int hc = ui.h * 128;
  __syncthreads();
  ld_tile<bf16_t>(qs, PRG(9) + (size_t)ui.rowbase * 512 + hc, 512, tid);
  ld_tile<bf16_t>(kh, PRG(10) + (size_t)ui.rowbase * 512 + hc, 512, tid);
  __syncthreads();
  {
    const int half = tid >> 7, ch = tid & 127;
    const float lb = hgrn_lb(p, l, hc + ch);
    bf16_t* src = kh + (half * 32) * 136 + ch;
    float run = 0.f;
#pragma unroll 8
    for (int t = 0; t < 32; ++t) { float lg, k; hgrn_gate(bf2f(src[t * 136]), lb, lg, k); run += lg; }
    tot[half * 128 + ch] = run;
    __syncthreads();
    run = half ? tot[ch] : 0.f;
#pragma unroll 8
    for (int t = 0; t < 32; ++t) {
      float lg, k; hgrn_gate(bf2f(src[t * 136]), lb, lg, k); run += lg;
      bc[(half * 32 + t) * 132 + ch] = run;
      src[t * 136] = f2bf(k);
    }
  }
  __syncthreads();
  {
    const int I = w, t = 16 * I + fr;
    f32x4 a[4];
#pragma unroll
    for (int J = 0; J < 4; ++J) a[J] = (f32x4){0.f, 0.f, 0.f, 0.f};
#pragma unroll
    for (int kk = 0; kk < 4; ++kk) {
      const int c0 = kk * 32 + fq * 8;
      const float* rI = (I > 0) ? bc + (16 * I - 1) * 132 + c0 : nullptr;
      const bf16x8 bq = scale_frag(qs + t * 136 + c0, bc + t * 132 + c0, rI, 1.f, false);
#pragma unroll
      for (int J = 0; J < 4; ++J) {
        if (J <= I) {
          const int s = 16 * J + fr;
          const bf16x8 ak = scale_frag(kh + s * 136 + c0, bc + s * 132 + c0, rI, -1.f, true);
          a[J] = __builtin_amdgcn_mfma_f32_16x16x32_bf16(ak, bq, a[J], 0, 0, 0);
        }
      }
    }
#pragma unroll
    for (int J = 0; J < 4; ++J) {
      float v[4];
#pragma unroll
      for (int j = 0; j < 4; ++j) { const int s = 16 * J + fq * 4 + j; v[j] = (s <= t) ? a[J][j] : 0.f; }
      u32x2 pk; pk.x = pack2(v[0], v[1]); pk.y = pack2(v[2], v[3]);
      *(u32x2*)(Ps + t * 72 + J * 16 + fq * 4) = pk;
    }
  }
  __syncthreads();
#pragma unroll 4
  for (int i = tid; i < 64 * 128; i += 256) { const int t = i >> 7, c = i & 127; qs[t * 136 + c] = f2bf(bf2f(qs[t * 136 + c]) * __expf(bc[t * 132 + c])); }
  __syncthreads();
  ld_T<bf16_t, 64, 72>(iT, PRG(11) + (size_t)ui.rowbase * 512 + hc, 512, tid);
  ld_tile128<bf16_t>(ST, p.SH() + (size_t)u * 16384, 128, tid);
  __syncthreads();
  f32x4 acc[8][1];
#pragma unroll
  for (int mi = 0; mi < 8; ++mi) acc[mi][0] = (f32x4){0.f, 0.f, 0.f, 0.f};
  wmma<8, 1, 2>(acc, iT, 72, Ps + 16 * w * 72, 72, fr, fq);
  wmma<8, 1, 4>(acc, ST, 136, qs + 16 * w * 136, 136, fr, fq);
  float ss = 0.f;
#pragma unroll
  for (int mi = 0; mi < 8; ++mi) ss += acc[mi][0][0] * acc[mi][0][0] + acc[mi][0][1] * acc[mi][0][1] + acc[mi][0][2] * acc[mi][0][2] + acc[mi][0][3] * acc[mi][0][3];
  ss += __shfl_xor(ss, 16); ss += __shfl_xor(ss, 32);
  const float rs = rsqrtf(ss * (1.f / 128.f) + 1e-6f);
  const size_t row = (size_t)ui.rowbase + 16 * w + fr;
#pragma unroll
  for (int mi = 0; mi < 8; ++mi) {
    const int col = hc + mi * 16 + fq * 4;
    const u32x2 zv = *(const u32x2*)(PRG(12) + row * 512 + col);
    const float4 g = *(const float4*)(p.g_hg + l * 512 + col);
    const f32x4 v = acc[mi][0];
    u32x2 pk;
    pk.x = pack2(v[0] * rs * g.x * silu(lo2f(zv.x)), v[1] * rs * g.y * silu(hi2f(zv.x)));
    pk.y = pack2(v[2] * rs * g.z * silu(lo2f(zv.y)), v[3] * rs * g.w * silu(hi2f(zv.y)));
    *(u32x2*)(p.H() + (size_t)2 * NTOK * 512 + row * 512 + col) = pk;
  }
}

__device__ void merge_tile(const Params& p, int l, int t, char* smem) {
  const int tm = t >> 3, tn = t & 7;
  const int tid = get_tid(), lane = tid & 63, wid = tid >> 6, wr = wid >> 1, wc = wid & 1, fr = lane & 15, fq = lane >> 4;
#pragma unroll 1
  for (int b = 0; b < 3; ++b) {
    f32x4 acc[4][4]; zero_acc(acc);
    gemm_kloop<bf16_t>(acc, p.U() + (size_t)tm * 128 * 1024, 1024, p.wt_in() + (size_t)l * NWT * 1024 + (size_t)(NMAIN + b * 1024 + tn * 128) * 1024, 1024, 1024, smem);
#pragma unroll
    for (int ni = 0; ni < 4; ++ni)
#pragma unroll
      for (int mi = 0; mi < 4; ++mi) {
        f32x4 v; v[0] = sigm(acc[mi][ni][0]); v[1] = sigm(acc[mi][ni][1]); v[2] = sigm(acc[mi][ni][2]); v[3] = sigm(acc[mi][ni][3]);
        *(f32x4*)(p.r() + ((size_t)tm * 128 + wr * 64 + ni * 16 + fr) * 1024 + tn * 128 + wc * 64 + mi * 16 + fq * 4) = v;
      }
    zero_acc(acc);
    gemm_kloop<bf16_t>(acc, p.H() + (size_t)b * NTOK * 512 + (size_t)tm * 128 * 512, 512, p.wt_br() + (size_t)(l * 3 + b) * 1024 * 512 + (size_t)tn * 128 * 512, 512, 512, smem);
#pragma unroll
    for (int ni = 0; ni < 4; ++ni) {
      const size_t row = (size_t)tm * 128 + wr * 64 + ni * 16 + fr;
#pragma unroll
      for (int mi = 0; mi < 4; ++mi) {
        const int col = tn * 128 + wc * 64 + mi * 16 + fq * 4;
        f32x4 v = *(const f32x4*)(p.r() + row * 1024 + col) * acc[mi][ni];
        float* part = p.y() + row * 1024 + col;
        if (b > 0) v += *(const f32x4*)part;
        if (b < 2) *(f32x4*)part = v;
        else { u32x2 pk; pk.x = pack2(v[0], v[1]); pk.y = pack2(v[2], v[3]); *(u32x2*)(p.merged() + row * 1024 + col) = pk; }
      }
    }
  }
}

__device__ void outproj_tile(const Params& p, int l, int t, char* smem) {
  const int tm = t >> 3, tn = t & 7;
  const int tid = get_tid(), lane = tid & 63, wid = tid >> 6, wr = wid >> 1, wc = wid & 1, fr = lane & 15, fq = lane >> 4;
  f32x4 acc[4][4]; zero_acc(acc);
  gemm_kloop<bf16_t>(acc, p.merged() + (size_t)tm * 128 * 1024, 1024, p.wt_out() + (size_t)l * 1048576 + (size_t)tn * 128 * 1024, 1024, 1024, smem);
#pragma unroll
  for (int ni = 0; ni < 4; ++ni) {
    const size_t row = (size_t)tm * 128 + wr * 64 + ni * 16 + fr;
#pragma unroll
    for (int mi = 0; mi < 4; ++mi) *(f32x4*)(p.y() + row * 1024 + tn * 128 + wc * 64 + mi * 16 + fq * 4) = acc[mi][ni];
  }
}


__device__ void outproj_tile256(const Params& p, int l, int t, char* smem) {
  constexpr int NT = 8;
  const int tm = t >> 3, tn = t & 7;
  const int tid = get_tid(), lane = tid & 63, wid = tid >> 6, wr = wid >> 1, wc = wid & 1, fr = lane & 15, fq = lane >> 4;
  f32x4 acc[4][NT];
#pragma unroll
  for (int a_ = 0; a_ < 4; ++a_)
#pragma unroll
    for (int b_ = 0; b_ < NT; ++b_) acc[a_][b_] = (f32x4){0.f, 0.f, 0.f, 0.f};
  gemm_glds<NT, 3>(acc, p.merged() + (size_t)tm * 256 * 1024, 1024, p.wt_out() + (size_t)l * 1048576 + (size_t)tn * 128 * 1024, 1024, 1024, smem);
#pragma unroll
  for (int ni = 0; ni < NT; ++ni) {
    const size_t row = (size_t)tm * 256 + wr * 128 + ni * 16 + fr;
#pragma unroll
    for (int m = 0; m < 2; ++m) {
      float* op = p.y() + row * 1024 + tn * 128 + wc * 64 + m * 32 + fq * 8;
      *(f32x4*)op = acc[2 * m][ni]; *(f32x4*)(op + 4) = acc[2 * m + 1][ni];
    }
  }
}


__device__ void gate_tile256(const Params& p, int l, int t, char* smem) {
  constexpr int NT = 8;
  const int tm = t / 24, tn = t % 24;
  const int tid = get_tid(), lane = tid & 63, wid = tid >> 6, wr = wid >> 1, wc = wid & 1, fr = lane & 15, fq = lane >> 4;
  f32x4 acc[4][NT];
#pragma unroll
  for (int a_ = 0; a_ < 4; ++a_)
#pragma unroll
    for (int b_ = 0; b_ < NT; ++b_) acc[a_][b_] = (f32x4){0.f, 0.f, 0.f, 0.f};
  gemm_glds<NT, 3>(acc, p.U() + (size_t)tm * 256 * 1024, 1024, p.wt_in() + (size_t)l * NWT * 1024 + (size_t)(NMAIN + tn * 128) * 1024, 1024, 1024, smem);
#pragma unroll
  for (int ni = 0; ni < NT; ++ni) {
    const size_t row = (size_t)tm * 256 + wr * 128 + ni * 16 + fr;
#pragma unroll
    for (int m = 0; m < 2; ++m) {
      const f32x4 v0 = acc[2 * m][ni], v1 = acc[2 * m + 1][ni];
      u32x4 pk; pk.x = pack2(sigm(v0[0]), sigm(v0[1])); pk.y = pack2(sigm(v0[2]), sigm(v0[3])); pk.z = pack2(sigm(v1[0]), sigm(v1[1])); pk.w = pack2(sigm(v1[2]), sigm(v1[3]));
      *(u32x4*)(p.Gb(tn >> 3) + row * 1024 + (tn & 7) * 128 + wc * 64 + m * 32 + fq * 8) = pk;
    }
  }
}
__device__ void merge_tile_g(const Params& p, int l, int t, char* smem) {
  const int tm = t >> 3, tn = t & 7;
  const int tid = get_tid(), lane = tid & 63, wid = tid >> 6, wr = wid >> 1, wc = wid & 1, fr = lane & 15, fq = lane >> 4;
  f32x4 macc[4][4]; zero_acc(macc);
#pragma unroll 1
  for (int b = 0; b < 3; ++b) {
    f32x4 acc[4][4]; zero_acc(acc);
    gemm_kloop<bf16_t>(acc, p.H() + (size_t)b * NTOK * 512 + (size_t)tm * 128 * 512, 512, p.wt_br() + (size_t)(l * 3 + b) * 1024 * 512 + (size_t)tn * 128 * 512, 512, 512, smem);
#pragma unroll
    for (int ni = 0; ni < 4; ++ni) {
      const size_t row = (size_t)tm * 128 + wr * 64 + ni * 16 + fr;
#pragma unroll
      for (int mi = 0; mi < 4; ++mi) {
        const u32x2 g = *(const u32x2*)(p.Gb(b) + row * 1024 + tn * 128 + wc * 64 + mi * 16 + fq * 4);
        macc[mi][ni][0] += lo2f(g.x) * acc[mi][ni][0]; macc[mi][ni][1] += hi2f(g.x) * acc[mi][ni][1];
        macc[mi][ni][2] += lo2f(g.y) * acc[mi][ni][2]; macc[mi][ni][3] += hi2f(g.y) * acc[mi][ni][3];
      }
    }
  }
#pragma unroll
  for (int ni = 0; ni < 4; ++ni) {
    const size_t row = (size_t)tm * 128 + wr * 64 + ni * 16 + fr;
#pragma unroll
    for (int mi = 0; mi < 4; ++mi) {
      u32x2 pk; pk.x = pack2(macc[mi][ni][0], macc[mi][ni][1]); pk.y = pack2(macc[mi][ni][2], macc[mi][ni][3]);
      *(u32x2*)(p.merged() + row * 1024 + tn * 128 + wc * 64 + mi * 16 + fq * 4) = pk;
    }
  }
}

__device__ void postnorm_phase(const Params& p, int l) {
  const int lane = threadIdx.x & 63, wid = threadIdx.x >> 6;
  const float* gp = p.g_post + l * 1024;
  for (int row = blockIdx.x * 4 + wid; row < NTOK; row += gridDim.x * 4) {
    const float* x = xrow(p, l, row);
    const float* y = p.y() + (size_t)row * 1024;
    float4 v[4]; float ss = 0.f;
#pragma unroll
    for (int i = 0; i < 4; ++i) { v[i] = *(const float4*)(y + i * 256 + lane * 4); ss += v[i].x * v[i].x + v[i].y * v[i].y + v[i].z * v[i].z + v[i].w * v[i].w; }
#pragma unroll
    for (int o = 32; o > 0; o >>= 1) ss += __shfl_xor(ss, o);
    const float rstd = rsqrtf(ss * (1.f / 1024.f) + 1e-6f);
#pragma unroll
    for (int i = 0; i < 4; ++i) {
      const int k = i * 256 + lane * 4;
      const float4 g = *(const float4*)(gp + k), xv = *(const float4*)(x + k);
      float4 r; r.x = xv.x + v[i].x * rstd * g.x; r.y = xv.y + v[i].y * rstd * g.y; r.z = xv.z + v[i].z * rstd * g.z; r.w = xv.w + v[i].w * rstd * g.w;
      *(float4*)(p.r() + (size_t)row * 1024 + k) = r;
      u32x2 pk; pk.x = pack2(r.x, r.y); pk.y = pack2(r.z, r.w);
      *(u32x2*)(p.rb() + (size_t)row * 1024 + k) = pk;
    }
  }
}

__device__ void ple_tile(const Params& p, int l, int t, char* smem) {
  const int tm = t >> 3, tn = t & 7;
  const int tid = get_tid(), lane = tid & 63, wid = tid >> 6, wr = wid >> 1, wc = wid & 1, fr = lane & 15, fq = lane >> 4;
  f32x4 acc[4][4]; zero_acc(acc);
  const int row0 = tm * 128;
  const float* pp = row0 < NPROMPT ? p.p_p + ((size_t)l * NPROMPT + row0) * 256 : p.p_s + ((size_t)l * 512 + (row0 - NPROMPT)) * 256;
  gemm_kloop<float>(acc, pp, 256, p.wt_pp() + (size_t)l * 262144 + (size_t)tn * 128 * 256, 256, 256, smem);
  u32x2 pb[4][4];
#pragma unroll
  for (int a = 0; a < 4; ++a)
#pragma unroll
    for (int c = 0; c < 4; ++c) { pb[a][c].x = pack2(acc[a][c][0], acc[a][c][1]); pb[a][c].y = pack2(acc[a][c][2], acc[a][c][3]); }
  zero_acc(acc);
  gemm_kloop<bf16_t>(acc, p.rb() + (size_t)tm * 128 * 1024, 1024, p.wt_pg() + (size_t)l * 1048576 + (size_t)tn * 128 * 1024, 1024, 1024, smem);
#pragma unroll
  for (int ni = 0; ni < 4; ++ni) {
    const size_t row = (size_t)row0 + wr * 64 + ni * 16 + fr;
#pragma unroll
    for (int mi = 0; mi < 4; ++mi) {
      const int col = tn * 128 + wc * 64 + mi * 16 + fq * 4;
      const f32x4 rv = *(const f32x4*)(p.r() + row * 1024 + col);
      f32x4 o;
      o[0] = rv[0] + sigm(acc[mi][ni][0]) * lo2f(pb[mi][ni].x); o[1] = rv[1] + sigm(acc[mi][ni][1]) * hi2f(pb[mi][ni].x);
      o[2] = rv[2] + sigm(acc[mi][ni][2]) * lo2f(pb[mi][ni].y); o[3] = rv[3] + sigm(acc[mi][ni][3]) * hi2f(pb[mi][ni].y);
      *(f32x4*)(p.o_y() + row * 1024 + col) = o;
    }
  }
}


template <typename TT>
__device__ __forceinline__ void mini_dot(f32x4& acc, const TT* Trow, const bf16_t* Wrow, int K) {
#pragma unroll 8
  for (int k = 0; k < K; k += 32) {
    const u32x4 tv = ld8(Trow + k), wv = ld8(Wrow + k);
    acc = __builtin_amdgcn_mfma_f32_16x16x32_bf16(__builtin_bit_cast(bf16x8, wv), __builtin_bit_cast(bf16x8, tv), acc, 0, 0, 0);
  }
}
__device__ void merge_mini(const Params& p, int l, int j) {
  const int tid = get_tid(), lane = tid & 63, w = tid >> 6, fr = lane & 15, fq = lane >> 4;
  const size_t row = (size_t)NPROMPT + (j >> 4) * 16 + fr;
  const int cb = (j & 15) * 64 + w * 16;
  f32x4 out = {0.f, 0.f, 0.f, 0.f};
#pragma unroll 1
  for (int b = 0; b < 3; ++b) {
    f32x4 g = {0.f, 0.f, 0.f, 0.f}, h = {0.f, 0.f, 0.f, 0.f};
    mini_dot<bf16_t>(g, p.U() + row * 1024 + fq * 8, p.wt_in() + (size_t)l * NWT * 1024 + (size_t)(NMAIN + b * 1024 + cb + fr) * 1024 + fq * 8, 1024);
    mini_dot<bf16_t>(h, p.H() + (size_t)b * NTOK * 512 + row * 512 + fq * 8, p.wt_br() + (size_t)(l * 3 + b) * 1024 * 512 + (size_t)(cb + fr) * 512 + fq * 8, 512);
    out[0] += sigm(g[0]) * h[0]; out[1] += sigm(g[1]) * h[1]; out[2] += sigm(g[2]) * h[2]; out[3] += sigm(g[3]) * h[3];
  }
  u32x2 pk; pk.x = pack2(out[0], out[1]); pk.y = pack2(out[2], out[3]);
  *(u32x2*)(p.merged() + row * 1024 + cb + fq * 4) = pk;
}
__device__ void outproj_mini(const Params& p, int l, int j) {
  const int tid = get_tid(), lane = tid & 63, w = tid >> 6, fr = lane & 15, fq = lane >> 4;
  const size_t row = (size_t)NPROMPT + (j >> 4) * 16 + fr;
  const int cb = (j & 15) * 64 + w * 16;
  f32x4 y = {0.f, 0.f, 0.f, 0.f};
  mini_dot<bf16_t>(y, p.merged() + row * 1024 + fq * 8, p.wt_out() + (size_t)l * 1048576 + (size_t)(cb + fr) * 1024 + fq * 8, 1024);
  *(f32x4*)(p.y() + row * 1024 + cb + fq * 4) = y;
}
__device__ void ple_mini(const Params& p, int l, int j) {
  const int tid = get_tid(), lane = tid & 63, w = tid >> 6, fr = lane & 15, fq = lane >> 4;
  const int srow = (j >> 4) * 16 + fr;
  const size_t row = (size_t)NPROMPT + srow;
  const int cb = (j & 15) * 64 + w * 16;
  f32x4 g = {0.f, 0.f, 0.f, 0.f}, pa = {0.f, 0.f, 0.f, 0.f};
  mini_dot<float>(pa, p.p_s + ((size_t)l * 512 + srow) * 256 + fq * 8, p.wt_pp() + (size_t)l * 262144 + (size_t)(cb + fr) * 256 + fq * 8, 256);
  mini_dot<bf16_t>(g, p.rb() + row * 1024 + fq * 8, p.wt_pg() + (size_t)l * 1048576 + (size_t)(cb + fr) * 1024 + fq * 8, 1024);
  const f32x4 rv = *(const f32x4*)(p.r() + row * 1024 + cb + fq * 4);
  f32x4 o; o[0] = rv[0] + sigm(g[0]) * pa[0]; o[1] = rv[1] + sigm(g[1]) * pa[1]; o[2] = rv[2] + sigm(g[2]) * pa[2]; o[3] = rv[3] + sigm(g[3]) * pa[3];
  *(f32x4*)(p.o_y() + row * 1024 + cb + fq * 4) = o;
}

#define XB_TMO      128
#define XB_XCNT(j)  (256  + 64 * (j))
#define XB_XSUB(j)  (1280 + 64 * (j))
#define XB_XGEN(j)  (2304 + 64 * (j))
#define XB_TOP      3328
#define XB_TOPGEN   3392
#define XCD_BAR_WORDS 3456
#define XB_SPIN_CAP (1u << 18)
#define LAS __attribute__((address_space(3)))
__device__ __forceinline__ unsigned xb_ld(unsigned* p)              { return __hip_atomic_load(p, __ATOMIC_RELAXED, __HIP_MEMORY_SCOPE_AGENT); }
__device__ __forceinline__ unsigned xb_add(unsigned* p, unsigned v) { return __hip_atomic_fetch_add(p, v, __ATOMIC_RELAXED, __HIP_MEMORY_SCOPE_AGENT); }
__device__ __forceinline__ unsigned xb_xcc_id() { return (unsigned)__builtin_amdgcn_s_getreg((3 << 11) | 20) & 0xFu; }
#define XB_SPIN(cond, bar) do { unsigned _sp = 0; while (cond) { __builtin_amdgcn_s_sleep(1); \
    if ((++_sp & 255u) == 0u) { if (xb_ld(&(bar)[XB_TMO])) break; if (_sp > XB_SPIN_CAP) { atomicAdd(&(bar)[XB_TMO], 1u); break; } } } } while (0)
__device__ __forceinline__ void xcd_barrier_complete(unsigned* bar, unsigned x, unsigned& nloc, unsigned& nx) {
    const unsigned G = gridDim.x * gridDim.y * gridDim.z;
    unsigned sum, cnt, mine, sp = 0u;
    for (;;) {
        sum = 0u; cnt = 0u; mine = 0u;
#pragma unroll
        for (unsigned j = 0; j < 16; ++j) { const unsigned c = xb_ld(&bar[XB_XCNT(j)]); sum += c; cnt += (c > 0u) ? 1u : 0u; mine = (j == x) ? c : mine; }
        if (sum == G) break;
        __builtin_amdgcn_s_sleep(1);
        if ((++sp & 255u) == 0u) { if (xb_ld(&bar[XB_TMO])) break; if (sp > XB_SPIN_CAP) { atomicAdd(&bar[XB_TMO], 1u); break; } }
    }
    nloc = mine > 0u ? mine : 1u; nx = cnt > 0u ? cnt : 1u;
}
__device__ __forceinline__ void xcd_barrier(unsigned* bar, volatile LAS unsigned* st) {
    asm volatile("s_waitcnt vmcnt(0)" ::: "memory");
    __syncthreads();
    if (threadIdx.x == 0) {
        const unsigned x = xb_xcc_id();
        __builtin_amdgcn_s_waitcnt(0);
        unsigned nloc = st[0], nx = st[1];
        if (nloc == 0u) { xcd_barrier_complete(bar, x, nloc, nx); st[0] = nloc; st[1] = nx; }
        const unsigned old = xb_add(&bar[XB_XSUB(x)], 1u);
        const unsigned gen = old / nloc;
        if (old + 1u == (gen + 1u) * nloc) {
            __builtin_amdgcn_fence(__ATOMIC_RELEASE, "agent");
            asm volatile("s_waitcnt vmcnt(0)" ::: "memory");
            const unsigned og = xb_add(&bar[XB_TOP], 1u);
            const unsigned tg = og / nx;
            if (og + 1u == (tg + 1u) * nx) xb_add(&bar[XB_TOPGEN], 1u);
            else XB_SPIN(xb_ld(&bar[XB_TOPGEN]) == tg, bar);
            __builtin_amdgcn_fence(__ATOMIC_ACQUIRE, "agent");
            xb_add(&bar[XB_XGEN(x)], 1u);
            asm volatile("s_waitcnt vmcnt(0)" ::: "memory");
        } else {
            XB_SPIN(xb_ld(&bar[XB_XGEN(x)]) == gen, bar);
            __builtin_amdgcn_fence(__ATOMIC_ACQUIRE, "agent");
            asm volatile("s_waitcnt vmcnt(0)" ::: "memory");
        }
    }
    __syncthreads();
}

template <int PH>
__device__ __forceinline__ void run_phase(const Params& p, char* smem) {
  const int bid = blockIdx.x, nb = gridDim.x;
  if (PH == 0) {
    for (int t = bid; t < 1696; t += nb) wconv_tile(p, t, smem);
    for (int i = bid * 256 + get_tid(); i < 2 * 8 * 1024; i += nb * 256) { const int ll = i >> 13, j = (i >> 10) & 7, k = i & 1023; p.wg8()[i] = p.w_in[((size_t)ll * 1024 + k) * NINSRC + 2560 + j]; }
    return;
  }
  constexpr int l = (PH - 1) / NPL, s = (PH - 1) % NPL;
  if (!((PHMASK >> s) & 1)) return;
  switch (s) {
    case 0: norm_phase(p, l); break;
    case 1: {
      const int per = (66 * 52) / 8, xcd = bid & 7, nloc = (nb + 7 - xcd) >> 3;
      for (int j = bid >> 3; j < per; j += nloc) {
        const int sq = xcd * per + j;
        const int tmg = sq / 416, rem = sq % 416, gm = (tmg == 8) ? 2 : 8;
        const int tng = rem / (gm * 8), rem2 = rem % (gm * 8), wdt = (tng == 6) ? 4 : 8;
        inproj_tile(p, l, (tmg * 8 + rem2 / wdt) * 52 + tng * 8 + rem2 % wdt, smem);
      }
      break;
    }
    case 2:
      for (int v = bid; v < 3 * NUNIT; v += nb) {
        const int ty = v % 3, u = v / 3;
        if (ty == 0) sb_unit(p, l, u, smem); else if (ty == 1) mlstm_local(p, l, u, smem); else hgrn_local(p, l, u, smem);
      }
      break;
    case 3: scan_phase(p, l, smem); break;
    case 4:
      for (int v = bid; v < 2 * NUNIT; v += nb) { if (v & 1) hgrn_out(p, l, v >> 1, smem); else mlstm_out(p, l, v >> 1, smem); }
      break;
    case 5: for (int t = bid; t < 1024; t += nb) merge_tile(p, l, t, smem); for (int j = bid; j < 512; j += nb) merge_mini(p, l, j); break;
    case 6: for (int t = bid; t < 1024; t += nb) outproj_tile(p, l, t, smem); for (int j = bid; j < 512; j += nb) outproj_mini(p, l, j); break;
    case 7: postnorm_phase(p, l); break;
    case 8: for (int t = bid; t < 1024; t += nb) ple_tile(p, l, t, smem); for (int j = bid; j < 512; j += nb) ple_mini(p, l, j); break;
  }
}

template <int PH>
__global__ void __launch_bounds__(256, 2) phase_kernel(Params p) {
  __shared__ __attribute__((aligned(16))) char smem[SMEM_BYTES];
  run_phase<PH>(p, smem);
}

#if FUSED
__device__ __forceinline__ int fetch_work(unsigned* ctr, volatile int* slot) {
  __syncthreads();
  if (threadIdx.x == 0) *slot = (int)__hip_atomic_fetch_add(ctr, 1u, __ATOMIC_RELAXED, __HIP_MEMORY_SCOPE_AGENT);
  __syncthreads();
  return *slot;
}
__device__ __forceinline__ void run_phase_rt(const Params& p, int ph, char* smem, volatile int* wslot) {
  const int bid = blockIdx.x, nb = gridDim.x;
  unsigned* ctr = (unsigned*)(p.ws + WS_BAR + 14336) + ph * 16;
  if (ph == 0) {
    for (int t = bid; t < 1696; t += nb) wconv_tile(p, t, smem);
    for (int i = bid * 256 + get_tid(); i < 2 * 8 * 1024; i += nb * 256) { const int ll = i >> 13, j = (i >> 10) & 7, k = i & 1023; p.wg8()[i] = p.w_in[((size_t)ll * 1024 + k) * NINSRC + 2560 + j]; }
    return;
  }
  const int l = (ph - 1) / NPL, s = (ph - 1) % NPL;
  switch (s) {
    case 0: norm_phase(p, l); break;
    case 1: {
      const int per = (66 * 52) / 8, xcd0 = (int)(xb_xcc_id() & 7u);
      for (int dx = 0; dx < 8; ++dx) {
        const int xcd = (xcd0 + dx) & 7;
        for (;;) {
          const int j = fetch_work(ctr + xcd, wslot);
          if (j >= per) break;
          const int sq = xcd * per + j;
          const int tmg = sq / 416, rem = sq % 416, gm = (tmg == 8) ? 2 : 8;
          const int tng = rem / (gm * 8), rem2 = rem % (gm * 8), wdt = (tng == 6) ? 4 : 8;
          inproj_tile(p, l, (tmg * 8 + rem2 / wdt) * 52 + tng * 8 + rem2 % wdt, smem);
        }
      }
      break;
    }
    case 2:
      for (;;) {
        const int v = fetch_work(ctr, wslot);
        if (v >= 3 * NUNIT) break;
        if (v < NUNIT) sb_unit(p, l, v, smem); else if (v < 2 * NUNIT) mlstm_local(p, l, v - NUNIT, smem); else hgrn_local(p, l, v - 2 * NUNIT, smem);
      }
      break;
    case 3: scan_phase(p, l, smem); break;
    case 4:
      for (;;) {
        const int v = fetch_work(ctr, wslot);
        if (v >= 3648) break;
        const int grp = v / 19, r = v % 19;
        if (r < 8) gate_tile256(p, l, grp * 8 + r, smem);
        else { const int u = grp * 11 + (r - 8); if (u < NUNIT) hgrn_out(p, l, u, smem); else mlstm_out(p, l, u - NUNIT, smem); }
      }
      break;
    case 5: for (;;) { const int v = fetch_work(ctr, wslot); if (v >= 1536) break; if (v < 1024) merge_tile_g(p, l, v, smem); else merge_mini(p, l, v - 1024); } break;
    case 6: for (;;) { const int v = fetch_work(ctr, wslot); if (v >= 1024) break; if (v < 512) outproj_tile256(p, l, v, smem); else outproj_mini(p, l, v - 512); } break;
    case 7: postnorm_phase(p, l); break;
    case 8: for (;;) { const int v = fetch_work(ctr, wslot); if (v >= 1536) break; if (v < 1024) ple_tile(p, l, v, smem); else ple_mini(p, l, v - 1024); } break;
  }
}

__global__ void __launch_bounds__(256, 2) mega(Params p_unused) {
  __shared__ __attribute__((aligned(16))) char smem[SMEM_BYTES];
  __shared__ uint4 xb_words;
  __shared__ int wslot;
  if (threadIdx.x == 0) {
    typedef const Params __attribute__((address_space(4))) * KP4;
    KP4 kp = (KP4)__builtin_amdgcn_kernarg_segment_ptr();
    asm volatile("" : "+s"(kp));
    char* wsb = ((const Params*)kp)->ws;
    xb_words = make_uint4(0u, 0u, 0u, 0u); (void)xb_add((unsigned*)(wsb + WS_BAR) + XB_XCNT(xb_xcc_id()), 1u);
  }
  __syncthreads();
  typedef const Params __attribute__((address_space(4))) * KP4;
#ifdef PROBE_KIND
  unsigned long long t_acc = 0;
#endif
#pragma unroll 1
  for (int ph = 0; ph < NPHASE; ++ph) {
    KP4 kp = (KP4)__builtin_amdgcn_kernarg_segment_ptr();
    asm volatile("" : "+s"(kp));
    const Params q = *(const Params*)kp;
#ifdef PROBE_KIND
    const unsigned long long tp0 = __builtin_amdgcn_s_memrealtime();
#endif
    run_phase_rt(q, ph, smem, &wslot);
#ifdef PROBE_KIND
    const unsigned long long tp1 = __builtin_amdgcn_s_memrealtime();
    if ((PROBE_KIND == 9 && ph == 0) || (PROBE_KIND < 9 && ph > 0 && (ph - 1) % NPL == PROBE_KIND)) t_acc += tp1 - tp0;
#endif
    if (ph + 1 < NPHASE) xcd_barrier((unsigned*)(q.ws + WS_BAR), (volatile LAS unsigned*)&xb_words);
    if (gridDim.y == 7777u) cg::this_grid().sync();
#ifdef PROBE_KIND
    if (PROBE_KIND == 10 && (PROBE_SEL < 0 || (ph > 0 && (ph - 1) % NPL == PROBE_SEL))) t_acc += __builtin_amdgcn_s_memrealtime() - tp1;
#endif
  }
#ifdef PROBE_GEMM
  {
    KP4 kp = (KP4)__builtin_amdgcn_kernarg_segment_ptr();
    asm volatile("" : "+s"(kp));
    const Params q = *(const Params*)kp;
    xcd_barrier((unsigned*)(q.ws + WS_BAR), (volatile LAS unsigned*)&xb_words);
    const unsigned long long tg0 = __builtin_amdgcn_s_memrealtime();
    f32x4 acc[4][8];
#pragma unroll
    for (int a_ = 0; a_ < 4; ++a_)
#pragma unroll
      for (int b_ = 0; b_ < 8; ++b_) acc[a_][b_] = (f32x4){0.f, 0.f, 0.f, 0.f};
    const int bid = blockIdx.x;
#pragma unroll 1
    for (int it = 0; it < 8; ++it) {
      int tm, tn;
      if (PROBE_GEMM == 0) { tm = 0; tn = 0; }
      else if (PROBE_GEMM == 1) { tm = bid & 63; tn = ((bid >> 6) * 6 + it) % 52; }
      else { const int xcd = bid & 7, idx = bid >> 3; tm = xcd * 8 + (idx & 7); tn = ((idx >> 3) + 8 * it) % 52; }
      gemm_glds<8, 3>(acc, q.U() + (size_t)tm * 256 * 1024, 1024, q.wt_in() + (size_t)tn * 128 * 1024, 1024, 1024, smem);
    }
    float sum = 0.f;
#pragma unroll
    for (int a_ = 0; a_ < 4; ++a_)
#pragma unroll
      for (int b_ = 0; b_ < 8; ++b_) sum += acc[a_][b_][0] + acc[a_][b_][1] + acc[a_][b_][2] + acc[a_][b_][3];
    if (sum == 123456.789f) q.hbc()[0] = sum;
    const unsigned long long tg1 = __builtin_amdgcn_s_memrealtime();
    if (blockIdx.x == 0) { while (__builtin_amdgcn_s_memrealtime() - tg1 < 4 * (tg1 - tg0)) __builtin_amdgcn_s_sleep(32); }
  }
#endif
#ifdef PROBE_KIND
  if (blockIdx.x == PROBE_BLOCK) { const unsigned long long te = __builtin_amdgcn_s_memrealtime(); while (__builtin_amdgcn_s_memrealtime() - te < 4 * t_acc) __builtin_amdgcn_s_sleep(32); }
#endif
}
#endif

template <int PH>
static void launch_all(const Params& p, int grid, hipStream_t stream) {
  hipLaunchKernelGGL(phase_kernel<PH>, dim3(grid), dim3(256), 0, stream, p);
  if constexpr (PH + 1 < NPHASE) launch_all<PH + 1>(p, grid, stream);
}

extern "C" void kernel_launch(void* const* d_in, const int* in_sizes, int n_in, void* d_out, int out_size, void* d_ws, size_t ws_size, hipStream_t stream) {
  Params p;
  memset(&p, 0, sizeof(p));
  const float* const* in = (const float* const*)d_in;
  p.x_p = in[0]; p.x_s = in[1]; p.p_p = in[2]; p.p_s = in[3]; p.st_C = in[4]; p.st_n = in[5]; p.st_m = in[6]; p.st_conv = in[7];
  p.ck = in[8]; p.cv = in[9]; p.st_S = in[10]; p.g_pre = in[11]; p.w_in = in[12]; p.b_i = in[13]; p.b_f = in[14]; p.w_conv = in[15];
  p.g_ml = in[16]; p.lb_logits = in[17]; p.g_hg = in[18]; p.w_br = in[19]; p.w_out = in[20]; p.g_post = in[21]; p.w_pg = in[22]; p.w_pp = in[23];
  p.out = (float*)d_out; p.ws = (char*)d_ws;
  if (WS_TOTAL > ws_size || (size_t)out_size < O_TOTAL) { fprintf(stderr, "workspace/out too small: need %zu have %zu\n", (size_t)WS_TOTAL, ws_size); return; }
  static int grid_blocks = 0;
  if (!grid_blocks) {
    int dev = 0, cus = 0, per_cu = 0;
    (void)hipGetDevice(&dev);
    (void)hipDeviceGetAttribute(&cus, hipDeviceAttributeMultiprocessorCount, dev);
#if FUSED
    (void)hipOccupancyMaxActiveBlocksPerMultiprocessor(&per_cu, mega, 256, 0);
#else
    per_cu = 2;
#endif
    if (per_cu > 2) per_cu = 2;
    if (per_cu < 1) per_cu = 1;
    grid_blocks = cus * per_cu;
  }
#if FUSED
  (void)hipMemsetAsync((char*)d_ws + WS_BAR, 0, 16384, stream);
  void* args[] = {&p};
  hipError_t e = hipLaunchCooperativeKernel((void*)mega, dim3(grid_blocks), dim3(256), args, 0, stream);
  if (e != hipSuccess) fprintf(stderr, "cooperative launch failed: %s (grid %d)\n", hipGetErrorString(e), grid_blocks);
#else
  launch_all<0>(p, grid_blocks, stream);
#endif
}
```

```cpp
#include <hip/hip_runtime.h>
#include <hip/hip_cooperative_groups.h>
#include <stdint.h>
#include <stdio.h>
#include <string.h>
namespace cg = cooperative_groups;

#ifndef FUSED
#define FUSED 1
#endif
#ifndef PHMASK
#define PHMASK 0x3ff
#endif

typedef unsigned short bf16_t;
typedef short bf16x8 __attribute__((ext_vector_type(8)));
typedef float f32x4 __attribute__((ext_vector_type(4)));
typedef unsigned u32x4 __attribute__((ext_vector_type(4)));
typedef unsigned u32x2 __attribute__((ext_vector_type(2)));

constexpr int NTOK = 16896, NPROMPT = 16384, NUNIT = 1056;
constexpr int NINSRC = 9736, NWT = 9728, NMAIN = 6656;
constexpr int SMEM_BYTES = 80896;
constexpr int NPL = 9;
constexpr int NPHASE = 1 + 2 * NPL;

constexpr size_t al256(size_t x) { return (x + 255) & ~(size_t)255; }
constexpr size_t WS_WT_IN = 0;
constexpr size_t WS_WT_BR = WS_WT_IN + al256((size_t)2 * NWT * 1024 * 2);
constexpr size_t WS_WT_OUT = WS_WT_BR + al256((size_t)2 * 3 * 1024 * 512 * 2);
constexpr size_t WS_WT_PG = WS_WT_OUT + al256((size_t)2 * 1048576 * 2);
constexpr size_t WS_WT_PP = WS_WT_PG + al256((size_t)2 * 1048576 * 2);
constexpr size_t WS_U = WS_WT_PP + al256((size_t)2 * 262144 * 2);
constexpr size_t WS_PR = WS_U + al256((size_t)NTOK * 1024 * 2);
constexpr size_t WS_QC = WS_PR + al256((size_t)13 * NTOK * 512 * 2);
constexpr size_t WS_KC = WS_QC + al256((size_t)NTOK * 512 * 2);
constexpr size_t WS_SM = WS_KC + al256((size_t)NTOK * 512 * 2);
constexpr size_t WS_SH = WS_SM + al256((size_t)NUNIT * 16384 * 2);
constexpr size_t WS_H = WS_SH + al256((size_t)NUNIT * 16384 * 2);
constexpr size_t WS_IG = WS_H + al256((size_t)3 * NTOK * 512 * 2);
constexpr size_t WS_LF = WS_IG + al256((size_t)NTOK * 16);
constexpr size_t WS_AC = WS_LF + al256((size_t)NTOK * 16);
constexpr size_t WS_BC = WS_AC + al256(NUNIT * 4);
constexpr size_t WS_MIN = WS_BC + al256(NUNIT * 4);
constexpr size_t WS_NLOC = WS_MIN + al256(NUNIT * 4);
constexpr size_t WS_HBC = WS_NLOC + al256((size_t)NUNIT * 512);
constexpr size_t WS_BAR = WS_HBC + al256((size_t)NUNIT * 512);
constexpr size_t WS_WG8 = WS_BAR + 16384;
constexpr size_t WS_TOTAL = WS_WG8 + 65536;
constexpr size_t GRP = (size_t)NTOK * 512 * 2;
constexpr size_t WS_G0 = WS_PR + 0 * GRP, WS_G1 = WS_PR + 5 * GRP, WS_G2 = WS_PR + 7 * GRP;
constexpr size_t WS_MERGED = WS_PR + 2 * GRP;
constexpr size_t WS_Y = WS_PR + 9 * GRP;
constexpr size_t WS_RB = WS_PR + 0 * GRP;
constexpr size_t WS_R = WS_PR + 5 * GRP;
static_assert(WS_Y + (size_t)NTOK * 1024 * 4 <= WS_QC, "alias overflow");
constexpr size_t O_PC = 16777216 + 524288, O_PN = O_PC + 262144, O_PM = O_PN + 2048, O_PCONV = O_PM + 16, O_PK = O_PCONV + 12288, O_PV = O_PK + 16777216,
                 O_PS = O_PV + 16777216, O_SC = O_PS + 262144, O_SN = O_SC + 1048576, O_SM = O_SN + 8192, O_SCONV = O_SM + 64, O_SK = O_SCONV + 49152,
                 O_SV = O_SK + 524288, O_SS = O_SV + 524288, O_TOTAL = O_SS + 1048576;

struct Params {
  const float *x_p, *x_s, *p_p, *p_s, *st_C, *st_n, *st_m, *st_conv, *ck, *cv, *st_S;
  const float *g_pre, *w_in, *b_i, *b_f, *w_conv, *g_ml, *lb_logits, *g_hg, *w_br, *w_out, *g_post, *w_pg, *w_pp;
  float* out; char* ws;
#define WSP(name, T, off) __device__ __forceinline__ T* name() const { return (T*)(ws + (off)); }
#define OUTP(name, off) __device__ __forceinline__ float* name() const { return out + (off); }
  OUTP(o_y, 0) OUTP(o_pC, O_PC) OUTP(o_pn, O_PN) OUTP(o_pm, O_PM) OUTP(o_pconv, O_PCONV) OUTP(o_pk, O_PK) OUTP(o_pv, O_PV) OUTP(o_pS, O_PS)
  OUTP(o_sC, O_SC) OUTP(o_sn, O_SN) OUTP(o_sm, O_SM) OUTP(o_sconv, O_SCONV) OUTP(o_sk, O_SK) OUTP(o_sv, O_SV) OUTP(o_sS, O_SS)
  WSP(wt_in, bf16_t, WS_WT_IN) WSP(wt_br, bf16_t, WS_WT_BR) WSP(wt_out, bf16_t, WS_WT_OUT) WSP(wt_pg, bf16_t, WS_WT_PG) WSP(wt_pp, bf16_t, WS_WT_PP)
  WSP(U, bf16_t, WS_U) WSP(PR, bf16_t, WS_PR) WSP(QC, bf16_t, WS_QC) WSP(KC, bf16_t, WS_KC) WSP(SM, bf16_t, WS_SM) WSP(SH, bf16_t, WS_SH) WSP(H, bf16_t, WS_H)
  WSP(ig, float, WS_IG) WSP(lf, float, WS_LF) WSP(ac, float, WS_AC) WSP(Bc, float, WS_BC) WSP(min_, float, WS_MIN) WSP(nloc, float, WS_NLOC) WSP(hbc, float, WS_HBC)
  __device__ __forceinline__ bf16_t* Gb(int b) const { return (bf16_t*)(ws + (b == 0 ? WS_G0 : b == 1 ? WS_G1 : WS_G2)); }
  WSP(wg8, float, WS_WG8) WSP(merged, bf16_t, WS_MERGED) WSP(y, float, WS_Y) WSP(r, float, WS_R) WSP(rb, bf16_t, WS_RB)
};

__device__ __forceinline__ int get_tid() { int t = threadIdx.x; asm volatile("" : "+v"(t)); return t; }
__device__ __forceinline__ bf16_t f2bf(float f) { unsigned u = __float_as_uint(f); u += 0x7fffu + ((u >> 16) & 1u); return (bf16_t)(u >> 16); }
__device__ __forceinline__ float bf2f(bf16_t h) { return __uint_as_float(((unsigned)h) << 16); }
__device__ __forceinline__ unsigned pack2(float a, float b) { return (unsigned)f2bf(a) | ((unsigned)f2bf(b) << 16); }
__device__ __forceinline__ float lo2f(unsigned v) { return __uint_as_float(v << 16); }
__device__ __forceinline__ float hi2f(unsigned v) { return __uint_as_float(v & 0xffff0000u); }
__device__ __forceinline__ float sigm(float x) { return 1.f / (1.f + __expf(-x)); }
__device__ __forceinline__ float silu(float x) { return x / (1.f + __expf(-x)); }
__device__ __forceinline__ float softplus(float x) { return fmaxf(x, 0.f) + __logf(1.f + __expf(-fabsf(x))); }
__device__ __forceinline__ float logsigm(float x) { return fminf(x, 0.f) - __logf(1.f + __expf(-fabsf(x))); }

template <int MT, int NT, int KS>
__device__ __forceinline__ void wmma(f32x4 (&acc)[MT][NT], const bf16_t* A, int lda, const bf16_t* B, int ldb, int fr, int fq) {
#pragma unroll
  for (int kk = 0; kk < KS; ++kk) {
    bf16x8 a[MT], b[NT];
#pragma unroll
    for (int mi = 0; mi < MT; ++mi) a[mi] = *(const bf16x8*)(A + (mi * 16 + fr) * lda + kk * 32 + fq * 8);
#pragma unroll
    for (int ni = 0; ni < NT; ++ni) b[ni] = *(const bf16x8*)(B + (ni * 16 + fr) * ldb + kk * 32 + fq * 8);
#pragma unroll
    for (int mi = 0; mi < MT; ++mi)
#pragma unroll
      for (int ni = 0; ni < NT; ++ni) acc[mi][ni] = __builtin_amdgcn_mfma_f32_16x16x32_bf16(a[mi], b[ni], acc[mi][ni], 0, 0, 0);
  }
}

__device__ __forceinline__ u32x4 ld8(const bf16_t* s) { return *(const u32x4*)s; }
__device__ __forceinline__ u32x4 ld8(const float* s) {
  float4 a = *(const float4*)s, b = *(const float4*)(s + 4);
  u32x4 r; r.x = pack2(a.x, a.y); r.y = pack2(a.z, a.w); r.z = pack2(b.x, b.y); r.w = pack2(b.z, b.w); return r;
}
template <typename T>
__device__ __forceinline__ void ld_tile(bf16_t* dst, const T* src, long ld, int tid) {
#pragma unroll
  for (int i = 0; i < 4; ++i) { int id = tid + 256 * i; int r = id >> 4, c = (id & 15) * 8; *(u32x4*)(dst + r * 136 + c) = ld8(src + (long)r * ld + c); }
}
template <typename T>
__device__ __forceinline__ void ld_tile128(bf16_t* dst, const T* src, long ld, int tid) {
#pragma unroll
  for (int i = 0; i < 8; ++i) { int id = tid + 256 * i; int r = id >> 4, c = (id & 15) * 8; *(u32x4*)(dst + r * 136 + c) = ld8(src + (long)r * ld + c); }
}
template <typename T, int ROWS, int DLD>
__device__ __forceinline__ void ld_T(bf16_t* dst, const T* src, long ld, int tid) {
#pragma unroll 2
  for (int id = tid; id < ROWS * 16; id += 256) {
    int r = id % ROWS, c = (id / ROWS) * 8;
    u32x4 v = ld8(src + (long)r * ld + c);
    bf16_t* d = dst + c * DLD + r;
    d[0] = (bf16_t)(v.x & 0xffff); d[DLD] = (bf16_t)(v.x >> 16); d[2 * DLD] = (bf16_t)(v.y & 0xffff); d[3 * DLD] = (bf16_t)(v.y >> 16);
    d[4 * DLD] = (bf16_t)(v.z & 0xffff); d[5 * DLD] = (bf16_t)(v.z >> 16); d[6 * DLD] = (bf16_t)(v.w & 0xffff); d[7 * DLD] = (bf16_t)(v.w >> 16);
  }
}

#define PRG(g) (p.PR() + (size_t)(g) * NTOK * 512)

__device__ __forceinline__ const float* xrow(const Params& p, int l, int row) {
  if (l == 0) return row < NPROMPT ? p.x_p + (size_t)row * 1024 : p.x_s + (size_t)(row - NPROMPT) * 1024;
  return p.o_y() + (size_t)row * 1024;
}

__device__ void wconv_tile(const Params& p, int t, char* smem) {
  float* tile = (float*)smem;
  const int tid = get_tid();
  int l = t / 848, r = t % 848;
  const float* src; bf16_t* dst; int K, ldsrc, kt, nt, skip = 1 << 30;
  if (r < 608) { src = p.w_in + (size_t)l * 1024 * NINSRC; dst = p.wt_in() + (size_t)l * NWT * 1024; K = 1024; ldsrc = NINSRC; kt = r % 16; nt = r / 16; skip = 2560; }
  else if (r < 704) { r -= 608; int b = r / 32; r %= 32; src = p.w_br + (size_t)(l * 3 + b) * 512 * 1024; dst = p.wt_br() + (size_t)(l * 3 + b) * 1024 * 512; K = 512; ldsrc = 1024; kt = r % 8; nt = r / 8; }
  else if (r < 768) { r -= 704; src = p.w_out + (size_t)l * 1048576; dst = p.wt_out() + (size_t)l * 1048576; K = 1024; ldsrc = 1024; kt = r % 16; nt = r / 16; }
  else if (r < 832) { r -= 768; src = p.w_pg + (size_t)l * 1048576; dst = p.wt_pg() + (size_t)l * 1048576; K = 1024; ldsrc = 1024; kt = r % 16; nt = r / 16; }
  else { r -= 832; src = p.w_pp + (size_t)l * 262144; dst = p.wt_pp() + (size_t)l * 262144; K = 256; ldsrc = 1024; kt = r % 4; nt = r / 4; }
  const int n0 = nt * 256, k0 = kt * 64;
  __syncthreads();
#pragma unroll
  for (int i = 0; i < 16; ++i) {
    const int k = i * 4 + (tid >> 6), n4 = (tid & 63) * 4;
    int ns = n0 + n4; if (ns >= skip) ns += 8;
    *(float4*)(tile + k * 260 + n4) = *(const float4*)(src + (size_t)(k0 + k) * ldsrc + ns);
  }
  __syncthreads();
  bf16_t* drow = dst + (size_t)(n0 + tid) * K + k0;
#pragma unroll
  for (int c = 0; c < 8; ++c) {
    u32x4 pk;
    pk.x = pack2(tile[(c * 8 + 0) * 260 + tid], tile[(c * 8 + 1) * 260 + tid]);
    pk.y = pack2(tile[(c * 8 + 2) * 260 + tid], tile[(c * 8 + 3) * 260 + tid]);
    pk.z = pack2(tile[(c * 8 + 4) * 260 + tid], tile[(c * 8 + 5) * 260 + tid]);
    pk.w = pack2(tile[(c * 8 + 6) * 260 + tid], tile[(c * 8 + 7) * 260 + tid]);
    *(u32x4*)(drow + c * 8) = pk;
  }
}

__device__ void norm_phase(const Params& p, int l) {
  const int lane = threadIdx.x & 63, wid = threadIdx.x >> 6;
  const float* gp = p.g_pre + l * 1024;
  const float* wg = p.wg8() + l * 8192;
  for (int row = blockIdx.x * 4 + wid; row < NTOK; row += gridDim.x * 4) {
    const float* x = xrow(p, l, row);
    float4 v[4]; float ss = 0.f;
#pragma unroll
    for (int i = 0; i < 4; ++i) { v[i] = *(const float4*)(x + i * 256 + lane * 4); ss += v[i].x * v[i].x + v[i].y * v[i].y + v[i].z * v[i].z + v[i].w * v[i].w; }
#pragma unroll
    for (int o = 32; o > 0; o >>= 1) ss += __shfl_xor(ss, o);
    const float rstd = rsqrtf(ss * (1.f / 1024.f) + 1e-6f);
    float d0 = 0, d1 = 0, d2 = 0, d3 = 0, d4 = 0, d5 = 0, d6 = 0, d7 = 0;
#pragma unroll
    for (int i = 0; i < 4; ++i) {
      const int k = i * 256 + lane * 4;
      float4 g = *(const float4*)(gp + k);
      float u0 = v[i].x * rstd * g.x, u1 = v[i].y * rstd * g.y, u2 = v[i].z * rstd * g.z, u3 = v[i].w * rstd * g.w;
      u32x2 pk; pk.x = pack2(u0, u1); pk.y = pack2(u2, u3);
      *(u32x2*)(p.U() + (size_t)row * 1024 + k) = pk;
      const float* wp = wg + k;
      float4 w;
      w = *(const float4*)(wp);            d0 += u0 * w.x + u1 * w.y + u2 * w.z + u3 * w.w;
      w = *(const float4*)(wp + 1024);     d1 += u0 * w.x + u1 * w.y + u2 * w.z + u3 * w.w;
      w = *(const float4*)(wp + 2 * 1024); d2 += u0 * w.x + u1 * w.y + u2 * w.z + u3 * w.w;
      w = *(const float4*)(wp + 3 * 1024); d3 += u0 * w.x + u1 * w.y + u2 * w.z + u3 * w.w;
      w = *(const float4*)(wp + 4 * 1024); d4 += u0 * w.x + u1 * w.y + u2 * w.z + u3 * w.w;
      w = *(const float4*)(wp + 5 * 1024); d5 += u0 * w.x + u1 * w.y + u2 * w.z + u3 * w.w;
      w = *(const float4*)(wp + 6 * 1024); d6 += u0 * w.x + u1 * w.y + u2 * w.z + u3 * w.w;
      w = *(const float4*)(wp + 7 * 1024); d7 += u0 * w.x + u1 * w.y + u2 * w.z + u3 * w.w;
    }
#pragma unroll
    for (int o = 32; o > 0; o >>= 1) {
      d0 += __shfl_xor(d0, o); d1 += __shfl_xor(d1, o); d2 += __shfl_xor(d2, o); d3 += __shfl_xor(d3, o);
      d4 += __shfl_xor(d4, o); d5 += __shfl_xor(d5, o); d6 += __shfl_xor(d6, o); d7 += __shfl_xor(d7, o);
    }
    if (lane < 4) {
      float di = lane == 0 ? d0 : lane == 1 ? d1 : lane == 2 ? d2 : d3;
      float df = lane == 0 ? d4 : lane == 1 ? d5 : lane == 2 ? d6 : d7;
      p.ig()[row * 4 + lane] = di + p.b_i[l * 4 + lane];
      p.lf()[row * 4 + lane] = logsigm(df + p.b_f[l * 4 + lane]);
    }
  }
}

template <typename TA>
__device__ __forceinline__ void gemm_kloop(f32x4 (&acc)[4][4], const TA* Tp, long ldt, const bf16_t* Wp, long ldw, int K, char* smem) {
  bf16_t* sT = (bf16_t*)smem;
  bf16_t* sW = sT + 2 * 9216;
  const int tid = get_tid(), lane = tid & 63, wid = tid >> 6, wr = wid >> 1, wc = wid & 1, fr = lane & 15, fq = lane >> 4;
  u32x4 rt[4], rw[4];
  const int r0 = tid >> 3, c0 = (tid & 7) * 8;
#define GLOAD(k0) _Pragma("unroll") for (int i = 0; i < 4; ++i) { rt[i] = ld8(Tp + (long)(r0 + 32 * i) * ldt + (k0) + c0); rw[i] = ld8(Wp + (long)(r0 + 32 * i) * ldw + (k0) + c0); }
#define SSTORE(buf) _Pragma("unroll") for (int i = 0; i < 4; ++i) { *(u32x4*)(sT + (buf) * 9216 + (r0 + 32 * i) * 72 + c0) = rt[i]; *(u32x4*)(sW + (buf) * 9216 + (r0 + 32 * i) * 72 + c0) = rw[i]; }
  GLOAD(0); SSTORE(0);
  __syncthreads();
  const int nk = K >> 6;
#pragma unroll 1
  for (int kt = 0; kt < nk; ++kt) {
    const int buf = kt & 1;
    if (kt + 1 < nk) { GLOAD((kt + 1) * 64); }
    const bf16_t* aT = sT + buf * 9216 + (wr * 64) * 72;
    const bf16_t* aW = sW + buf * 9216 + (wc * 64) * 72;
    wmma<4, 4, 2>(acc, aW, 72, aT, 72, fr, fq);
    if (kt + 1 < nk) { SSTORE(buf ^ 1); }
    __syncthreads();
  }
#undef GLOAD
#undef SSTORE
}
__device__ __forceinline__ void zero_acc(f32x4 (&acc)[4][4]) {
#pragma unroll
  for (int a = 0; a < 4; ++a)
#pragma unroll
    for (int b = 0; b < 4; ++b) acc[a][b] = (f32x4){0.f, 0.f, 0.f, 0.f};
}


template <int NT, int NSTAGE>
__device__ __forceinline__ void gemm_glds(f32x4 (&acc)[4][NT], const bf16_t* Tp, long ldt, const bf16_t* Wp, long ldw, int K, char* smem) {
  constexpr int TR = 2 * NT * 16, STAGE_B = (TR + 128) * 64, LT = TR / 64, LPS = LT + 2;
  static_assert(NSTAGE * STAGE_B <= SMEM_BYTES, "ring too large");
  static_assert(NSTAGE == 3 || NSTAGE == 4, "waits below are written for 3 or 4 stages");
  const int tid = get_tid(), lane = tid & 63, wid = tid >> 6, wr = wid >> 1, wc = wid & 1, fr = lane & 15, fq = lane >> 4;
  const int lr = tid >> 2, cp = tid & 3, lc = (cp ^ ((lr >> 2) & 3)) * 8;
  const bf16_t* gT = Tp + (long)lr * ldt + lc;
  const int plr = ((lr >> 5) & 1) * 32 + ((lr >> 2) & 3) * 8 + ((lr >> 4) & 1) * 4 + (lr & 3);
  const bf16_t* gW = Wp + (long)plr * ldw + lc;
  const int rd_off = fr * 64 + ((fq ^ ((fr >> 2) & 3)) * 16);
#define GL_ISSUE(kt_, slot_) do { char* sb_ = smem + (slot_) * STAGE_B + tid * 16; \
    _Pragma("unroll") for (int i_ = 0; i_ < LT; ++i_) __builtin_amdgcn_global_load_lds((const unsigned*)(gT + (long)i_ * 64 * ldt + (kt_) * 32), (__attribute__((address_space(3))) unsigned*)(sb_ + i_ * 4096), 16, 0, 0); \
    _Pragma("unroll") for (int i_ = 0; i_ < 2; ++i_) __builtin_amdgcn_global_load_lds((const unsigned*)(gW + (long)i_ * 64 * ldw + (kt_) * 32), (__attribute__((address_space(3))) unsigned*)(sb_ + TR * 64 + i_ * 4096), 16, 0, 0); } while (0)
  asm volatile("s_waitcnt vmcnt(0)" ::: "memory");
  __builtin_amdgcn_s_barrier();
  const int nk = K >> 5;
#pragma unroll
  for (int s_ = 0; s_ < NSTAGE - 1; ++s_) if (s_ < nk) GL_ISSUE(s_, s_);
  int slot = 0, islot = NSTAGE - 1;
#pragma unroll 1
  for (int kt = 0; kt < nk; ++kt) {
    const int rem = nk - 1 - kt;
    if (NSTAGE == 4) {
      if (rem >= 2) asm volatile("s_waitcnt vmcnt(%0)" ::"n"(2 * LPS) : "memory");
      else if (rem == 1) asm volatile("s_waitcnt vmcnt(%0)" ::"n"(LPS) : "memory");
      else asm volatile("s_waitcnt vmcnt(0)" ::: "memory");
    } else {
      if (rem >= 1) asm volatile("s_waitcnt vmcnt(%0)" ::"n"(LPS) : "memory");
      else asm volatile("s_waitcnt vmcnt(0)" ::: "memory");
    }
    __builtin_amdgcn_s_barrier();
    const unsigned aT = (unsigned)(uintptr_t)(smem + slot * STAGE_B + (wr * NT * 16) * 64 + rd_off);
    const unsigned aW = (unsigned)(uintptr_t)(smem + slot * STAGE_B + TR * 64 + (wc * 64) * 64 + rd_off);
    bf16x8 a[4], b[NT];
#pragma unroll
    for (int mi = 0; mi < 4; ++mi) asm volatile("ds_read_b128 %0, %1 offset:%2" : "=v"(a[mi]) : "v"(aW), "n"(mi * 1024));
#pragma unroll
    for (int ni = 0; ni < NT; ++ni) asm volatile("ds_read_b128 %0, %1 offset:%2" : "=v"(b[ni]) : "v"(aT), "n"(ni * 1024));
    if constexpr (NT == 4) asm volatile("s_waitcnt lgkmcnt(0)" : "+v"(a[0]), "+v"(a[1]), "+v"(a[2]), "+v"(a[3]), "+v"(b[0]), "+v"(b[1]), "+v"(b[2]), "+v"(b[3]));
    else asm volatile("s_waitcnt lgkmcnt(0)" : "+v"(a[0]), "+v"(a[1]), "+v"(a[2]), "+v"(a[3]), "+v"(b[0]), "+v"(b[1]), "+v"(b[2]), "+v"(b[3]), "+v"(b[4]), "+v"(b[5]), "+v"(b[6]), "+v"(b[7]));
    const bool doiss = (kt + NSTAGE - 1 < nk);
    const int ktn = kt + NSTAGE - 1;
    char* sbi = smem + islot * STAGE_B + tid * 16;
#pragma unroll
    for (int mi = 0; mi < 4; ++mi) {
#pragma unroll
      for (int ni = 0; ni < NT; ++ni) acc[mi][ni] = __builtin_amdgcn_mfma_f32_16x16x32_bf16(a[mi], b[ni], acc[mi][ni], 0, 0, 0);
      __builtin_amdgcn_sched_barrier(0);
      if (doiss) {
#pragma unroll
        for (int q = 0; q < 2; ++q) {
          const int idx = mi * 2 + q;
          if (idx < LT) __builtin_amdgcn_global_load_lds((const unsigned*)(gT + (long)idx * 64 * ldt + ktn * 32), (__attribute__((address_space(3))) unsigned*)(sbi + idx * 4096), 16, 0, 0);
          else if (idx < LPS) __builtin_amdgcn_global_load_lds((const unsigned*)(gW + (long)(idx - LT) * 64 * ldw + ktn * 32), (__attribute__((address_space(3))) unsigned*)(sbi + TR * 64 + (idx - LT) * 4096), 16, 0, 0);
        }
      }
      __builtin_amdgcn_sched_barrier(0);
    }
    slot = (slot + 1 == NSTAGE) ? 0 : slot + 1;
    islot = (islot + 1 == NSTAGE) ? 0 : islot + 1;
  }
#undef GL_ISSUE
  __syncthreads();
}

__device__ void inproj_tile(const Params& p, int l, int t, char* smem) {
  constexpr int NT = 8;
  const int tm = t / 52, tn = t % 52;
  const int tid = get_tid(), lane = tid & 63, wid = tid >> 6, wr = wid >> 1, wc = wid & 1, fr = lane & 15, fq = lane >> 4;
  f32x4 acc[4][NT];
#pragma unroll
  for (int a_ = 0; a_ < 4; ++a_)
#pragma unroll
    for (int b_ = 0; b_ < NT; ++b_) acc[a_][b_] = (f32x4){0.f, 0.f, 0.f, 0.f};
  gemm_glds<NT, 3>(acc, p.U() + (size_t)tm * (NT * 32) * 1024, 1024, p.wt_in() + (size_t)l * NWT * 1024 + (size_t)tn * 128 * 1024, 1024, 1024, smem);
  const int g = tn >> 2;
  bf16_t* dst = PRG(g);
#pragma unroll
  for (int ni = 0; ni < NT; ++ni) {
    const int row = tm * (NT * 32) + wr * (NT * 16) + ni * 16 + fr;
    const bool samp = row >= NPROMPT;
    const int rr = samp ? row - NPROMPT : row;
    const int b = samp ? (rr >> 6) : (rr >> 13), tt = samp ? (rr & 63) : (rr & 8191), T = samp ? 64 : 8192, NB = samp ? 8 : 2;
#pragma unroll
    for (int m = 0; m < 2; ++m) {
      const int cg_ = (tn & 3) * 128 + wc * 64 + m * 32 + fq * 8;
      const f32x4 v0 = acc[2 * m][ni], v1 = acc[2 * m + 1][ni];
      u32x4 pk; pk.x = pack2(v0[0], v0[1]); pk.y = pack2(v0[2], v0[3]); pk.z = pack2(v1[0], v1[1]); pk.w = pack2(v1[2], v1[3]);
      *(u32x4*)(dst + (size_t)row * 512 + cg_) = pk;
      if (g == 6 || g == 7) {
        float* o = (g == 6) ? (samp ? p.o_sk() : p.o_pk()) : (samp ? p.o_sv() : p.o_pv());
        const int hh = cg_ >> 7, d = cg_ & 127;
        float* op = o + ((size_t)((l * NB + b) * 4 + hh) * T + tt) * 128 + d;
        *(f32x4*)op = v0; *(f32x4*)(op + 4) = v1;
      } else if (g < 2) {
        if (tt >= T - 3) {
          float* o = samp ? p.o_sconv() : p.o_pconv();
          float* op = o + ((size_t)(l * NB + b) * 3 + (tt - (T - 3))) * 1024 + g * 512 + cg_;
          *(f32x4*)op = v0; *(f32x4*)(op + 4) = v1;
        }
      }
    }
  }
}

struct UnitInfo { int samp, b, h, c, rowbase, seq; };
__device__ __forceinline__ UnitInfo unit_info(int u) {
  UnitInfo i;
  if (u < 1024) { i.samp = 0; i.seq = u >> 7; i.b = i.seq >> 2; i.h = i.seq & 3; i.c = u & 127; i.rowbase = i.b * 8192 + i.c * 64; }
  else { int sq = u - 1024; i.samp = 1; i.seq = sq; i.b = sq >> 2; i.h = sq & 3; i.c = 0; i.rowbase = NPROMPT + i.b * 64; }
  return i;
}

__device__ void sb_unit(const Params& p, int l, int u, char* smem) {
  bf16_t* Qs = (bf16_t*)smem;
  bf16_t* Ks = Qs + 64 * 136;
  bf16_t* Vt = Ks + 64 * 136;
  bf16_t* Ps = Vt + 128 * 72;
  const int tid = get_tid(), lane = tid & 63, w = tid >> 6, fr = lane & 15, fq = lane >> 4;
  const UnitInfo ui = unit_info(u);
  const int nblk = ui.samp ? 65 : ui.c + 1;
  const int hc = ui.h * 128;
  __syncthreads();
  ld_tile<bf16_t>(Qs, PRG(5) + (size_t)ui.rowbase * 512 + hc, 512, tid);
  f32x4 o[8][1];
#pragma unroll
  for (int mi = 0; mi < 8; ++mi) o[mi][0] = (f32x4){0.f, 0.f, 0.f, 0.f};
  float R = 0.f;
  const int tq = 16 * w + fr;
  for (int i = nblk - 1; i >= 0; --i) {
    if (!ui.samp || i == 64) {
      const size_t krow = ui.samp ? (size_t)ui.rowbase : (size_t)ui.b * 8192 + (size_t)i * 64;
      ld_tile<bf16_t>(Ks, PRG(6) + krow * 512 + hc, 512, tid);
      ld_T<bf16_t, 64, 72>(Vt, PRG(7) + krow * 512 + hc, 512, tid);
    } else {
      const size_t off = ((size_t)((l * 8 + ui.b) * 4 + ui.h) * 4096 + (size_t)i * 64) * 128;
      ld_tile<float>(Ks, p.ck + off, 128, tid);
      ld_T<float, 64, 72>(Vt, p.cv + off, 128, tid);
    }
    __syncthreads();
    f32x4 z[4][1];
#pragma unroll
    for (int mi = 0; mi < 4; ++mi) z[mi][0] = (f32x4){0.f, 0.f, 0.f, 0.f};
    wmma<4, 1, 4>(z, Ks, 136, Qs + 16 * w * 136, 136, fr, fq);
    const bool diag = (i == nblk - 1);
    float L[4][4], lsg[4][4], G[4];
#pragma unroll
    for (int mi = 0; mi < 4; ++mi) {
      G[mi] = 0.f;
#pragma unroll
      for (int j = 0; j < 4; ++j) {
        const int kk = mi * 16 + fq * 4 + j;
        const float zz = z[mi][0][j] * 0.08838834764831845f;
        const float sp = softplus(zz);
        const bool valid = !diag || kk < tq;
        L[mi][j] = valid ? -sp : 0.f;
        lsg[mi][j] = valid ? zz - sp : -1e30f;
        G[mi] += L[mi][j];
      }
    }
    float sufm = 0.f;
#pragma unroll
    for (int mi = 3; mi >= 0; --mi) {
      const float g0 = __shfl(G[mi], fr), g1 = __shfl(G[mi], fr + 16), g2 = __shfl(G[mi], fr + 32), g3 = __shfl(G[mi], fr + 48);
      const float later = (fq < 1 ? g1 : 0.f) + (fq < 2 ? g2 : 0.f) + (fq < 3 ? g3 : 0.f);
      const float s3 = R + sufm + later, s2 = s3 + L[mi][3], s1 = s2 + L[mi][2], s0 = s1 + L[mi][1];
      const float a0 = __expf(lsg[mi][0] + s0), a1 = __expf(lsg[mi][1] + s1), a2 = __expf(lsg[mi][2] + s2), a3 = __expf(lsg[mi][3] + s3);
      u32x2 pk; pk.x = pack2(a0, a1); pk.y = pack2(a2, a3);
      *(u32x2*)(Ps + tq * 72 + mi * 16 + fq * 4) = pk;
      sufm += (g0 + g1) + (g2 + g3);
    }
    R += sufm;
    __syncthreads();
    wmma<8, 1, 2>(o, Vt, 72, Ps + 16 * w * 72, 72, fr, fq);
    if (__syncthreads_and(R < -110.f)) break;
  }
  const size_t row = (size_t)ui.rowbase + tq;
#pragma unroll
  for (int mi = 0; mi < 8; ++mi) {
    const int col = hc + mi * 16 + fq * 4;
    u32x2 zz = *(const u32x2*)(PRG(8) + row * 512 + col);
    f32x4 v = o[mi][0];
    u32x2 pk;
    pk.x = pack2(v[0] * silu(lo2f(zz.x)), v[1] * silu(hi2f(zz.x)));
    pk.y = pack2(v[2] * silu(lo2f(zz.y)), v[3] * silu(hi2f(zz.y)));
    *(u32x2*)(p.H() + (size_t)1 * NTOK * 512 + row * 512 + col) = pk;
  }
}

__device__ void mlstm_local(const Params& p, int l, int u, char* smem) {
  bf16_t* kdT = (bf16_t*)smem;
  bf16_t* vT = kdT + 128 * 72;
  bf16_t* xq = vT + 128 * 72;
  bf16_t* xk = xq + 67 * 136;
  float* dec = (float*)(xk + 67 * 136);
  const int tid = get_tid(), lane = tid & 63, w = tid >> 6, fr = lane & 15, fq = lane >> 4;
  const UnitInfo ui = unit_info(u);
  const int hc = ui.h * 128;
  __syncthreads();
  if (w == 0) {
    const float lfv = p.lf()[(ui.rowbase + lane) * 4 + ui.h], igv = p.ig()[(ui.rowbase + lane) * 4 + ui.h];
    float bs = lfv;
#pragma unroll
    for (int o = 1; o < 64; o <<= 1) { float t = __shfl_up(bs, o); if (lane >= o) bs += t; }
    const float g = igv - bs;
    float gm = g;
#pragma unroll
    for (int o = 32; o > 0; o >>= 1) gm = fmaxf(gm, __shfl_xor(gm, o));
    const float bL = __shfl(bs, 63);
    dec[lane] = __expf(g - gm);
    if (lane == 0) { p.ac()[u] = bL + gm; p.Bc()[u] = bL; }
  }
  ld_tile<bf16_t>(xq + 3 * 136, PRG(0) + (size_t)ui.rowbase * 512 + hc, 512, tid);
  ld_tile<bf16_t>(xk + 3 * 136, PRG(1) + (size_t)ui.rowbase * 512 + hc, 512, tid);
  ld_T<bf16_t, 64, 72>(vT, PRG(2) + (size_t)ui.rowbase * 512 + hc, 512, tid);
  {
    const int isk = tid >> 7, ch = tid & 127, col = hc + ch;
    bf16_t* xs = isk ? xk : xq;
    if (ui.samp) {
      const float* cs = p.st_conv + (size_t)(l * 8 + ui.b) * 3072 + isk * 512 + col;
      xs[ch] = f2bf(cs[0]); xs[136 + ch] = f2bf(cs[1024]); xs[272 + ch] = f2bf(cs[2048]);
    } else if (ui.c > 0) {
      const bf16_t* src = PRG(isk) + (size_t)ui.rowbase * 512 + col;
      xs[ch] = src[-3 * 512]; xs[136 + ch] = src[-2 * 512]; xs[272 + ch] = src[-1 * 512];
    } else { xs[ch] = 0; xs[136 + ch] = 0; xs[272 + ch] = 0; }
  }
  __syncthreads();
  {
    const int isk = tid >> 7, ch = tid & 127, col = hc + ch;
    bf16_t* xs = isk ? xk : xq;
    const float* wc_ = p.w_conv + (size_t)l * 4096 + isk * 512 + col;
    const float w0 = wc_[0], w1 = wc_[1024], w2 = wc_[2048], w3 = wc_[3072];
    float x0 = bf2f(xs[ch]), x1 = bf2f(xs[136 + ch]), x2 = bf2f(xs[272 + ch]);
#pragma unroll 8
    for (int t = 0; t < 64; ++t) {
      const float x3 = bf2f(xs[(t + 3) * 136 + ch]);
      float y = silu(w0 * x0 + w1 * x1 + w2 * x2 + w3 * x3);
      if (isk) y *= 0.08838834764831845f;
      const bf16_t yb = f2bf(y);
      xs[t * 136 + ch] = yb;
      if (isk) kdT[ch * 72 + t] = f2bf(bf2f(yb) * dec[t]);
      x0 = x1; x1 = x2; x2 = x3;
    }
  }
  __syncthreads();
#pragma unroll
  for (int i = 0; i < 4; ++i) {
    const int id = tid + 256 * i, r = id >> 4, c = (id & 15) * 8;
    *(u32x4*)(p.QC() + (size_t)(ui.rowbase + r) * 512 + hc + c) = *(const u32x4*)(xq + r * 136 + c);
    *(u32x4*)(p.KC() + (size_t)(ui.rowbase + r) * 512 + hc + c) = *(const u32x4*)(xk + r * 136 + c);
  }
  if (tid < 128) { float s_ = 0.f;
#pragma unroll 8
    for (int t = 0; t < 64; ++t) s_ += bf2f(kdT[tid * 72 + t]); p.nloc()[u * 128 + tid] = s_; }
  f32x4 acc[8][2];
#pragma unroll
  for (int a_ = 0; a_ < 8; ++a_) { acc[a_][0] = (f32x4){0.f, 0.f, 0.f, 0.f}; acc[a_][1] = (f32x4){0.f, 0.f, 0.f, 0.f}; }
  wmma<8, 2, 2>(acc, kdT, 72, vT + 32 * w * 72, 72, fr, fq);
  bf16_t* sm = p.SM() + (size_t)u * 16384;
#pragma unroll
  for (int mi = 0; mi < 8; ++mi)
#pragma unroll
    for (int ni = 0; ni < 2; ++ni) {
      u32x2 pk; pk.x = pack2(acc[mi][ni][0], acc[mi][ni][1]); pk.y = pack2(acc[mi][ni][2], acc[mi][ni][3]);
      *(u32x2*)(sm + (32 * w + ni * 16 + fr) * 128 + mi * 16 + fq * 4) = pk;
    }
}

__device__ __forceinline__ float hgrn_lb(const Params& p, int l, int ch512) {
  if (l == 0) return 0.f;
  return sigm(p.lb_logits[512 + ch512] - p.lb_logits[ch512]);
}
__device__ __forceinline__ void hgrn_gate(float f, float lb, float& lg, float& kh) {
  const float e = __expf(-fabsf(f));
  const float sp = f >= 0.f ? 1.f / (1.f + e) : e / (1.f + e);
  const float sn = f >= 0.f ? e / (1.f + e) : 1.f / (1.f + e);
  lg = (lb == 0.f) ? (fminf(f, 0.f) - __logf(1.f + e)) : __logf(lb + (1.f - lb) * sp);
  kh = (1.f - lb) * sn;
}

__device__ void hgrn_local(const Params& p, int l, int u, char* smem) {
  bf16_t* kdT = (bf16_t*)smem;
  bf16_t* iT = kdT + 128 * 72;
  bf16_t* fs = iT + 128 * 72;
  float* tot = (float*)(fs + 64 * 136);
  const int tid = get_tid(), lane = tid & 63, w = tid >> 6, fr = lane & 15, fq = lane >> 4;
  const UnitInfo ui = unit_info(u);
  const int hc = ui.h * 128;
  __syncthreads();
  ld_tile<bf16_t>(fs, PRG(10) + (size_t)ui.rowbase * 512 + hc, 512, tid);
  ld_T<bf16_t, 64, 72>(iT, PRG(11) + (size_t)ui.rowbase * 512 + hc, 512, tid);
  const int half = tid >> 7, ch = tid & 127;
  const float lb = hgrn_lb(p, l, hc + ch);
  __syncthreads();
  const bf16_t* src = fs + (half * 32) * 136 + ch;
  {
    float run = 0.f;
#pragma unroll 8
    for (int t = 0; t < 32; ++t) { float lg, kh; hgrn_gate(bf2f(src[t * 136]), lb, lg, kh); run += lg; }
    tot[half * 128 + ch] = run;
  }
  __syncthreads();
  {
    const float t0 = tot[ch], t1 = tot[128 + ch];
    const float bcL = t0 + t1;
    float run = half ? t0 : 0.f;
#pragma unroll 8
    for (int t = 0; t < 32; ++t) {
      float lg, kh; hgrn_gate(bf2f(src[t * 136]), lb, lg, kh); run += lg;
      kdT[ch * 72 + half * 32 + t] = f2bf(kh * __expf(bcL - run));
    }
    if (half == 0) p.hbc()[u * 128 + ch] = bcL;
  }
  __syncthreads();
  f32x4 acc[8][2];
#pragma unroll
  for (int a_ = 0; a_ < 8; ++a_) { acc[a_][0] = (f32x4){0.f, 0.f, 0.f, 0.f}; acc[a_][1] = (f32x4){0.f, 0.f, 0.f, 0.f}; }
  wmma<8, 2, 2>(acc, kdT, 72, iT + 32 * w * 72, 72, fr, fq);
  bf16_t* sh = p.SH() + (size_t)u * 16384;
#pragma unroll
  for (int mi = 0; mi < 8; ++mi)
#pragma unroll
    for (int ni = 0; ni < 2; ++ni) {
      u32x2 pk; pk.x = pack2(acc[mi][ni][0], acc[mi][ni][1]); pk.y = pack2(acc[mi][ni][2], acc[mi][ni][3]);
      *(u32x2*)(sh + (32 * w + ni * 16 + fr) * 128 + mi * 16 + fq * 4) = pk;
    }
}

__device__ void scan_phase(const Params& p, int l, char* smem) {
  float* cdc = (float*)smem;
  float* cwl = cdc + 128;
  float* cmi = cwl + 128;
  const int tid = get_tid();
  for (int vb = blockIdx.x; vb < 520; vb += gridDim.x) {
    const int kind = vb >> 8;
    const int seq = (kind == 2) ? (vb - 512) : ((vb >> 5) & 7);
    __syncthreads();
    if (kind != 1) {
      if (tid < 128) { cdc[tid] = p.ac()[seq * 128 + tid]; cwl[tid] = p.Bc()[seq * 128 + tid]; }
      __syncthreads();
      if (tid == 0) {
        float m = 0.f;
        for (int c = 0; c < 128; ++c) {
          const float a = cdc[c], B = cwl[c];
          const float mo = fmaxf(a, B + m);
          cdc[c] = __expf(B + m - mo); cwl[c] = __expf(a - mo); cmi[c] = m; m = mo;
        }
        if (kind == 0 && (vb & 31) == 0) p.o_pm()[l * 8 + seq] = m;
      }
      __syncthreads();
      if (kind == 0 && (vb & 31) == 0 && tid < 128) p.min_()[seq * 128 + tid] = cmi[tid];
    }
    if (kind == 2) {
      if (tid < 128) {
        float n = 0.f;
        float* base = p.nloc() + (size_t)seq * 128 * 128 + tid;
        for (int c0 = 0; c0 < 128; c0 += 16) {
          float lv[16];
#pragma unroll
          for (int j = 0; j < 16; ++j) lv[j] = base[(c0 + j) * 128];
#pragma unroll
          for (int j = 0; j < 16; ++j) { const float nl = lv[j]; lv[j] = n; n = cdc[c0 + j] * n + cwl[c0 + j] * nl; }
#pragma unroll
          for (int j = 0; j < 16; ++j) base[(c0 + j) * 128] = lv[j];
        }
        p.o_pn()[(l * 8 + seq) * 128 + tid] = n;
      }
      continue;
    }
    const int pr = (vb & 31) * 256 + tid, e = pr * 2, er = e >> 7, ec = e & 127;
    unsigned* base = (unsigned*)((kind ? p.SH() : p.SM()) + (size_t)seq * 128 * 16384) + pr;
    const float* hb = p.hbc() + (size_t)seq * 128 * 128 + ec;
    float c0v = 0.f, c1v = 0.f;
    unsigned lv[16], nx[16];
    float2 hv[16], hn[16];
#pragma unroll
    for (int j = 0; j < 16; ++j) { nx[j] = base[(size_t)j * 8192]; hn[j] = kind ? *(const float2*)(hb + j * 128) : make_float2(0.f, 0.f); }
    for (int c0 = 0; c0 < 128; c0 += 16) {
#pragma unroll
      for (int j = 0; j < 16; ++j) { lv[j] = nx[j]; hv[j] = hn[j]; }
      if (c0 + 16 < 128) {
#pragma unroll
        for (int j = 0; j < 16; ++j) { nx[j] = base[(size_t)(c0 + 16 + j) * 8192]; if (kind) hn[j] = *(const float2*)(hb + (c0 + 16 + j) * 128); }
      }
#pragma unroll
      for (int j = 0; j < 16; ++j) {
        const unsigned v = lv[j];
        lv[j] = pack2(c0v, c1v);
        const float d0 = kind ? __expf(hv[j].x) : cdc[c0 + j];
        const float d1 = kind ? __expf(hv[j].y) : d0;
        const float wl = kind ? 1.f : cwl[c0 + j];
        c0v = d0 * c0v + wl * lo2f(v); c1v = d1 * c1v + wl * hi2f(v);
      }
#pragma unroll
      for (int j = 0; j < 16; ++j) base[(size_t)(c0 + j) * 8192] = lv[j];
    }
    float* o = (kind ? p.o_pS() : p.o_pC()) + (size_t)(l * 8 + seq) * 16384;
    o[ec * 128 + er] = c0v; o[(ec + 1) * 128 + er] = c1v;
  }
  const int gt = blockIdx.x * 256 + tid, nth = gridDim.x * 256;
  for (int it = gt; it < 524288; it += nth) {
    const int kind = it >> 18, sq = (it >> 13) & 31, pr = it & 8191, e = pr * 2, u = 1024 + sq, er = e >> 7, ec = e & 127;
    if (kind == 0) {
      const float* c0p = p.st_C + (size_t)(l * 32 + sq) * 16384;
      const float C0 = c0p[ec * 128 + er], C1 = c0p[(ec + 1) * 128 + er], m = p.st_m[l * 32 + sq];
      unsigned* slot = (unsigned*)(p.SM() + (size_t)u * 16384) + pr;
      const unsigned lv = *slot;
      const float a = p.ac()[u], B = p.Bc()[u];
      const float mo = fmaxf(a, B + m), dc = __expf(B + m - mo), wl = __expf(a - mo);
      *slot = pack2(C0, C1);
      float* o = p.o_sC() + (size_t)(l * 32 + sq) * 16384;
      o[ec * 128 + er] = dc * C0 + wl * lo2f(lv); o[(ec + 1) * 128 + er] = dc * C1 + wl * hi2f(lv);
      if (pr == 0) { p.min_()[u] = m; p.o_sm()[l * 32 + sq] = mo; }
    } else {
      const float* s0p = p.st_S + (size_t)(l * 32 + sq) * 16384;
      const float S0 = s0p[ec * 128 + er], S1 = s0p[(ec + 1) * 128 + er];
      unsigned* slot = (unsigned*)(p.SH() + (size_t)u * 16384) + pr;
      const unsigned lv = *slot;
      const float d0 = __expf(p.hbc()[u * 128 + ec]), d1 = __expf(p.hbc()[u * 128 + ec + 1]);
      *slot = pack2(S0, S1);
      float* o = p.o_sS() + (size_t)(l * 32 + sq) * 16384;
      o[ec * 128 + er] = d0 * S0 + lo2f(lv); o[(ec + 1) * 128 + er] = d1 * S1 + hi2f(lv);
    }
  }
  for (int it = gt; it < 4096; it += nth) {
    const int sq = it >> 7, d = it & 127, u = 1024 + sq;
    const float n0 = p.st_n[(l * 32 + sq) * 128 + d], m = p.st_m[l * 32 + sq];
    const float a = p.ac()[u], B = p.Bc()[u];
    const float mo = fmaxf(a, B + m), dc = __expf(B + m - mo), wl = __expf(a - mo);
    const float nl = p.nloc()[u * 128 + d];
    p.nloc()[u * 128 + d] = n0;
    p.o_sn()[(l * 32 + sq) * 128 + d] = dc * n0 + wl * nl;
  }
}

__device__ void mlstm_out(const Params& p, int l, int u, char* smem) {
  bf16_t* Qs = (bf16_t*)smem;
  bf16_t* CT = Qs + 64 * 136;
  bf16_t* Ks = CT;
  bf16_t* Vt = Ks + 64 * 136;
  bf16_t* Ps = Vt + 144 * 72;
  float* misc = (float*)(smem + 17408 + 47360);
  float *bsum = misc, *gs = misc + 64, *mt = misc + 128, *wint = misc + 192;
  const int tid = get_tid(), lane = tid & 63, w = tid >> 6, fr = lane & 15, fq = lane >> 4;
  const UnitInfo ui = unit_info(u);
  const int hc = ui.h * 128;
  __syncthreads();
  if (w == 0) {
    const float lfv = p.lf()[(ui.rowbase + lane) * 4 + ui.h], igv = p.ig()[(ui.rowbase + lane) * 4 + ui.h];
    float bs = lfv;
#pragma unroll
    for (int o = 1; o < 64; o <<= 1) { float t = __shfl_up(bs, o); if (lane >= o) bs += t; }
    const float g = igv - bs;
    float cm = g;
#pragma unroll
    for (int o = 1; o < 64; o <<= 1) { float t = __shfl_up(cm, o); if (lane >= o) cm = fmaxf(cm, t); }
    const float m_in = p.min_()[u];
    const float mtt = bs + fmaxf(cm, m_in);
    bsum[lane] = bs; gs[lane] = g; mt[lane] = mtt; wint[lane] = __expf(bs + m_in - mtt);
  }
  ld_tile<bf16_t>(Qs, p.QC() + (size_t)ui.rowbase * 512 + hc, 512, tid);
  ld_tile128<bf16_t>(CT, p.SM() + (size_t)u * 16384, 128, tid);
  if (tid < 128) CT[128 * 136 + tid] = f2bf(p.nloc()[u * 128 + tid]);
  for (int i = tid; i < 15 * 128; i += 256) CT[(129 + (i >> 7)) * 136 + (i & 127)] = 0;
  __syncthreads();
  f32x4 acc[9][1];
#pragma unroll
  for (int mi = 0; mi < 9; ++mi) acc[mi][0] = (f32x4){0.f, 0.f, 0.f, 0.f};
  wmma<9, 1, 4>(acc, CT, 136, Qs + 16 * w * 136, 136, fr, fq);
  const int t = 16 * w + fr;
  const float wi = wint[t];
#pragma unroll
  for (int mi = 0; mi < 9; ++mi) acc[mi][0] *= wi;
  __syncthreads();
  ld_tile<bf16_t>(Ks, p.KC() + (size_t)ui.rowbase * 512 + hc, 512, tid);
  ld_T<bf16_t, 64, 72>(Vt, PRG(2) + (size_t)ui.rowbase * 512 + hc, 512, tid);
  if (tid < 64) Vt[128 * 72 + tid] = 0x3F80;
  for (int i = tid; i < 15 * 64; i += 256) Vt[(129 + (i >> 6)) * 72 + (i & 63)] = 0;
  __syncthreads();
  f32x4 st[4][1];
#pragma unroll
  for (int mi = 0; mi < 4; ++mi) st[mi][0] = (f32x4){0.f, 0.f, 0.f, 0.f};
  wmma<4, 1, 4>(st, Ks, 136, Qs + 16 * w * 136, 136, fr, fq);
  const float bt = bsum[t], mtt = mt[t];
#pragma unroll
  for (int mi = 0; mi < 4; ++mi) {
    float a[4];
#pragma unroll
    for (int j = 0; j < 4; ++j) {
      const int s = mi * 16 + fq * 4 + j;
      a[j] = (s <= t) ? st[mi][0][j] * __expf(bt + gs[s] - mtt) : 0.f;
    }
    u32x2 pk; pk.x = pack2(a[0], a[1]); pk.y = pack2(a[2], a[3]);
    *(u32x2*)(Ps + t * 72 + mi * 16 + fq * 4) = pk;
  }
  __syncthreads();
  wmma<9, 1, 2>(acc, Vt, 72, Ps + 16 * w * 72, 72, fr, fq);
  const float den = __shfl(acc[8][0][0], fr);
  const float inv = 1.f / fmaxf(fabsf(den), __expf(-mtt));
  float ss = 0.f;
#pragma unroll
  for (int mi = 0; mi < 8; ++mi) { acc[mi][0] *= inv; ss += acc[mi][0][0] * acc[mi][0][0] + acc[mi][0][1] * acc[mi][0][1] + acc[mi][0][2] * acc[mi][0][2] + acc[mi][0][3] * acc[mi][0][3]; }
  ss += __shfl_xor(ss, 16); ss += __shfl_xor(ss, 32);
  const float rs = rsqrtf(ss * (1.f / 128.f) + 1e-6f);
  const size_t row = (size_t)ui.rowbase + t;
#pragma unroll
  for (int mi = 0; mi < 8; ++mi) {
    const int col = hc + mi * 16 + fq * 4;
    const u32x2 ov = *(const u32x2*)(PRG(3) + row * 512 + col);
    const u32x2 zv = *(const u32x2*)(PRG(4) + row * 512 + col);
    const float4 g = *(const float4*)(p.g_ml + l * 512 + col);
    const f32x4 v = acc[mi][0];
    u32x2 pk;
    pk.x = pack2(v[0] * rs * g.x * sigm(lo2f(ov.x)) * silu(lo2f(zv.x)), v[1] * rs * g.y * sigm(hi2f(ov.x)) * silu(hi2f(zv.x)));
    pk.y = pack2(v[2] * rs * g.z * sigm(lo2f(ov.y)) * silu(lo2f(zv.y)), v[3] * rs * g.w * sigm(hi2f(ov.y)) * silu(hi2f(zv.y)));
    *(u32x2*)(p.H() + row * 512 + col) = pk;
  }
}

__device__ __forceinline__ bf16x8 scale_frag(const bf16_t* src, const float* ea, const float* eb, float sgn, bool clampit) {
  u32x4 raw = *(const u32x4*)src;
  float4 a0 = *(const float4*)ea, a1 = *(const float4*)(ea + 4);
  float4 b0 = {0.f, 0.f, 0.f, 0.f}, b1 = {0.f, 0.f, 0.f, 0.f};
  if (eb) { b0 = *(const float4*)eb; b1 = *(const float4*)(eb + 4); }
  float e[8] = {a0.x - b0.x, a0.y - b0.y, a0.z - b0.z, a0.w - b0.w, a1.x - b1.x, a1.y - b1.y, a1.z - b1.z, a1.w - b1.w};
  float v[8] = {lo2f(raw.x), hi2f(raw.x), lo2f(raw.y), hi2f(raw.y), lo2f(raw.z), hi2f(raw.z), lo2f(raw.w), hi2f(raw.w)};
  unsigned o[4];
#pragma unroll
  for (int i = 0; i < 4; ++i) {
    float x0 = sgn * e[2 * i], x1 = sgn * e[2 * i + 1];
    if (clampit) { x0 = fminf(x0, 80.f); x1 = fminf(x1, 80.f); }
    o[i] = pack2(v[2 * i] * __expf(x0), v[2 * i + 1] * __expf(x1));
  }
  u32x4 r = {o[0], o[1], o[2], o[3]};
  return __builtin_bit_cast(bf16x8, r);
}

__device__ void hgrn_out(const Params& p, int l, int u, char* smem) {
  float* bc = (float*)smem;
  bf16_t* ST = (bf16_t*)smem;
  bf16_t* qs = (bf16_t*)(smem + 34816);
  bf16_t* kh = (bf16_t*)(smem + 34816 + 17408);
  bf16_t* iT = kh;
  bf16_t* Ps = (bf16_t*)(smem + 34816 + 17408 + 18432);
  float* tot = (float*)(smem + 79872);
  const int tid = get_tid(), lane = tid & 63, w = tid >> 6, fr = lane & 15, fq = lane >> 4;
  const UnitInfo ui = unit_info(u);
  const int hc = ui.h * 128;
  __syncthreads();
  ld_tile<bf16_t>(qs, PRG(9) + (size_t)ui.rowbase * 512 + hc, 512, tid);
  ld_tile<bf16_t>(kh, PRG(10) + (size_t)ui.rowbase * 512 + hc, 512, tid);
  __syncthreads();
  {
    const int half = tid >> 7, ch = tid & 127;
    const float lb = hgrn_lb(p, l, hc + ch);
    bf16_t* src = kh + (half * 32) * 136 + ch;
    float run = 0.f;
#pragma unroll 8
    for (int t = 0; t < 32; ++t) { float lg, k; hgrn_gate(bf2f(src[t * 136]), lb, lg, k); run += lg; }
    tot[half * 128 + ch] = run;
    __syncthreads();
    run = half ? tot[ch] : 0.f;
#pragma unroll 8
    for (int t = 0; t < 32; ++t) {
      float lg, k; hgrn_gate(bf2f(src[t * 136]), lb, lg, k); run += lg;
      bc[(half * 32 + t) * 132 + ch] = run;
      src[t * 136] = f2bf(k);
    }
  }
  __syncthreads();
  {
    const int I = w, t = 16 * I + fr;
    f32x4 a[4];
#pragma unroll
    for (int J = 0; J < 4; ++J) a[J] = (f32x4){0.f, 0.f, 0.f, 0.f};
#pragma unroll
    for (int kk = 0; kk < 4; ++kk) {
      const int c0 = kk * 32 + fq * 8;
      const float* rI = (I > 0) ? bc + (16 * I - 1) * 132 + c0 : nullptr;
      const bf16x8 bq = scale_frag(qs + t * 136 + c0, bc + t * 132 + c0, rI, 1.f, false);
#pragma unroll
      for (int J = 0; J < 4; ++J) {
        if (J <= I) {
          const int s = 16 * J + fr;
          const bf16x8 ak = scale_frag(kh + s * 136 + c0, bc + s * 132 + c0, rI, -1.f, true);
          a[J] = __builtin_amdgcn_mfma_f32_16x16x32_bf16(ak, bq, a[J], 0, 0, 0);
        }
      }
    }
#pragma unroll
    for (int J = 0; J < 4; ++J) {
      float v[4];
#pragma unroll
      for (int j = 0; j < 4; ++j) { const int s = 16 * J + fq * 4 + j; v[j] = (s <= t) ? a[J][j] : 0.f; }
      u32x2 pk; pk.x = pack2(v[0], v[1]); pk.y = pack2(v[2], v[3]);
      *(u32x2*)(Ps + t * 72 + J * 16 + fq * 4) = pk;
    }
  }
  __syncthreads();
#pragma unroll 4
  for (int i = tid; i < 64 * 128; i += 256) { const int t = i >> 7, c = i & 127; qs[t * 136 + c] = f2bf(bf2f(qs[t * 136 + c]) * __expf(bc[t * 132 + c])); }
  __syncthreads();
  ld_T<bf16_t, 64, 72>(iT, PRG(11) + (size_t)ui.rowbase * 512 + hc, 512, tid);
  ld_tile128<bf16_t>(ST, p.SH() + (size_t)u * 16384, 128, tid);
  __syncthreads();
  f32x4 acc[8][1];
#pragma unroll
  for (int mi = 0; mi < 8; ++mi) acc[mi][0] = (f32x4){0.f, 0.f, 0.f, 0.f};
  wmma<8, 1, 2>(acc, iT, 72, Ps + 16 * w * 72, 72, fr, fq);
  wmma<8, 1, 4>(acc, ST, 136, qs + 16 * w * 136, 136, fr, fq);
  float ss = 0.f;
#pragma unroll
  for (int mi = 0; mi < 8; ++mi) ss += acc[mi][0][0] * acc[mi][0][0] + acc[mi][0][1] * acc[mi][0][1] + acc[mi][0][2] * acc[mi][0][2] + acc[mi][0][3] * acc[mi][0][3];
  ss += __shfl_xor(ss, 16); ss += __shfl_xor(ss, 32);
  const float rs = rsqrtf(ss * (1.f / 128.f) + 1e-6f);
  const size_t row = (size_t)ui.rowbase + 16 * w + fr;
#pragma unroll
  for (int mi = 0; mi < 8; ++mi) {
    const int col = hc + mi * 16 + fq * 4;
    const u32x2 zv = *(const u32x2*)(PRG(12) + row * 512 + col);
    const float4 g = *(const float4*)(p.g_hg + l * 512 + col);
    const f32x4 v = acc[mi][0];
    u32x2 pk;
    pk.x = pack2(v[0] * rs * g.x * silu(lo2f(zv.x)), v[1] * rs * g.y * silu(hi2f(zv.x)));
    pk.y = pack2(v[2] * rs * g.z * silu(lo2f(zv.y)), v[3] * rs * g.w * silu(hi2f(zv.y)));
    *(u32x2*)(p.H() + (size_t)2 * NTOK * 512 + row * 512 + col) = pk;
  }
}

__device__ void merge_tile(const Params& p, int l, int t, char* smem) {
  const int tm = t >> 3, tn = t & 7;
  const int tid = get_tid(), lane = tid & 63, wid = tid >> 6, wr = wid >> 1, wc = wid & 1, fr = lane & 15, fq = lane >> 4;
#pragma unroll 1
  for (int b = 0; b < 3; ++b) {
    f32x4 acc[4][4]; zero_acc(acc);
    gemm_kloop<bf16_t>(acc, p.U() + (size_t)tm * 128 * 1024, 1024, p.wt_in() + (size_t)l * NWT * 1024 + (size_t)(NMAIN + b * 1024 + tn * 128) * 1024, 1024, 1024, smem);
#pragma unroll
    for (int ni = 0; ni < 4; ++ni)
#pragma unroll
      for (int mi = 0; mi < 4; ++mi) {
        f32x4 v; v[0] = sigm(acc[mi][ni][0]); v[1] = sigm(acc[mi][ni][1]); v[2] = sigm(acc[mi][ni][2]); v[3] = sigm(acc[mi][ni][3]);
        *(f32x4*)(p.r() + ((size_t)tm * 128 + wr * 64 + ni * 16 + fr) * 1024 + tn * 128 + wc * 64 + mi * 16 + fq * 4) = v;
      }
    zero_acc(acc);
    gemm_kloop<bf16_t>(acc, p.H() + (size_t)b * NTOK * 512 + (size_t)tm * 128 * 512, 512, p.wt_br() + (size_t)(l * 3 + b) * 1024 * 512 + (size_t)tn * 128 * 512, 512, 512, smem);
#pragma unroll
    for (int ni = 0; ni < 4; ++ni) {
      const size_t row = (size_t)tm * 128 + wr * 64 + ni * 16 + fr;
#pragma unroll
      for (int mi = 0; mi < 4; ++mi) {
        const int col = tn * 128 + wc * 64 + mi * 16 + fq * 4;
        f32x4 v = *(const f32x4*)(p.r() + row * 1024 + col) * acc[mi][ni];
        float* part = p.y() + row * 1024 + col;
        if (b > 0) v += *(const f32x4*)part;
        if (b < 2) *(f32x4*)part = v;
        else { u32x2 pk; pk.x = pack2(v[0], v[1]); pk.y = pack2(v[2], v[3]); *(u32x2*)(p.merged() + row * 1024 + col) = pk; }
      }
    }
  }
}

__device__ void outproj_tile(const Params& p, int l, int t, char* smem) {
  const int tm = t >> 3, tn = t & 7;
  const int tid = get_tid(), lane = tid & 63, wid = tid >> 6, wr = wid >> 1, wc = wid & 1, fr = lane & 15, fq = lane >> 4;
  f32x4 acc[4][4]; zero_acc(acc);
  gemm_kloop<bf16_t>(acc, p.merged() + (size_t)tm * 128 * 1024, 1024, p.wt_out() + (size_t)l * 1048576 + (size_t)tn * 128 * 1024, 1024, 1024, smem);
#pragma unroll
  for (int ni = 0; ni < 4; ++ni) {
    const size_t row = (size_t)tm * 128 + wr * 64 + ni * 16 + fr;
#pragma unroll
    for (int mi = 0; mi < 4; ++mi) *(f32x4*)(p.y() + row * 1024 + tn * 128 + wc * 64 + mi * 16 + fq * 4) = acc[mi][ni];
  }
}


__device__ void outproj_tile256(const Params& p, int l, int t, char* smem) {
  constexpr int NT = 8;
  const int tm = t >> 3, tn = t & 7;
  const int tid = get_tid(), lane = tid & 63, wid = tid >> 6, wr = wid >> 1, wc = wid & 1, fr = lane & 15, fq = lane >> 4;
  f32x4 acc[4][NT];
#pragma unroll
  for (int a_ = 0; a_ < 4; ++a_)
#pragma unroll
    for (int b_ = 0; b_ < NT; ++b_) acc[a_][b_] = (f32x4){0.f, 0.f, 0.f, 0.f};
  gemm_glds<NT, 3>(acc, p.merged() + (size_t)tm * 256 * 1024, 1024, p.wt_out() + (size_t)l * 1048576 + (size_t)tn * 128 * 1024, 1024, 1024, smem);
#pragma unroll
  for (int ni = 0; ni < NT; ++ni) {
    const size_t row = (size_t)tm * 256 + wr * 128 + ni * 16 + fr;
#pragma unroll
    for (int m = 0; m < 2; ++m) {
      float* op = p.y() + row * 1024 + tn * 128 + wc * 64 + m * 32 + fq * 8;
      *(f32x4*)op = acc[2 * m][ni]; *(f32x4*)(op + 4) = acc[2 * m + 1][ni];
    }
  }
}


__device__ void gate_tile256(const Params& p, int l, int t, char* smem) {
  constexpr int NT = 8;
  const int tm = t / 24, tn = t % 24;
  const int tid = get_tid(), lane = tid & 63, wid = tid >> 6, wr = wid >> 1, wc = wid & 1, fr = lane & 15, fq = lane >> 4;
  f32x4 acc[4][NT];
#pragma unroll
  for (int a_ = 0; a_ < 4; ++a_)
#pragma unroll
    for (int b_ = 0; b_ < NT; ++b_) acc[a_][b_] = (f32x4){0.f, 0.f, 0.f, 0.f};
  gemm_glds<NT, 3>(acc, p.U() + (size_t)tm * 256 * 1024, 1024, p.wt_in() + (size_t)l * NWT * 1024 + (size_t)(NMAIN + tn * 128) * 1024, 1024, 1024, smem);
#pragma unroll
  for (int ni = 0; ni < NT; ++ni) {
    const size_t row = (size_t)tm * 256 + wr * 128 + ni * 16 + fr;
#pragma unroll
    for (int m = 0; m < 2; ++m) {
      const f32x4 v0 = acc[2 * m][ni], v1 = acc[2 * m + 1][ni];
      u32x4 pk; pk.x = pack2(sigm(v0[0]), sigm(v0[1])); pk.y = pack2(sigm(v0[2]), sigm(v0[3])); pk.z = pack2(sigm(v1[0]), sigm(v1[1])); pk.w = pack2(sigm(v1[2]), sigm(v1[3]));
      *(u32x4*)(p.Gb(tn >> 3) + row * 1024 + (tn & 7) * 128 + wc * 64 + m * 32 + fq * 8) = pk;
    }
  }
}
__device__ void merge_tile_g(const Params& p, int l, int t, char* smem) {
  const int tm = t >> 3, tn = t & 7;
  const int tid = get_tid(), lane = tid & 63, wid = tid >> 6, wr = wid >> 1, wc = wid & 1, fr = lane & 15, fq = lane >> 4;
  f32x4 macc[4][4]; zero_acc(macc);
#pragma unroll 1
  for (int b = 0; b < 3; ++b) {
    f32x4 acc[4][4]; zero_acc(acc);
    gemm_kloop<bf16_t>(acc, p.H() + (size_t)b * NTOK * 512 + (size_t)tm * 128 * 512, 512, p.wt_br() + (size_t)(l * 3 + b) * 1024 * 512 + (size_t)tn * 128 * 512, 512, 512, smem);
#pragma unroll
    for (int ni = 0; ni < 4; ++ni) {
      const size_t row = (size_t)tm * 128 + wr * 64 + ni * 16 + fr;
#pragma unroll
      for (int mi = 0; mi < 4; ++mi) {
        const u32x2 g = *(const u32x2*)(p.Gb(b) + row * 1024 + tn * 128 + wc * 64 + mi * 16 + fq * 4);
        macc[mi][ni][0] += lo2f(g.x) * acc[mi][ni][0]; macc[mi][ni][1] += hi2f(g.x) * acc[mi][ni][1];
        macc[mi][ni][2] += lo2f(g.y) * acc[mi][ni][2]; macc[mi][ni][3] += hi2f(g.y) * acc[mi][ni][3];
      }
    }
  }
#pragma unroll
  for (int ni = 0; ni < 4; ++ni) {
    const size_t row = (size_t)tm * 128 + wr * 64 + ni * 16 + fr;
#pragma unroll
    for (int mi = 0; mi < 4; ++mi) {
      u32x2 pk; pk.x = pack2(macc[mi][ni][0], macc[mi][ni][1]); pk.y = pack2(macc[mi][ni][2], macc[mi][ni][3]);
      *(u32x2*)(p.merged() + row * 1024 + tn * 128 + wc * 64 + mi * 16 + fq * 4) = pk;
    }
  }
}

__device__ void postnorm_phase(const Params& p, int l) {
  const int lane = threadIdx.x & 63, wid = threadIdx.x >> 6;
  const float* gp = p.g_post + l * 1024;
  for (int row = blockIdx.x * 4 + wid; row < NTOK; row += gridDim.x * 4) {
    const float* x = xrow(p, l, row);
    const float* y = p.y() + (size_t)row * 1024;
    float4 v[4]; float ss = 0.f;
#pragma unroll
    for (int i = 0; i < 4; ++i) { v[i] = *(const float4*)(y + i * 256 + lane * 4); ss += v[i].x * v[i].x + v[i].y * v[i].y + v[i].z * v[i].z + v[i].w * v[i].w; }
#pragma unroll
    for (int o = 32; o > 0; o >>= 1) ss += __shfl_xor(ss, o);
    const float rstd = rsqrtf(ss * (1.f / 1024.f) + 1e-6f);
#pragma unroll
    for (int i = 0; i < 4; ++i) {
      const int k = i * 256 + lane * 4;
      const float4 g = *(const float4*)(gp + k), xv = *(const float4*)(x + k);
      float4 r; r.x = xv.x + v[i].x * rstd * g.x; r.y = xv.y + v[i].y * rstd * g.y; r.z = xv.z + v[i].z * rstd * g.z; r.w = xv.w + v[i].w * rstd * g.w;
      *(float4*)(p.r() + (size_t)row * 1024 + k) = r;
      u32x2 pk; pk.x = pack2(r.x, r.y); pk.y = pack2(r.z, r.w);
      *(u32x2*)(p.rb() + (size_t)row * 1024 + k) = pk;
    }
  }
}

__device__ void ple_tile(const Params& p, int l, int t, char* smem) {
  const int tm = t >> 3, tn = t & 7;
  const int tid = get_tid(), lane = tid & 63, wid = tid >> 6, wr = wid >> 1, wc = wid & 1, fr = lane & 15, fq = lane >> 4;
  f32x4 acc[4][4]; zero_acc(acc);
  const int row0 = tm * 128;
  const float* pp = row0 < NPROMPT ? p.p_p + ((size_t)l * NPROMPT + row0) * 256 : p.p_s + ((size_t)l * 512 + (row0 - NPROMPT)) * 256;
  gemm_kloop<float>(acc, pp, 256, p.wt_pp() + (size_t)l * 262144 + (size_t)tn * 128 * 256, 256, 256, smem);
  u32x2 pb[4][4];
#pragma unroll
  for (int a = 0; a < 4; ++a)
#pragma unroll
    for (int c = 0; c < 4; ++c) { pb[a][c].x = pack2(acc[a][c][0], acc[a][c][1]); pb[a][c].y = pack2(acc[a][c][2], acc[a][c][3]); }
  zero_acc(acc);
  gemm_kloop<bf16_t>(acc, p.rb() + (size_t)tm * 128 * 1024, 1024, p.wt_pg() + (size_t)l * 1048576 + (size_t)tn * 128 * 1024, 1024, 1024, smem);
#pragma unroll
  for (int ni = 0; ni < 4; ++ni) {
    const size_t row = (size_t)row0 + wr * 64 + ni * 16 + fr;
#pragma unroll
    for (int mi = 0; mi < 4; ++mi) {
      const int col = tn * 128 + wc * 64 + mi * 16 + fq * 4;
      const f32x4 rv = *(const f32x4*)(p.r() + row * 1024 + col);
      f32x4 o;
      o[0] = rv[0] + sigm(acc[mi][ni][0]) * lo2f(pb[mi][ni].x); o[1] = rv[1] + sigm(acc[mi][ni][1]) * hi2f(pb[mi][ni].x);
      o[2] = rv[2] + sigm(acc[mi][ni][2]) * lo2f(pb[mi][ni].y); o[3] = rv[3] + sigm(acc[mi][ni][3]) * hi2f(pb[mi][ni].y);
      *(f32x4*)(p.o_y() + row * 1024 + col) = o;
    }
  }
}


template <typename TT>
__device__ __forceinline__ void mini_dot(f32x4& acc, const TT* Trow, const bf16_t* Wrow, int K) {
#pragma unroll 8
  for (int k = 0; k < K; k += 32) {
    const u32x4 tv = ld8(Trow + k), wv = ld8(Wrow + k);
    acc = __builtin_amdgcn_mfma_f32_16x16x32_bf16(__builtin_bit_cast(bf16x8, wv), __builtin_bit_cast(bf16x8, tv), acc, 0, 0, 0);
  }
}
__device__ void merge_mini(const Params& p, int l, int j) {
  const int tid = get_tid(), lane = tid & 63, w = tid >> 6, fr = lane & 15, fq = lane >> 4;
  const size_t row = (size_t)NPROMPT + (j >> 4) * 16 + fr;
  const int cb = (j & 15) * 64 + w * 16;
  f32x4 out = {0.f, 0.f, 0.f, 0.f};
#pragma unroll 1
  for (int b = 0; b < 3; ++b) {
    f32x4 h = {0.f, 0.f, 0.f, 0.f};
    mini_dot<bf16_t>(h, p.H() + (size_t)b * NTOK * 512 + row * 512 + fq * 8, p.wt_br() + (size_t)(l * 3 + b) * 1024 * 512 + (size_t)(cb + fr) * 512 + fq * 8, 512);
    const u32x2 g = *(const u32x2*)(p.Gb(b) + row * 1024 + cb + fq * 4);
    out[0] += lo2f(g.x) * h[0]; out[1] += hi2f(g.x) * h[1]; out[2] += lo2f(g.y) * h[2]; out[3] += hi2f(g.y) * h[3];
  }
  u32x2 pk; pk.x = pack2(out[0], out[1]); pk.y = pack2(out[2], out[3]);
  *(u32x2*)(p.merged() + row * 1024 + cb + fq * 4) = pk;
}
__device__ void outproj_mini(const Params& p, int l, int j) {
  const int tid = get_tid(), lane = tid & 63, w = tid >> 6, fr = lane & 15, fq = lane >> 4;
  const size_t row = (size_t)NPROMPT + (j >> 4) * 16 + fr;
  const int cb = (j & 15) * 64 + w * 16;
  f32x4 y = {0.f, 0.f, 0.f, 0.f};
  mini_dot<bf16_t>(y, p.merged() + row * 1024 + fq * 8, p.wt_out() + (size_t)l * 1048576 + (size_t)(cb + fr) * 1024 + fq * 8, 1024);
  *(f32x4*)(p.y() + row * 1024 + cb + fq * 4) = y;
}
__device__ void ple_mini(const Params& p, int l, int j) {
  const int tid = get_tid(), lane = tid & 63, w = tid >> 6, fr = lane & 15, fq = lane >> 4;
  const int srow = (j >> 4) * 16 + fr;
  const size_t row = (size_t)NPROMPT + srow;
  const int cb = (j & 15) * 64 + w * 16;
  f32x4 g = {0.f, 0.f, 0.f, 0.f}, pa = {0.f, 0.f, 0.f, 0.f};
  mini_dot<float>(pa, p.p_s + ((size_t)l * 512 + srow) * 256 + fq * 8, p.wt_pp() + (size_t)l * 262144 + (size_t)(cb + fr) * 256 + fq * 8, 256);
  mini_dot<bf16_t>(g, p.rb() + row * 1024 + fq * 8, p.wt_pg() + (size_t)l * 1048576 + (size_t)(cb + fr) * 1024 + fq * 8, 1024);
  const f32x4 rv = *(const f32x4*)(p.r() + row * 1024 + cb + fq * 4);
  f32x4 o; o[0] = rv[0] + sigm(g[0]) * pa[0]; o[1] = rv[1] + sigm(g[1]) * pa[1]; o[2] = rv[2] + sigm(g[2]) * pa[2]; o[3] = rv[3] + sigm(g[3]) * pa[3];
  *(f32x4*)(p.o_y() + row * 1024 + cb + fq * 4) = o;
}

#define XB_TMO      128
#define XB_XCNT(j)  (256  + 64 * (j))
#define XB_XSUB(j)  (1280 + 64 * (j))
#define XB_XGEN(j)  (2304 + 64 * (j))
#define XB_TOP      3328
#define XB_TOPGEN   3392
#define XCD_BAR_WORDS 3456
#define XB_SPIN_CAP (1u << 18)
#define LAS __attribute__((address_space(3)))
__device__ __forceinline__ unsigned xb_ld(unsigned* p)              { return __hip_atomic_load(p, __ATOMIC_RELAXED, __HIP_MEMORY_SCOPE_AGENT); }
__device__ __forceinline__ unsigned xb_add(unsigned* p, unsigned v) { return __hip_atomic_fetch_add(p, v, __ATOMIC_RELAXED, __HIP_MEMORY_SCOPE_AGENT); }
__device__ __forceinline__ unsigned xb_xcc_id() { return (unsigned)__builtin_amdgcn_s_getreg((3 << 11) | 20) & 0xFu; }
#define XB_SPIN(cond, bar) do { unsigned _sp = 0; while (cond) { __builtin_amdgcn_s_sleep(1); \
    if ((++_sp & 255u) == 0u) { if (xb_ld(&(bar)[XB_TMO])) break; if (_sp > XB_SPIN_CAP) { atomicAdd(&(bar)[XB_TMO], 1u); break; } } } } while (0)
__device__ __forceinline__ void xcd_barrier_complete(unsigned* bar, unsigned x, unsigned& nloc, unsigned& nx) {
    const unsigned G = gridDim.x * gridDim.y * gridDim.z;
    unsigned sum, cnt, mine, sp = 0u;
    for (;;) {
        sum = 0u; cnt = 0u; mine = 0u;
#pragma unroll
        for (unsigned j = 0; j < 16; ++j) { const unsigned c = xb_ld(&bar[XB_XCNT(j)]); sum += c; cnt += (c > 0u) ? 1u : 0u; mine = (j == x) ? c : mine; }
        if (sum == G) break;
        __builtin_amdgcn_s_sleep(1);
        if ((++sp & 255u) == 0u) { if (xb_ld(&bar[XB_TMO])) break; if (sp > XB_SPIN_CAP) { atomicAdd(&bar[XB_TMO], 1u); break; } }
    }
    nloc = mine > 0u ? mine : 1u; nx = cnt > 0u ? cnt : 1u;
}
__device__ __forceinline__ void xcd_barrier(unsigned* bar, volatile LAS unsigned* st) {
    asm volatile("s_waitcnt vmcnt(0)" ::: "memory");
    __syncthreads();
    if (threadIdx.x == 0) {
        const unsigned x = xb_xcc_id();
        __builtin_amdgcn_s_waitcnt(0);
        unsigned nloc = st[0], nx = st[1];
        if (nloc == 0u) { xcd_barrier_complete(bar, x, nloc, nx); st[0] = nloc; st[1] = nx; }
        const unsigned old = xb_add(&bar[XB_XSUB(x)], 1u);
        const unsigned gen = old / nloc;
        if (old + 1u == (gen + 1u) * nloc) {
            __builtin_amdgcn_fence(__ATOMIC_RELEASE, "agent");
            asm volatile("s_waitcnt vmcnt(0)" ::: "memory");
            const unsigned og = xb_add(&bar[XB_TOP], 1u);
            const unsigned tg = og / nx;
            if (og + 1u == (tg + 1u) * nx) xb_add(&bar[XB_TOPGEN], 1u);
            else XB_SPIN(xb_ld(&bar[XB_TOPGEN]) == tg, bar);
            __builtin_amdgcn_fence(__ATOMIC_ACQUIRE, "agent");
            xb_add(&bar[XB_XGEN(x)], 1u);
            asm volatile("s_waitcnt vmcnt(0)" ::: "memory");
        } else {
            XB_SPIN(xb_ld(&bar[XB_XGEN(x)]) == gen, bar);
            __builtin_amdgcn_fence(__ATOMIC_ACQUIRE, "agent");
            asm volatile("s_waitcnt vmcnt(0)" ::: "memory");
        }
    }
    __syncthreads();
}

template <int PH>
__device__ __forceinline__ void run_phase(const Params& p, char* smem) {
  const int bid = blockIdx.x, nb = gridDim.x;
  if (PH == 0) {
    for (int t = bid; t < 1696; t += nb) wconv_tile(p, t, smem);
    for (int i = bid * 256 + get_tid(); i < 2 * 8 * 1024; i += nb * 256) { const int ll = i >> 13, j = (i >> 10) & 7, k = i & 1023; p.wg8()[i] = p.w_in[((size_t)ll * 1024 + k) * NINSRC + 2560 + j]; }
    return;
  }
  constexpr int l = (PH - 1) / NPL, s = (PH - 1) % NPL;
  if (!((PHMASK >> s) & 1)) return;
  switch (s) {
    case 0: norm_phase(p, l); break;
    case 1: {
      const int per = (66 * 52) / 8, xcd = bid & 7, nloc = (nb + 7 - xcd) >> 3;
      for (int j = bid >> 3; j < per; j += nloc) {
        const int sq = xcd * per + j;
        const int tmg = sq / 416, rem = sq % 416, gm = (tmg == 8) ? 2 : 8;
        const int tng = rem / (gm * 8), rem2 = rem % (gm * 8), wdt = (tng == 6) ? 4 : 8;
        inproj_tile(p, l, (tmg * 8 + rem2 / wdt) * 52 + tng * 8 + rem2 % wdt, smem);
      }
      break;
    }
    case 2:
      for (int v = bid; v < 3 * NUNIT; v += nb) {
        const int ty = v % 3, u = v / 3;
        if (ty == 0) sb_unit(p, l, u, smem); else if (ty == 1) mlstm_local(p, l, u, smem); else hgrn_local(p, l, u, smem);
      }
      break;
    case 3: scan_phase(p, l, smem); break;
    case 4:
      for (int v = bid; v < 2 * NUNIT; v += nb) { if (v & 1) hgrn_out(p, l, v >> 1, smem); else mlstm_out(p, l, v >> 1, smem); }
      break;
    case 5: for (int t = bid; t < 1024; t += nb) merge_tile(p, l, t, smem); for (int j = bid; j < 512; j += nb) merge_mini(p, l, j); break;
    case 6: for (int t = bid; t < 1024; t += nb) outproj_tile(p, l, t, smem); for (int j = bid; j < 512; j += nb) outproj_mini(p, l, j); break;
    case 7: postnorm_phase(p, l); break;
    case 8: for (int t = bid; t < 1024; t += nb) ple_tile(p, l, t, smem); for (int j = bid; j < 512; j += nb) ple_mini(p, l, j); break;
  }
}

template <int PH>
__global__ void __launch_bounds__(256, 2) phase_kernel(Params p) {
  __shared__ __attribute__((aligned(16))) char smem[SMEM_BYTES];
  run_phase<PH>(p, smem);
}

#if FUSED
__device__ __forceinline__ int fetch_work(unsigned* ctr, volatile int* slot) {
  __syncthreads();
  if (threadIdx.x == 0) *slot = (int)__hip_atomic_fetch_add(ctr, 1u, __ATOMIC_RELAXED, __HIP_MEMORY_SCOPE_AGENT);
  __syncthreads();
  return *slot;
}
__device__ __forceinline__ void run_phase_rt(const Params& p, int ph, char* smem, volatile int* wslot) {
  const int bid = blockIdx.x, nb = gridDim.x;
  unsigned* ctr = (unsigned*)(p.ws + WS_BAR + 14336) + ph * 16;
  if (ph == 0) {
    for (int t = bid; t < 1696; t += nb) wconv_tile(p, t, smem);
    for (int i = bid * 256 + get_tid(); i < 2 * 8 * 1024; i += nb * 256) { const int ll = i >> 13, j = (i >> 10) & 7, k = i & 1023; p.wg8()[i] = p.w_in[((size_t)ll * 1024 + k) * NINSRC + 2560 + j]; }
    return;
  }
  const int l = (ph - 1) / NPL, s = (ph - 1) % NPL;
  switch (s) {
    case 0: norm_phase(p, l); break;
    case 1: {
      const int per = (66 * 52) / 8, xcd0 = (int)(xb_xcc_id() & 7u);
      for (int dx = 0; dx < 8; ++dx) {
        const int xcd = (xcd0 + dx) & 7;
        for (;;) {
          const int j = fetch_work(ctr + xcd, wslot);
          if (j >= per) break;
          const int sq = xcd * per + j;
          const int tmg = sq / 416, rem = sq % 416, gm = (tmg == 8) ? 2 : 8;
          const int tng = rem / (gm * 8), rem2 = rem % (gm * 8), wdt = (tng == 6) ? 4 : 8;
          inproj_tile(p, l, (tmg * 8 + rem2 / wdt) * 52 + tng * 8 + rem2 % wdt, smem);
        }
      }
      break;
    }
    case 2:
      for (;;) {
        const int v = fetch_work(ctr, wslot);
        if (v >= 3 * NUNIT) break;
        if (v < NUNIT) sb_unit(p, l, v, smem); else if (v < 2 * NUNIT) mlstm_local(p, l, v - NUNIT, smem); else hgrn_local(p, l, v - 2 * NUNIT, smem);
      }
      break;
    case 3: scan_phase(p, l, smem); break;
    case 4:
      for (;;) {
        const int v = fetch_work(ctr, wslot);
        if (v >= 3696) break;
        if (v < 48) { gate_tile256(p, l, 1536 + v, smem); continue; }
        const int grp = (v - 48) / 19, r = (v - 48) % 19;
        if (r < 8) gate_tile256(p, l, grp * 8 + r, smem);
        else { const int u = grp * 11 + (r - 8); if (u < NUNIT) hgrn_out(p, l, u, smem); else mlstm_out(p, l, u - NUNIT, smem); }
      }
      break;
    case 5: for (;;) { const int v = fetch_work(ctr, wslot); if (v >= 1536) break; if (v < 1024) merge_tile_g(p, l, v, smem); else merge_mini(p, l, v - 1024); } break;
    case 6: for (;;) { const int v = fetch_work(ctr, wslot); if (v >= 1024) break; if (v < 512) outproj_tile256(p, l, v, smem); else outproj_mini(p, l, v - 512); } break;
    case 7: postnorm_phase(p, l); break;
    case 8: for (;;) { const int v = fetch_work(ctr, wslot); if (v >= 1536) break; if (v < 1024) ple_tile(p, l, v, smem); else ple_mini(p, l, v - 1024); } break;
  }
}

__global__ void __launch_bounds__(256, 2) mega(Params p_unused) {
  __shared__ __attribute__((aligned(16))) char smem[SMEM_BYTES];
  __shared__ uint4 xb_words;
  __shared__ int wslot;
  if (threadIdx.x == 0) {
    typedef const Params __attribute__((address_space(4))) * KP4;
    KP4 kp = (KP4)__builtin_amdgcn_kernarg_segment_ptr();
    asm volatile("" : "+s"(kp));
    char* wsb = ((const Params*)kp)->ws;
    xb_words = make_uint4(0u, 0u, 0u, 0u); (void)xb_add((unsigned*)(wsb + WS_BAR) + XB_XCNT(xb_xcc_id()), 1u);
  }
  __syncthreads();
  typedef const Params __attribute__((address_space(4))) * KP4;
#ifdef PROBE_KIND
  unsigned long long t_acc = 0;
#endif
#pragma unroll 1
  for (int ph = 0; ph < NPHASE; ++ph) {
    KP4 kp = (KP4)__builtin_amdgcn_kernarg_segment_ptr();
    asm volatile("" : "+s"(kp));
    const Params q = *(const Params*)kp;
#ifdef PROBE_KIND
    const unsigned long long tp0 = __builtin_amdgcn_s_memrealtime();
#endif
    run_phase_rt(q, ph, smem, &wslot);
#ifdef PROBE_KIND
    const unsigned long long tp1 = __builtin_amdgcn_s_memrealtime();
    if ((PROBE_KIND == 9 && ph == 0) || (PROBE_KIND < 9 && ph > 0 && (ph - 1) % NPL == PROBE_KIND)) t_acc += tp1 - tp0;
#endif
    if (ph + 1 < NPHASE) xcd_barrier((unsigned*)(q.ws + WS_BAR), (volatile LAS unsigned*)&xb_words);
    if (gridDim.y == 7777u) cg::this_grid().sync();
#ifdef PROBE_KIND
    if (PROBE_KIND == 10 && (PROBE_SEL < 0 || (ph > 0 && (ph - 1) % NPL == PROBE_SEL))) t_acc += __builtin_amdgcn_s_memrealtime() - tp1;
#endif
  }
#ifdef PROBE_GEMM
  {
    KP4 kp = (KP4)__builtin_amdgcn_kernarg_segment_ptr();
    asm volatile("" : "+s"(kp));
    const Params q = *(const Params*)kp;
    xcd_barrier((unsigned*)(q.ws + WS_BAR), (volatile LAS unsigned*)&xb_words);
    const unsigned long long tg0 = __builtin_amdgcn_s_memrealtime();
    f32x4 acc[4][8];
#pragma unroll
    for (int a_ = 0; a_ < 4; ++a_)
#pragma unroll
      for (int b_ = 0; b_ < 8; ++b_) acc[a_][b_] = (f32x4){0.f, 0.f, 0.f, 0.f};
    const int bid = blockIdx.x;
#pragma unroll 1
    for (int it = 0; it < 8; ++it) {
      int tm, tn;
      if (PROBE_GEMM == 0) { tm = 0; tn = 0; }
      else if (PROBE_GEMM == 1) { tm = bid & 63; tn = ((bid >> 6) * 6 + it) % 52; }
      else { const int xcd = bid & 7, idx = bid >> 3; tm = xcd * 8 + (idx & 7); tn = ((idx >> 3) + 8 * it) % 52; }
      gemm_glds<8, 3>(acc, q.U() + (size_t)tm * 256 * 1024, 1024, q.wt_in() + (size_t)tn * 128 * 1024, 1024, 1024, smem);
    }
    float sum = 0.f;
#pragma unroll
    for (int a_ = 0; a_ < 4; ++a_)
#pragma unroll
      for (int b_ = 0; b_ < 8; ++b_) sum += acc[a_][b_][0] + acc[a_][b_][1] + acc[a_][b_][2] + acc[a_][b_][3];
    if (sum == 123456.789f) q.hbc()[0] = sum;
    const unsigned long long tg1 = __builtin_amdgcn_s_memrealtime();
    if (blockIdx.x == 0) { while (__builtin_amdgcn_s_memrealtime() - tg1 < 4 * (tg1 - tg0)) __builtin_amdgcn_s_sleep(32); }
  }
#endif
#ifdef PROBE_KIND
  if (blockIdx.x == PROBE_BLOCK) { const unsigned long long te = __builtin_amdgcn_s_memrealtime(); while (__builtin_amdgcn_s_memrealtime() - te < 4 * t_acc) __builtin_amdgcn_s_sleep(32); }
#endif
}
#endif

template <int PH>
static void launch_all(const Params& p, int grid, hipStream_t stream) {
  hipLaunchKernelGGL(phase_kernel<PH>, dim3(grid), dim3(256), 0, stream, p);
  if constexpr (PH + 1 < NPHASE) launch_all<PH + 1>(p, grid, stream);
}

extern "C" void kernel_launch(void* const* d_in, const int* in_sizes, int n_in, void* d_out, int out_size, void* d_ws, size_t ws_size, hipStream_t stream) {
  Params p;
  memset(&p, 0, sizeof(p));
  const float* const* in = (const float* const*)d_in;
  p.x_p = in[0]; p.x_s = in[1]; p.p_p = in[2]; p.p_s = in[3]; p.st_C = in[4]; p.st_n = in[5]; p.st_m = in[6]; p.st_conv = in[7];
  p.ck = in[8]; p.cv = in[9]; p.st_S = in[10]; p.g_pre = in[11]; p.w_in = in[12]; p.b_i = in[13]; p.b_f = in[14]; p.w_conv = in[15];
  p.g_ml = in[16]; p.lb_logits = in[17]; p.g_hg = in[18]; p.w_br = in[19]; p.w_out = in[20]; p.g_post = in[21]; p.w_pg = in[22]; p.w_pp = in[23];
  p.out = (float*)d_out; p.ws = (char*)d_ws;
  if (WS_TOTAL > ws_size || (size_t)out_size < O_TOTAL) { fprintf(stderr, "workspace/out too small: need %zu have %zu\n", (size_t)WS_TOTAL, ws_size); return; }
  static int grid_blocks = 0;
  if (!grid_blocks) {
    int dev = 0, cus = 0, per_cu = 0;
    (void)hipGetDevice(&dev);
    (void)hipDeviceGetAttribute(&cus, hipDeviceAttributeMultiprocessorCount, dev);
#if FUSED
    (void)hipOccupancyMaxActiveBlocksPerMultiprocessor(&per_cu, mega, 256, 0);
#else
    per_cu = 2;
#endif
    if (per_cu > 2) per_cu = 2;
    if (per_cu < 1) per_cu = 1;
    grid_blocks = cus * per_cu;
  }
#if FUSED
  (void)hipMemsetAsync((char*)d_ws + WS_BAR, 0, 16384, stream);
  void* args[] = {&p};
  hipError_t e = hipLaunchCooperativeKernel((void*)mega, dim3(grid_blocks), dim3(256), args, 0, stream);
  if (e != hipSuccess) fprintf(stderr, "cooperative launch failed: %s (grid %d)\n", hipGetErrorString(e), grid_blocks);
#else
  launch_all<0>(p, grid_blocks, stream);
#endif
}
```

```cpp
#include <hip/hip_runtime.h>
#include <hip/hip_cooperative_groups.h>
#include <stdint.h>
#include <stdio.h>
#include <string.h>
namespace cg = cooperative_groups;

#ifndef FUSED
#define FUSED 1
#endif
#ifndef PHMASK
#define PHMASK 0x3ff
#endif

typedef unsigned short bf16_t;
typedef short bf16x8 __attribute__((ext_vector_type(8)));
typedef float f32x4 __attribute__((ext_vector_type(4)));
typedef unsigned u32x4 __attribute__((ext_vector_type(4)));
typedef unsigned u32x2 __attribute__((ext_vector_type(2)));

constexpr int NTOK = 16896, NPROMPT = 16384, NUNIT = 1056;
constexpr int NINSRC = 9736, NWT = 9728, NMAIN = 6656;
constexpr int SMEM_BYTES = 80896;
constexpr int NPL = 9;
constexpr int NPHASE = 1 + 2 * NPL;

constexpr size_t al256(size_t x) { return (x + 255) & ~(size_t)255; }
constexpr size_t WS_WT_IN = 0;
constexpr size_t WS_WT_BR = WS_WT_IN + al256((size_t)2 * NWT * 1024 * 2);
constexpr size_t WS_WT_OUT = WS_WT_BR + al256((size_t)2 * 3 * 1024 * 512 * 2);
constexpr size_t WS_WT_PG = WS_WT_OUT + al256((size_t)2 * 1048576 * 2);
constexpr size_t WS_WT_PP = WS_WT_PG + al256((size_t)2 * 1048576 * 2);
constexpr size_t WS_U = WS_WT_PP + al256((size_t)2 * 262144 * 2);
constexpr size_t WS_PR = WS_U + al256((size_t)NTOK * 1024 * 2);
constexpr size_t WS_QC = WS_PR + al256((size_t)13 * NTOK * 512 * 2);
constexpr size_t WS_KC = WS_QC + al256((size_t)NTOK * 512 * 2);
constexpr size_t WS_SM = WS_KC + al256((size_t)NTOK * 512 * 2);
constexpr size_t WS_SH = WS_SM + al256((size_t)NUNIT * 16384 * 2);
constexpr size_t WS_H = WS_SH + al256((size_t)NUNIT * 16384 * 2);
constexpr size_t WS_IG = WS_H + al256((size_t)3 * NTOK * 512 * 2);
constexpr size_t WS_LF = WS_IG + al256((size_t)NTOK * 16);
constexpr size_t WS_AC = WS_LF + al256((size_t)NTOK * 16);
constexpr size_t WS_BC = WS_AC + al256(NUNIT * 4);
constexpr size_t WS_MIN = WS_BC + al256(NUNIT * 4);
constexpr size_t WS_NLOC = WS_MIN + al256(NUNIT * 4);
constexpr size_t WS_HBC = WS_NLOC + al256((size_t)NUNIT * 512);
constexpr size_t WS_BAR = WS_HBC + al256((size_t)NUNIT * 512);
constexpr size_t WS_WG8 = WS_BAR + 16384;
constexpr size_t WS_TOTAL = WS_WG8 + 65536;
constexpr size_t GRP = (size_t)NTOK * 512 * 2;
constexpr size_t WS_G0 = WS_PR + 0 * GRP, WS_G1 = WS_PR + 5 * GRP, WS_G2 = WS_PR + 7 * GRP;
constexpr size_t WS_MERGED = WS_PR + 2 * GRP;
constexpr size_t WS_Y = WS_PR + 9 * GRP;
constexpr size_t WS_RB = WS_PR + 0 * GRP;
constexpr size_t WS_R = WS_PR + 5 * GRP;
static_assert(WS_Y + (size_t)NTOK * 1024 * 4 <= WS_QC, "alias overflow");
constexpr size_t O_PC = 16777216 + 524288, O_PN = O_PC + 262144, O_PM = O_PN + 2048, O_PCONV = O_PM + 16, O_PK = O_PCONV + 12288, O_PV = O_PK + 16777216,
                 O_PS = O_PV + 16777216, O_SC = O_PS + 262144, O_SN = O_SC + 1048576, O_SM = O_SN + 8192, O_SCONV = O_SM + 64, O_SK = O_SCONV + 49152,
                 O_SV = O_SK + 524288, O_SS = O_SV + 524288, O_TOTAL = O_SS + 1048576;

struct Params {
  const float *x_p, *x_s, *p_p, *p_s, *st_C, *st_n, *st_m, *st_conv, *ck, *cv, *st_S;
  const float *g_pre, *w_in, *b_i, *b_f, *w_conv, *g_ml, *lb_logits, *g_hg, *w_br, *w_out, *g_post, *w_pg, *w_pp;
  float* out; char* ws;
#define WSP(name, T, off) __device__ __forceinline__ T* name() const { return (T*)(ws + (off)); }
#define OUTP(name, off) __device__ __forceinline__ float* name() const { return out + (off); }
  OUTP(o_y, 0) OUTP(o_pC, O_PC) OUTP(o_pn, O_PN) OUTP(o_pm, O_PM) OUTP(o_pconv, O_PCONV) OUTP(o_pk, O_PK) OUTP(o_pv, O_PV) OUTP(o_pS, O_PS)
  OUTP(o_sC, O_SC) OUTP(o_sn, O_SN) OUTP(o_sm, O_SM) OUTP(o_sconv, O_SCONV) OUTP(o_sk, O_SK) OUTP(o_sv, O_SV) OUTP(o_sS, O_SS)
  WSP(wt_in, bf16_t, WS_WT_IN) WSP(wt_br, bf16_t, WS_WT_BR) WSP(wt_out, bf16_t, WS_WT_OUT) WSP(wt_pg, bf16_t, WS_WT_PG) WSP(wt_pp, bf16_t, WS_WT_PP)
  WSP(U, bf16_t, WS_U) WSP(PR, bf16_t, WS_PR) WSP(QC, bf16_t, WS_QC) WSP(KC, bf16_t, WS_KC) WSP(SM, bf16_t, WS_SM) WSP(SH, bf16_t, WS_SH) WSP(H, bf16_t, WS_H)
  WSP(ig, float, WS_IG) WSP(lf, float, WS_LF) WSP(ac, float, WS_AC) WSP(Bc, float, WS_BC) WSP(min_, float, WS_MIN) WSP(nloc, float, WS_NLOC) WSP(hbc, float, WS_HBC)
  __device__ __forceinline__ bf16_t* Gb(int b) const { return (bf16_t*)(ws + (b == 0 ? WS_G0 : b == 1 ? WS_G1 : WS_G2)); }
  WSP(wg8, float, WS_WG8) WSP(merged, bf16_t, WS_MERGED) WSP(y, float, WS_Y) WSP(r, float, WS_R) WSP(rb, bf16_t, WS_RB)
};

__device__ __forceinline__ int get_tid() { int t = threadIdx.x; asm volatile("" : "+v"(t)); return t; }
__device__ __forceinline__ bf16_t f2bf(float f) { unsigned u = __float_as_uint(f); u += 0x7fffu + ((u >> 16) & 1u); return (bf16_t)(u >> 16); }
__device__ __forceinline__ float bf2f(bf16_t h) { return __uint_as_float(((unsigned)h) << 16); }
__device__ __forceinline__ unsigned pack2(float a, float b) { return (unsigned)f2bf(a) | ((unsigned)f2bf(b) << 16); }
__device__ __forceinline__ float lo2f(unsigned v) { return __uint_as_float(v << 16); }
__device__ __forceinline__ float hi2f(unsigned v) { return __uint_as_float(v & 0xffff0000u); }
__device__ __forceinline__ float sigm(float x) { return 1.f / (1.f + __expf(-x)); }
__device__ __forceinline__ float silu(float x) { return x / (1.f + __expf(-x)); }
__device__ __forceinline__ float softplus(float x) { return fmaxf(x, 0.f) + __logf(1.f + __expf(-fabsf(x))); }
__device__ __forceinline__ float logsigm(float x) { return fminf(x, 0.f) - __logf(1.f + __expf(-fabsf(x))); }

template <int MT, int NT, int KS>
__device__ __forceinline__ void wmma(f32x4 (&acc)[MT][NT], const bf16_t* A, int lda, const bf16_t* B, int ldb, int fr, int fq) {
#pragma unroll
  for (int kk = 0; kk < KS; ++kk) {
    bf16x8 a[MT], b[NT];
#pragma unroll
    for (int mi = 0; mi < MT; ++mi) a[mi] = *(const bf16x8*)(A + (mi * 16 + fr) * lda + kk * 32 + fq * 8);
#pragma unroll
    for (int ni = 0; ni < NT; ++ni) b[ni] = *(const bf16x8*)(B + (ni * 16 + fr) * ldb + kk * 32 + fq * 8);
#pragma unroll
    for (int mi = 0; mi < MT; ++mi)
#pragma unroll
      for (int ni = 0; ni < NT; ++ni) acc[mi][ni] = __builtin_amdgcn_mfma_f32_16x16x32_bf16(a[mi], b[ni], acc[mi][ni], 0, 0, 0);
  }
}

__device__ __forceinline__ u32x4 ld8(const bf16_t* s) { return *(const u32x4*)s; }
__device__ __forceinline__ u32x4 ld8(const float* s) {
  float4 a = *(const float4*)s, b = *(const float4*)(s + 4);
  u32x4 r; r.x = pack2(a.x, a.y); r.y = pack2(a.z, a.w); r.z = pack2(b.x, b.y); r.w = pack2(b.z, b.w); return r;
}
template <typename T>
__device__ __forceinline__ void ld_tile(bf16_t* dst, const T* src, long ld, int tid) {
#pragma unroll
  for (int i = 0; i < 4; ++i) { int id = tid + 256 * i; int r = id >> 4, c = (id & 15) * 8; *(u32x4*)(dst + r * 136 + c) = ld8(src + (long)r * ld + c); }
}
template <typename T>
__device__ __forceinline__ void ld_tile128(bf16_t* dst, const T* src, long ld, int tid) {
#pragma unroll
  for (int i = 0; i < 8; ++i) { int id = tid + 256 * i; int r = id >> 4, c = (id & 15) * 8; *(u32x4*)(dst + r * 136 + c) = ld8(src + (long)r * ld + c); }
}
template <typename T, int ROWS, int DLD>
__device__ __forceinline__ void ld_T(bf16_t* dst, const T* src, long ld, int tid) {
#pragma unroll 2
  for (int id = tid; id < ROWS * 16; id += 256) {
    int r = id % ROWS, c = (id / ROWS) * 8;
    u32x4 v = ld8(src + (long)r * ld + c);
    bf16_t* d = dst + c * DLD + r;
    d[0] = (bf16_t)(v.x & 0xffff); d[DLD] = (bf16_t)(v.x >> 16); d[2 * DLD] = (bf16_t)(v.y & 0xffff); d[3 * DLD] = (bf16_t)(v.y >> 16);
    d[4 * DLD] = (bf16_t)(v.z & 0xffff); d[5 * DLD] = (bf16_t)(v.z >> 16); d[6 * DLD] = (bf16_t)(v.w & 0xffff); d[7 * DLD] = (bf16_t)(v.w >> 16);
  }
}

#define PRG(g) (p.PR() + (size_t)(g) * NTOK * 512)

__device__ __forceinline__ const float* xrow(const Params& p, int l, int row) {
  if (l == 0) return row < NPROMPT ? p.x_p + (size_t)row * 1024 : p.x_s + (size_t)(row - NPROMPT) * 1024;
  return p.o_y() + (size_t)row * 1024;
}

__device__ void wconv_tile(const Params& p, int t, char* smem) {
  float* tile = (float*)smem;
  const int tid = get_tid();
  int l = t / 848, r = t % 848;
  const float* src; bf16_t* dst; int K, ldsrc, kt, nt, skip = 1 << 30;
  if (r < 608) { src = p.w_in + (size_t)l * 1024 * NINSRC; dst = p.wt_in() + (size_t)l * NWT * 1024; K = 1024; ldsrc = NINSRC; kt = r % 16; nt = r / 16; skip = 2560; }
  else if (r < 704) { r -= 608; int b = r / 32; r %= 32; src = p.w_br + (size_t)(l * 3 + b) * 512 * 1024; dst = p.wt_br() + (size_t)(l * 3 + b) * 1024 * 512; K = 512; ldsrc = 1024; kt = r % 8; nt = r / 8; }
  else if (r < 768) { r -= 704; src = p.w_out + (size_t)l * 1048576; dst = p.wt_out() + (size_t)l * 1048576; K = 1024; ldsrc = 1024; kt = r % 16; nt = r / 16; }
  else if (r < 832) { r -= 768; src = p.w_pg + (size_t)l * 1048576; dst = p.wt_pg() + (size_t)l * 1048576; K = 1024; ldsrc = 1024; kt = r % 16; nt = r / 16; }
  else { r -= 832; src = p.w_pp + (size_t)l * 262144; dst = p.wt_pp() + (size_t)l * 262144; K = 256; ldsrc = 1024; kt = r % 4; nt = r / 4; }
  const int n0 = nt * 256, k0 = kt * 64;
  __syncthreads();
#pragma unroll
  for (int i = 0; i < 16; ++i) {
    const int k = i * 4 + (tid >> 6), n4 = (tid & 63) * 4;
    int ns = n0 + n4; if (ns >= skip) ns += 8;
    *(float4*)(tile + k * 260 + n4) = *(const float4*)(src + (size_t)(k0 + k) * ldsrc + ns);
  }
  __syncthreads();
  bf16_t* drow = dst + (size_t)(n0 + tid) * K + k0;
#pragma unroll
  for (int c = 0; c < 8; ++c) {
    u32x4 pk;
    pk.x = pack2(tile[(c * 8 + 0) * 260 + tid], tile[(c * 8 + 1) * 260 + tid]);
    pk.y = pack2(tile[(c * 8 + 2) * 260 + tid], tile[(c * 8 + 3) * 260 + tid]);
    pk.z = pack2(tile[(c * 8 + 4) * 260 + tid], tile[(c * 8 + 5) * 260 + tid]);
    pk.w = pack2(tile[(c * 8 + 6) * 260 + tid], tile[(c * 8 + 7) * 260 + tid]);
    *(u32x4*)(drow + c * 8) = pk;
  }
}

__device__ void norm_phase(const Params& p, int l) {
  const int lane = threadIdx.x & 63, wid = threadIdx.x >> 6;
  const float* gp = p.g_pre + l * 1024;
  const float* wg = p.wg8() + l * 8192;
  for (int row = blockIdx.x * 4 + wid; row < NTOK; row += gridDim.x * 4) {
    const float* x = xrow(p, l, row);
    float4 v[4]; float ss = 0.f;
#pragma unroll
    for (int i = 0; i < 4; ++i) { v[i] = *(const float4*)(x + i * 256 + lane * 4); ss += v[i].x * v[i].x + v[i].y * v[i].y + v[i].z * v[i].z + v[i].w * v[i].w; }
#pragma unroll
    for (int o = 32; o > 0; o >>= 1) ss += __shfl_xor(ss, o);
    const float rstd = rsqrtf(ss * (1.f / 1024.f) + 1e-6f);
    float d0 = 0, d1 = 0, d2 = 0, d3 = 0, d4 = 0, d5 = 0, d6 = 0, d7 = 0;
#pragma unroll
    for (int i = 0; i < 4; ++i) {
      const int k = i * 256 + lane * 4;
      float4 g = *(const float4*)(gp + k);
      float u0 = v[i].x * rstd * g.x, u1 = v[i].y * rstd * g.y, u2 = v[i].z * rstd * g.z, u3 = v[i].w * rstd * g.w;
      u32x2 pk; pk.x = pack2(u0, u1); pk.y = pack2(u2, u3);
      *(u32x2*)(p.U() + (size_t)row * 1024 + k) = pk;
      const float* wp = wg + k;
      float4 w;
      w = *(const float4*)(wp);            d0 += u0 * w.x + u1 * w.y + u2 * w.z + u3 * w.w;
      w = *(const float4*)(wp + 1024);     d1 += u0 * w.x + u1 * w.y + u2 * w.z + u3 * w.w;
      w = *(const float4*)(wp + 2 * 1024); d2 += u0 * w.x + u1 * w.y + u2 * w.z + u3 * w.w;
      w = *(const float4*)(wp + 3 * 1024); d3 += u0 * w.x + u1 * w.y + u2 * w.z + u3 * w.w;
      w = *(const float4*)(wp + 4 * 1024); d4 += u0 * w.x + u1 * w.y + u2 * w.z + u3 * w.w;
      w = *(const float4*)(wp + 5 * 1024); d5 += u0 * w.x + u1 * w.y + u2 * w.z + u3 * w.w;
      w = *(const float4*)(wp + 6 * 1024); d6 += u0 * w.x + u1 * w.y + u2 * w.z + u3 * w.w;
      w = *(const float4*)(wp + 7 * 1024); d7 += u0 * w.x + u1 * w.y + u2 * w.z + u3 * w.w;
    }
#pragma unroll
    for (int o = 32; o > 0; o >>= 1) {
      d0 += __shfl_xor(d0, o); d1 += __shfl_xor(d1, o); d2 += __shfl_xor(d2, o); d3 += __shfl_xor(d3, o);
      d4 += __shfl_xor(d4, o); d5 += __shfl_xor(d5, o); d6 += __shfl_xor(d6, o); d7 += __shfl_xor(d7, o);
    }
    if (lane < 4) {
      float di = lane == 0 ? d0 : lane == 1 ? d1 : lane == 2 ? d2 : d3;
      float df = lane == 0 ? d4 : lane == 1 ? d5 : lane == 2 ? d6 : d7;
      p.ig()[row * 4 + lane] = di + p.b_i[l * 4 + lane];
      p.lf()[row * 4 + lane] = logsigm(df + p.b_f[l * 4 + lane]);
    }
  }
}

template <typename TA>
__device__ __forceinline__ void gemm_kloop(f32x4 (&acc)[4][4], const TA* Tp, long ldt, const bf16_t* Wp, long ldw, int K, char* smem) {
  bf16_t* sT = (bf16_t*)smem;
  bf16_t* sW = sT + 2 * 9216;
  const int tid = get_tid(), lane = tid & 63, wid = tid >> 6, wr = wid >> 1, wc = wid & 1, fr = lane & 15, fq = lane >> 4;
  u32x4 rt[4], rw[4];
  const int r0 = tid >> 3, c0 = (tid & 7) * 8;
#define GLOAD(k0) _Pragma("unroll") for (int i = 0; i < 4; ++i) { rt[i] = ld8(Tp + (long)(r0 + 32 * i) * ldt + (k0) + c0); rw[i] = ld8(Wp + (long)(r0 + 32 * i) * ldw + (k0) + c0); }
#define SSTORE(buf) _Pragma("unroll") for (int i = 0; i < 4; ++i) { *(u32x4*)(sT + (buf) * 9216 + (r0 + 32 * i) * 72 + c0) = rt[i]; *(u32x4*)(sW + (buf) * 9216 + (r0 + 32 * i) * 72 + c0) = rw[i]; }
  GLOAD(0); SSTORE(0);
  __syncthreads();
  const int nk = K >> 6;
#pragma unroll 1
  for (int kt = 0; kt < nk; ++kt) {
    const int buf = kt & 1;
    if (kt + 1 < nk) { GLOAD((kt + 1) * 64); }
    const bf16_t* aT = sT + buf * 9216 + (wr * 64) * 72;
    const bf16_t* aW = sW + buf * 9216 + (wc * 64) * 72;
    wmma<4, 4, 2>(acc, aW, 72, aT, 72, fr, fq);
    if (kt + 1 < nk) { SSTORE(buf ^ 1); }
    __syncthreads();
  }
#undef GLOAD
#undef SSTORE
}
__device__ __forceinline__ void zero_acc(f32x4 (&acc)[4][4]) {
#pragma unroll
  for (int a = 0; a < 4; ++a)
#pragma unroll
    for (int b = 0; b < 4; ++b) acc[a][b] = (f32x4){0.f, 0.f, 0.f, 0.f};
}


template <int NT, int NSTAGE>
__device__ __forceinline__ void gemm_glds(f32x4 (&acc)[4][NT], const bf16_t* Tp, long ldt, const bf16_t* Wp, long ldw, int K, char* smem) {
  constexpr int TR = 2 * NT * 16, STAGE_B = (TR + 128) * 64, LT = TR / 64, LPS = LT + 2;
  static_assert(NSTAGE * STAGE_B <= SMEM_BYTES, "ring too large");
  static_assert(NSTAGE == 3 || NSTAGE == 4, "waits below are written for 3 or 4 stages");
  const int tid = get_tid(), lane = tid & 63, wid = tid >> 6, wr = wid >> 1, wc = wid & 1, fr = lane & 15, fq = lane >> 4;
  const int lr = tid >> 2, cp = tid & 3, lc = (cp ^ ((lr >> 2) & 3)) * 8;
  const bf16_t* gT = Tp + (long)lr * ldt + lc;
  const int plr = ((lr >> 5) & 1) * 32 + ((lr >> 2) & 3) * 8 + ((lr >> 4) & 1) * 4 + (lr & 3);
  const bf16_t* gW = Wp + (long)plr * ldw + lc;
  const int rd_off = fr * 64 + ((fq ^ ((fr >> 2) & 3)) * 16);
#define GL_ISSUE(kt_, slot_) do { char* sb_ = smem + (slot_) * STAGE_B + tid * 16; \
    _Pragma("unroll") for (int i_ = 0; i_ < LT; ++i_) __builtin_amdgcn_global_load_lds((const unsigned*)(gT + (long)i_ * 64 * ldt + (kt_) * 32), (__attribute__((address_space(3))) unsigned*)(sb_ + i_ * 4096), 16, 0, 0); \
    _Pragma("unroll") for (int i_ = 0; i_ < 2; ++i_) __builtin_amdgcn_global_load_lds((const unsigned*)(gW + (long)i_ * 64 * ldw + (kt_) * 32), (__attribute__((address_space(3))) unsigned*)(sb_ + TR * 64 + i_ * 4096), 16, 0, 0); } while (0)
  asm volatile("s_waitcnt vmcnt(0)" ::: "memory");
  __builtin_amdgcn_s_barrier();
  const int nk = K >> 5;
#pragma unroll
  for (int s_ = 0; s_ < NSTAGE - 1; ++s_) if (s_ < nk) GL_ISSUE(s_, s_);
  int slot = 0, islot = NSTAGE - 1;
#pragma unroll 1
  for (int kt = 0; kt < nk; ++kt) {
    const int rem = nk - 1 - kt;
    if (NSTAGE == 4) {
      if (rem >= 2) asm volatile("s_waitcnt vmcnt(%0)" ::"n"(2 * LPS) : "memory");
      else if (rem == 1) asm volatile("s_waitcnt vmcnt(%0)" ::"n"(LPS) : "memory");
      else asm volatile("s_waitcnt vmcnt(0)" ::: "memory");
    } else {
      if (rem >= 1) asm volatile("s_waitcnt vmcnt(%0)" ::"n"(LPS) : "memory");
      else asm volatile("s_waitcnt vmcnt(0)" ::: "memory");
    }
    __builtin_amdgcn_s_barrier();
    const unsigned aT = (unsigned)(uintptr_t)(smem + slot * STAGE_B + (wr * NT * 16) * 64 + rd_off);
    const unsigned aW = (unsigned)(uintptr_t)(smem + slot * STAGE_B + TR * 64 + (wc * 64) * 64 + rd_off);
    bf16x8 a[4], b[NT];
#pragma unroll
    for (int mi = 0; mi < 4; ++mi) asm volatile("ds_read_b128 %0, %1 offset:%2" : "=v"(a[mi]) : "v"(aW), "n"(mi * 1024));
#pragma unroll
    for (int ni = 0; ni < NT; ++ni) asm volatile("ds_read_b128 %0, %1 offset:%2" : "=v"(b[ni]) : "v"(aT), "n"(ni * 1024));
    if constexpr (NT == 4) asm volatile("s_waitcnt lgkmcnt(0)" : "+v"(a[0]), "+v"(a[1]), "+v"(a[2]), "+v"(a[3]), "+v"(b[0]), "+v"(b[1]), "+v"(b[2]), "+v"(b[3]));
    else asm volatile("s_waitcnt lgkmcnt(0)" : "+v"(a[0]), "+v"(a[1]), "+v"(a[2]), "+v"(a[3]), "+v"(b[0]), "+v"(b[1]), "+v"(b[2]), "+v"(b[3]), "+v"(b[4]), "+v"(b[5]), "+v"(b[6]), "+v"(b[7]));
    const bool doiss = (kt + NSTAGE - 1 < nk);
    const int ktn = kt + NSTAGE - 1;
    char* sbi = smem + islot * STAGE_B + tid * 16;
#pragma unroll
    for (int mi = 0; mi < 4; ++mi) {
#pragma unroll
      for (int ni = 0; ni < NT; ++ni) acc[mi][ni] = __builtin_amdgcn_mfma_f32_16x16x32_bf16(a[mi], b[ni], acc[mi][ni], 0, 0, 0);
      __builtin_amdgcn_sched_barrier(0);
      if (doiss) {
#pragma unroll
        for (int q = 0; q < 2; ++q) {
          const int idx = mi * 2 + q;
          if (idx < LT) __builtin_amdgcn_global_load_lds((const unsigned*)(gT + (long)idx * 64 * ldt + ktn * 32), (__attribute__((address_space(3))) unsigned*)(sbi + idx * 4096), 16, 0, 0);
          else if (idx < LPS) __builtin_amdgcn_global_load_lds((const unsigned*)(gW + (long)(idx - LT) * 64 * ldw + ktn * 32), (__attribute__((address_space(3))) unsigned*)(sbi + TR * 64 + (idx - LT) * 4096), 16, 0, 0);
        }
      }
      __builtin_amdgcn_sched_barrier(0);
    }
    slot = (slot + 1 == NSTAGE) ? 0 : slot + 1;
    islot = (islot + 1 == NSTAGE) ? 0 : islot + 1;
  }
#undef GL_ISSUE
  __syncthreads();
}

__device__ void inproj_tile(const Params& p, int l, int t, char* smem) {
  constexpr int NT = 8;
  const int tm = t / 52, tn = t % 52;
  const int tid = get_tid(), lane = tid & 63, wid = tid >> 6, wr = wid >> 1, wc = wid & 1, fr = lane & 15, fq = lane >> 4;
  f32x4 acc[4][NT];
#pragma unroll
  for (int a_ = 0; a_ < 4; ++a_)
#pragma unroll
    for (int b_ = 0; b_ < NT; ++b_) acc[a_][b_] = (f32x4){0.f, 0.f, 0.f, 0.f};
  gemm_glds<NT, 3>(acc, p.U() + (size_t)tm * (NT * 32) * 1024, 1024, p.wt_in() + (size_t)l * NWT * 1024 + (size_t)tn * 128 * 1024, 1024, 1024, smem);
  const int g = tn >> 2;
  bf16_t* dst = PRG(g);
#pragma unroll
  for (int ni = 0; ni < NT; ++ni) {
    const int row = tm * (NT * 32) + wr * (NT * 16) + ni * 16 + fr;
    const bool samp = row >= NPROMPT;
    const int rr = samp ? row - NPROMPT : row;
    const int b = samp ? (rr >> 6) : (rr >> 13), tt = samp ? (rr & 63) : (rr & 8191), T = samp ? 64 : 8192, NB = samp ? 8 : 2;
#pragma unroll
    for (int m = 0; m < 2; ++m) {
      const int cg_ = (tn & 3) * 128 + wc * 64 + m * 32 + fq * 8;
      const f32x4 v0 = acc[2 * m][ni], v1 = acc[2 * m + 1][ni];
      u32x4 pk; pk.x = pack2(v0[0], v0[1]); pk.y = pack2(v0[2], v0[3]); pk.z = pack2(v1[0], v1[1]); pk.w = pack2(v1[2], v1[3]);
      *(u32x4*)(dst + (size_t)row * 512 + cg_) = pk;
      if (g == 6 || g == 7) {
        float* o = (g == 6) ? (samp ? p.o_sk() : p.o_pk()) : (samp ? p.o_sv() : p.o_pv());
        const int hh = cg_ >> 7, d = cg_ & 127;
        float* op = o + ((size_t)((l * NB + b) * 4 + hh) * T + tt) * 128 + d;
        *(f32x4*)op = v0; *(f32x4*)(op + 4) = v1;
      } else if (g < 2) {
        if (tt >= T - 3) {
          float* o = samp ? p.o_sconv() : p.o_pconv();
          float* op = o + ((size_t)(l * NB + b) * 3 + (tt - (T - 3))) * 1024 + g * 512 + cg_;
          *(f32x4*)op = v0; *(f32x4*)(op + 4) = v1;
        }
      }
    }
  }
}

struct UnitInfo { int samp, b, h, c, rowbase, seq; };
__device__ __forceinline__ UnitInfo unit_info(int u) {
  UnitInfo i;
  if (u < 1024) { i.samp = 0; i.seq = u >> 7; i.b = i.seq >> 2; i.h = i.seq & 3; i.c = u & 127; i.rowbase = i.b * 8192 + i.c * 64; }
  else { int sq = u - 1024; i.samp = 1; i.seq = sq; i.b = sq >> 2; i.h = sq & 3; i.c = 0; i.rowbase = NPROMPT + i.b * 64; }
  return i;
}

__device__ void sb_unit(const Params& p, int l, int u, char* smem) {
  bf16_t* Qs = (bf16_t*)smem;
  bf16_t* Ks = Qs + 64 * 136;
  bf16_t* Vt = Ks + 64 * 136;
  bf16_t* Ps = Vt + 128 * 72;
  const int tid = get_tid(), lane = tid & 63, w = tid >> 6, fr = lane & 15, fq = lane >> 4;
  const UnitInfo ui = unit_info(u);
  const int nblk = ui.samp ? 65 : ui.c + 1;
  const int hc = ui.h * 128;
  __syncthreads();
  ld_tile<bf16_t>(Qs, PRG(5) + (size_t)ui.rowbase * 512 + hc, 512, tid);
  f32x4 o[8][1];
#pragma unroll
  for (int mi = 0; mi < 8; ++mi) o[mi][0] = (f32x4){0.f, 0.f, 0.f, 0.f};
  float R = 0.f;
  const int tq = 16 * w + fr;
  for (int i = nblk - 1; i >= 0; --i) {
    if (!ui.samp || i == 64) {
      const size_t krow = ui.samp ? (size_t)ui.rowbase : (size_t)ui.b * 8192 + (size_t)i * 64;
      ld_tile<bf16_t>(Ks, PRG(6) + krow * 512 + hc, 512, tid);
      ld_T<bf16_t, 64, 72>(Vt, PRG(7) + krow * 512 + hc, 512, tid);
    } else {
      const size_t off = ((size_t)((l * 8 + ui.b) * 4 + ui.h) * 4096 + (size_t)i * 64) * 128;
      ld_tile<float>(Ks, p.ck + off, 128, tid);
      ld_T<float, 64, 72>(Vt, p.cv + off, 128, tid);
    }
    __syncthreads();
    f32x4 z[4][1];
#pragma unroll
    for (int mi = 0; mi < 4; ++mi) z[mi][0] = (f32x4){0.f, 0.f, 0.f, 0.f};
    wmma<4, 1, 4>(z, Ks, 136, Qs + 16 * w * 136, 136, fr, fq);
    const bool diag = (i == nblk - 1);
    float L[4][4], lsg[4][4], G[4];
#pragma unroll
    for (int mi = 0; mi < 4; ++mi) {
      G[mi] = 0.f;
#pragma unroll
      for (int j = 0; j < 4; ++j) {
        const int kk = mi * 16 + fq * 4 + j;
        const float zz = z[mi][0][j] * 0.08838834764831845f;
        const float sp = softplus(zz);
        const bool valid = !diag || kk < tq;
        L[mi][j] = valid ? -sp : 0.f;
        lsg[mi][j] = valid ? zz - sp : -1e30f;
        G[mi] += L[mi][j];
      }
    }
    float sufm = 0.f;
#pragma unroll
    for (int mi = 3; mi >= 0; --mi) {
      const float g0 = __shfl(G[mi], fr), g1 = __shfl(G[mi], fr + 16), g2 = __shfl(G[mi], fr + 32), g3 = __shfl(G[mi], fr + 48);
      const float later = (fq < 1 ? g1 : 0.f) + (fq < 2 ? g2 : 0.f) + (fq < 3 ? g3 : 0.f);
      const float s3 = R + sufm + later, s2 = s3 + L[mi][3], s1 = s2 + L[mi][2], s0 = s1 + L[mi][1];
      const float a0 = __expf(lsg[mi][0] + s0), a1 = __expf(lsg[mi][1] + s1), a2 = __expf(lsg[mi][2] + s2), a3 = __expf(lsg[mi][3] + s3);
      u32x2 pk; pk.x = pack2(a0, a1); pk.y = pack2(a2, a3);
      *(u32x2*)(Ps + tq * 72 + mi * 16 + fq * 4) = pk;
      sufm += (g0 + g1) + (g2 + g3);
    }
    R += sufm;
    __syncthreads();
    wmma<8, 1, 2>(o, Vt, 72, Ps + 16 * w * 72, 72, fr, fq);
    if (__syncthreads_and(R < -110.f)) break;
  }
  const size_t row = (size_t)ui.rowbase + tq;
#pragma unroll
  for (int mi = 0; mi < 8; ++mi) {
    const int col = hc + mi * 16 + fq * 4;
    u32x2 zz = *(const u32x2*)(PRG(8) + row * 512 + col);
    f32x4 v = o[mi][0];
    u32x2 pk;
    pk.x = pack2(v[0] * silu(lo2f(zz.x)), v[1] * silu(hi2f(zz.x)));
    pk.y = pack2(v[2] * silu(lo2f(zz.y)), v[3] * silu(hi2f(zz.y)));
    *(u32x2*)(p.H() + (size_t)1 * NTOK * 512 + row * 512 + col) = pk;
  }
}

__device__ void mlstm_local(const Params& p, int l, int u, char* smem) {
  bf16_t* kdT = (bf16_t*)smem;
  bf16_t* vT = kdT + 128 * 72;
  bf16_t* xq = vT + 128 * 72;
  bf16_t* xk = xq + 67 * 136;
  float* dec = (float*)(xk + 67 * 136);
  const int tid = get_tid(), lane = tid & 63, w = tid >> 6, fr = lane & 15, fq = lane >> 4;
  const UnitInfo ui = unit_info(u);
  const int hc = ui.h * 128;
  __syncthreads();
  if (w == 0) {
    const float lfv = p.lf()[(ui.rowbase + lane) * 4 + ui.h], igv = p.ig()[(ui.rowbase + lane) * 4 + ui.h];
    float bs = lfv;
#pragma unroll
    for (int o = 1; o < 64; o <<= 1) { float t = __shfl_up(bs, o); if (lane >= o) bs += t; }
    const float g = igv - bs;
    float gm = g;
#pragma unroll
    for (int o = 32; o > 0; o >>= 1) gm = fmaxf(gm, __shfl_xor(gm, o));
    const float bL = __shfl(bs, 63);
    dec[lane] = __expf(g - gm);
    if (lane == 0) { p.ac()[u] = bL + gm; p.Bc()[u] = bL; }
  }
  ld_tile<bf16_t>(xq + 3 * 136, PRG(0) + (size_t)ui.rowbase * 512 + hc, 512, tid);
  ld_tile<bf16_t>(xk + 3 * 136, PRG(1) + (size_t)ui.rowbase * 512 + hc, 512, tid);
  ld_T<bf16_t, 64, 72>(vT, PRG(2) + (size_t)ui.rowbase * 512 + hc, 512, tid);
  {
    const int isk = tid >> 7, ch = tid & 127, col = hc + ch;
    bf16_t* xs = isk ? xk : xq;
    if (ui.samp) {
      const float* cs = p.st_conv + (size_t)(l * 8 + ui.b) * 3072 + isk * 512 + col;
      xs[ch] = f2bf(cs[0]); xs[136 + ch] = f2bf(cs[1024]); xs[272 + ch] = f2bf(cs[2048]);
    } else if (ui.c > 0) {
      const bf16_t* src = PRG(isk) + (size_t)ui.rowbase * 512 + col;
      xs[ch] = src[-3 * 512]; xs[136 + ch] = src[-2 * 512]; xs[272 + ch] = src[-1 * 512];
    } else { xs[ch] = 0; xs[136 + ch] = 0; xs[272 + ch] = 0; }
  }
  __syncthreads();
  {
    const int isk = tid >> 7, ch = tid & 127, col = hc + ch;
    bf16_t* xs = isk ? xk : xq;
    const float* wc_ = p.w_conv + (size_t)l * 4096 + isk * 512 + col;
    const float w0 = wc_[0], w1 = wc_[1024], w2 = wc_[2048], w3 = wc_[3072];
    float x0 = bf2f(xs[ch]), x1 = bf2f(xs[136 + ch]), x2 = bf2f(xs[272 + ch]);
#pragma unroll 8
    for (int t = 0; t < 64; ++t) {
      const float x3 = bf2f(xs[(t + 3) * 136 + ch]);
      float y = silu(w0 * x0 + w1 * x1 + w2 * x2 + w3 * x3);
      if (isk) y *= 0.08838834764831845f;
      const bf16_t yb = f2bf(y);
      xs[t * 136 + ch] = yb;
      if (isk) kdT[ch * 72 + t] = f2bf(bf2f(yb) * dec[t]);
      x0 = x1; x1 = x2; x2 = x3;
    }
  }
  __syncthreads();
#pragma unroll
  for (int i = 0; i < 4; ++i) {
    const int id = tid + 256 * i, r = id >> 4, c = (id & 15) * 8;
    *(u32x4*)(p.QC() + (size_t)(ui.rowbase + r) * 512 + hc + c) = *(const u32x4*)(xq + r * 136 + c);
    *(u32x4*)(p.KC() + (size_t)(ui.rowbase + r) * 512 + hc + c) = *(const u32x4*)(xk + r * 136 + c);
  }
  if (tid < 128) { float s_ = 0.f;
#pragma unroll 8
    for (int t = 0; t < 64; ++t) s_ += bf2f(kdT[tid * 72 + t]); p.nloc()[u * 128 + tid] = s_; }
  f32x4 acc[8][2];
#pragma unroll
  for (int a_ = 0; a_ < 8; ++a_) { acc[a_][0] = (f32x4){0.f, 0.f, 0.f, 0.f}; acc[a_][1] = (f32x4){0.f, 0.f, 0.f, 0.f}; }
  wmma<8, 2, 2>(acc, kdT, 72, vT + 32 * w * 72, 72, fr, fq);
  bf16_t* sm = p.SM() + (size_t)u * 16384;
#pragma unroll
  for (int mi = 0; mi < 8; ++mi)
#pragma unroll
    for (int ni = 0; ni < 2; ++ni) {
      u32x2 pk; pk.x = pack2(acc[mi][ni][0], acc[mi][ni][1]); pk.y = pack2(acc[mi][ni][2], acc[mi][ni][3]);
      *(u32x2*)(sm + (32 * w + ni * 16 + fr) * 128 + mi * 16 + fq * 4) = pk;
    }
}

__device__ __forceinline__ float hgrn_lb(const Params& p, int l, int ch512) {
  if (l == 0) return 0.f;
  return sigm(p.lb_logits[512 + ch512] - p.lb_logits[ch512]);
}
__device__ __forceinline__ void hgrn_gate(float f, float lb, float& lg, float& kh) {
  const float e = __expf(-fabsf(f));
  const float sp = f >= 0.f ? 1.f / (1.f + e) : e / (1.f + e);
  const float sn = f >= 0.f ? e / (1.f + e) : 1.f / (1.f + e);
  lg = (lb == 0.f) ? (fminf(f, 0.f) - __logf(1.f + e)) : __logf(lb + (1.f - lb) * sp);
  kh = (1.f - lb) * sn;
}

__device__ void hgrn_local(const Params& p, int l, int u, char* smem) {
  bf16_t* kdT = (bf16_t*)smem;
  bf16_t* iT = kdT + 128 * 72;
  bf16_t* fs = iT + 128 * 72;
  float* tot = (float*)(fs + 64 * 136);
  const int tid = get_tid(), lane = tid & 63, w = tid >> 6, fr = lane & 15, fq = lane >> 4;
  const UnitInfo ui = unit_info(u);
  const int hc = ui.h * 128;
  __syncthreads();
  ld_tile<bf16_t>(fs, PRG(10) + (size_t)ui.rowbase * 512 + hc, 512, tid);
  ld_T<bf16_t, 64, 72>(iT, PRG(11) + (size_t)ui.rowbase * 512 + hc, 512, tid);
  const int half = tid >> 7, ch = tid & 127;
  const float lb = hgrn_lb(p, l, hc + ch);
  __syncthreads();
  const bf16_t* src = fs + (half * 32) * 136 + ch;
  {
    float run = 0.f;
#pragma unroll 8
    for (int t = 0; t < 32; ++t) { float lg, kh; hgrn_gate(bf2f(src[t * 136]), lb, lg, kh); run += lg; }
    tot[half * 128 + ch] = run;
  }
  __syncthreads();
  {
    const float t0 = tot[ch], t1 = tot[128 + ch];
    const float bcL = t0 + t1;
    float run = half ? t0 : 0.f;
#pragma unroll 8
    for (int t = 0; t < 32; ++t) {
      float lg, kh; hgrn_gate(bf2f(src[t * 136]), lb, lg, kh); run += lg;
      kdT[ch * 72 + half * 32 + t] = f2bf(kh * __expf(bcL - run));
    }
    if (half == 0) p.hbc()[u * 128 + ch] = bcL;
  }
  __syncthreads();
  f32x4 acc[8][2];
#pragma unroll
  for (int a_ = 0; a_ < 8; ++a_) { acc[a_][0] = (f32x4){0.f, 0.f, 0.f, 0.f}; acc[a_][1] = (f32x4){0.f, 0.f, 0.f, 0.f}; }
  wmma<8, 2, 2>(acc, kdT, 72, iT + 32 * w * 72, 72, fr, fq);
  bf16_t* sh = p.SH() + (size_t)u * 16384;
#pragma unroll
  for (int mi = 0; mi < 8; ++mi)
#pragma unroll
    for (int ni = 0; ni < 2; ++ni) {
      u32x2 pk; pk.x = pack2(acc[mi][ni][0], acc[mi][ni][1]); pk.y = pack2(acc[mi][ni][2], acc[mi][ni][3]);
      *(u32x2*)(sh + (32 * w + ni * 16 + fr) * 128 + mi * 16 + fq * 4) = pk;
    }
}

__device__ void scan_phase(const Params& p, int l, char* smem) {
  float* cdc = (float*)smem;
  float* cwl = cdc + 128;
  float* cmi = cwl + 128;
  const int tid = get_tid();
  for (int vb = blockIdx.x; vb < 520; vb += gridDim.x) {
    const int kind = vb >> 8;
    const int seq = (kind == 2) ? (vb - 512) : ((vb >> 5) & 7);
    __syncthreads();
    if (kind != 1) {
      if (tid < 128) { cdc[tid] = p.ac()[seq * 128 + tid]; cwl[tid] = p.Bc()[seq * 128 + tid]; }
      __syncthreads();
      if (tid == 0) {
        float m = 0.f;
        for (int c = 0; c < 128; ++c) {
          const float a = cdc[c], B = cwl[c];
          const float mo = fmaxf(a, B + m);
          cdc[c] = __expf(B + m - mo); cwl[c] = __expf(a - mo); cmi[c] = m; m = mo;
        }
        if (kind == 0 && (vb & 31) == 0) p.o_pm()[l * 8 + seq] = m;
      }
      __syncthreads();
      if (kind == 0 && (vb & 31) == 0 && tid < 128) p.min_()[seq * 128 + tid] = cmi[tid];
    }
    if (kind == 2) {
      if (tid < 128) {
        float n = 0.f;
        float* base = p.nloc() + (size_t)seq * 128 * 128 + tid;
        for (int c0 = 0; c0 < 128; c0 += 16) {
          float lv[16];
#pragma unroll
          for (int j = 0; j < 16; ++j) lv[j] = base[(c0 + j) * 128];
#pragma unroll
          for (int j = 0; j < 16; ++j) { const float nl = lv[j]; lv[j] = n; n = cdc[c0 + j] * n + cwl[c0 + j] * nl; }
#pragma unroll
          for (int j = 0; j < 16; ++j) base[(c0 + j) * 128] = lv[j];
        }
        p.o_pn()[(l * 8 + seq) * 128 + tid] = n;
      }
      continue;
    }
    const int pr = (vb & 31) * 256 + tid, e = pr * 2, er = e >> 7, ec = e & 127;
    unsigned* base = (unsigned*)((kind ? p.SH() : p.SM()) + (size_t)seq * 128 * 16384) + pr;
    const float* hb = p.hbc() + (size_t)seq * 128 * 128 + ec;
    float c0v = 0.f, c1v = 0.f;
    unsigned lv[16], nx[16];
    float2 hv[16], hn[16];
#pragma unroll
    for (int j = 0; j < 16; ++j) { nx[j] = base[(size_t)j * 8192]; hn[j] = kind ? *(const float2*)(hb + j * 128) : make_float2(0.f, 0.f); }
    for (int c0 = 0; c0 < 128; c0 += 16) {
#pragma unroll
      for (int j = 0; j < 16; ++j) { lv[j] = nx[j]; hv[j] = hn[j]; }
      if (c0 + 16 < 128) {
#pragma unroll
        for (int j = 0; j < 16; ++j) { nx[j] = base[(size_t)(c0 + 16 + j) * 8192]; if (kind) hn[j] = *(const float2*)(hb + (c0 + 16 + j) * 128); }
      }
#pragma unroll
      for (int j = 0; j < 16; ++j) {
        const unsigned v = lv[j];
        lv[j] = pack2(c0v, c1v);
        const float d0 = kind ? __expf(hv[j].x) : cdc[c0 + j];
        const float d1 = kind ? __expf(hv[j].y) : d0;
        const float wl = kind ? 1.f : cwl[c0 + j];
        c0v = d0 * c0v + wl * lo2f(v); c1v = d1 * c1v + wl * hi2f(v);
      }
#pragma unroll
      for (int j = 0; j < 16; ++j) base[(size_t)(c0 + j) * 8192] = lv[j];
    }
    float* o = (kind ? p.o_pS() : p.o_pC()) + (size_t)(l * 8 + seq) * 16384;
    o[ec * 128 + er] = c0v; o[(ec + 1) * 128 + er] = c1v;
  }
  const int gt = blockIdx.x * 256 + tid, nth = gridDim.x * 256;
  for (int it = gt; it < 524288; it += nth) {
    const int kind = it >> 18, sq = (it >> 13) & 31, pr = it & 8191, e = pr * 2, u = 1024 + sq, er = e >> 7, ec = e & 127;
    if (kind == 0) {
      const float* c0p = p.st_C + (size_t)(l * 32 + sq) * 16384;
      const float C0 = c0p[ec * 128 + er], C1 = c0p[(ec + 1) * 128 + er], m = p.st_m[l * 32 + sq];
      unsigned* slot = (unsigned*)(p.SM() + (size_t)u * 16384) + pr;
      const unsigned lv = *slot;
      const float a = p.ac()[u], B = p.Bc()[u];
      const float mo = fmaxf(a, B + m), dc = __expf(B + m - mo), wl = __expf(a - mo);
      *slot = pack2(C0, C1);
      float* o = p.o_sC() + (size_t)(l * 32 + sq) * 16384;
      o[ec * 128 + er] = dc * C0 + wl * lo2f(lv); o[(ec + 1) * 128 + er] = dc * C1 + wl * hi2f(lv);
      if (pr == 0) { p.min_()[u] = m; p.o_sm()[l * 32 + sq] = mo; }
    } else {
      const float* s0p = p.st_S + (size_t)(l * 32 + sq) * 16384;
      const float S0 = s0p[ec * 128 + er], S1 = s0p[(ec + 1) * 128 + er];
      unsigned* slot = (unsigned*)(p.SH() + (size_t)u * 16384) + pr;
      const unsigned lv = *slot;
      const float d0 = __expf(p.hbc()[u * 128 + ec]), d1 = __expf(p.hbc()[u * 128 + ec + 1]);
      *slot = pack2(S0, S1);
      float* o = p.o_sS() + (size_t)(l * 32 + sq) * 16384;
      o[ec * 128 + er] = d0 * S0 + lo2f(lv); o[(ec + 1) * 128 + er] = d1 * S1 + hi2f(lv);
    }
  }
  for (int it = gt; it < 4096; it += nth) {
    const int sq = it >> 7, d = it & 127, u = 1024 + sq;
    const float n0 = p.st_n[(l * 32 + sq) * 128 + d], m = p.st_m[l * 32 + sq];
    const float a = p.ac()[u], B = p.Bc()[u];
    const float mo = fmaxf(a, B + m), dc = __expf(B + m - mo), wl = __expf(a - mo);
    const float nl = p.nloc()[u * 128 + d];
    p.nloc()[u * 128 + d] = n0;
    p.o_sn()[(l * 32 + sq) * 128 + d] = dc * n0 + wl * nl;
  }
}

__device__ void mlstm_out(const Params& p, int l, int u, char* smem) {
  bf16_t* Qs = (bf16_t*)smem;
  bf16_t* CT = Qs + 64 * 136;
  bf16_t* Ks = CT;
  bf16_t* Vt = Ks + 64 * 136;
  bf16_t* Ps = Vt + 144 * 72;
  float* misc = (float*)(smem + 17408 + 47360);
  float *bsum = misc, *gs = misc + 64, *mt = misc + 128, *wint = misc + 192;
  const int tid = get_tid(), lane = tid & 63, w = tid >> 6, fr = lane & 15, fq = lane >> 4;
  const UnitInfo ui = unit_info(u);
  const int hc = ui.h * 128;
  __syncthreads();
  if (w == 0) {
    const float lfv = p.lf()[(ui.rowbase + lane) * 4 + ui.h], igv = p.ig()[(ui.rowbase + lane) * 4 + ui.h];
    float bs = lfv;
#pragma unroll
    for (int o = 1; o < 64; o <<= 1) { float t = __shfl_up(bs, o); if (lane >= o) bs += t; }
    const float g = igv - bs;
    float cm = g;
#pragma unroll
    for (int o = 1; o < 64; o <<= 1) { float t = __shfl_up(cm, o); if (lane >= o) cm = fmaxf(cm, t); }
    const float m_in = p.min_()[u];
    const float mtt = bs + fmaxf(cm, m_in);
    bsum[lane] = bs; gs[lane] = g; mt[lane] = mtt; wint[lane] = __expf(bs + m_in - mtt);
  }
  ld_tile<bf16_t>(Qs, p.QC() + (size_t)ui.rowbase * 512 + hc, 512, tid);
  ld_tile128<bf16_t>(CT, p.SM() + (size_t)u * 16384, 128, tid);
  if (tid < 128) CT[128 * 136 + tid] = f2bf(p.nloc()[u * 128 + tid]);
  for (int i = tid; i < 15 * 128; i += 256) CT[(129 + (i >> 7)) * 136 + (i & 127)] = 0;
  __syncthreads();
  f32x4 acc[9][1];
#pragma unroll
  for (int mi = 0; mi < 9; ++mi) acc[mi][0] = (f32x4){0.f, 0.f, 0.f, 0.f};
  wmma<9, 1, 4>(acc, CT, 136, Qs + 16 * w * 136, 136, fr, fq);
  const int t = 16 * w + fr;
  const float wi = wint[t];
#pragma unroll
  for (int mi = 0; mi < 9; ++mi) acc[mi][0] *= wi;
  __syncthreads();
  ld_tile<bf16_t>(Ks, p.KC() + (size_t)ui.rowbase * 512 + hc, 512, tid);
  ld_T<bf16_t, 64, 72>(Vt, PRG(2) + (size_t)ui.rowbase * 512 + hc, 512, tid);
  if (tid < 64) Vt[128 * 72 + tid] = 0x3F80;
  for (int i = tid; i < 15 * 64; i += 256) Vt[(129 + (i >> 6)) * 72 + (i & 63)] = 0;
  __syncthreads();
  f32x4 st[4][1];
#pragma unroll
  for (int mi = 0; mi < 4; ++mi) st[mi][0] = (f32x4){0.f, 0.f, 0.f, 0.f};
  wmma<4, 1, 4>(st, Ks, 136, Qs + 16 * w * 136, 136, fr, fq);
  const float bt = bsum[t], mtt = mt[t];
#pragma unroll
  for (int mi = 0; mi < 4; ++mi) {
    float a[4];
#pragma unroll
    for (int j = 0; j < 4; ++j) {
      const int s = mi * 16 + fq * 4 + j;
      a[j] = (s <= t) ? st[mi][0][j] * __expf(bt + gs[s] - mtt) : 0.f;
    }
    u32x2 pk; pk.x = pack2(a[0], a[1]); pk.y = pack2(a[2], a[3]);
    *(u32x2*)(Ps + t * 72 + mi * 16 + fq * 4) = pk;
  }
  __syncthreads();
  wmma<9, 1, 2>(acc, Vt, 72, Ps + 16 * w * 72, 72, fr, fq);
  const float den = __shfl(acc[8][0][0], fr);
  const float inv = 1.f / fmaxf(fabsf(den), __expf(-mtt));
  float ss = 0.f;
#pragma unroll
  for (int mi = 0; mi < 8; ++mi) { acc[mi][0] *= inv; ss += acc[mi][0][0] * acc[mi][0][0] + acc[mi][0][1] * acc[mi][0][1] + acc[mi][0][2] * acc[mi][0][2] + acc[mi][0][3] * acc[mi][0][3]; }
  ss += __shfl_xor(ss, 16); ss += __shfl_xor(ss, 32);
  const float rs = rsqrtf(ss * (1.f / 128.f) + 1e-6f);
  const size_t row = (size_t)ui.rowbase + t;
#pragma unroll
  for (int mi = 0; mi < 8; ++mi) {
    const int col = hc + mi * 16 + fq * 4;
    const u32x2 ov = *(const u32x2*)(PRG(3) + row * 512 + col);
    const u32x2 zv = *(const u32x2*)(PRG(4) + row * 512 + col);
    const float4 g = *(const float4*)(p.g_ml + l * 512 + col);
    const f32x4 v = acc[mi][0];
    u32x2 pk;
    pk.x = pack2(v[0] * rs * g.x * sigm(lo2f(ov.x)) * silu(lo2f(zv.x)), v[1] * rs * g.y * sigm(hi2f(ov.x)) * silu(hi2f(zv.x)));
    pk.y = pack2(v[2] * rs * g.z * sigm(lo2f(ov.y)) * silu(lo2f(zv.y)), v[3] * rs * g.w * sigm(hi2f(ov.y)) * silu(hi2f(zv.y)));
    *(u32x2*)(p.H() + row * 512 + col) = pk;
  }
}

__device__ __forceinline__ bf16x8 scale_frag(const bf16_t* src, const float* ea, const float* eb, float sgn, bool clampit) {
  u32x4 raw = *(const u32x4*)src;
  float4 a0 = *(const float4*)ea, a1 = *(const float4*)(ea + 4);
  float4 b0 = {0.f, 0.f, 0.f, 0.f}, b1 = {0.f, 0.f, 0.f, 0.f};
  if (eb) { b0 = *(const float4*)eb; b1 = *(const float4*)(eb + 4); }
  float e[8] = {a0.x - b0.x, a0.y - b0.y, a0.z - b0.z, a0.w - b0.w, a1.x - b1.x, a1.y - b1.y, a1.z - b1.z, a1.w - b1.w};
  float v[8] = {lo2f(raw.x), hi2f(raw.x), lo2f(raw.y), hi2f(raw.y), lo2f(raw.z), hi2f(raw.z), lo2f(raw.w), hi2f(raw.w)};
  unsigned o[4];
#pragma unroll
  for (int i = 0; i < 4; ++i) {
    float x0 = sgn * e[2 * i], x1 = sgn * e[2 * i + 1];
    if (clampit) { x0 = fminf(x0, 80.f); x1 = fminf(x1, 80.f); }
    o[i] = pack2(v[2 * i] * __expf(x0), v[2 * i + 1] * __expf(x1));
  }
  u32x4 r = {o[0], o[1], o[2], o[3]};
  return __builtin_bit_cast(bf16x8, r);
}

__device__ void hgrn_out(const Params& p, int l, int u, char* smem) {
  float* bc = (float*)smem;
  bf16_t* ST = (bf16_t*)smem;
  bf16_t* qs = (bf16_t*)(smem + 34816);
  bf16_t* kh = (bf16_t*)(smem + 34816 + 17408);
  bf16_t* iT = kh;
  bf16_t* Ps = (bf16_t*)(smem + 34816 + 17408 + 18432);
  float* tot = (float*)(smem + 79872);
  const int tid = get_tid(), lane = tid & 63, w = tid >> 6, fr = lane & 15, fq = lane >> 4;
  const UnitInfo ui = unit_info(u);
  const int hc = ui.h * 128;
  __syncthreads();
  ld_tile<bf16_t>(qs, PRG(9) + (size_t)ui.rowbase * 512 + hc, 512, tid);
  ld_tile<bf16_t>(kh, PRG(10) + (size_t)ui.rowbase * 512 + hc, 512, tid);
  __syncthreads();
  {
    const int half = tid >> 7, ch = tid & 127;
    const float lb = hgrn_lb(p, l, hc + ch);
    bf16_t* src = kh + (half * 32) * 136 + ch;
    float run = 0.f;
#pragma unroll 8
    for (int t = 0; t < 32; ++t) { float lg, k; hgrn_gate(bf2f(src[t * 136]), lb, lg, k); run += lg; }
    tot[half * 128 + ch] = run;
    __syncthreads();
    run = half ? tot[ch] : 0.f;
#pragma unroll 8
    for (int t = 0; t < 32; ++t) {
      float lg, k; hgrn_gate(bf2f(src[t * 136]), lb, lg, k); run += lg;
      bc[(half * 32 + t) * 132 + ch] = run;
      src[t * 136] = f2bf(k);
    }
  }
  __syncthreads();
  {
    const int I = w, t = 16 * I + fr;
    f32x4 a[4];
#pragma unroll
    for (int J = 0; J < 4; ++J) a[J] = (f32x4){0.f, 0.f, 0.f, 0.f};
#pragma unroll
    for (int kk = 0; kk < 4; ++kk) {
      const int c0 = kk * 32 + fq * 8;
      const float* rI = (I > 0) ? bc + (16 * I - 1) * 132 + c0 : nullptr;
      const bf16x8 bq = scale_frag(qs + t * 136 + c0, bc + t * 132 + c0, rI, 1.f, false);
#pragma unroll
      for (int J = 0; J < 4; ++J) {
        if (J <= I) {
          const int s = 16 * J + fr;
          const bf16x8 ak = scale_frag(kh + s * 136 + c0, bc + s * 132 + c0, rI, -1.f, true);
          a[J] = __builtin_amdgcn_mfma_f32_16x16x32_bf16(ak, bq, a[J], 0, 0, 0);
        }
      }
    }
#pragma unroll
    for (int J = 0; J < 4; ++J) {
      float v[4];
#pragma unroll
      for (int j = 0; j < 4; ++j) { const int s = 16 * J + fq * 4 + j; v[j] = (s <= t) ? a[J][j] : 0.f; }
      u32x2 pk; pk.x = pack2(v[0], v[1]); pk.y = pack2(v[2], v[3]);
      *(u32x2*)(Ps + t * 72 + J * 16 + fq * 4) = pk;
    }
  }
  __syncthreads();
#pragma unroll 4
  for (int i = tid; i < 64 * 128; i += 256) { const int t = i >> 7, c = i & 127; qs[t * 136 + c] = f2bf(bf2f(qs[t * 136 + c]) * __expf(bc[t * 132 + c])); }
  __syncthreads();
  ld_T<bf16_t, 64, 72>(iT, PRG(11) + (size_t)ui.rowbase * 512 + hc, 512, tid);
  ld_tile128<bf16_t>(ST, p.SH() + (size_t)u * 16384, 128, tid);
  __syncthreads();
  f32x4 acc[8][1];
#pragma unroll
  for (int mi = 0; mi < 8; ++mi) acc[mi][0] = (f32x4){0.f, 0.f, 0.f, 0.f};
  wmma<8, 1, 2>(acc, iT, 72, Ps + 16 * w * 72, 72, fr, fq);
  wmma<8, 1, 4>(acc, ST, 136, qs + 16 * w * 136, 136, fr, fq);
  float ss = 0.f;
#pragma unroll
  for (int mi = 0; mi < 8; ++mi) ss += acc[mi][0][0] * acc[mi][0][0] + acc[mi][0][1] * acc[mi][0][1] + acc[mi][0][2] * acc[mi][0][2] + acc[mi][0][3] * acc[mi][0][3];
  ss += __shfl_xor(ss, 16); ss += __shfl_xor(ss, 32);
  const float rs = rsqrtf(ss * (1.f / 128.f) + 1e-6f);
  const size_t row = (size_t)ui.rowbase + 16 * w + fr;
#pragma unroll
  for (int mi = 0; mi < 8; ++mi) {
    const int col = hc + mi * 16 + fq * 4;
    const u32x2 zv = *(const u32x2*)(PRG(12) + row * 512 + col);
    const float4 g = *(const float4*)(p.g_hg + l * 512 + col);
    const f32x4 v = acc[mi][0];
    u32x2 pk;
    pk.x = pack2(v[0] * rs * g.x * silu(lo2f(zv.x)), v[1] * rs * g.y * silu(hi2f(zv.x)));
    pk.y = pack2(v[2] * rs * g.z * silu(lo2f(zv.y)), v[3] * rs * g.w * silu(hi2f(zv.y)));
    *(u32x2*)(p.H() + (size_t)2 * NTOK * 512 + row * 512 + col) = pk;
  }
}

__device__ void merge_tile(const Params& p, int l, int t, char* smem) {
  const int tm = t >> 3, tn = t & 7;
  const int tid = get_tid(), lane = tid & 63, wid = tid >> 6, wr = wid >> 1, wc = wid & 1, fr = lane & 15, fq = lane >> 4;
#pragma unroll 1
  for (int b = 0; b < 3; ++b) {
    f32x4 acc[4][4]; zero_acc(acc);
    gemm_kloop<bf16_t>(acc, p.U() + (size_t)tm * 128 * 1024, 1024, p.wt_in() + (size_t)l * NWT * 1024 + (size_t)(NMAIN + b * 1024 + tn * 128) * 1024, 1024, 1024, smem);
#pragma unroll
    for (int ni = 0; ni < 4; ++ni)
#pragma unroll
      for (int mi = 0; mi < 4; ++mi) {
        f32x4 v; v[0] = sigm(acc[mi][ni][0]); v[1] = sigm(acc[mi][ni][1]); v[2] = sigm(acc[mi][ni][2]); v[3] = sigm(acc[mi][ni][3]);
        *(f32x4*)(p.r() + ((size_t)tm * 128 + wr * 64 + ni * 16 + fr) * 1024 + tn * 128 + wc * 64 + mi * 16 + fq * 4) = v;
      }
    zero_acc(acc);
    gemm_kloop<bf16_t>(acc, p.H() + (size_t)b * NTOK * 512 + (size_t)tm * 128 * 512, 512, p.wt_br() + (size_t)(l * 3 + b) * 1024 * 512 + (size_t)tn * 128 * 512, 512, 512, smem);
#pragma unroll
    for (int ni = 0; ni < 4; ++ni) {
      const size_t row = (size_t)tm * 128 + wr * 64 + ni * 16 + fr;
#pragma unroll
      for (int mi = 0; mi < 4; ++mi) {
        const int col = tn * 128 + wc * 64 + mi * 16 + fq * 4;
        f32x4 v = *(const f32x4*)(p.r() + row * 1024 + col) * acc[mi][ni];
        float* part = p.y() + row * 1024 + col;
        if (b > 0) v += *(const f32x4*)part;
        if (b < 2) *(f32x4*)part = v;
        else { u32x2 pk; pk.x = pack2(v[0], v[1]); pk.y = pack2(v[2], v[3]); *(u32x2*)(p.merged() + row * 1024 + col) = pk; }
      }
    }
  }
}

__device__ void outproj_tile(const Params& p, int l, int t, char* smem) {
  const int tm = t >> 3, tn = t & 7;
  const int tid = get_tid(), lane = tid & 63, wid = tid >> 6, wr = wid >> 1, wc = wid & 1, fr = lane & 15, fq = lane >> 4;
  f32x4 acc[4][4]; zero_acc(acc);
  gemm_kloop<bf16_t>(acc, p.merged() + (size_t)tm * 128 * 1024, 1024, p.wt_out() + (size_t)l * 1048576 + (size_t)tn * 128 * 1024, 1024, 1024, smem);
#pragma unroll
  for (int ni = 0; ni < 4; ++ni) {
    const size_t row = (size_t)tm * 128 + wr * 64 + ni * 16 + fr;
#pragma unroll
    for (int mi = 0; mi < 4; ++mi) *(f32x4*)(p.y() + row * 1024 + tn * 128 + wc * 64 + mi * 16 + fq * 4) = acc[mi][ni];
  }
}


__device__ void outproj_tile256(const Params& p, int l, int t, char* smem) {
  constexpr int NT = 8;
  const int tm = t >> 3, tn = t & 7;
  const int tid = get_tid(), lane = tid & 63, wid = tid >> 6, wr = wid >> 1, wc = wid & 1, fr = lane & 15, fq = lane >> 4;
  f32x4 acc[4][NT];
#pragma unroll
  for (int a_ = 0; a_ < 4; ++a_)
#pragma unroll
    for (int b_ = 0; b_ < NT; ++b_) acc[a_][b_] = (f32x4){0.f, 0.f, 0.f, 0.f};
  gemm_glds<NT, 3>(acc, p.merged() + (size_t)tm * 256 * 1024, 1024, p.wt_out() + (size_t)l * 1048576 + (size_t)tn * 128 * 1024, 1024, 1024, smem);
#pragma unroll
  for (int ni = 0; ni < NT; ++ni) {
    const size_t row = (size_t)tm * 256 + wr * 128 + ni * 16 + fr;
#pragma unroll
    for (int m = 0; m < 2; ++m) {
      float* op = p.y() + row * 1024 + tn * 128 + wc * 64 + m * 32 + fq * 8;
      *(f32x4*)op = acc[2 * m][ni]; *(f32x4*)(op + 4) = acc[2 * m + 1][ni];
    }
  }
}


__device__ void gate_tile256(const Params& p, int l, int t, char* smem) {
  constexpr int NT = 8;
  const int tm = t / 24, tn = t % 24;
  const int tid = get_tid(), lane = tid & 63, wid = tid >> 6, wr = wid >> 1, wc = wid & 1, fr = lane & 15, fq = lane >> 4;
  f32x4 acc[4][NT];
#pragma unroll
  for (int a_ = 0; a_ < 4; ++a_)
#pragma unroll
    for (int b_ = 0; b_ < NT; ++b_) acc[a_][b_] = (f32x4){0.f, 0.f, 0.f, 0.f};
  gemm_glds<NT, 3>(acc, p.U() + (size_t)tm * 256 * 1024, 1024, p.wt_in() + (size_t)l * NWT * 1024 + (size_t)(NMAIN + tn * 128) * 1024, 1024, 1024, smem);
#pragma unroll
  for (int ni = 0; ni < NT; ++ni) {
    const size_t row = (size_t)tm * 256 + wr * 128 + ni * 16 + fr;
#pragma unroll
    for (int m = 0; m < 2; ++m) {
      const f32x4 v0 = acc[2 * m][ni], v1 = acc[2 * m + 1][ni];
      u32x4 pk; pk.x = pack2(sigm(v0[0]), sigm(v0[1])); pk.y = pack2(sigm(v0[2]), sigm(v0[3])); pk.z = pack2(sigm(v1[0]), sigm(v1[1])); pk.w = pack2(sigm(v1[2]), sigm(v1[3]));
      *(u32x4*)(p.Gb(tn >> 3) + row * 1024 + (tn & 7) * 128 + wc * 64 + m * 32 + fq * 8) = pk;
    }
  }
}
__device__ void merge_tile_g(const Params& p, int l, int t, char* smem) {
  const int tm = t >> 3, tn = t & 7;
  const int tid = get_tid(), lane = tid & 63, wid = tid >> 6, wr = wid >> 1, wc = wid & 1, fr = lane & 15, fq = lane >> 4;
  f32x4 macc[4][4]; zero_acc(macc);
#pragma unroll 1
  for (int b = 0; b < 3; ++b) {
    f32x4 acc[4][4]; zero_acc(acc);
    gemm_kloop<bf16_t>(acc, p.H() + (size_t)b * NTOK * 512 + (size_t)tm * 128 * 512, 512, p.wt_br() + (size_t)(l * 3 + b) * 1024 * 512 + (size_t)tn * 128 * 512, 512, 512, smem);
#pragma unroll
    for (int ni = 0; ni < 4; ++ni) {
      const size_t row = (size_t)tm * 128 + wr * 64 + ni * 16 + fr;
#pragma unroll
      for (int mi = 0; mi < 4; ++mi) {
        const u32x2 g = *(const u32x2*)(p.Gb(b) + row * 1024 + tn * 128 + wc * 64 + mi * 16 + fq * 4);
        macc[mi][ni][0] += lo2f(g.x) * acc[mi][ni][0]; macc[mi][ni][1] += hi2f(g.x) * acc[mi][ni][1];
        macc[mi][ni][2] += lo2f(g.y) * acc[mi][ni][2]; macc[mi][ni][3] += hi2f(g.y) * acc[mi][ni][3];
      }
    }
  }
#pragma unroll
  for (int ni = 0; ni < 4; ++ni) {
    const size_t row = (size_t)tm * 128 + wr * 64 + ni * 16 + fr;
#pragma unroll
    for (int mi = 0; mi < 4; ++mi) {
      u32x2 pk; pk.x = pack2(macc[mi][ni][0], macc[mi][ni][1]); pk.y = pack2(macc[mi][ni][2], macc[mi][ni][3]);
      *(u32x2*)(p.merged() + row * 1024 + tn * 128 + wc * 64 + mi * 16 + fq * 4) = pk;
    }
  }
}

__device__ void postnorm_phase(const Params& p, int l) {
  const int lane = threadIdx.x & 63, wid = threadIdx.x >> 6;
  const float* gp = p.g_post + l * 1024;
  for (int row = blockIdx.x * 4 + wid; row < NTOK; row += gridDim.x * 4) {
    const float* x = xrow(p, l, row);
    const float* y = p.y() + (size_t)row * 1024;
    float4 v[4]; float ss = 0.f;
#pragma unroll
    for (int i = 0; i < 4; ++i) { v[i] = *(const float4*)(y + i * 256 + lane * 4); ss += v[i].x * v[i].x + v[i].y * v[i].y + v[i].z * v[i].z + v[i].w * v[i].w; }
#pragma unroll
    for (int o = 32; o > 0; o >>= 1) ss += __shfl_xor(ss, o);
    const float rstd = rsqrtf(ss * (1.f / 1024.f) + 1e-6f);
#pragma unroll
    for (int i = 0; i < 4; ++i) {
      const int k = i * 256 + lane * 4;
      const float4 g = *(const float4*)(gp + k), xv = *(const float4*)(x + k);
      float4 r; r.x = xv.x + v[i].x * rstd * g.x; r.y = xv.y + v[i].y * rstd * g.y; r.z = xv.z + v[i].z * rstd * g.z; r.w = xv.w + v[i].w * rstd * g.w;
      *(float4*)(p.r() + (size_t)row * 1024 + k) = r;
      u32x2 pk; pk.x = pack2(r.x, r.y); pk.y = pack2(r.z, r.w);
      *(u32x2*)(p.rb() + (size_t)row * 1024 + k) = pk;
    }
  }
}

__device__ void ple_tile(const Params& p, int l, int t, char* smem) {
  const int tm = t >> 3, tn = t & 7;
  const int tid = get_tid(), lane = tid & 63, wid = tid >> 6, wr = wid >> 1, wc = wid & 1, fr = lane & 15, fq = lane >> 4;
  f32x4 acc[4][4]; zero_acc(acc);
  const int row0 = tm * 128;
  const float* pp = row0 < NPROMPT ? p.p_p + ((size_t)l * NPROMPT + row0) * 256 : p.p_s + ((size_t)l * 512 + (row0 - NPROMPT)) * 256;
  gemm_kloop<float>(acc, pp, 256, p.wt_pp() + (size_t)l * 262144 + (size_t)tn * 128 * 256, 256, 256, smem);
  u32x2 pb[4][4];
#pragma unroll
  for (int a = 0; a < 4; ++a)
#pragma unroll
    for (int c = 0; c < 4; ++c) { pb[a][c].x = pack2(acc[a][c][0], acc[a][c][1]); pb[a][c].y = pack2(acc[a][c][2], acc[a][c][3]); }
  zero_acc(acc);
  gemm_kloop<bf16_t>(acc, p.rb() + (size_t)tm * 128 * 1024, 1024, p.wt_pg() + (size_t)l * 1048576 + (size_t)tn * 128 * 1024, 1024, 1024, smem);
#pragma unroll
  for (int ni = 0; ni < 4; ++ni) {
    const size_t row = (size_t)row0 + wr * 64 + ni * 16 + fr;
#pragma unroll
    for (int mi = 0; mi < 4; ++mi) {
      const int col = tn * 128 + wc * 64 + mi * 16 + fq * 4;
      const f32x4 rv = *(const f32x4*)(p.r() + row * 1024 + col);
      f32x4 o;
      o[0] = rv[0] + sigm(acc[mi][ni][0]) * lo2f(pb[mi][ni].x); o[1] = rv[1] + sigm(acc[mi][ni][1]) * hi2f(pb[mi][ni].x);
      o[2] = rv[2] + sigm(acc[mi][ni][2]) * lo2f(pb[mi][ni].y); o[3] = rv[3] + sigm(acc[mi][ni][3]) * hi2f(pb[mi][ni].y);
      *(f32x4*)(p.o_y() + row * 1024 + col) = o;
    }
  }
}


template <typename TT>
__device__ __forceinline__ void mini_dot(f32x4& acc, const TT* Trow, const bf16_t* Wrow, int K) {
#pragma unroll 8
  for (int k = 0; k < K; k += 32) {
    const u32x4 tv = ld8(Trow + k), wv = ld8(Wrow + k);
    acc = __builtin_amdgcn_mfma_f32_16x16x32_bf16(__builtin_bit_cast(bf16x8, wv), __builtin_bit_cast(bf16x8, tv), acc, 0, 0, 0);
  }
}
__device__ void merge_mini(const Params& p, int l, int j) {
  const int tid = get_tid(), lane = tid & 63, w = tid >> 6, fr = lane & 15, fq = lane >> 4;
  const size_t row = (size_t)NPROMPT + (j >> 4) * 16 + fr;
  const int cb = (j & 15) * 64 + w * 16;
  f32x4 out = {0.f, 0.f, 0.f, 0.f};
#pragma unroll 1
  for (int b = 0; b < 3; ++b) {
    f32x4 h = {0.f, 0.f, 0.f, 0.f};
    mini_dot<bf16_t>(h, p.H() + (size_t)b * NTOK * 512 + row * 512 + fq * 8, p.wt_br() + (size_t)(l * 3 + b) * 1024 * 512 + (size_t)(cb + fr) * 512 + fq * 8, 512);
    const u32x2 g = *(const u32x2*)(p.Gb(b) + row * 1024 + cb + fq * 4);
    out[0] += lo2f(g.x) * h[0]; out[1] += hi2f(g.x) * h[1]; out[2] += lo2f(g.y) * h[2]; out[3] += hi2f(g.y) * h[3];
  }
  u32x2 pk; pk.x = pack2(out[0], out[1]); pk.y = pack2(out[2], out[3]);
  *(u32x2*)(p.merged() + row * 1024 + cb + fq * 4) = pk;
}
__device__ void outproj_mini(const Params& p, int l, int j) {
  const int tid = get_tid(), lane = tid & 63, w = tid >> 6, fr = lane & 15, fq = lane >> 4;
  const size_t row = (size_t)NPROMPT + (j >> 4) * 16 + fr;
  const int cb = (j & 15) * 64 + w * 16;
  f32x4 y = {0.f, 0.f, 0.f, 0.f};
  mini_dot<bf16_t>(y, p.merged() + row * 1024 + fq * 8, p.wt_out() + (size_t)l * 1048576 + (size_t)(cb + fr) * 1024 + fq * 8, 1024);
  *(f32x4*)(p.y() + row * 1024 + cb + fq * 4) = y;
}
__device__ void ple_mini(const Params& p, int l, int j) {
  const int tid = get_tid(), lane = tid & 63, w = tid >> 6, fr = lane & 15, fq = lane >> 4;
  const int srow = (j >> 4) * 16 + fr;
  const size_t row = (size_t)NPROMPT + srow;
  const int cb = (j & 15) * 64 + w * 16;
  f32x4 g = {0.f, 0.f, 0.f, 0.f}, pa = {0.f, 0.f, 0.f, 0.f};
  mini_dot<float>(pa, p.p_s + ((size_t)l * 512 + srow) * 256 + fq * 8, p.wt_pp() + (size_t)l * 262144 + (size_t)(cb + fr) * 256 + fq * 8, 256);
  mini_dot<bf16_t>(g, p.rb() + row * 1024 + fq * 8, p.wt_pg() + (size_t)l * 1048576 + (size_t)(cb + fr) * 1024 + fq * 8, 1024);
  const f32x4 rv = *(const f32x4*)(p.r() + row * 1024 + cb + fq * 4);
  f32x4 o; o[0] = rv[0] + sigm(g[0]) * pa[0]; o[1] = rv[1] + sigm(g[1]) * pa[1]; o[2] = rv[2] + sigm(g[2]) * pa[2]; o[3] = rv[3] + sigm(g[3]) * pa[3];
  *(f32x4*)(p.o_y() + row * 1024 + cb + fq * 4) = o;
}

#define XB_TMO      128
#define XB_XCNT(j)  (256  + 64 * (j))
#define XB_XSUB(j)  (1280 + 64 * (j))
#define XB_XGEN(j)  (2304 + 64 * (j))
#define XB_TOP      3328
#define XB_TOPGEN   3392
#define XCD_BAR_WORDS 3456
#define XB_SPIN_CAP (1u << 18)
#define LAS __attribute__((address_space(3)))
__device__ __forceinline__ unsigned xb_ld(unsigned* p)              { return __hip_atomic_load(p, __ATOMIC_RELAXED, __HIP_MEMORY_SCOPE_AGENT); }
__device__ __forceinline__ unsigned xb_add(unsigned* p, unsigned v) { return __hip_atomic_fetch_add(p, v, __ATOMIC_RELAXED, __HIP_MEMORY_SCOPE_AGENT); }
__device__ __forceinline__ unsigned xb_xcc_id() { return (unsigned)__builtin_amdgcn_s_getreg((3 << 11) | 20) & 0xFu; }
#define XB_SPIN(cond, bar) do { unsigned _sp = 0; while (cond) { __builtin_amdgcn_s_sleep(1); \
    if ((++_sp & 255u) == 0u) { if (xb_ld(&(bar)[XB_TMO])) break; if (_sp > XB_SPIN_CAP) { atomicAdd(&(bar)[XB_TMO], 1u); break; } } } } while (0)
__device__ __forceinline__ void xcd_barrier_complete(unsigned* bar, unsigned x, unsigned& nloc, unsigned& nx) {
    const unsigned G = gridDim.x * gridDim.y * gridDim.z;
    unsigned sum, cnt, mine, sp = 0u;
    for (;;) {
        sum = 0u; cnt = 0u; mine = 0u;
#pragma unroll
        for (unsigned j = 0; j < 16; ++j) { const unsigned c = xb_ld(&bar[XB_XCNT(j)]); sum += c; cnt += (c > 0u) ? 1u : 0u; mine = (j == x) ? c : mine; }
        if (sum == G) break;
        __builtin_amdgcn_s_sleep(1);
        if ((++sp & 255u) == 0u) { if (xb_ld(&bar[XB_TMO])) break; if (sp > XB_SPIN_CAP) { atomicAdd(&bar[XB_TMO], 1u); break; } }
    }
    nloc = mine > 0u ? mine : 1u; nx = cnt > 0u ? cnt : 1u;
}
__device__ __forceinline__ void xcd_barrier(unsigned* bar, volatile LAS unsigned* st) {
    asm volatile("s_waitcnt vmcnt(0)" ::: "memory");
    __syncthreads();
    if (threadIdx.x == 0) {
        const unsigned x = xb_xcc_id();
        __builtin_amdgcn_s_waitcnt(0);
        unsigned nloc = st[0], nx = st[1];
        if (nloc == 0u) { xcd_barrier_complete(bar, x, nloc, nx); st[0] = nloc; st[1] = nx; }
        const unsigned old = xb_add(&bar[XB_XSUB(x)], 1u);
        const unsigned gen = old / nloc;
        if (old + 1u == (gen + 1u) * nloc) {
            __builtin_amdgcn_fence(__ATOMIC_RELEASE, "agent");
            asm volatile("s_waitcnt vmcnt(0)" ::: "memory");
            const unsigned og = xb_add(&bar[XB_TOP], 1u);
            const unsigned tg = og / nx;
            if (og + 1u == (tg + 1u) * nx) xb_add(&bar[XB_TOPGEN], 1u);
            else XB_SPIN(xb_ld(&bar[XB_TOPGEN]) == tg, bar);
            __builtin_amdgcn_fence(__ATOMIC_ACQUIRE, "agent");
            xb_add(&bar[XB_XGEN(x)], 1u);
            asm volatile("s_waitcnt vmcnt(0)" ::: "memory");
        } else {
            XB_SPIN(xb_ld(&bar[XB_XGEN(x)]) == gen, bar);
            __builtin_amdgcn_fence(__ATOMIC_ACQUIRE, "agent");
            asm volatile("s_waitcnt vmcnt(0)" ::: "memory");
        }
    }
    __syncthreads();
}

template <int PH>
__device__ __forceinline__ void run_phase(const Params& p, char* smem) {
  const int bid = blockIdx.x, nb = gridDim.x;
  if (PH == 0) {
    for (int t = bid; t < 1696; t += nb) wconv_tile(p, t, smem);
    for (int i = bid * 256 + get_tid(); i < 2 * 8 * 1024; i += nb * 256) { const int ll = i >> 13, j = (i >> 10) & 7, k = i & 1023; p.wg8()[i] = p.w_in[((size_t)ll * 1024 + k) * NINSRC + 2560 + j]; }
    return;
  }
  constexpr int l = (PH - 1) / NPL, s = (PH - 1) % NPL;
  if (!((PHMASK >> s) & 1)) return;
  switch (s) {
    case 0: norm_phase(p, l); break;
    case 1: {
      const int per = (66 * 52) / 8, xcd = bid & 7, nloc = (nb + 7 - xcd) >> 3;
      for (int j = bid >> 3; j < per; j += nloc) {
        const int sq = xcd * per + j;
        const int tmg = sq / 416, rem = sq % 416, gm = (tmg == 8) ? 2 : 8;
        const int tng = rem / (gm * 8), rem2 = rem % (gm * 8), wdt = (tng == 6) ? 4 : 8;
        inproj_tile(p, l, (tmg * 8 + rem2 / wdt) * 52 + tng * 8 + rem2 % wdt, smem);
      }
      break;
    }
    case 2:
      for (int v = bid; v < 3 * NUNIT; v += nb) {
        const int ty = v % 3, u = v / 3;
        if (ty == 0) sb_unit(p, l, u, smem); else if (ty == 1) mlstm_local(p, l, u, smem); else hgrn_local(p, l, u, smem);
      }
      break;
    case 3: scan_phase(p, l, smem); break;
    case 4:
      for (int v = bid; v < 2 * NUNIT; v += nb) { if (v & 1) hgrn_out(p, l, v >> 1, smem); else mlstm_out(p, l, v >> 1, smem); }
      break;
    case 5: for (int t = bid; t < 1024; t += nb) merge_tile(p, l, t, smem); for (int j = bid; j < 512; j += nb) merge_mini(p, l, j); break;
    case 6: for (int t = bid; t < 1024; t += nb) outproj_tile(p, l, t, smem); for (int j = bid; j < 512; j += nb) outproj_mini(p, l, j); break;
    case 7: postnorm_phase(p, l); break;
    case 8: for (int t = bid; t < 1024; t += nb) ple_tile(p, l, t, smem); for (int j = bid; j < 512; j += nb) ple_mini(p, l, j); break;
  }
}

template <int PH>
__global__ void __launch_bounds__(256, 2) phase_kernel(Params p) {
  __shared__ __attribute__((aligned(16))) char smem[SMEM_BYTES];
  run_phase<PH>(p, smem);
}

#if FUSED
__device__ __forceinline__ int fetch_work(unsigned* ctr, volatile int* slot) {
  __syncthreads();
  if (threadIdx.x == 0) *slot = (int)__hip_atomic_fetch_add(ctr, 1u, __ATOMIC_RELAXED, __HIP_MEMORY_SCOPE_AGENT);
  __syncthreads();
  return *slot;
}
__device__ __forceinline__ void run_phase_rt(const Params& p, int ph, char* smem, volatile int* wslot) {
  const int bid = blockIdx.x, nb = gridDim.x;
  unsigned* ctr = (unsigned*)(p.ws + WS_BAR + 14336) + ph * 16;
  if (ph == 0) {
    for (int t = bid; t < 1696; t += nb) wconv_tile(p, t, smem);
    for (int i = bid * 256 + get_tid(); i < 2 * 8 * 1024; i += nb * 256) { const int ll = i >> 13, j = (i >> 10) & 7, k = i & 1023; p.wg8()[i] = p.w_in[((size_t)ll * 1024 + k) * NINSRC + 2560 + j]; }
    return;
  }
  const int l = (ph - 1) / NPL, s = (ph - 1) % NPL;
  switch (s) {
    case 0: norm_phase(p, l); break;
    case 1: {
      const int per = (66 * 52) / 8, xcd0 = (int)(xb_xcc_id() & 7u);
      for (int dx = 0; dx < 8; ++dx) {
        const int xcd = (xcd0 + dx) & 7;
        for (;;) {
          const int j = fetch_work(ctr + xcd, wslot);
          if (j >= per) break;
          const int sq = xcd * per + j;
          const int tmg = sq / 416, rem = sq % 416, gm = (tmg == 8) ? 2 : 8;
          const int tng = rem / (gm * 8), rem2 = rem % (gm * 8), wdt = (tng == 6) ? 4 : 8;
          inproj_tile(p, l, (tmg * 8 + rem2 / wdt) * 52 + tng * 8 + rem2 % wdt, smem);
        }
      }
      break;
    }
    case 2:
      for (;;) {
        const int v = fetch_work(ctr, wslot);
        if (v >= 3 * NUNIT) break;
        if (v < NUNIT) sb_unit(p, l, v, smem); else if (v < 2 * NUNIT) mlstm_local(p, l, v - NUNIT, smem); else hgrn_local(p, l, v - 2 * NUNIT, smem);
      }
      break;
    case 3: {
      scan_phase(p, l, smem);
      const int v = fetch_work(ctr + 8, wslot);
      if (v < 1584) gate_tile256(p, l, v < 48 ? 1536 + v : v - 48, smem);
      break;
    }
    case 4: {
      unsigned* gq = ctr - 16 + 8;
      bool gleft = true, uleft = true;
      while (gleft || uleft) {
        if (gleft) { const int v = fetch_work(gq, wslot); if (v < 1584) gate_tile256(p, l, v < 48 ? 1536 + v : v - 48, smem); else gleft = false; }
        for (int k = 0; k < 2 && uleft; ++k) {
          const int u = fetch_work(ctr, wslot);
          if (u >= 2 * NUNIT) uleft = false;
          else if (u < NUNIT) hgrn_out(p, l, u, smem); else mlstm_out(p, l, u - NUNIT, smem);
        }
      }
      break;
    }
    case 5: for (;;) { const int v = fetch_work(ctr, wslot); if (v >= 1536) break; if (v < 1024) merge_tile_g(p, l, v, smem); else merge_mini(p, l, v - 1024); } break;
    case 6: for (;;) { const int v = fetch_work(ctr, wslot); if (v >= 1024) break; if (v < 512) outproj_tile256(p, l, v, smem); else outproj_mini(p, l, v - 512); } break;
    case 7: postnorm_phase(p, l); break;
    case 8: for (;;) { const int v = fetch_work(ctr, wslot); if (v >= 1536) break; if (v < 1024) ple_tile(p, l, v, smem); else ple_mini(p, l, v - 1024); } break;
  }
}

__global__ void __launch_bounds__(256, 2) mega(Params p_unused) {
  __shared__ __attribute__((aligned(16))) char smem[SMEM_BYTES];
  __shared__ uint4 xb_words;
  __shared__ int wslot;
  if (threadIdx.x == 0) {
    typedef const Params __attribute__((address_space(4))) * KP4;
    KP4 kp = (KP4)__builtin_amdgcn_kernarg_segment_ptr();
    asm volatile("" : "+s"(kp));
    char* wsb = ((const Params*)kp)->ws;
    xb_words = make_uint4(0u, 0u, 0u, 0u); (void)xb_add((unsigned*)(wsb + WS_BAR) + XB_XCNT(xb_xcc_id()), 1u);
  }
  __syncthreads();
  typedef const Params __attribute__((address_space(4))) * KP4;
#ifdef PROBE_KIND
  unsigned long long t_acc = 0;
#endif
#pragma unroll 1
  for (int ph = 0; ph < NPHASE; ++ph) {
    KP4 kp = (KP4)__builtin_amdgcn_kernarg_segment_ptr();
    asm volatile("" : "+s"(kp));
    const Params q = *(const Params*)kp;
#ifdef PROBE_KIND
    const unsigned long long tp0 = __builtin_amdgcn_s_memrealtime();
#endif
    run_phase_rt(q, ph, smem, &wslot);
#ifdef PROBE_KIND
    const unsigned long long tp1 = __builtin_amdgcn_s_memrealtime();
    if ((PROBE_KIND == 9 && ph == 0) || (PROBE_KIND < 9 && ph > 0 && (ph - 1) % NPL == PROBE_KIND)) t_acc += tp1 - tp0;
#endif
    if (ph + 1 < NPHASE) xcd_barrier((unsigned*)(q.ws + WS_BAR), (volatile LAS unsigned*)&xb_words);
    if (gridDim.y == 7777u) cg::this_grid().sync();
#ifdef PROBE_KIND
    if (PROBE_KIND == 10 && (PROBE_SEL < 0 || (ph > 0 && (ph - 1) % NPL == PROBE_SEL))) t_acc += __builtin_amdgcn_s_memrealtime() - tp1;
#endif
  }
#ifdef PROBE_GEMM
  {
    KP4 kp = (KP4)__builtin_amdgcn_kernarg_segment_ptr();
    asm volatile("" : "+s"(kp));
    const Params q = *(const Params*)kp;
    xcd_barrier((unsigned*)(q.ws + WS_BAR), (volatile LAS unsigned*)&xb_words);
    const unsigned long long tg0 = __builtin_amdgcn_s_memrealtime();
    f32x4 acc[4][8];
#pragma unroll
    for (int a_ = 0; a_ < 4; ++a_)
#pragma unroll
      for (int b_ = 0; b_ < 8; ++b_) acc[a_][b_] = (f32x4){0.f, 0.f, 0.f, 0.f};
    const int bid = blockIdx.x;
#pragma unroll 1
    for (int it = 0; it < 8; ++it) {
      int tm, tn;
      if (PROBE_GEMM == 0) { tm = 0; tn = 0; }
      else if (PROBE_GEMM == 1) { tm = bid & 63; tn = ((bid >> 6) * 6 + it) % 52; }
      else { const int xcd = bid & 7, idx = bid >> 3; tm = xcd * 8 + (idx & 7); tn = ((idx >> 3) + 8 * it) % 52; }
      gemm_glds<8, 3>(acc, q.U() + (size_t)tm * 256 * 1024, 1024, q.wt_in() + (size_t)tn * 128 * 1024, 1024, 1024, smem);
    }
    float sum = 0.f;
#pragma unroll
    for (int a_ = 0; a_ < 4; ++a_)
#pragma unroll
      for (int b_ = 0; b_ < 8; ++b_) sum += acc[a_][b_][0] + acc[a_][b_][1] + acc[a_][b_][2] + acc[a_][b_][3];
    if (sum == 123456.789f) q.hbc()[0] = sum;
    const unsigned long long tg1 = __builtin_amdgcn_s_memrealtime();
    if (blockIdx.x == 0) { while (__builtin_amdgcn_s_memrealtime() - tg1 < 4 * (tg1 - tg0)) __builtin_amdgcn_s_sleep(32); }
  }
#endif
#ifdef PROBE_KIND
  if (blockIdx.x == PROBE_BLOCK) { const unsigned long long te = __builtin_amdgcn_s_memrealtime(); while (__builtin_amdgcn_s_memrealtime() - te < 4 * t_acc) __builtin_amdgcn_s_sleep(32); }
#endif
}
#endif

template <int PH>
static void launch_all(const Params& p, int grid, hipStream_t stream) {
  hipLaunchKernelGGL(phase_kernel<PH>, dim3(grid), dim3(256), 0, stream, p);
  if constexpr (PH + 1 < NPHASE) launch_all<PH + 1>(p, grid, stream);
}

extern "C" void kernel_launch(void* const* d_in, const int* in_sizes, int n_in, void* d_out, int out_size, void* d_ws, size_t ws_size, hipStream_t stream) {
  Params p;
  memset(&p, 0, sizeof(p));
  const float* const* in = (const float* const*)d_in;
  p.x_p = in[0]; p.x_s = in[1]; p.p_p = in[2]; p.p_s = in[3]; p.st_C = in[4]; p.st_n = in[5]; p.st_m = in[6]; p.st_conv = in[7];
  p.ck = in[8]; p.cv = in[9]; p.st_S = in[10]; p.g_pre = in[11]; p.w_in = in[12]; p.b_i = in[13]; p.b_f = in[14]; p.w_conv = in[15];
  p.g_ml = in[16]; p.lb_logits = in[17]; p.g_hg = in[18]; p.w_br = in[19]; p.w_out = in[20]; p.g_post = in[21]; p.w_pg = in[22]; p.w_pp = in[23];
  p.out = (float*)d_out; p.ws = (char*)d_ws;
  if (WS_TOTAL > ws_size || (size_t)out_size < O_TOTAL) { fprintf(stderr, "workspace/out too small: need %zu have %zu\n", (size_t)WS_TOTAL, ws_size); return; }
  static int grid_blocks = 0;
  if (!grid_blocks) {
    int dev = 0, cus = 0, per_cu = 0;
    (void)hipGetDevice(&dev);
    (void)hipDeviceGetAttribute(&cus, hipDeviceAttributeMultiprocessorCount, dev);
#if FUSED
    (void)hipOccupancyMaxActiveBlocksPerMultiprocessor(&per_cu, mega, 256, 0);
#else
    per_cu = 2;
#endif
    if (per_cu > 2) per_cu = 2;
    if (per_cu < 1) per_cu = 1;
    grid_blocks = cus * per_cu;
  }
#if FUSED
  (void)hipMemsetAsync((char*)d_ws + WS_BAR, 0, 16384, stream);
  void* args[] = {&p};
  hipError_t e = hipLaunchCooperativeKernel((void*)mega, dim3(grid_blocks), dim3(256), args, 0, stream);
  if (e != hipSuccess) fprintf(stderr, "cooperative launch failed: %s (grid %d)\n", hipGetErrorString(e), grid_blocks);
#else
  launch_all<0>(p, grid_blocks, stream);
#endif
}
```

```cpp
#include <hip/hip_runtime.h>
#include <hip/hip_cooperative_groups.h>
#include <stdint.h>
#include <stdio.h>
#include <string.h>
namespace cg = cooperative_groups;

#ifndef FUSED
#define FUSED 1
#endif
#ifndef PHMASK
#define PHMASK 0x3ff
#endif

typedef unsigned short bf16_t;
typedef short bf16x8 __attribute__((ext_vector_type(8)));
typedef float f32x4 __attribute__((ext_vector_type(4)));
typedef unsigned u32x4 __attribute__((ext_vector_type(4)));
typedef unsigned u32x2 __attribute__((ext_vector_type(2)));

constexpr int NTOK = 16896, NPROMPT = 16384, NUNIT = 1056;
constexpr int NINSRC = 9736, NWT = 9728, NMAIN = 6656;
constexpr int SMEM_BYTES = 80896;
constexpr int NPL = 9;
constexpr int NPHASE = 1 + 2 * NPL;

constexpr size_t al256(size_t x) { return (x + 255) & ~(size_t)255; }
constexpr size_t WS_WT_IN = 0;
constexpr size_t WS_WT_BR = WS_WT_IN + al256((size_t)2 * NWT * 1024 * 2);
constexpr size_t WS_WT_OUT = WS_WT_BR + al256((size_t)2 * 3 * 1024 * 512 * 2);
constexpr size_t WS_WT_PG = WS_WT_OUT + al256((size_t)2 * 1048576 * 2);
constexpr size_t WS_WT_PP = WS_WT_PG + al256((size_t)2 * 1048576 * 2);
constexpr size_t WS_U = WS_WT_PP + al256((size_t)2 * 262144 * 2);
constexpr size_t WS_PR = WS_U + al256((size_t)NTOK * 1024 * 2);
constexpr size_t WS_QC = WS_PR + al256((size_t)13 * NTOK * 512 * 2);
constexpr size_t WS_KC = WS_QC + al256((size_t)NTOK * 512 * 2);
constexpr size_t WS_SM = WS_KC + al256((size_t)NTOK * 512 * 2);
constexpr size_t WS_SH = WS_SM + al256((size_t)NUNIT * 16384 * 2);
constexpr size_t WS_H = WS_SH + al256((size_t)NUNIT * 16384 * 2);
constexpr size_t WS_IG = WS_H + al256((size_t)3 * NTOK * 512 * 2);
constexpr size_t WS_LF = WS_IG + al256((size_t)NTOK * 16);
constexpr size_t WS_AC = WS_LF + al256((size_t)NTOK * 16);
constexpr size_t WS_BC = WS_AC + al256(NUNIT * 4);
constexpr size_t WS_MIN = WS_BC + al256(NUNIT * 4);
constexpr size_t WS_NLOC = WS_MIN + al256(NUNIT * 4);
constexpr size_t WS_HBC = WS_NLOC + al256((size_t)NUNIT * 512);
constexpr size_t WS_BAR = WS_HBC + al256((size_t)NUNIT * 512);
constexpr size_t WS_WG8 = WS_BAR + 16384;
constexpr size_t WS_TOTAL = WS_WG8 + 65536;
constexpr size_t GRP = (size_t)NTOK * 512 * 2;
constexpr size_t WS_G0 = WS_PR + 0 * GRP, WS_G1 = WS_PR + 5 * GRP, WS_G2 = WS_PR + 7 * GRP;
constexpr size_t WS_MERGED = WS_PR + 2 * GRP;
constexpr size_t WS_Y = WS_PR + 9 * GRP;
constexpr size_t WS_RB = WS_PR + 0 * GRP;
constexpr size_t WS_R = WS_PR + 5 * GRP;
static_assert(WS_Y + (size_t)NTOK * 1024 * 4 <= WS_QC, "alias overflow");
constexpr size_t O_PC = 16777216 + 524288, O_PN = O_PC + 262144, O_PM = O_PN + 2048, O_PCONV = O_PM + 16, O_PK = O_PCONV + 12288, O_PV = O_PK + 16777216,
                 O_PS = O_PV + 16777216, O_SC = O_PS + 262144, O_SN = O_SC + 1048576, O_SM = O_SN + 8192, O_SCONV = O_SM + 64, O_SK = O_SCONV + 49152,
                 O_SV = O_SK + 524288, O_SS = O_SV + 524288, O_TOTAL = O_SS + 1048576;

struct Params {
  const float *x_p, *x_s, *p_p, *p_s, *st_C, *st_n, *st_m, *st_conv, *ck, *cv, *st_S;
  const float *g_pre, *w_in, *b_i, *b_f, *w_conv, *g_ml, *lb_logits, *g_hg, *w_br, *w_out, *g_post, *w_pg, *w_pp;
  float* out; char* ws;
#define WSP(name, T, off) __device__ __forceinline__ T* name() const { return (T*)(ws + (off)); }
#define OUTP(name, off) __device__ __forceinline__ float* name() const { return out + (off); }
  OUTP(o_y, 0) OUTP(o_pC, O_PC) OUTP(o_pn, O_PN) OUTP(o_pm, O_PM) OUTP(o_pconv, O_PCONV) OUTP(o_pk, O_PK) OUTP(o_pv, O_PV) OUTP(o_pS, O_PS)
  OUTP(o_sC, O_SC) OUTP(o_sn, O_SN) OUTP(o_sm, O_SM) OUTP(o_sconv, O_SCONV) OUTP(o_sk, O_SK) OUTP(o_sv, O_SV) OUTP(o_sS, O_SS)
  WSP(wt_in, bf16_t, WS_WT_IN) WSP(wt_br, bf16_t, WS_WT_BR) WSP(wt_out, bf16_t, WS_WT_OUT) WSP(wt_pg, bf16_t, WS_WT_PG) WSP(wt_pp, bf16_t, WS_WT_PP)
  WSP(U, bf16_t, WS_U) WSP(PR, bf16_t, WS_PR) WSP(QC, bf16_t, WS_QC) WSP(KC, bf16_t, WS_KC) WSP(SM, bf16_t, WS_SM) WSP(SH, bf16_t, WS_SH) WSP(H, bf16_t, WS_H)
  WSP(ig, float, WS_IG) WSP(lf, float, WS_LF) WSP(ac, float, WS_AC) WSP(Bc, float, WS_BC) WSP(min_, float, WS_MIN) WSP(nloc, float, WS_NLOC) WSP(hbc, float, WS_HBC)
  __device__ __forceinline__ bf16_t* Gb(int b) const { return (bf16_t*)(ws + (b == 0 ? WS_G0 : b == 1 ? WS_G1 : WS_G2)); }
  WSP(wg8, float, WS_WG8) WSP(merged, bf16_t, WS_MERGED) WSP(y, float, WS_Y) WSP(r, float, WS_R) WSP(rb, bf16_t, WS_RB)
};

__device__ __forceinline__ int get_tid() { int t = threadIdx.x; asm volatile("" : "+v"(t)); return t; }
__device__ __forceinline__ bf16_t f2bf(float f) { unsigned u = __float_as_uint(f); u += 0x7fffu + ((u >> 16) & 1u); return (bf16_t)(u >> 16); }
__device__ __forceinline__ float bf2f(bf16_t h) { return __uint_as_float(((unsigned)h) << 16); }
__device__ __forceinline__ unsigned pack2(float a, float b) { return (unsigned)f2bf(a) | ((unsigned)f2bf(b) << 16); }
__device__ __forceinline__ float lo2f(unsigned v) { return __uint_as_float(v << 16); }
__device__ __forceinline__ float hi2f(unsigned v) { return __uint_as_float(v & 0xffff0000u); }
__device__ __forceinline__ float sigm(float x) { return 1.f / (1.f + __expf(-x)); }
__device__ __forceinline__ float silu(float x) { return x / (1.f + __expf(-x)); }
__device__ __forceinline__ float softplus(float x) { return fmaxf(x, 0.f) + __logf(1.f + __expf(-fabsf(x))); }
__device__ __forceinline__ float logsigm(float x) { return fminf(x, 0.f) - __logf(1.f + __expf(-fabsf(x))); }

template <int MT, int NT, int KS>
__device__ __forceinline__ void wmma(f32x4 (&acc)[MT][NT], const bf16_t* A, int lda, const bf16_t* B, int ldb, int fr, int fq) {
#pragma unroll
  for (int kk = 0; kk < KS; ++kk) {
    bf16x8 a[MT], b[NT];
#pragma unroll
    for (int mi = 0; mi < MT; ++mi) a[mi] = *(const bf16x8*)(A + (mi * 16 + fr) * lda + kk * 32 + fq * 8);
#pragma unroll
    for (int ni = 0; ni < NT; ++ni) b[ni] = *(const bf16x8*)(B + (ni * 16 + fr) * ldb + kk * 32 + fq * 8);
#pragma unroll
    for (int mi = 0; mi < MT; ++mi)
#pragma unroll
      for (int ni = 0; ni < NT; ++ni) acc[mi][ni] = __builtin_amdgcn_mfma_f32_16x16x32_bf16(a[mi], b[ni], acc[mi][ni], 0, 0, 0);
  }
}

__device__ __forceinline__ u32x4 ld8(const bf16_t* s) { return *(const u32x4*)s; }
__device__ __forceinline__ u32x4 ld8(const float* s) {
  float4 a = *(const float4*)s, b = *(const float4*)(s + 4);
  u32x4 r; r.x = pack2(a.x, a.y); r.y = pack2(a.z, a.w); r.z = pack2(b.x, b.y); r.w = pack2(b.z, b.w); return r;
}
template <typename T>
__device__ __forceinline__ void ld_tile(bf16_t* dst, const T* src, long ld, int tid) {
#pragma unroll
  for (int i = 0; i < 4; ++i) { int id = tid + 256 * i; int r = id >> 4, c = (id & 15) * 8; *(u32x4*)(dst + r * 136 + c) = ld8(src + (long)r * ld + c); }
}
template <typename T>
__device__ __forceinline__ void ld_tile128(bf16_t* dst, const T* src, long ld, int tid) {
#pragma unroll
  for (int i = 0; i < 8; ++i) { int id = tid + 256 * i; int r = id >> 4, c = (id & 15) * 8; *(u32x4*)(dst + r * 136 + c) = ld8(src + (long)r * ld + c); }
}
template <typename T, int ROWS, int DLD>
__device__ __forceinline__ void ld_T(bf16_t* dst, const T* src, long ld, int tid) {
#pragma unroll 2
  for (int id = tid; id < ROWS * 16; id += 256) {
    int r = id % ROWS, c = (id / ROWS) * 8;
    u32x4 v = ld8(src + (long)r * ld + c);
    bf16_t* d = dst + c * DLD + r;
    d[0] = (bf16_t)(v.x & 0xffff); d[DLD] = (bf16_t)(v.x >> 16); d[2 * DLD] = (bf16_t)(v.y & 0xffff); d[3 * DLD] = (bf16_t)(v.y >> 16);
    d[4 * DLD] = (bf16_t)(v.z & 0xffff); d[5 * DLD] = (bf16_t)(v.z >> 16); d[6 * DLD] = (bf16_t)(v.w & 0xffff); d[7 * DLD] = (bf16_t)(v.w >> 16);
  }
}

#define PRG(g) (p.PR() + (size_t)(g) * NTOK * 512)

__device__ __forceinline__ const float* xrow(const Params& p, int l, int row) {
  if (l == 0) return row < NPROMPT ? p.x_p + (size_t)row * 1024 : p.x_s + (size_t)(row - NPROMPT) * 1024;
  return p.o_y() + (size_t)row * 1024;
}

__device__ void wconv_tile(const Params& p, int t, char* smem) {
  float* tile = (float*)smem;
  const int tid = get_tid();
  int l = t / 848, r = t % 848;
  const float* src; bf16_t* dst; int K, ldsrc, kt, nt, skip = 1 << 30;
  if (r < 608) { src = p.w_in + (size_t)l * 1024 * NINSRC; dst = p.wt_in() + (size_t)l * NWT * 1024; K = 1024; ldsrc = NINSRC; kt = r % 16; nt = r / 16; skip = 2560; }
  else if (r < 704) { r -= 608; int b = r / 32; r %= 32; src = p.w_br + (size_t)(l * 3 + b) * 512 * 1024; dst = p.wt_br() + (size_t)(l * 3 + b) * 1024 * 512; K = 512; ldsrc = 1024; kt = r % 8; nt = r / 8; }
  else if (r < 768) { r -= 704; src = p.w_out + (size_t)l * 1048576; dst = p.wt_out() + (size_t)l * 1048576; K = 1024; ldsrc = 1024; kt = r % 16; nt = r / 16; }
  else if (r < 832) { r -= 768; src = p.w_pg + (size_t)l * 1048576; dst = p.wt_pg() + (size_t)l * 1048576; K = 1024; ldsrc = 1024; kt = r % 16; nt = r / 16; }
  else { r -= 832; src = p.w_pp + (size_t)l * 262144; dst = p.wt_pp() + (size_t)l * 262144; K = 256; ldsrc = 1024; kt = r % 4; nt = r / 4; }
  const int n0 = nt * 256, k0 = kt * 64;
  __syncthreads();
#pragma unroll
  for (int i = 0; i < 16; ++i) {
    const int k = i * 4 + (tid >> 6), n4 = (tid & 63) * 4;
    int ns = n0 + n4; if (ns >= skip) ns += 8;
    *(float4*)(tile + k * 260 + n4) = *(const float4*)(src + (size_t)(k0 + k) * ldsrc + ns);
  }
  __syncthreads();
  bf16_t* drow = dst + (size_t)(n0 + tid) * K + k0;
#pragma unroll
  for (int c = 0; c < 8; ++c) {
    u32x4 pk;
    pk.x = pack2(tile[(c * 8 + 0) * 260 + tid], tile[(c * 8 + 1) * 260 + tid]);
    pk.y = pack2(tile[(c * 8 + 2) * 260 + tid], tile[(c * 8 + 3) * 260 + tid]);
    pk.z = pack2(tile[(c * 8 + 4) * 260 + tid], tile[(c * 8 + 5) * 260 + tid]);
    pk.w = pack2(tile[(c * 8 + 6) * 260 + tid], tile[(c * 8 + 7) * 260 + tid]);
    *(u32x4*)(drow + c * 8) = pk;
  }
}

__device__ void norm_phase(const Params& p, int l, char* smem) {
  const int lane = threadIdx.x & 63, wid = threadIdx.x >> 6;
  const float* gp = p.g_pre + l * 1024;
  float* wgs = (float*)smem;
  __syncthreads();
  {
    const float* wsrc = p.w_in + (size_t)l * 1024 * NINSRC + 2560;
    for (int k = threadIdx.x; k < 1024; k += 256) {
      const float4 a = *(const float4*)(wsrc + (size_t)k * NINSRC), b = *(const float4*)(wsrc + (size_t)k * NINSRC + 4);
      wgs[k] = a.x; wgs[1024 + k] = a.y; wgs[2048 + k] = a.z; wgs[3072 + k] = a.w;
      wgs[4096 + k] = b.x; wgs[5120 + k] = b.y; wgs[6144 + k] = b.z; wgs[7168 + k] = b.w;
    }
  }
  __syncthreads();
  const float* wg = wgs;
  for (int row = blockIdx.x * 4 + wid; row < NTOK; row += gridDim.x * 4) {
    const float* x = xrow(p, l, row);
    float4 v[4]; float ss = 0.f;
#pragma unroll
    for (int i = 0; i < 4; ++i) { v[i] = *(const float4*)(x + i * 256 + lane * 4); ss += v[i].x * v[i].x + v[i].y * v[i].y + v[i].z * v[i].z + v[i].w * v[i].w; }
#pragma unroll
    for (int o = 32; o > 0; o >>= 1) ss += __shfl_xor(ss, o);
    const float rstd = rsqrtf(ss * (1.f / 1024.f) + 1e-6f);
    float d0 = 0, d1 = 0, d2 = 0, d3 = 0, d4 = 0, d5 = 0, d6 = 0, d7 = 0;
#pragma unroll
    for (int i = 0; i < 4; ++i) {
      const int k = i * 256 + lane * 4;
      float4 g = *(const float4*)(gp + k);
      float u0 = v[i].x * rstd * g.x, u1 = v[i].y * rstd * g.y, u2 = v[i].z * rstd * g.z, u3 = v[i].w * rstd * g.w;
      u32x2 pk; pk.x = pack2(u0, u1); pk.y = pack2(u2, u3);
      *(u32x2*)(p.U() + (size_t)row * 1024 + k) = pk;
      const float* wp = wg + k;
      float4 w;
      w = *(const float4*)(wp);            d0 += u0 * w.x + u1 * w.y + u2 * w.z + u3 * w.w;
      w = *(const float4*)(wp + 1024);     d1 += u0 * w.x + u1 * w.y + u2 * w.z + u3 * w.w;
      w = *(const float4*)(wp + 2 * 1024); d2 += u0 * w.x + u1 * w.y + u2 * w.z + u3 * w.w;
      w = *(const float4*)(wp + 3 * 1024); d3 += u0 * w.x + u1 * w.y + u2 * w.z + u3 * w.w;
      w = *(const float4*)(wp + 4 * 1024); d4 += u0 * w.x + u1 * w.y + u2 * w.z + u3 * w.w;
      w = *(const float4*)(wp + 5 * 1024); d5 += u0 * w.x + u1 * w.y + u2 * w.z + u3 * w.w;
      w = *(const float4*)(wp + 6 * 1024); d6 += u0 * w.x + u1 * w.y + u2 * w.z + u3 * w.w;
      w = *(const float4*)(wp + 7 * 1024); d7 += u0 * w.x + u1 * w.y + u2 * w.z + u3 * w.w;
    }
#pragma unroll
    for (int o = 32; o > 0; o >>= 1) {
      d0 += __shfl_xor(d0, o); d1 += __shfl_xor(d1, o); d2 += __shfl_xor(d2, o); d3 += __shfl_xor(d3, o);
      d4 += __shfl_xor(d4, o); d5 += __shfl_xor(d5, o); d6 += __shfl_xor(d6, o); d7 += __shfl_xor(d7, o);
    }
    if (lane < 4) {
      float di = lane == 0 ? d0 : lane == 1 ? d1 : lane == 2 ? d2 : d3;
      float df = lane == 0 ? d4 : lane == 1 ? d5 : lane == 2 ? d6 : d7;
      p.ig()[row * 4 + lane] = di + p.b_i[l * 4 + lane];
      p.lf()[row * 4 + lane] = logsigm(df + p.b_f[l * 4 + lane]);
    }
  }
}

template <typename TA>
__device__ __forceinline__ void gemm_kloop(f32x4 (&acc)[4][4], const TA* Tp, long ldt, const bf16_t* Wp, long ldw, int K, char* smem) {
  bf16_t* sT = (bf16_t*)smem;
  bf16_t* sW = sT + 2 * 9216;
  const int tid = get_tid(), lane = tid & 63, wid = tid >> 6, wr = wid >> 1, wc = wid & 1, fr = lane & 15, fq = lane >> 4;
  u32x4 rt[4], rw[4];
  const int r0 = tid >> 3, c0 = (tid & 7) * 8;
#define GLOAD(k0) _Pragma("unroll") for (int i = 0; i < 4; ++i) { rt[i] = ld8(Tp + (long)(r0 + 32 * i) * ldt + (k0) + c0); rw[i] = ld8(Wp + (long)(r0 + 32 * i) * ldw + (k0) + c0); }
#define SSTORE(buf) _Pragma("unroll") for (int i = 0; i < 4; ++i) { *(u32x4*)(sT + (buf) * 9216 + (r0 + 32 * i) * 72 + c0) = rt[i]; *(u32x4*)(sW + (buf) * 9216 + (r0 + 32 * i) * 72 + c0) = rw[i]; }
  GLOAD(0); SSTORE(0);
  __syncthreads();
  const int nk = K >> 6;
#pragma unroll 1
  for (int kt = 0; kt < nk; ++kt) {
    const int buf = kt & 1;
    if (kt + 1 < nk) { GLOAD((kt + 1) * 64); }
    const bf16_t* aT = sT + buf * 9216 + (wr * 64) * 72;
    const bf16_t* aW = sW + buf * 9216 + (wc * 64) * 72;
    wmma<4, 4, 2>(acc, aW, 72, aT, 72, fr, fq);
    if (kt + 1 < nk) { SSTORE(buf ^ 1); }
    __syncthreads();
  }
#undef GLOAD
#undef SSTORE
}
__device__ __forceinline__ void zero_acc(f32x4 (&acc)[4][4]) {
#pragma unroll
  for (int a = 0; a < 4; ++a)
#pragma unroll
    for (int b = 0; b < 4; ++b) acc[a][b] = (f32x4){0.f, 0.f, 0.f, 0.f};
}


template <int NT, int NSTAGE>
__device__ __forceinline__ void gemm_glds(f32x4 (&acc)[4][NT], const bf16_t* Tp, long ldt, const bf16_t* Wp, long ldw, int K, char* smem) {
  constexpr int TR = 2 * NT * 16, STAGE_B = (TR + 128) * 64, LT = TR / 64, LPS = LT + 2;
  static_assert(NSTAGE * STAGE_B <= SMEM_BYTES, "ring too large");
  static_assert(NSTAGE == 3 || NSTAGE == 4, "waits below are written for 3 or 4 stages");
  const int tid = get_tid(), lane = tid & 63, wid = tid >> 6, wr = wid >> 1, wc = wid & 1, fr = lane & 15, fq = lane >> 4;
  const int lr = tid >> 2, cp = tid & 3, lc = (cp ^ ((lr >> 2) & 3)) * 8;
  const bf16_t* gT = Tp + (long)lr * ldt + lc;
  const int plr = ((lr >> 5) & 1) * 32 + ((lr >> 2) & 3) * 8 + ((lr >> 4) & 1) * 4 + (lr & 3);
  const bf16_t* gW = Wp + (long)plr * ldw + lc;
  const int rd_off = fr * 64 + ((fq ^ ((fr >> 2) & 3)) * 16);
#define GL_ISSUE(kt_, slot_) do { char* sb_ = smem + (slot_) * STAGE_B + tid * 16; \
    _Pragma("unroll") for (int i_ = 0; i_ < LT; ++i_) __builtin_amdgcn_global_load_lds((const unsigned*)(gT + (long)i_ * 64 * ldt + (kt_) * 32), (__attribute__((address_space(3))) unsigned*)(sb_ + i_ * 4096), 16, 0, 0); \
    _Pragma("unroll") for (int i_ = 0; i_ < 2; ++i_) __builtin_amdgcn_global_load_lds((const unsigned*)(gW + (long)i_ * 64 * ldw + (kt_) * 32), (__attribute__((address_space(3))) unsigned*)(sb_ + TR * 64 + i_ * 4096), 16, 0, 0); } while (0)
  asm volatile("s_waitcnt vmcnt(0)" ::: "memory");
  __builtin_amdgcn_s_barrier();
  const int nk = K >> 5;
#pragma unroll
  for (int s_ = 0; s_ < NSTAGE - 1; ++s_) if (s_ < nk) GL_ISSUE(s_, s_);
  int slot = 0, islot = NSTAGE - 1;
#pragma unroll 1
  for (int kt = 0; kt < nk; ++kt) {
    const int rem = nk - 1 - kt;
    if (NSTAGE == 4) {
      if (rem >= 2) asm volatile("s_waitcnt vmcnt(%0)" ::"n"(2 * LPS) : "memory");
      else if (rem == 1) asm volatile("s_waitcnt vmcnt(%0)" ::"n"(LPS) : "memory");
      else asm volatile("s_waitcnt vmcnt(0)" ::: "memory");
    } else {
      if (rem >= 1) asm volatile("s_waitcnt vmcnt(%0)" ::"n"(LPS) : "memory");
      else asm volatile("s_waitcnt vmcnt(0)" ::: "memory");
    }
    __builtin_amdgcn_s_barrier();
    const unsigned aT = (unsigned)(uintptr_t)(smem + slot * STAGE_B + (wr * NT * 16) * 64 + rd_off);
    const unsigned aW = (unsigned)(uintptr_t)(smem + slot * STAGE_B + TR * 64 + (wc * 64) * 64 + rd_off);
    bf16x8 a[4], b[NT];
#pragma unroll
    for (int mi = 0; mi < 4; ++mi) asm volatile("ds_read_b128 %0, %1 offset:%2" : "=v"(a[mi]) : "v"(aW), "n"(mi * 1024));
#pragma unroll
    for (int ni = 0; ni < NT; ++ni) asm volatile("ds_read_b128 %0, %1 offset:%2" : "=v"(b[ni]) : "v"(aT), "n"(ni * 1024));
    if constexpr (NT == 4) asm volatile("s_waitcnt lgkmcnt(0)" : "+v"(a[0]), "+v"(a[1]), "+v"(a[2]), "+v"(a[3]), "+v"(b[0]), "+v"(b[1]), "+v"(b[2]), "+v"(b[3]));
    else asm volatile("s_waitcnt lgkmcnt(0)" : "+v"(a[0]), "+v"(a[1]), "+v"(a[2]), "+v"(a[3]), "+v"(b[0]), "+v"(b[1]), "+v"(b[2]), "+v"(b[3]), "+v"(b[4]), "+v"(b[5]), "+v"(b[6]), "+v"(b[7]));
    const bool doiss = (kt + NSTAGE - 1 < nk);
    const int ktn = kt + NSTAGE - 1;
    char* sbi = smem + islot * STAGE_B + tid * 16;
#pragma unroll
    for (int mi = 0; mi < 4; ++mi) {
#pragma unroll
      for (int ni = 0; ni < NT; ++ni) acc[mi][ni] = __builtin_amdgcn_mfma_f32_16x16x32_bf16(a[mi], b[ni], acc[mi][ni], 0, 0, 0);
      __builtin_amdgcn_sched_barrier(0);
      if (doiss) {
#pragma unroll
        for (int q = 0; q < 2; ++q) {
          const int idx = mi * 2 + q;
          if (idx < LT) __builtin_amdgcn_global_load_lds((const unsigned*)(gT + (long)idx * 64 * ldt + ktn * 32), (__attribute__((address_space(3))) unsigned*)(sbi + idx * 4096), 16, 0, 0);
          else if (idx < LPS) __builtin_amdgcn_global_load_lds((const unsigned*)(gW + (long)(idx - LT) * 64 * ldw + ktn * 32), (__attribute__((address_space(3))) unsigned*)(sbi + TR * 64 + (idx - LT) * 4096), 16, 0, 0);
        }
      }
      __builtin_amdgcn_sched_barrier(0);
    }
    slot = (slot + 1 == NSTAGE) ? 0 : slot + 1;
    islot = (islot + 1 == NSTAGE) ? 0 : islot + 1;
  }
#undef GL_ISSUE
  __syncthreads();
}

__device__ void inproj_tile(const Params& p, int l, int t, char* smem) {
  constexpr int NT = 8;
  const int tm = t / 52, tn = t % 52;
  const int tid = get_tid(), lane = tid & 63, wid = tid >> 6, wr = wid >> 1, wc = wid & 1, fr = lane & 15, fq = lane >> 4;
  f32x4 acc[4][NT];
#pragma unroll
  for (int a_ = 0; a_ < 4; ++a_)
#pragma unroll
    for (int b_ = 0; b_ < NT; ++b_) acc[a_][b_] = (f32x4){0.f, 0.f, 0.f, 0.f};
  gemm_glds<NT, 3>(acc, p.U() + (size_t)tm * (NT * 32) * 1024, 1024, p.wt_in() + (size_t)l * NWT * 1024 + (size_t)tn * 128 * 1024, 1024, 1024, smem);
  const int g = tn >> 2;
  bf16_t* dst = PRG(g);
#pragma unroll
  for (int ni = 0; ni < NT; ++ni) {
    const int row = tm * (NT * 32) + wr * (NT * 16) + ni * 16 + fr;
    const bool samp = row >= NPROMPT;
    const int rr = samp ? row - NPROMPT : row;
    const int b = samp ? (rr >> 6) : (rr >> 13), tt = samp ? (rr & 63) : (rr & 8191), T = samp ? 64 : 8192, NB = samp ? 8 : 2;
#pragma unroll
    for (int m = 0; m < 2; ++m) {
      const int cg_ = (tn & 3) * 128 + wc * 64 + m * 32 + fq * 8;
      const f32x4 v0 = acc[2 * m][ni], v1 = acc[2 * m + 1][ni];
      u32x4 pk; pk.x = pack2(v0[0], v0[1]); pk.y = pack2(v0[2], v0[3]); pk.z = pack2(v1[0], v1[1]); pk.w = pack2(v1[2], v1[3]);
      *(u32x4*)(dst + (size_t)row * 512 + cg_) = pk;
      if (g == 6 || g == 7) {
        float* o = (g == 6) ? (samp ? p.o_sk() : p.o_pk()) : (samp ? p.o_sv() : p.o_pv());
        const int hh = cg_ >> 7, d = cg_ & 127;
        float* op = o + ((size_t)((l * NB + b) * 4 + hh) * T + tt) * 128 + d;
        *(f32x4*)op = v0; *(f32x4*)(op + 4) = v1;
      } else if (g < 2) {
        if (tt >= T - 3) {
          float* o = samp ? p.o_sconv() : p.o_pconv();
          float* op = o + ((size_t)(l * NB + b) * 3 + (tt - (T - 3))) * 1024 + g * 512 + cg_;
          *(f32x4*)op = v0; *(f32x4*)(op + 4) = v1;
        }
      }
    }
  }
}

struct UnitInfo { int samp, b, h, c, rowbase, seq; };
__device__ __forceinline__ UnitInfo unit_info(int u) {
  UnitInfo i;
  if (u < 1024) { i.samp = 0; i.seq = u >> 7; i.b = i.seq >> 2; i.h = i.seq & 3; i.c = u & 127; i.rowbase = i.b * 8192 + i.c * 64; }
  else { int sq = u - 1024; i.samp = 1; i.seq = sq; i.b = sq >> 2; i.h = sq & 3; i.c = 0; i.rowbase = NPROMPT + i.b * 64; }
  return i;
}

__device__ void sb_unit(const Params& p, int l, int u, char* smem) {
  bf16_t* Qs = (bf16_t*)smem;
  bf16_t* Ks = Qs + 64 * 136;
  bf16_t* Vt = Ks + 64 * 136;
  bf16_t* Ps = Vt + 128 * 72;
  const int tid = get_tid(), lane = tid & 63, w = tid >> 6, fr = lane & 15, fq = lane >> 4;
  const UnitInfo ui = unit_info(u);
  const int nblk = ui.samp ? 65 : ui.c + 1;
  const int hc = ui.h * 128;
  __syncthreads();
  ld_tile<bf16_t>(Qs, PRG(5) + (size_t)ui.rowbase * 512 + hc, 512, tid);
  f32x4 o[8][1];
#pragma unroll
  for (int mi = 0; mi < 8; ++mi) o[mi][0] = (f32x4){0.f, 0.f, 0.f, 0.f};
  float R = 0.f;
  const int tq = 16 * w + fr;
  for (int i = nblk - 1; i >= 0; --i) {
    if (!ui.samp || i == 64) {
      const size_t krow = ui.samp ? (size_t)ui.rowbase : (size_t)ui.b * 8192 + (size_t)i * 64;
      ld_tile<bf16_t>(Ks, PRG(6) + krow * 512 + hc, 512, tid);
      ld_T<bf16_t, 64, 72>(Vt, PRG(7) + krow * 512 + hc, 512, tid);
    } else {
      const size_t off = ((size_t)((l * 8 + ui.b) * 4 + ui.h) * 4096 + (size_t)i * 64) * 128;
      ld_tile<float>(Ks, p.ck + off, 128, tid);
      ld_T<float, 64, 72>(Vt, p.cv + off, 128, tid);
    }
    __syncthreads();
    f32x4 z[4][1];
#pragma unroll
    for (int mi = 0; mi < 4; ++mi) z[mi][0] = (f32x4){0.f, 0.f, 0.f, 0.f};
    wmma<4, 1, 4>(z, Ks, 136, Qs + 16 * w * 136, 136, fr, fq);
    const bool diag = (i == nblk - 1);
    float L[4][4], lsg[4][4], G[4];
#pragma unroll
    for (int mi = 0; mi < 4; ++mi) {
      G[mi] = 0.f;
#pragma unroll
      for (int j = 0; j < 4; ++j) {
        const int kk = mi * 16 + fq * 4 + j;
        const float zz = z[mi][0][j] * 0.08838834764831845f;
        const float sp = softplus(zz);
        const bool valid = !diag || kk < tq;
        L[mi][j] = valid ? -sp : 0.f;
        lsg[mi][j] = valid ? zz - sp : -1e30f;
        G[mi] += L[mi][j];
      }
    }
    float sufm = 0.f;
#pragma unroll
    for (int mi = 3; mi >= 0; --mi) {
      const float g0 = __shfl(G[mi], fr), g1 = __shfl(G[mi], fr + 16), g2 = __shfl(G[mi], fr + 32), g3 = __shfl(G[mi], fr + 48);
      const float later = (fq < 1 ? g1 : 0.f) + (fq < 2 ? g2 : 0.f) + (fq < 3 ? g3 : 0.f);
      const float s3 = R + sufm + later, s2 = s3 + L[mi][3], s1 = s2 + L[mi][2], s0 = s1 + L[mi][1];
      const float a0 = __expf(lsg[mi][0] + s0), a1 = __expf(lsg[mi][1] + s1), a2 = __expf(lsg[mi][2] + s2), a3 = __expf(lsg[mi][3] + s3);
      u32x2 pk; pk.x = pack2(a0, a1); pk.y = pack2(a2, a3);
      *(u32x2*)(Ps + tq * 72 + mi * 16 + fq * 4) = pk;
      sufm += (g0 + g1) + (g2 + g3);
    }
    R += sufm;
    __syncthreads();
    wmma<8, 1, 2>(o, Vt, 72, Ps + 16 * w * 72, 72, fr, fq);
    if (__syncthreads_and(R < -110.f)) break;
  }
  const size_t row = (size_t)ui.rowbase + tq;
#pragma unroll
  for (int mi = 0; mi < 8; ++mi) {
    const int col = hc + mi * 16 + fq * 4;
    u32x2 zz = *(const u32x2*)(PRG(8) + row * 512 + col);
    f32x4 v = o[mi][0];
    u32x2 pk;
    pk.x = pack2(v[0] * silu(lo2f(zz.x)), v[1] * silu(hi2f(zz.x)));
    pk.y = pack2(v[2] * silu(lo2f(zz.y)), v[3] * silu(hi2f(zz.y)));
    *(u32x2*)(p.H() + (size_t)1 * NTOK * 512 + row * 512 + col) = pk;
  }
}

__device__ void mlstm_local(const Params& p, int l, int u, char* smem) {
  bf16_t* kdT = (bf16_t*)smem;
  bf16_t* vT = kdT + 128 * 72;
  bf16_t* xq = vT + 128 * 72;
  bf16_t* xk = xq + 67 * 136;
  float* dec = (float*)(xk + 67 * 136);
  const int tid = get_tid(), lane = tid & 63, w = tid >> 6, fr = lane & 15, fq = lane >> 4;
  const UnitInfo ui = unit_info(u);
  const int hc = ui.h * 128;
  __syncthreads();
  if (w == 0) {
    const float lfv = p.lf()[(ui.rowbase + lane) * 4 + ui.h], igv = p.ig()[(ui.rowbase + lane) * 4 + ui.h];
    float bs = lfv;
#pragma unroll
    for (int o = 1; o < 64; o <<= 1) { float t = __shfl_up(bs, o); if (lane >= o) bs += t; }
    const float g = igv - bs;
    float gm = g;
#pragma unroll
    for (int o = 32; o > 0; o >>= 1) gm = fmaxf(gm, __shfl_xor(gm, o));
    const float bL = __shfl(bs, 63);
    dec[lane] = __expf(g - gm);
    if (lane == 0) { p.ac()[u] = bL + gm; p.Bc()[u] = bL; }
  }
  ld_tile<bf16_t>(xq + 3 * 136, PRG(0) + (size_t)ui.rowbase * 512 + hc, 512, tid);
  ld_tile<bf16_t>(xk + 3 * 136, PRG(1) + (size_t)ui.rowbase * 512 + hc, 512, tid);
  ld_T<bf16_t, 64, 72>(vT, PRG(2) + (size_t)ui.rowbase * 512 + hc, 512, tid);
  {
    const int isk = tid >> 7, ch = tid & 127, col = hc + ch;
    bf16_t* xs = isk ? xk : xq;
    if (ui.samp) {
      const float* cs = p.st_conv + (size_t)(l * 8 + ui.b) * 3072 + isk * 512 + col;
      xs[ch] = f2bf(cs[0]); xs[136 + ch] = f2bf(cs[1024]); xs[272 + ch] = f2bf(cs[2048]);
    } else if (ui.c > 0) {
      const bf16_t* src = PRG(isk) + (size_t)ui.rowbase * 512 + col;
      xs[ch] = src[-3 * 512]; xs[136 + ch] = src[-2 * 512]; xs[272 + ch] = src[-1 * 512];
    } else { xs[ch] = 0; xs[136 + ch] = 0; xs[272 + ch] = 0; }
  }
  __syncthreads();
  {
    const int isk = tid >> 7, ch = tid & 127, col = hc + ch;
    bf16_t* xs = isk ? xk : xq;
    const float* wc_ = p.w_conv + (size_t)l * 4096 + isk * 512 + col;
    const float w0 = wc_[0], w1 = wc_[1024], w2 = wc_[2048], w3 = wc_[3072];
    float x0 = bf2f(xs[ch]), x1 = bf2f(xs[136 + ch]), x2 = bf2f(xs[272 + ch]);
#pragma unroll 8
    for (int t = 0; t < 64; ++t) {
      const float x3 = bf2f(xs[(t + 3) * 136 + ch]);
      float y = silu(w0 * x0 + w1 * x1 + w2 * x2 + w3 * x3);
      if (isk) y *= 0.08838834764831845f;
      const bf16_t yb = f2bf(y);
      xs[t * 136 + ch] = yb;
      if (isk) kdT[ch * 72 + t] = f2bf(bf2f(yb) * dec[t]);
      x0 = x1; x1 = x2; x2 = x3;
    }
  }
  __syncthreads();
#pragma unroll
  for (int i = 0; i < 4; ++i) {
    const int id = tid + 256 * i, r = id >> 4, c = (id & 15) * 8;
    *(u32x4*)(p.QC() + (size_t)(ui.rowbase + r) * 512 + hc + c) = *(const u32x4*)(xq + r * 136 + c);
    *(u32x4*)(p.KC() + (size_t)(ui.rowbase + r) * 512 + hc + c) = *(const u32x4*)(xk + r * 136 + c);
  }
  if (tid < 128) { float s_ = 0.f;
#pragma unroll 8
    for (int t = 0; t < 64; ++t) s_ += bf2f(kdT[tid * 72 + t]); p.nloc()[u * 128 + tid] = s_; }
  f32x4 acc[8][2];
#pragma unroll
  for (int a_ = 0; a_ < 8; ++a_) { acc[a_][0] = (f32x4){0.f, 0.f, 0.f, 0.f}; acc[a_][1] = (f32x4){0.f, 0.f, 0.f, 0.f}; }
  wmma<8, 2, 2>(acc, kdT, 72, vT + 32 * w * 72, 72, fr, fq);
  bf16_t* sm = p.SM() + (size_t)u * 16384;
#pragma unroll
  for (int mi = 0; mi < 8; ++mi)
#pragma unroll
    for (int ni = 0; ni < 2; ++ni) {
      u32x2 pk; pk.x = pack2(acc[mi][ni][0], acc[mi][ni][1]); pk.y = pack2(acc[mi][ni][2], acc[mi][ni][3]);
      *(u32x2*)(sm + (32 * w + ni * 16 + fr) * 128 + mi * 16 + fq * 4) = pk;
    }
}

__device__ __forceinline__ float hgrn_lb(const Params& p, int l, int ch512) {
  if (l == 0) return 0.f;
  return sigm(p.lb_logits[512 + ch512] - p.lb_logits[ch512]);
}
__device__ __forceinline__ void hgrn_gate(float f, float lb, float& lg, float& kh) {
  const float e = __expf(-fabsf(f));
  const float sp = f >= 0.f ? 1.f / (1.f + e) : e / (1.f + e);
  const float sn = f >= 0.f ? e / (1.f + e) : 1.f / (1.f + e);
  lg = (lb == 0.f) ? (fminf(f, 0.f) - __logf(1.f + e)) : __logf(lb + (1.f - lb) * sp);
  kh = (1.f - lb) * sn;
}

__device__ void hgrn_local(const Params& p, int l, int u, char* smem) {
  bf16_t* kdT = (bf16_t*)smem;
  bf16_t* iT = kdT + 128 * 72;
  bf16_t* fs = iT + 128 * 72;
  float* tot = (float*)(fs + 64 * 136);
  const int tid = get_tid(), lane = tid & 63, w = tid >> 6, fr = lane & 15, fq = lane >> 4;
  const UnitInfo ui = unit_info(u);
  const int hc = ui.h * 128;
  __syncthreads();
  ld_tile<bf16_t>(fs, PRG(10) + (size_t)ui.rowbase * 512 + hc, 512, tid);
  ld_T<bf16_t, 64, 72>(iT, PRG(11) + (size_t)ui.rowbase * 512 + hc, 512, tid);
  const int half = tid >> 7, ch = tid & 127;
  const float lb = hgrn_lb(p, l, hc + ch);
  __syncthreads();
  const bf16_t* src = fs + (half * 32) * 136 + ch;
  {
    float run = 0.f;
#pragma unroll 8
    for (int t = 0; t < 32; ++t) { float lg, kh; hgrn_gate(bf2f(src[t * 136]), lb, lg, kh); run += lg; }
    tot[half * 128 + ch] = run;
  }
  __syncthreads();
  {
    const float t0 = tot[ch], t1 = tot[128 + ch];
    const float bcL = t0 + t1;
    float run = half ? t0 : 0.f;
#pragma unroll 8
    for (int t = 0; t < 32; ++t) {
      float lg, kh; hgrn_gate(bf2f(src[t * 136]), lb, lg, kh); run += lg;
      kdT[ch * 72 + half * 32 + t] = f2bf(kh * __expf(bcL - run));
    }
    if (half == 0) p.hbc()[u * 128 + ch] = bcL;
  }
  __syncthreads();
  f32x4 acc[8][2];
#pragma unroll
  for (int a_ = 0; a_ < 8; ++a_) { acc[a_][0] = (f32x4){0.f, 0.f, 0.f, 0.f}; acc[a_][1] = (f32x4){0.f, 0.f, 0.f, 0.f}; }
  wmma<8, 2, 2>(acc, kdT, 72, iT + 32 * w * 72, 72, fr, fq);
  bf16_t* sh = p.SH() + (size_t)u * 16384;
#pragma unroll
  for (int mi = 0; mi < 8; ++mi)
#pragma unroll
    for (int ni = 0; ni < 2; ++ni) {
      u32x2 pk; pk.x = pack2(acc[mi][ni][0], acc[mi][ni][1]); pk.y = pack2(acc[mi][ni][2], acc[mi][ni][3]);
      *(u32x2*)(sh + (32 * w + ni * 16 + fr) * 128 + mi * 16 + fq * 4) = pk;
    }
}

__device__ void scan_phase(const Params& p, int l, char* smem) {
  float* cdc = (float*)smem;
  float* cwl = cdc + 128;
  float* cmi = cwl + 128;
  const int tid = get_tid();
  for (int vb = blockIdx.x; vb < 520; vb += gridDim.x) {
    const int kind = vb >> 8;
    const int seq = (kind == 2) ? (vb - 512) : ((vb >> 5) & 7);
    __syncthreads();
    if (kind != 1) {
      if (tid < 128) { cdc[tid] = p.ac()[seq * 128 + tid]; cwl[tid] = p.Bc()[seq * 128 + tid]; }
      __syncthreads();
      if (tid == 0) {
        float m = 0.f;
        for (int c = 0; c < 128; ++c) {
          const float a = cdc[c], B = cwl[c];
          const float mo = fmaxf(a, B + m);
          cdc[c] = __expf(B + m - mo); cwl[c] = __expf(a - mo); cmi[c] = m; m = mo;
        }
        if (kind == 0 && (vb & 31) == 0) p.o_pm()[l * 8 + seq] = m;
      }
      __syncthreads();
      if (kind == 0 && (vb & 31) == 0 && tid < 128) p.min_()[seq * 128 + tid] = cmi[tid];
    }
    if (kind == 2) {
      if (tid < 128) {
        float n = 0.f;
        float* base = p.nloc() + (size_t)seq * 128 * 128 + tid;
        for (int c0 = 0; c0 < 128; c0 += 16) {
          float lv[16];
#pragma unroll
          for (int j = 0; j < 16; ++j) lv[j] = base[(c0 + j) * 128];
#pragma unroll
          for (int j = 0; j < 16; ++j) { const float nl = lv[j]; lv[j] = n; n = cdc[c0 + j] * n + cwl[c0 + j] * nl; }
#pragma unroll
          for (int j = 0; j < 16; ++j) base[(c0 + j) * 128] = lv[j];
        }
        p.o_pn()[(l * 8 + seq) * 128 + tid] = n;
      }
      continue;
    }
    const int pr = (vb & 31) * 256 + tid, e = pr * 2, er = e >> 7, ec = e & 127;
    unsigned* base = (unsigned*)((kind ? p.SH() : p.SM()) + (size_t)seq * 128 * 16384) + pr;
    const float* hb = p.hbc() + (size_t)seq * 128 * 128 + ec;
    float c0v = 0.f, c1v = 0.f;
    unsigned lv[16], nx[16];
    float2 hv[16], hn[16];
#pragma unroll
    for (int j = 0; j < 16; ++j) { nx[j] = base[(size_t)j * 8192]; hn[j] = kind ? *(const float2*)(hb + j * 128) : make_float2(0.f, 0.f); }
    for (int c0 = 0; c0 < 128; c0 += 16) {
#pragma unroll
      for (int j = 0; j < 16; ++j) { lv[j] = nx[j]; hv[j] = hn[j]; }
      if (c0 + 16 < 128) {
#pragma unroll
        for (int j = 0; j < 16; ++j) { nx[j] = base[(size_t)(c0 + 16 + j) * 8192]; if (kind) hn[j] = *(const float2*)(hb + (c0 + 16 + j) * 128); }
      }
#pragma unroll
      for (int j = 0; j < 16; ++j) {
        const unsigned v = lv[j];
        lv[j] = pack2(c0v, c1v);
        const float d0 = kind ? __expf(hv[j].x) : cdc[c0 + j];
        const float d1 = kind ? __expf(hv[j].y) : d0;
        const float wl = kind ? 1.f : cwl[c0 + j];
        c0v = d0 * c0v + wl * lo2f(v); c1v = d1 * c1v + wl * hi2f(v);
      }
#pragma unroll
      for (int j = 0; j < 16; ++j) base[(size_t)(c0 + j) * 8192] = lv[j];
    }
    float* o = (kind ? p.o_pS() : p.o_pC()) + (size_t)(l * 8 + seq) * 16384;
    o[ec * 128 + er] = c0v; o[(ec + 1) * 128 + er] = c1v;
  }
  const int gt = blockIdx.x * 256 + tid, nth = gridDim.x * 256;
  for (int it = gt; it < 524288; it += nth) {
    const int kind = it >> 18, sq = (it >> 13) & 31, pr = it & 8191, e = pr * 2, u = 1024 + sq, er = e >> 7, ec = e & 127;
    if (kind == 0) {
      const float* c0p = p.st_C + (size_t)(l * 32 + sq) * 16384;
      const float C0 = c0p[ec * 128 + er], C1 = c0p[(ec + 1) * 128 + er], m = p.st_m[l * 32 + sq];
      unsigned* slot = (unsigned*)(p.SM() + (size_t)u * 16384) + pr;
      const unsigned lv = *slot;
      const float a = p.ac()[u], B = p.Bc()[u];
      const float mo = fmaxf(a, B + m), dc = __expf(B + m - mo), wl = __expf(a - mo);
      *slot = pack2(C0, C1);
      float* o = p.o_sC() + (size_t)(l * 32 + sq) * 16384;
      o[ec * 128 + er] = dc * C0 + wl * lo2f(lv); o[(ec + 1) * 128 + er] = dc * C1 + wl * hi2f(lv);
      if (pr == 0) { p.min_()[u] = m; p.o_sm()[l * 32 + sq] = mo; }
    } else {
      const float* s0p = p.st_S + (size_t)(l * 32 + sq) * 16384;
      const float S0 = s0p[ec * 128 + er], S1 = s0p[(ec + 1) * 128 + er];
      unsigned* slot = (unsigned*)(p.SH() + (size_t)u * 16384) + pr;
      const unsigned lv = *slot;
      const float d0 = __expf(p.hbc()[u * 128 + ec]), d1 = __expf(p.hbc()[u * 128 + ec + 1]);
      *slot = pack2(S0, S1);
      float* o = p.o_sS() + (size_t)(l * 32 + sq) * 16384;
      o[ec * 128 + er] = d0 * S0 + lo2f(lv); o[(ec + 1) * 128 + er] = d1 * S1 + hi2f(lv);
    }
  }
  for (int it = gt; it < 4096; it += nth) {
    const int sq = it >> 7, d = it & 127, u = 1024 + sq;
    const float n0 = p.st_n[(l * 32 + sq) * 128 + d], m = p.st_m[l * 32 + sq];
    const float a = p.ac()[u], B = p.Bc()[u];
    const float mo = fmaxf(a, B + m), dc = __expf(B + m - mo), wl = __expf(a - mo);
    const float nl = p.nloc()[u * 128 + d];
    p.nloc()[u * 128 + d] = n0;
    p.o_sn()[(l * 32 + sq) * 128 + d] = dc * n0 + wl * nl;
  }
}

__device__ void mlstm_out(const Params& p, int l, int u, char* smem) {
  bf16_t* Qs = (bf16_t*)smem;
  bf16_t* CT = Qs + 64 * 136;
  bf16_t* Ks = CT;
  bf16_t* Vt = Ks + 64 * 136;
  bf16_t* Ps = Vt + 144 * 72;
  float* misc = (float*)(smem + 17408 + 47360);
  float *bsum = misc, *gs = misc + 64, *mt = misc + 128, *wint = misc + 192;
  const int tid = get_tid(), lane = tid & 63, w = tid >> 6, fr = lane & 15, fq = lane >> 4;
  const UnitInfo ui = unit_info(u);
  const int hc = ui.h * 128;
  __syncthreads();
  if (w == 0) {
    const float lfv = p.lf()[(ui.rowbase + lane) * 4 + ui.h], igv = p.ig()[(ui.rowbase + lane) * 4 + ui.h];
    float bs = lfv;
#pragma unroll
    for (int o = 1; o < 64; o <<= 1) { float t = __shfl_up(bs, o); if (lane >= o) bs += t; }
    const float g = igv - bs;
    float cm = g;
#pragma unroll
    for (int o = 1; o < 64; o <<= 1) { float t = __shfl_up(cm, o); if (lane >= o) cm = fmaxf(cm, t); }
    const float m_in = p.min_()[u];
    const float mtt = bs + fmaxf(cm, m_in);
    bsum[lane] = bs; gs[lane] = g; mt[lane] = mtt; wint[lane] = __expf(bs + m_in - mtt);
  }
  ld_tile<bf16_t>(Qs, p.QC() + (size_t)ui.rowbase * 512 + hc, 512, tid);
  ld_tile128<bf16_t>(CT, p.SM() + (size_t)u * 16384, 128, tid);
  if (tid < 128) CT[128 * 136 + tid] = f2bf(p.nloc()[u * 128 + tid]);
  for (int i = tid; i < 15 * 128; i += 256) CT[(129 + (i >> 7)) * 136 + (i & 127)] = 0;
  __syncthreads();
  f32x4 acc[9][1];
#pragma unroll
  for (int mi = 0; mi < 9; ++mi) acc[mi][0] = (f32x4){0.f, 0.f, 0.f, 0.f};
  wmma<9, 1, 4>(acc, CT, 136, Qs + 16 * w * 136, 136, fr, fq);
  const int t = 16 * w + fr;
  const float wi = wint[t];
#pragma unroll
  for (int mi = 0; mi < 9; ++mi) acc[mi][0] *= wi;
  __syncthreads();
  ld_tile<bf16_t>(Ks, p.KC() + (size_t)ui.rowbase * 512 + hc, 512, tid);
  ld_T<bf16_t, 64, 72>(Vt, PRG(2) + (size_t)ui.rowbase * 512 + hc, 512, tid);
  if (tid < 64) Vt[128 * 72 + tid] = 0x3F80;
  for (int i = tid; i < 15 * 64; i += 256) Vt[(129 + (i >> 6)) * 72 + (i & 63)] = 0;
  __syncthreads();
  f32x4 st[4][1];
#pragma unroll
  for (int mi = 0; mi < 4; ++mi) st[mi][0] = (f32x4){0.f, 0.f, 0.f, 0.f};
  wmma<4, 1, 4>(st, Ks, 136, Qs + 16 * w * 136, 136, fr, fq);
  const float bt = bsum[t], mtt = mt[t];
#pragma unroll
  for (int mi = 0; mi < 4; ++mi) {
    float a[4];
#pragma unroll
    for (int j = 0; j < 4; ++j) {
      const int s = mi * 16 + fq * 4 + j;
      a[j] = (s <= t) ? st[mi][0][j] * __expf(bt + gs[s] - mtt) : 0.f;
    }
    u32x2 pk; pk.x = pack2(a[0], a[1]); pk.y = pack2(a[2], a[3]);
    *(u32x2*)(Ps + t * 72 + mi * 16 + fq * 4) = pk;
  }
  __syncthreads();
  wmma<9, 1, 2>(acc, Vt, 72, Ps + 16 * w * 72, 72, fr, fq);
  const float den = __shfl(acc[8][0][0], fr);
  const float inv = 1.f / fmaxf(fabsf(den), __expf(-mtt));
  float ss = 0.f;
#pragma unroll
  for (int mi = 0; mi < 8; ++mi) { acc[mi][0] *= inv; ss += acc[mi][0][0] * acc[mi][0][0] + acc[mi][0][1] * acc[mi][0][1] + acc[mi][0][2] * acc[mi][0][2] + acc[mi][0][3] * acc[mi][0][3]; }
  ss += __shfl_xor(ss, 16); ss += __shfl_xor(ss, 32);
  const float rs = rsqrtf(ss * (1.f / 128.f) + 1e-6f);
  const size_t row = (size_t)ui.rowbase + t;
#pragma unroll
  for (int mi = 0; mi < 8; ++mi) {
    const int col = hc + mi * 16 + fq * 4;
    const u32x2 ov = *(const u32x2*)(PRG(3) + row * 512 + col);
    const u32x2 zv = *(const u32x2*)(PRG(4) + row * 512 + col);
    const float4 g = *(const float4*)(p.g_ml + l * 512 + col);
    const f32x4 v = acc[mi][0];
    u32x2 pk;
    pk.x = pack2(v[0] * rs * g.x * sigm(lo2f(ov.x)) * silu(lo2f(zv.x)), v[1] * rs * g.y * sigm(hi2f(ov.x)) * silu(hi2f(zv.x)));
    pk.y = pack2(v[2] * rs * g.z * sigm(lo2f(ov.y)) * silu(lo2f(zv.y)), v[3] * rs * g.w * sigm(hi2f(ov.y)) * silu(hi2f(zv.y)));
    *(u32x2*)(p.H() + row * 512 + col) = pk;
  }
}

__device__ __forceinline__ bf16x8 scale_frag(const bf16_t* src, const float* ea, const float* eb, float sgn, bool clampit) {
  u32x4 raw = *(const u32x4*)src;
  float4 a0 = *(const float4*)ea, a1 = *(const float4*)(ea + 4);
  float4 b0 = {0.f, 0.f, 0.f, 0.f}, b1 = {0.f, 0.f, 0.f, 0.f};
  if (eb) { b0 = *(const float4*)eb; b1 = *(const float4*)(eb + 4); }
  float e[8] = {a0.x - b0.x, a0.y - b0.y, a0.z - b0.z, a0.w - b0.w, a1.x - b1.x, a1.y - b1.y, a1.z - b1.z, a1.w - b1.w};
  float v[8] = {lo2f(raw.x), hi2f(raw.x), lo2f(raw.y), hi2f(raw.y), lo2f(raw.z), hi2f(raw.z), lo2f(raw.w), hi2f(raw.w)};
  unsigned o[4];
#pragma unroll
  for (int i = 0; i < 4; ++i) {
    float x0 = sgn * e[2 * i], x1 = sgn * e[2 * i + 1];
    if (clampit) { x0 = fminf(x0, 80.f); x1 = fminf(x1, 80.f); }
    o[i] = pack2(v[2 * i] * __expf(x0), v[2 * i + 1] * __expf(x1));
  }
  u32x4 r = {o[0], o[1], o[2], o[3]};
  return __builtin_bit_cast(bf16x8, r);
}

__device__ void hgrn_out(const Params& p, int l, int u, char* smem) {
  float* bc = (float*)smem;
  bf16_t* ST = (bf16_t*)smem;
  bf16_t* qs = (bf16_t*)(smem + 34816);
  bf16_t* kh = (bf16_t*)(smem + 34816 + 17408);
  bf16_t* iT = kh;
  bf16_t* Ps = (bf16_t*)(smem + 34816 + 17408 + 18432);
  float* tot = (float*)(smem + 79872);
  const int tid = get_tid(), lane = tid & 63, w = tid >> 6, fr = lane & 15, fq = lane >> 4;
  const UnitInfo ui = unit_info(u);
  const int hc = ui.h * 128;
  __syncthreads();
  ld_tile<bf16_t>(qs, PRG(9) + (size_t)ui.rowbase * 512 + hc, 512, tid);
  ld_tile<bf16_t>(kh, PRG(10) + (size_t)ui.rowbase * 512 + hc, 512, tid);
  __syncthreads();
  {
    const int half = tid >> 7, ch = tid & 127;
    const float lb = hgrn_lb(p, l, hc + ch);
    bf16_t* src = kh + (half * 32) * 136 + ch;
    float run = 0.f;
#pragma unroll 8
    for (int t = 0; t < 32; ++t) { float lg, k; hgrn_gate(bf2f(src[t * 136]), lb, lg, k); run += lg; }
    tot[half * 128 + ch] = run;
    __syncthreads();
    run = half ? tot[ch] : 0.f;
#pragma unroll 8
    for (int t = 0; t < 32; ++t) {
      float lg, k; hgrn_gate(bf2f(src[t * 136]), lb, lg, k); run += lg;
      bc[(half * 32 + t) * 132 + ch] = run;
      src[t * 136] = f2bf(k);
    }
  }
  __syncthreads();
  {
    const int I = w, t = 16 * I + fr;
    f32x4 a[4];
#pragma unroll
    for (int J = 0; J < 4; ++J) a[J] = (f32x4){0.f, 0.f, 0.f, 0.f};
#pragma unroll
    for (int kk = 0; kk < 4; ++kk) {
      const int c0 = kk * 32 + fq * 8;
      const float* rI = (I > 0) ? bc + (16 * I - 1) * 132 + c0 : nullptr;
      const bf16x8 bq = scale_frag(qs + t * 136 + c0, bc + t * 132 + c0, rI, 1.f, false);
#pragma unroll
      for (int J = 0; J < 4; ++J) {
        if (J <= I) {
          const int s = 16 * J + fr;
          const bf16x8 ak = scale_frag(kh + s * 136 + c0, bc + s * 132 + c0, rI, -1.f, true);
          a[J] = __builtin_amdgcn_mfma_f32_16x16x32_bf16(ak, bq, a[J], 0, 0, 0);
        }
      }
    }
#pragma unroll
    for (int J = 0; J < 4; ++J) {
      float v[4];
#pragma unroll
      for (int j = 0; j < 4; ++j) { const int s = 16 * J + fq * 4 + j; v[j] = (s <= t) ? a[J][j] : 0.f; }
      u32x2 pk; pk.x = pack2(v[0], v[1]); pk.y = pack2(v[2], v[3]);
      *(u32x2*)(Ps + t * 72 + J * 16 + fq * 4) = pk;
    }
  }
  __syncthreads();
#pragma unroll 4
  for (int i = tid; i < 64 * 128; i += 256) { const int t = i >> 7, c = i & 127; qs[t * 136 + c] = f2bf(bf2f(qs[t * 136 + c]) * __expf(bc[t * 132 + c])); }
  __syncthreads();
  ld_T<bf16_t, 64, 72>(iT, PRG(11) + (size_t)ui.rowbase * 512 + hc, 512, tid);
  ld_tile128<bf16_t>(ST, p.SH() + (size_t)u * 16384, 128, tid);
  __syncthreads();
  f32x4 acc[8][1];
#pragma unroll
  for (int mi = 0; mi < 8; ++mi) acc[mi][0] = (f32x4){0.f, 0.f, 0.f, 0.f};
  wmma<8, 1, 2>(acc, iT, 72, Ps + 16 * w * 72, 72, fr, fq);
  wmma<8, 1, 4>(acc, ST, 136, qs + 16 * w * 136, 136, fr, fq);
  float ss = 0.f;
#pragma unroll
  for (int mi = 0; mi < 8; ++mi) ss += acc[mi][0][0] * acc[mi][0][0] + acc[mi][0][1] * acc[mi][0][1] + acc[mi][0][2] * acc[mi][0][2] + acc[mi][0][3] * acc[mi][0][3];
  ss += __shfl_xor(ss, 16); ss += __shfl_xor(ss, 32);
  const float rs = rsqrtf(ss * (1.f / 128.f) + 1e-6f);
  const size_t row = (size_t)ui.rowbase + 16 * w + fr;
#pragma unroll
  for (int mi = 0; mi < 8; ++mi) {
    const int col = hc + mi * 16 + fq * 4;
    const u32x2 zv = *(const u32x2*)(PRG(12) + row * 512 + col);
    const float4 g = *(const float4*)(p.g_hg + l * 512 + col);
    const f32x4 v = acc[mi][0];
    u32x2 pk;
    pk.x = pack2(v[0] * rs * g.x * silu(lo2f(zv.x)), v[1] * rs * g.y * silu(hi2f(zv.x)));
    pk.y = pack2(v[2] * rs * g.z * silu(lo2f(zv.y)), v[3] * rs * g.w * silu(hi2f(zv.y)));
    *(u32x2*)(p.H() + (size_t)2 * NTOK * 512 + row * 512 + col) = pk;
  }
}

__device__ void merge_tile(const Params& p, int l, int t, char* smem) {
  const int tm = t >> 3, tn = t & 7;
  const int tid = get_tid(), lane = tid & 63, wid = tid >> 6, wr = wid >> 1, wc = wid & 1, fr = lane & 15, fq = lane >> 4;
#pragma unroll 1
  for (int b = 0; b < 3; ++b) {
    f32x4 acc[4][4]; zero_acc(acc);
    gemm_kloop<bf16_t>(acc, p.U() + (size_t)tm * 128 * 1024, 1024, p.wt_in() + (size_t)l * NWT * 1024 + (size_t)(NMAIN + b * 1024 + tn * 128) * 1024, 1024, 1024, smem);
#pragma unroll
    for (int ni = 0; ni < 4; ++ni)
#pragma unroll
      for (int mi = 0; mi < 4; ++mi) {
        f32x4 v; v[0] = sigm(acc[mi][ni][0]); v[1] = sigm(acc[mi][ni][1]); v[2] = sigm(acc[mi][ni][2]); v[3] = sigm(acc[mi][ni][3]);
        *(f32x4*)(p.r() + ((size_t)tm * 128 + wr * 64 + ni * 16 + fr) * 1024 + tn * 128 + wc * 64 + mi * 16 + fq * 4) = v;
      }
    zero_acc(acc);
    gemm_kloop<bf16_t>(acc, p.H() + (size_t)b * NTOK * 512 + (size_t)tm * 128 * 512, 512, p.wt_br() + (size_t)(l * 3 + b) * 1024 * 512 + (size_t)tn * 128 * 512, 512, 512, smem);
#pragma unroll
    for (int ni = 0; ni < 4; ++ni) {
      const size_t row = (size_t)tm * 128 + wr * 64 + ni * 16 + fr;
#pragma unroll
      for (int mi = 0; mi < 4; ++mi) {
        const int col = tn * 128 + wc * 64 + mi * 16 + fq * 4;
        f32x4 v = *(const f32x4*)(p.r() + row * 1024 + col) * acc[mi][ni];
        float* part = p.y() + row * 1024 + col;
        if (b > 0) v += *(const f32x4*)part;
        if (b < 2) *(f32x4*)part = v;
        else { u32x2 pk; pk.x = pack2(v[0], v[1]); pk.y = pack2(v[2], v[3]); *(u32x2*)(p.merged() + row * 1024 + col) = pk; }
      }
    }
  }
}

__device__ void outproj_tile(const Params& p, int l, int t, char* smem) {
  const int tm = t >> 3, tn = t & 7;
  const int tid = get_tid(), lane = tid & 63, wid = tid >> 6, wr = wid >> 1, wc = wid & 1, fr = lane & 15, fq = lane >> 4;
  f32x4 acc[4][4]; zero_acc(acc);
  gemm_kloop<bf16_t>(acc, p.merged() + (size_t)tm * 128 * 1024, 1024, p.wt_out() + (size_t)l * 1048576 + (size_t)tn * 128 * 1024, 1024, 1024, smem);
#pragma unroll
  for (int ni = 0; ni < 4; ++ni) {
    const size_t row = (size_t)tm * 128 + wr * 64 + ni * 16 + fr;
#pragma unroll
    for (int mi = 0; mi < 4; ++mi) *(f32x4*)(p.y() + row * 1024 + tn * 128 + wc * 64 + mi * 16 + fq * 4) = acc[mi][ni];
  }
}


__device__ void outproj_tile256(const Params& p, int l, int t, char* smem) {
  constexpr int NT = 8;
  const int tm = t >> 3, tn = t & 7;
  const int tid = get_tid(), lane = tid & 63, wid = tid >> 6, wr = wid >> 1, wc = wid & 1, fr = lane & 15, fq = lane >> 4;
  f32x4 acc[4][NT];
#pragma unroll
  for (int a_ = 0; a_ < 4; ++a_)
#pragma unroll
    for (int b_ = 0; b_ < NT; ++b_) acc[a_][b_] = (f32x4){0.f, 0.f, 0.f, 0.f};
  gemm_glds<NT, 3>(acc, p.merged() + (size_t)tm * 256 * 1024, 1024, p.wt_out() + (size_t)l * 1048576 + (size_t)tn * 128 * 1024, 1024, 1024, smem);
#pragma unroll
  for (int ni = 0; ni < NT; ++ni) {
    const size_t row = (size_t)tm * 256 + wr * 128 + ni * 16 + fr;
#pragma unroll
    for (int m = 0; m < 2; ++m) {
      float* op = p.y() + row * 1024 + tn * 128 + wc * 64 + m * 32 + fq * 8;
      *(f32x4*)op = acc[2 * m][ni]; *(f32x4*)(op + 4) = acc[2 * m + 1][ni];
    }
  }
}


__device__ void gate_tile256(const Params& p, int l, int t, char* smem) {
  constexpr int NT = 8;
  const int tm = t / 24, tn = t % 24;
  const int tid = get_tid(), lane = tid & 63, wid = tid >> 6, wr = wid >> 1, wc = wid & 1, fr = lane & 15, fq = lane >> 4;
  f32x4 acc[4][NT];
#pragma unroll
  for (int a_ = 0; a_ < 4; ++a_)
#pragma unroll
    for (int b_ = 0; b_ < NT; ++b_) acc[a_][b_] = (f32x4){0.f, 0.f, 0.f, 0.f};
  gemm_glds<NT, 3>(acc, p.U() + (size_t)tm * 256 * 1024, 1024, p.wt_in() + (size_t)l * NWT * 1024 + (size_t)(NMAIN + tn * 128) * 1024, 1024, 1024, smem);
#pragma unroll
  for (int ni = 0; ni < NT; ++ni) {
    const size_t row = (size_t)tm * 256 + wr * 128 + ni * 16 + fr;
#pragma unroll
    for (int m = 0; m < 2; ++m) {
      const f32x4 v0 = acc[2 * m][ni], v1 = acc[2 * m + 1][ni];
      u32x4 pk; pk.x = pack2(sigm(v0[0]), sigm(v0[1])); pk.y = pack2(sigm(v0[2]), sigm(v0[3])); pk.z = pack2(sigm(v1[0]), sigm(v1[1])); pk.w = pack2(sigm(v1[2]), sigm(v1[3]));
      *(u32x4*)(p.Gb(tn >> 3) + row * 1024 + (tn & 7) * 128 + wc * 64 + m * 32 + fq * 8) = pk;
    }
  }
}
__device__ void merge_tile_g(const Params& p, int l, int t, char* smem) {
  const int tm = t >> 3, tn = t & 7;
  const int tid = get_tid(), lane = tid & 63, wid = tid >> 6, wr = wid >> 1, wc = wid & 1, fr = lane & 15, fq = lane >> 4;
  f32x4 macc[4][4]; zero_acc(macc);
#pragma unroll 1
  for (int b = 0; b < 3; ++b) {
    f32x4 acc[4][4]; zero_acc(acc);
    gemm_kloop<bf16_t>(acc, p.H() + (size_t)b * NTOK * 512 + (size_t)tm * 128 * 512, 512, p.wt_br() + (size_t)(l * 3 + b) * 1024 * 512 + (size_t)tn * 128 * 512, 512, 512, smem);
#pragma unroll
    for (int ni = 0; ni < 4; ++ni) {
      const size_t row = (size_t)tm * 128 + wr * 64 + ni * 16 + fr;
#pragma unroll
      for (int mi = 0; mi < 4; ++mi) {
        const u32x2 g = *(const u32x2*)(p.Gb(b) + row * 1024 + tn * 128 + wc * 64 + mi * 16 + fq * 4);
        macc[mi][ni][0] += lo2f(g.x) * acc[mi][ni][0]; macc[mi][ni][1] += hi2f(g.x) * acc[mi][ni][1];
        macc[mi][ni][2] += lo2f(g.y) * acc[mi][ni][2]; macc[mi][ni][3] += hi2f(g.y) * acc[mi][ni][3];
      }
    }
  }
#pragma unroll
  for (int ni = 0; ni < 4; ++ni) {
    const size_t row = (size_t)tm * 128 + wr * 64 + ni * 16 + fr;
#pragma unroll
    for (int mi = 0; mi < 4; ++mi) {
      u32x2 pk; pk.x = pack2(macc[mi][ni][0], macc[mi][ni][1]); pk.y = pack2(macc[mi][ni][2], macc[mi][ni][3]);
      *(u32x2*)(p.merged() + row * 1024 + tn * 128 + wc * 64 + mi * 16 + fq * 4) = pk;
    }
  }
}

__device__ void postnorm_phase(const Params& p, int l) {
  const int lane = threadIdx.x & 63, wid = threadIdx.x >> 6;
  const float* gp = p.g_post + l * 1024;
  for (int row = blockIdx.x * 4 + wid; row < NTOK; row += gridDim.x * 4) {
    const float* x = xrow(p, l, row);
    const float* y = p.y() + (size_t)row * 1024;
    float4 v[4]; float ss = 0.f;
#pragma unroll
    for (int i = 0; i < 4; ++i) { v[i] = *(const float4*)(y + i * 256 + lane * 4); ss += v[i].x * v[i].x + v[i].y * v[i].y + v[i].z * v[i].z + v[i].w * v[i].w; }
#pragma unroll
    for (int o = 32; o > 0; o >>= 1) ss += __shfl_xor(ss, o);
    const float rstd = rsqrtf(ss * (1.f / 1024.f) + 1e-6f);
#pragma unroll
    for (int i = 0; i < 4; ++i) {
      const int k = i * 256 + lane * 4;
      const float4 g = *(const float4*)(gp + k), xv = *(const float4*)(x + k);
      float4 r; r.x = xv.x + v[i].x * rstd * g.x; r.y = xv.y + v[i].y * rstd * g.y; r.z = xv.z + v[i].z * rstd * g.z; r.w = xv.w + v[i].w * rstd * g.w;
      u32x2 pk; pk.x = pack2(r.x, r.y); pk.y = pack2(r.z, r.w);
      *(u32x2*)(p.rb() + (size_t)row * 1024 + k) = pk;
    }
  }
}

__device__ void ple_tile(const Params& p, int l, int t, char* smem) {
  const int tm = t >> 3, tn = t & 7;
  const int tid = get_tid(), lane = tid & 63, wid = tid >> 6, wr = wid >> 1, wc = wid & 1, fr = lane & 15, fq = lane >> 4;
  f32x4 acc[4][4]; zero_acc(acc);
  const int row0 = tm * 128;
  const float* pp = row0 < NPROMPT ? p.p_p + ((size_t)l * NPROMPT + row0) * 256 : p.p_s + ((size_t)l * 512 + (row0 - NPROMPT)) * 256;
  gemm_kloop<float>(acc, pp, 256, p.wt_pp() + (size_t)l * 262144 + (size_t)tn * 128 * 256, 256, 256, smem);
  u32x2 pb[4][4];
#pragma unroll
  for (int a = 0; a < 4; ++a)
#pragma unroll
    for (int c = 0; c < 4; ++c) { pb[a][c].x = pack2(acc[a][c][0], acc[a][c][1]); pb[a][c].y = pack2(acc[a][c][2], acc[a][c][3]); }
  zero_acc(acc);
  gemm_kloop<bf16_t>(acc, p.rb() + (size_t)tm * 128 * 1024, 1024, p.wt_pg() + (size_t)l * 1048576 + (size_t)tn * 128 * 1024, 1024, 1024, smem);
#pragma unroll
  for (int ni = 0; ni < 4; ++ni) {
    const size_t row = (size_t)row0 + wr * 64 + ni * 16 + fr;
#pragma unroll
    for (int mi = 0; mi < 4; ++mi) {
      const int col = tn * 128 + wc * 64 + mi * 16 + fq * 4;
      const u32x2 rbv = *(const u32x2*)(p.rb() + row * 1024 + col);
      const f32x4 rv = {lo2f(rbv.x), hi2f(rbv.x), lo2f(rbv.y), hi2f(rbv.y)};
      f32x4 o;
      o[0] = rv[0] + sigm(acc[mi][ni][0]) * lo2f(pb[mi][ni].x); o[1] = rv[1] + sigm(acc[mi][ni][1]) * hi2f(pb[mi][ni].x);
      o[2] = rv[2] + sigm(acc[mi][ni][2]) * lo2f(pb[mi][ni].y); o[3] = rv[3] + sigm(acc[mi][ni][3]) * hi2f(pb[mi][ni].y);
      *(f32x4*)(p.o_y() + row * 1024 + col) = o;
    }
  }
}


template <typename TT>
__device__ __forceinline__ void mini_dot(f32x4& acc, const TT* Trow, const bf16_t* Wrow, int K) {
#pragma unroll 8
  for (int k = 0; k < K; k += 32) {
    const u32x4 tv = ld8(Trow + k), wv = ld8(Wrow + k);
    acc = __builtin_amdgcn_mfma_f32_16x16x32_bf16(__builtin_bit_cast(bf16x8, wv), __builtin_bit_cast(bf16x8, tv), acc, 0, 0, 0);
  }
}
__device__ void merge_mini(const Params& p, int l, int j) {
  const int tid = get_tid(), lane = tid & 63, w = tid >> 6, fr = lane & 15, fq = lane >> 4;
  const size_t row = (size_t)NPROMPT + (j >> 4) * 16 + fr;
  const int cb = (j & 15) * 64 + w * 16;
  f32x4 out = {0.f, 0.f, 0.f, 0.f};
#pragma unroll 1
  for (int b = 0; b < 3; ++b) {
    f32x4 h = {0.f, 0.f, 0.f, 0.f};
    mini_dot<bf16_t>(h, p.H() + (size_t)b * NTOK * 512 + row * 512 + fq * 8, p.wt_br() + (size_t)(l * 3 + b) * 1024 * 512 + (size_t)(cb + fr) * 512 + fq * 8, 512);
    const u32x2 g = *(const u32x2*)(p.Gb(b) + row * 1024 + cb + fq * 4);
    out[0] += lo2f(g.x) * h[0]; out[1] += hi2f(g.x) * h[1]; out[2] += lo2f(g.y) * h[2]; out[3] += hi2f(g.y) * h[3];
  }
  u32x2 pk; pk.x = pack2(out[0], out[1]); pk.y = pack2(out[2], out[3]);
  *(u32x2*)(p.merged() + row * 1024 + cb + fq * 4) = pk;
}
__device__ void outproj_mini(const Params& p, int l, int j) {
  const int tid = get_tid(), lane = tid & 63, w = tid >> 6, fr = lane & 15, fq = lane >> 4;
  const size_t row = (size_t)NPROMPT + (j >> 4) * 16 + fr;
  const int cb = (j & 15) * 64 + w * 16;
  f32x4 y = {0.f, 0.f, 0.f, 0.f};
  mini_dot<bf16_t>(y, p.merged() + row * 1024 + fq * 8, p.wt_out() + (size_t)l * 1048576 + (size_t)(cb + fr) * 1024 + fq * 8, 1024);
  *(f32x4*)(p.y() + row * 1024 + cb + fq * 4) = y;
}
__device__ void ple_mini(const Params& p, int l, int j) {
  const int tid = get_tid(), lane = tid & 63, w = tid >> 6, fr = lane & 15, fq = lane >> 4;
  const int srow = (j >> 4) * 16 + fr;
  const size_t row = (size_t)NPROMPT + srow;
  const int cb = (j & 15) * 64 + w * 16;
  f32x4 g = {0.f, 0.f, 0.f, 0.f}, pa = {0.f, 0.f, 0.f, 0.f};
  mini_dot<float>(pa, p.p_s + ((size_t)l * 512 + srow) * 256 + fq * 8, p.wt_pp() + (size_t)l * 262144 + (size_t)(cb + fr) * 256 + fq * 8, 256);
  mini_dot<bf16_t>(g, p.rb() + row * 1024 + fq * 8, p.wt_pg() + (size_t)l * 1048576 + (size_t)(cb + fr) * 1024 + fq * 8, 1024);
  const u32x2 rbv = *(const u32x2*)(p.rb() + row * 1024 + cb + fq * 4);
  const f32x4 rv = {lo2f(rbv.x), hi2f(rbv.x), lo2f(rbv.y), hi2f(rbv.y)};
  f32x4 o; o[0] = rv[0] + sigm(g[0]) * pa[0]; o[1] = rv[1] + sigm(g[1]) * pa[1]; o[2] = rv[2] + sigm(g[2]) * pa[2]; o[3] = rv[3] + sigm(g[3]) * pa[3];
  *(f32x4*)(p.o_y() + row * 1024 + cb + fq * 4) = o;
}

#define XB_TMO      128
#define XB_XCNT(j)  (256  + 64 * (j))
#define XB_XSUB(j)  (1280 + 64 * (j))
#define XB_XGEN(j)  (2304 + 64 * (j))
#define XB_TOP      3328
#define XB_TOPGEN   3392
#define XCD_BAR_WORDS 3456
#define XB_SPIN_CAP (1u << 18)
#define LAS __attribute__((address_space(3)))
__device__ __forceinline__ unsigned xb_ld(unsigned* p)              { return __hip_atomic_load(p, __ATOMIC_RELAXED, __HIP_MEMORY_SCOPE_AGENT); }
__device__ __forceinline__ unsigned xb_add(unsigned* p, unsigned v) { return __hip_atomic_fetch_add(p, v, __ATOMIC_RELAXED, __HIP_MEMORY_SCOPE_AGENT); }
__device__ __forceinline__ unsigned xb_xcc_id() { return (unsigned)__builtin_amdgcn_s_getreg((3 << 11) | 20) & 0xFu; }
#define XB_SPIN(cond, bar) do { unsigned _sp = 0; while (cond) { __builtin_amdgcn_s_sleep(1); \
    if ((++_sp & 255u) == 0u) { if (xb_ld(&(bar)[XB_TMO])) break; if (_sp > XB_SPIN_CAP) { atomicAdd(&(bar)[XB_TMO], 1u); break; } } } } while (0)
__device__ __forceinline__ void xcd_barrier_complete(unsigned* bar, unsigned x, unsigned& nloc, unsigned& nx) {
    const unsigned G = gridDim.x * gridDim.y * gridDim.z;
    unsigned sum, cnt, mine, sp = 0u;
    for (;;) {
        sum = 0u; cnt = 0u; mine = 0u;
#pragma unroll
        for (unsigned j = 0; j < 16; ++j) { const unsigned c = xb_ld(&bar[XB_XCNT(j)]); sum += c; cnt += (c > 0u) ? 1u : 0u; mine = (j == x) ? c : mine; }
        if (sum == G) break;
        __builtin_amdgcn_s_sleep(1);
        if ((++sp & 255u) == 0u) { if (xb_ld(&bar[XB_TMO])) break; if (sp > XB_SPIN_CAP) { atomicAdd(&bar[XB_TMO], 1u); break; } }
    }
    nloc = mine > 0u ? mine : 1u; nx = cnt > 0u ? cnt : 1u;
}
__device__ __forceinline__ void xcd_barrier(unsigned* bar, volatile LAS unsigned* st) {
    asm volatile("s_waitcnt vmcnt(0)" ::: "memory");
    __syncthreads();
    if (threadIdx.x == 0) {
        const unsigned x = xb_xcc_id();
        __builtin_amdgcn_s_waitcnt(0);
        unsigned nloc = st[0], nx = st[1];
        if (nloc == 0u) { xcd_barrier_complete(bar, x, nloc, nx); st[0] = nloc; st[1] = nx; }
        const unsigned old = xb_add(&bar[XB_XSUB(x)], 1u);
        const unsigned gen = old / nloc;
        if (old + 1u == (gen + 1u) * nloc) {
            __builtin_amdgcn_fence(__ATOMIC_RELEASE, "agent");
            asm volatile("s_waitcnt vmcnt(0)" ::: "memory");
            const unsigned og = xb_add(&bar[XB_TOP], 1u);
            const unsigned tg = og / nx;
            if (og + 1u == (tg + 1u) * nx) xb_add(&bar[XB_TOPGEN], 1u);
            else XB_SPIN(xb_ld(&bar[XB_TOPGEN]) == tg, bar);
            __builtin_amdgcn_fence(__ATOMIC_ACQUIRE, "agent");
            xb_add(&bar[XB_XGEN(x)], 1u);
            asm volatile("s_waitcnt vmcnt(0)" ::: "memory");
        } else {
            XB_SPIN(xb_ld(&bar[XB_XGEN(x)]) == gen, bar);
            __builtin_amdgcn_fence(__ATOMIC_ACQUIRE, "agent");
            asm volatile("s_waitcnt vmcnt(0)" ::: "memory");
        }
    }
    __syncthreads();
}

template <int PH>
__device__ __forceinline__ void run_phase(const Params& p, char* smem) {
  const int bid = blockIdx.x, nb = gridDim.x;
  if (PH == 0) {
    for (int t = bid; t < 1696; t += nb) wconv_tile(p, t, smem);
    for (int i = bid * 256 + get_tid(); i < 2 * 8 * 1024; i += nb * 256) { const int ll = i >> 13, j = (i >> 10) & 7, k = i & 1023; p.wg8()[i] = p.w_in[((size_t)ll * 1024 + k) * NINSRC + 2560 + j]; }
    return;
  }
  constexpr int l = (PH - 1) / NPL, s = (PH - 1) % NPL;
  if (!((PHMASK >> s) & 1)) return;
  switch (s) {
    case 0: norm_phase(p, l, smem); break;
    case 1: {
      const int per = (66 * 52) / 8, xcd = bid & 7, nloc = (nb + 7 - xcd) >> 3;
      for (int j = bid >> 3; j < per; j += nloc) {
        const int sq = xcd * per + j;
        const int tmg = sq / 416, rem = sq % 416, gm = (tmg == 8) ? 2 : 8;
        const int tng = rem / (gm * 8), rem2 = rem % (gm * 8), wdt = (tng == 6) ? 4 : 8;
        inproj_tile(p, l, (tmg * 8 + rem2 / wdt) * 52 + tng * 8 + rem2 % wdt, smem);
      }
      break;
    }
    case 2:
      for (int v = bid; v < 3 * NUNIT; v += nb) {
        const int ty = v % 3, u = v / 3;
        if (ty == 0) sb_unit(p, l, u, smem); else if (ty == 1) mlstm_local(p, l, u, smem); else hgrn_local(p, l, u, smem);
      }
      break;
    case 3: scan_phase(p, l, smem); break;
    case 4:
      for (int v = bid; v < 2 * NUNIT; v += nb) { if (v & 1) hgrn_out(p, l, v >> 1, smem); else mlstm_out(p, l, v >> 1, smem); }
      break;
    case 5: for (int t = bid; t < 1024; t += nb) merge_tile(p, l, t, smem); for (int j = bid; j < 512; j += nb) merge_mini(p, l, j); break;
    case 6: for (int t = bid; t < 1024; t += nb) outproj_tile(p, l, t, smem); for (int j = bid; j < 512; j += nb) outproj_mini(p, l, j); break;
    case 7: postnorm_phase(p, l); break;
    case 8: for (int t = bid; t < 1024; t += nb) ple_tile(p, l, t, smem); for (int j = bid; j < 512; j += nb) ple_mini(p, l, j); break;
  }
}

template <int PH>
__global__ void __launch_bounds__(256, 2) phase_kernel(Params p) {
  __shared__ __attribute__((aligned(16))) char smem[SMEM_BYTES];
  run_phase<PH>(p, smem);
}

#if FUSED
__device__ __forceinline__ int fetch_work(unsigned* ctr, volatile int* slot) {
  __syncthreads();
  if (threadIdx.x == 0) *slot = (int)__hip_atomic_fetch_add(ctr, 1u, __ATOMIC_RELAXED, __HIP_MEMORY_SCOPE_AGENT);
  __syncthreads();
  return *slot;
}
__device__ __forceinline__ void run_phase_rt(const Params& p, int ph, char* smem, volatile int* wslot) {
  const int bid = blockIdx.x, nb = gridDim.x;
  unsigned* ctr = (unsigned*)(p.ws + WS_BAR + 14336) + ph * 16;
  int l = 0, s = 0;
  if (ph == 0) { for (int t = bid; t < 1696; t += nb) wconv_tile(p, t, smem); }
  else { if (ph == 1) return; l = (ph - 1) / NPL; s = (ph - 1) % NPL; }
  switch (s) {
    case 0: norm_phase(p, l, smem); break;
    case 1: {
      const int per = (66 * 52) / 8, xcd0 = (int)(xb_xcc_id() & 7u);
      for (int dx = 0; dx < 8; ++dx) {
        const int xcd = (xcd0 + dx) & 7;
        for (;;) {
          const int j = fetch_work(ctr + xcd, wslot);
          if (j >= per) break;
          const int sq = xcd * per + j;
          const int tmg = sq / 416, rem = sq % 416, gm = (tmg == 8) ? 2 : 8;
          const int tng = rem / (gm * 8), rem2 = rem % (gm * 8), wdt = (tng == 6) ? 4 : 8;
          inproj_tile(p, l, (tmg * 8 + rem2 / wdt) * 52 + tng * 8 + rem2 % wdt, smem);
        }
      }
      break;
    }
    case 2:
      for (;;) {
        const int v = fetch_work(ctr, wslot);
        if (v >= 3 * NUNIT) break;
        if (v < NUNIT) sb_unit(p, l, v, smem); else if (v < 2 * NUNIT) mlstm_local(p, l, v - NUNIT, smem); else hgrn_local(p, l, v - 2 * NUNIT, smem);
      }
      break;
    case 3: {
      scan_phase(p, l, smem);
      const int v = fetch_work(ctr + 8, wslot);
      if (v < 1584) gate_tile256(p, l, v < 48 ? 1536 + v : v - 48, smem);
      break;
    }
    case 4: {
      unsigned* gq = ctr - 16 + 8;
      bool gleft = true, uleft = true;
      while (gleft || uleft) {
        if (gleft) { const int v = fetch_work(gq, wslot); if (v < 1584) gate_tile256(p, l, v < 48 ? 1536 + v : v - 48, smem); else gleft = false; }
        for (int k = 0; k < 2 && uleft; ++k) {
          const int u = fetch_work(ctr, wslot);
          if (u >= 2 * NUNIT) uleft = false;
          else if (u < NUNIT) hgrn_out(p, l, u, smem); else mlstm_out(p, l, u - NUNIT, smem);
        }
      }
      break;
    }
    case 5: for (;;) { const int v = fetch_work(ctr, wslot); if (v >= 1536) break; if (v < 1024) merge_tile_g(p, l, v, smem); else merge_mini(p, l, v - 1024); } break;
    case 6: for (;;) { const int v = fetch_work(ctr, wslot); if (v >= 1024) break; if (v < 512) outproj_tile256(p, l, v, smem); else outproj_mini(p, l, v - 512); } break;
    case 7: postnorm_phase(p, l); break;
    case 8: for (;;) { const int v = fetch_work(ctr, wslot); if (v >= 1536) break; if (v < 1024) ple_tile(p, l, v, smem); else ple_mini(p, l, v - 1024); } break;
  }
}

__global__ void __launch_bounds__(256, 2) mega(Params p_unused) {
  __shared__ __attribute__((aligned(16))) char smem[SMEM_BYTES];
  __shared__ uint4 xb_words;
  __shared__ int wslot;
  if (threadIdx.x == 0) {
    typedef const Params __attribute__((address_space(4))) * KP4;
    KP4 kp = (KP4)__builtin_amdgcn_kernarg_segment_ptr();
    asm volatile("" : "+s"(kp));
    char* wsb = ((const Params*)kp)->ws;
    xb_words = make_uint4(0u, 0u, 0u, 0u); (void)xb_add((unsigned*)(wsb + WS_BAR) + XB_XCNT(xb_xcc_id()), 1u);
  }
  __syncthreads();
  typedef const Params __attribute__((address_space(4))) * KP4;
#ifdef PROBE_KIND
  unsigned long long t_acc = 0;
#endif
#pragma unroll 1
  for (int ph = 0; ph < NPHASE; ++ph) {
    KP4 kp = (KP4)__builtin_amdgcn_kernarg_segment_ptr();
    asm volatile("" : "+s"(kp));
    const Params q = *(const Params*)kp;
#ifdef PROBE_KIND
    const unsigned long long tp0 = __builtin_amdgcn_s_memrealtime();
#endif
    run_phase_rt(q, ph, smem, &wslot);
#ifdef PROBE_KIND
    const unsigned long long tp1 = __builtin_amdgcn_s_memrealtime();
    if ((PROBE_KIND == 9 && ph == 0) || (PROBE_KIND < 9 && ph > 0 && (ph - 1) % NPL == PROBE_KIND)) t_acc += tp1 - tp0;
#endif
    if (ph + 1 < NPHASE && ph != 1) xcd_barrier((unsigned*)(q.ws + WS_BAR), (volatile LAS unsigned*)&xb_words);
    if (gridDim.y == 7777u) cg::this_grid().sync();
#ifdef PROBE_KIND
    if (PROBE_KIND == 10 && (PROBE_SEL < 0 || (ph > 0 && (ph - 1) % NPL == PROBE_SEL))) t_acc += __builtin_amdgcn_s_memrealtime() - tp1;
#endif
  }
#ifdef PROBE_GEMM
  {
    KP4 kp = (KP4)__builtin_amdgcn_kernarg_segment_ptr();
    asm volatile("" : "+s"(kp));
    const Params q = *(const Params*)kp;
    xcd_barrier((unsigned*)(q.ws + WS_BAR), (volatile LAS unsigned*)&xb_words);
    const unsigned long long tg0 = __builtin_amdgcn_s_memrealtime();
    f32x4 acc[4][8];
#pragma unroll
    for (int a_ = 0; a_ < 4; ++a_)
#pragma unroll
      for (int b_ = 0; b_ < 8; ++b_) acc[a_][b_] = (f32x4){0.f, 0.f, 0.f, 0.f};
    const int bid = blockIdx.x;
#pragma unroll 1
    for (int it = 0; it < 8; ++it) {
      int tm, tn;
      if (PROBE_GEMM == 0) { tm = 0; tn = 0; }
      else if (PROBE_GEMM == 1) { tm = bid & 63; tn = ((bid >> 6) * 6 + it) % 52; }
      else { const int xcd = bid & 7, idx = bid >> 3; tm = xcd * 8 + (idx & 7); tn = ((idx >> 3) + 8 * it) % 52; }
      gemm_glds<8, 3>(acc, q.U() + (size_t)tm * 256 * 1024, 1024, q.wt_in() + (size_t)tn * 128 * 1024, 1024, 1024, smem);
    }
    float sum = 0.f;
#pragma unroll
    for (int a_ = 0; a_ < 4; ++a_)
#pragma unroll
      for (int b_ = 0; b_ < 8; ++b_) sum += acc[a_][b_][0] + acc[a_][b_][1] + acc[a_][b_][2] + acc[a_][b_][3];
    if (sum == 123456.789f) q.hbc()[0] = sum;
    const unsigned long long tg1 = __builtin_amdgcn_s_memrealtime();
    if (blockIdx.x == 0) { while (__builtin_amdgcn_s_memrealtime() - tg1 < 4 * (tg1 - tg0)) __builtin_amdgcn_s_sleep(32); }
  }
#endif
#ifdef PROBE_KIND
  if (blockIdx.x == PROBE_BLOCK) { const unsigned long long te = __builtin_amdgcn_s_memrealtime(); while (__builtin_amdgcn_s_memrealtime() - te < 4 * t_acc) __builtin_amdgcn_s_sleep(32); }
#endif
}
#endif

template <int PH>
static void launch_all(const Params& p, int grid, hipStream_t stream) {
  hipLaunchKernelGGL(phase_kernel<PH>, dim3(grid), dim3(256), 0, stream, p);
  if constexpr (PH + 1 < NPHASE) launch_all<PH + 1>(p, grid, stream);
}

extern "C" void kernel_launch(void* const* d_in, const int* in_sizes, int n_in, void* d_out, int out_size, void* d_ws, size_t ws_size, hipStream_t stream) {
  Params p;
  memset(&p, 0, sizeof(p));
  const float* const* in = (const float* const*)d_in;
  p.x_p = in[0]; p.x_s = in[1]; p.p_p = in[2]; p.p_s = in[3]; p.st_C = in[4]; p.st_n = in[5]; p.st_m = in[6]; p.st_conv = in[7];
  p.ck = in[8]; p.cv = in[9]; p.st_S = in[10]; p.g_pre = in[11]; p.w_in = in[12]; p.b_i = in[13]; p.b_f = in[14]; p.w_conv = in[15];
  p.g_ml = in[16]; p.lb_logits = in[17]; p.g_hg = in[18]; p.w_br = in[19]; p.w_out = in[20]; p.g_post = in[21]; p.w_pg = in[22]; p.w_pp = in[23];
  p.out = (float*)d_out; p.ws = (char*)d_ws;
  if (WS_TOTAL > ws_size || (size_t)out_size < O_TOTAL) { fprintf(stderr, "workspace/out too small: need %zu have %zu\n", (size_t)WS_TOTAL, ws_size); return; }
  static int grid_blocks = 0;
  if (!grid_blocks) {
    int dev = 0, cus = 0, per_cu = 0;
    (void)hipGetDevice(&dev);
    (void)hipDeviceGetAttribute(&cus, hipDeviceAttributeMultiprocessorCount, dev);
#if FUSED
    (void)hipOccupancyMaxActiveBlocksPerMultiprocessor(&per_cu, mega, 256, 0);
#else
    per_cu = 2;
#endif
    if (per_cu > 2) per_cu = 2;
    if (per_cu < 1) per_cu = 1;
    grid_blocks = cus * per_cu;
  }
#if FUSED
  (void)hipMemsetAsync((char*)d_ws + WS_BAR, 0, 16384, stream);
  void* args[] = {&p};
  hipError_t e = hipLaunchCooperativeKernel((void*)mega, dim3(grid_blocks), dim3(256), args, 0, stream);
  if (e != hipSuccess) fprintf(stderr, "cooperative launch failed: %s (grid %d)\n", hipGetErrorString(e), grid_blocks);
#else
  launch_all<0>(p, grid_blocks, stream);
#endif
}
```

```cpp
#include <hip/hip_runtime.h>
#include <hip/hip_cooperative_groups.h>
#include <stdint.h>
#include <stdio.h>
#include <string.h>
namespace cg = cooperative_groups;

#ifndef FUSED
#define FUSED 1
#endif
#ifndef PHMASK
#define PHMASK 0x3ff
#endif

typedef unsigned short bf16_t;
typedef short bf16x8 __attribute__((ext_vector_type(8)));
typedef float f32x4 __attribute__((ext_vector_type(4)));
typedef unsigned u32x4 __attribute__((ext_vector_type(4)));
typedef unsigned u32x2 __attribute__((ext_vector_type(2)));

constexpr int NTOK = 16896, NPROMPT = 16384, NUNIT = 1056;
constexpr int NINSRC = 9736, NWT = 9728, NMAIN = 6656;
constexpr int SMEM_BYTES = 80896;
constexpr int NPL = 9;
constexpr int NPHASE = 1 + 2 * NPL;

constexpr size_t al256(size_t x) { return (x + 255) & ~(size_t)255; }
constexpr size_t WS_WT_IN = 0;
constexpr size_t WS_WT_BR = WS_WT_IN + al256((size_t)2 * NWT * 1024 * 2);
constexpr size_t WS_WT_OUT = WS_WT_BR + al256((size_t)2 * 3 * 1024 * 512 * 2);
constexpr size_t WS_WT_PG = WS_WT_OUT + al256((size_t)2 * 1048576 * 2);
constexpr size_t WS_WT_PP = WS_WT_PG + al256((size_t)2 * 1048576 * 2);
constexpr size_t WS_U = WS_WT_PP + al256((size_t)2 * 262144 * 2);
constexpr size_t WS_PR = WS_U + al256((size_t)NTOK * 1024 * 2);
constexpr size_t WS_QC = WS_PR + al256((size_t)13 * NTOK * 512 * 2);
constexpr size_t WS_KC = WS_QC + al256((size_t)NTOK * 512 * 2);
constexpr size_t WS_SM = WS_KC + al256((size_t)NTOK * 512 * 2);
constexpr size_t WS_SH = WS_SM + al256((size_t)NUNIT * 16384 * 2);
constexpr size_t WS_H = WS_SH + al256((size_t)NUNIT * 16384 * 2);
constexpr size_t WS_IG = WS_H + al256((size_t)3 * NTOK * 512 * 2);
constexpr size_t WS_LF = WS_IG + al256((size_t)NTOK * 16);
constexpr size_t WS_AC = WS_LF + al256((size_t)NTOK * 16);
constexpr size_t WS_BC = WS_AC + al256(NUNIT * 4);
constexpr size_t WS_MIN = WS_BC + al256(NUNIT * 4);
constexpr size_t WS_NLOC = WS_MIN + al256(NUNIT * 4);
constexpr size_t WS_HBC = WS_NLOC + al256((size_t)NUNIT * 512);
constexpr size_t WS_BAR = WS_HBC + al256((size_t)NUNIT * 512);
constexpr size_t WS_WG8 = WS_BAR + 16384;
constexpr size_t WS_TOTAL = WS_WG8 + 65536;
constexpr size_t GRP = (size_t)NTOK * 512 * 2;
constexpr size_t WS_G0 = WS_PR + 0 * GRP, WS_G1 = WS_PR + 5 * GRP, WS_G2 = WS_PR + 7 * GRP;
constexpr size_t WS_MERGED = WS_PR + 2 * GRP;
constexpr size_t WS_Y = WS_PR + 9 * GRP;
constexpr size_t WS_RB = WS_PR + 0 * GRP;
constexpr size_t WS_R = WS_PR + 5 * GRP;
static_assert(WS_Y + (size_t)NTOK * 1024 * 4 <= WS_QC, "alias overflow");
constexpr size_t O_PC = 16777216 + 524288, O_PN = O_PC + 262144, O_PM = O_PN + 2048, O_PCONV = O_PM + 16, O_PK = O_PCONV + 12288, O_PV = O_PK + 16777216,
                 O_PS = O_PV + 16777216, O_SC = O_PS + 262144, O_SN = O_SC + 1048576, O_SM = O_SN + 8192, O_SCONV = O_SM + 64, O_SK = O_SCONV + 49152,
                 O_SV = O_SK + 524288, O_SS = O_SV + 524288, O_TOTAL = O_SS + 1048576;

struct Params {
  const float *x_p, *x_s, *p_p, *p_s, *st_C, *st_n, *st_m, *st_conv, *ck, *cv, *st_S;
  const float *g_pre, *w_in, *b_i, *b_f, *w_conv, *g_ml, *lb_logits, *g_hg, *w_br, *w_out, *g_post, *w_pg, *w_pp;
  float* out; char* ws;
#define WSP(name, T, off) __device__ __forceinline__ T* name() const { return (T*)(ws + (off)); }
#define OUTP(name, off) __device__ __forceinline__ float* name() const { return out + (off); }
  OUTP(o_y, 0) OUTP(o_pC, O_PC) OUTP(o_pn, O_PN) OUTP(o_pm, O_PM) OUTP(o_pconv, O_PCONV) OUTP(o_pk, O_PK) OUTP(o_pv, O_PV) OUTP(o_pS, O_PS)
  OUTP(o_sC, O_SC) OUTP(o_sn, O_SN) OUTP(o_sm, O_SM) OUTP(o_sconv, O_SCONV) OUTP(o_sk, O_SK) OUTP(o_sv, O_SV) OUTP(o_sS, O_SS)
  WSP(wt_in, bf16_t, WS_WT_IN) WSP(wt_br, bf16_t, WS_WT_BR) WSP(wt_out, bf16_t, WS_WT_OUT) WSP(wt_pg, bf16_t, WS_WT_PG) WSP(wt_pp, bf16_t, WS_WT_PP)
  WSP(U, bf16_t, WS_U) WSP(PR, bf16_t, WS_PR) WSP(QC, bf16_t, WS_QC) WSP(KC, bf16_t, WS_KC) WSP(SM, bf16_t, WS_SM) WSP(SH, bf16_t, WS_SH) WSP(H, bf16_t, WS_H)
  WSP(ig, float, WS_IG) WSP(lf, float, WS_LF) WSP(ac, float, WS_AC) WSP(Bc, float, WS_BC) WSP(min_, float, WS_MIN) WSP(nloc, float, WS_NLOC) WSP(hbc, float, WS_HBC)
  __device__ __forceinline__ bf16_t* Gb(int b) const { return (bf16_t*)(ws + (b == 0 ? WS_G0 : b == 1 ? WS_G1 : WS_G2)); }
  WSP(wg8, float, WS_WG8) WSP(merged, bf16_t, WS_MERGED) WSP(y, float, WS_Y) WSP(r, float, WS_R) WSP(rb, bf16_t, WS_RB)
};

__device__ __forceinline__ int get_tid() { int t = threadIdx.x; asm volatile("" : "+v"(t)); return t; }
__device__ __forceinline__ bf16_t f2bf(float f) { unsigned u = __float_as_uint(f); u += 0x7fffu + ((u >> 16) & 1u); return (bf16_t)(u >> 16); }
__device__ __forceinline__ float bf2f(bf16_t h) { return __uint_as_float(((unsigned)h) << 16); }
__device__ __forceinline__ unsigned pack2(float a, float b) { return (unsigned)f2bf(a) | ((unsigned)f2bf(b) << 16); }
__device__ __forceinline__ float lo2f(unsigned v) { return __uint_as_float(v << 16); }
__device__ __forceinline__ float hi2f(unsigned v) { return __uint_as_float(v & 0xffff0000u); }
__device__ __forceinline__ float sigm(float x) { return 1.f / (1.f + __expf(-x)); }
__device__ __forceinline__ float silu(float x) { return x / (1.f + __expf(-x)); }
__device__ __forceinline__ float softplus(float x) { return fmaxf(x, 0.f) + __logf(1.f + __expf(-fabsf(x))); }
__device__ __forceinline__ float logsigm(float x) { return fminf(x, 0.f) - __logf(1.f + __expf(-fabsf(x))); }

template <int MT, int NT, int KS>
__device__ __forceinline__ void wmma(f32x4 (&acc)[MT][NT], const bf16_t* A, int lda, const bf16_t* B, int ldb, int fr, int fq) {
#pragma unroll
  for (int kk = 0; kk < KS; ++kk) {
    bf16x8 a[MT], b[NT];
#pragma unroll
    for (int mi = 0; mi < MT; ++mi) a[mi] = *(const bf16x8*)(A + (mi * 16 + fr) * lda + kk * 32 + fq * 8);
#pragma unroll
    for (int ni = 0; ni < NT; ++ni) b[ni] = *(const bf16x8*)(B + (ni * 16 + fr) * ldb + kk * 32 + fq * 8);
#pragma unroll
    for (int mi = 0; mi < MT; ++mi)
#pragma unroll
      for (int ni = 0; ni < NT; ++ni) acc[mi][ni] = __builtin_amdgcn_mfma_f32_16x16x32_bf16(a[mi], b[ni], acc[mi][ni], 0, 0, 0);
  }
}

__device__ __forceinline__ u32x4 ld8(const bf16_t* s) { return *(const u32x4*)s; }
__device__ __forceinline__ u32x4 ld8(const float* s) {
  float4 a = *(const float4*)s, b = *(const float4*)(s + 4);
  u32x4 r; r.x = pack2(a.x, a.y); r.y = pack2(a.z, a.w); r.z = pack2(b.x, b.y); r.w = pack2(b.z, b.w); return r;
}
template <typename T>
__device__ __forceinline__ void ld_tile(bf16_t* dst, const T* src, long ld, int tid) {
#pragma unroll
  for (int i = 0; i < 4; ++i) { int id = tid + 256 * i; int r = id >> 4, c = (id & 15) * 8; *(u32x4*)(dst + r * 136 + c) = ld8(src + (long)r * ld + c); }
}
template <typename T>
__device__ __forceinline__ void ld_tile128(bf16_t* dst, const T* src, long ld, int tid) {
#pragma unroll
  for (int i = 0; i < 8; ++i) { int id = tid + 256 * i; int r = id >> 4, c = (id & 15) * 8; *(u32x4*)(dst + r * 136 + c) = ld8(src + (long)r * ld + c); }
}
template <typename T, int ROWS, int DLD>
__device__ __forceinline__ void ld_T(bf16_t* dst, const T* src, long ld, int tid) {
#pragma unroll 2
  for (int id = tid; id < ROWS * 16; id += 256) {
    int r = id % ROWS, c = (id / ROWS) * 8;
    u32x4 v = ld8(src + (long)r * ld + c);
    bf16_t* d = dst + c * DLD + r;
    d[0] = (bf16_t)(v.x & 0xffff); d[DLD] = (bf16_t)(v.x >> 16); d[2 * DLD] = (bf16_t)(v.y & 0xffff); d[3 * DLD] = (bf16_t)(v.y >> 16);
    d[4 * DLD] = (bf16_t)(v.z & 0xffff); d[5 * DLD] = (bf16_t)(v.z >> 16); d[6 * DLD] = (bf16_t)(v.w & 0xffff); d[7 * DLD] = (bf16_t)(v.w >> 16);
  }
}

#define PRG(g) (p.PR() + (size_t)(g) * NTOK * 512)

__device__ __forceinline__ const float* xrow(const Params& p, int l, int row) {
  if (l == 0) return row < NPROMPT ? p.x_p + (size_t)row * 1024 : p.x_s + (size_t)(row - NPROMPT) * 1024;
  return p.o_y() + (size_t)row * 1024;
}

__device__ void wconv_tile(const Params& p, int t, char* smem) {
  float* tile = (float*)smem;
  const int tid = get_tid();
  int l = t / 848, r = t % 848;
  const float* src; bf16_t* dst; int K, ldsrc, kt, nt, skip = 1 << 30;
  if (r < 608) { src = p.w_in + (size_t)l * 1024 * NINSRC; dst = p.wt_in() + (size_t)l * NWT * 1024; K = 1024; ldsrc = NINSRC; kt = r % 16; nt = r / 16; skip = 2560; }
  else if (r < 704) { r -= 608; int b = r / 32; r %= 32; src = p.w_br + (size_t)(l * 3 + b) * 512 * 1024; dst = p.wt_br() + (size_t)(l * 3 + b) * 1024 * 512; K = 512; ldsrc = 1024; kt = r % 8; nt = r / 8; }
  else if (r < 768) { r -= 704; src = p.w_out + (size_t)l * 1048576; dst = p.wt_out() + (size_t)l * 1048576; K = 1024; ldsrc = 1024; kt = r % 16; nt = r / 16; }
  else if (r < 832) { r -= 768; src = p.w_pg + (size_t)l * 1048576; dst = p.wt_pg() + (size_t)l * 1048576; K = 1024; ldsrc = 1024; kt = r % 16; nt = r / 16; }
  else { r -= 832; src = p.w_pp + (size_t)l * 262144; dst = p.wt_pp() + (size_t)l * 262144; K = 256; ldsrc = 1024; kt = r % 4; nt = r / 4; }
  const int n0 = nt * 256, k0 = kt * 64;
  __syncthreads();
#pragma unroll
  for (int i = 0; i < 16; ++i) {
    const int k = i * 4 + (tid >> 6), n4 = (tid & 63) * 4;
    int ns = n0 + n4; if (ns >= skip) ns += 8;
    *(float4*)(tile + k * 260 + n4) = *(const float4*)(src + (size_t)(k0 + k) * ldsrc + ns);
  }
  __syncthreads();
  bf16_t* drow = dst + (size_t)(n0 + tid) * K + k0;
#pragma unroll
  for (int c = 0; c < 8; ++c) {
    u32x4 pk;
    pk.x = pack2(tile[(c * 8 + 0) * 260 + tid], tile[(c * 8 + 1) * 260 + tid]);
    pk.y = pack2(tile[(c * 8 + 2) * 260 + tid], tile[(c * 8 + 3) * 260 + tid]);
    pk.z = pack2(tile[(c * 8 + 4) * 260 + tid], tile[(c * 8 + 5) * 260 + tid]);
    pk.w = pack2(tile[(c * 8 + 6) * 260 + tid], tile[(c * 8 + 7) * 260 + tid]);
    *(u32x4*)(drow + c * 8) = pk;
  }
}

__device__ void norm_phase(const Params& p, int l, char* smem) {
  const int lane = threadIdx.x & 63, wid = threadIdx.x >> 6;
  const float* gp = p.g_pre + l * 1024;
  float* wgs = (float*)smem;
  __syncthreads();
  {
    const float* wsrc = p.w_in + (size_t)l * 1024 * NINSRC + 2560;
    for (int k = threadIdx.x; k < 1024; k += 256) {
      const float4 a = *(const float4*)(wsrc + (size_t)k * NINSRC), b = *(const float4*)(wsrc + (size_t)k * NINSRC + 4);
      wgs[k] = a.x; wgs[1024 + k] = a.y; wgs[2048 + k] = a.z; wgs[3072 + k] = a.w;
      wgs[4096 + k] = b.x; wgs[5120 + k] = b.y; wgs[6144 + k] = b.z; wgs[7168 + k] = b.w;
    }
  }
  __syncthreads();
  const float* wg = wgs;
  for (int row = blockIdx.x * 4 + wid; row < NTOK; row += gridDim.x * 4) {
    const float* x = xrow(p, l, row);
    float4 v[4]; float ss = 0.f;
#pragma unroll
    for (int i = 0; i < 4; ++i) { v[i] = *(const float4*)(x + i * 256 + lane * 4); ss += v[i].x * v[i].x + v[i].y * v[i].y + v[i].z * v[i].z + v[i].w * v[i].w; }
#pragma unroll
    for (int o = 32; o > 0; o >>= 1) ss += __shfl_xor(ss, o);
    const float rstd = rsqrtf(ss * (1.f / 1024.f) + 1e-6f);
    float d0 = 0, d1 = 0, d2 = 0, d3 = 0, d4 = 0, d5 = 0, d6 = 0, d7 = 0;
#pragma unroll
    for (int i = 0; i < 4; ++i) {
      const int k = i * 256 + lane * 4;
      float4 g = *(const float4*)(gp + k);
      float u0 = v[i].x * rstd * g.x, u1 = v[i].y * rstd * g.y, u2 = v[i].z * rstd * g.z, u3 = v[i].w * rstd * g.w;
      u32x2 pk; pk.x = pack2(u0, u1); pk.y = pack2(u2, u3);
      *(u32x2*)(p.U() + (size_t)row * 1024 + k) = pk;
      const float* wp = wg + k;
      float4 w;
      w = *(const float4*)(wp);            d0 += u0 * w.x + u1 * w.y + u2 * w.z + u3 * w.w;
      w = *(const float4*)(wp + 1024);     d1 += u0 * w.x + u1 * w.y + u2 * w.z + u3 * w.w;
      w = *(const float4*)(wp + 2 * 1024); d2 += u0 * w.x + u1 * w.y + u2 * w.z + u3 * w.w;
      w = *(const float4*)(wp + 3 * 1024); d3 += u0 * w.x + u1 * w.y + u2 * w.z + u3 * w.w;
      w = *(const float4*)(wp + 4 * 1024); d4 += u0 * w.x + u1 * w.y + u2 * w.z + u3 * w.w;
      w = *(const float4*)(wp + 5 * 1024); d5 += u0 * w.x + u1 * w.y + u2 * w.z + u3 * w.w;
      w = *(const float4*)(wp + 6 * 1024); d6 += u0 * w.x + u1 * w.y + u2 * w.z + u3 * w.w;
      w = *(const float4*)(wp + 7 * 1024); d7 += u0 * w.x + u1 * w.y + u2 * w.z + u3 * w.w;
    }
#pragma unroll
    for (int o = 32; o > 0; o >>= 1) {
      d0 += __shfl_xor(d0, o); d1 += __shfl_xor(d1, o); d2 += __shfl_xor(d2, o); d3 += __shfl_xor(d3, o);
      d4 += __shfl_xor(d4, o); d5 += __shfl_xor(d5, o); d6 += __shfl_xor(d6, o); d7 += __shfl_xor(d7, o);
    }
    if (lane < 4) {
      float di = lane == 0 ? d0 : lane == 1 ? d1 : lane == 2 ? d2 : d3;
      float df = lane == 0 ? d4 : lane == 1 ? d5 : lane == 2 ? d6 : d7;
      p.ig()[row * 4 + lane] = di + p.b_i[l * 4 + lane];
      p.lf()[row * 4 + lane] = logsigm(df + p.b_f[l * 4 + lane]);
    }
  }
}

template <typename TA>
__device__ __forceinline__ void gemm_kloop(f32x4 (&acc)[4][4], const TA* Tp, long ldt, const bf16_t* Wp, long ldw, int K, char* smem) {
  bf16_t* sT = (bf16_t*)smem;
  bf16_t* sW = sT + 2 * 9216;
  const int tid = get_tid(), lane = tid & 63, wid = tid >> 6, wr = wid >> 1, wc = wid & 1, fr = lane & 15, fq = lane >> 4;
  u32x4 rt[4], rw[4];
  const int r0 = tid >> 3, c0 = (tid & 7) * 8;
#define GLOAD(k0) _Pragma("unroll") for (int i = 0; i < 4; ++i) { rt[i] = ld8(Tp + (long)(r0 + 32 * i) * ldt + (k0) + c0); rw[i] = ld8(Wp + (long)(r0 + 32 * i) * ldw + (k0) + c0); }
#define SSTORE(buf) _Pragma("unroll") for (int i = 0; i < 4; ++i) { *(u32x4*)(sT + (buf) * 9216 + (r0 + 32 * i) * 72 + c0) = rt[i]; *(u32x4*)(sW + (buf) * 9216 + (r0 + 32 * i) * 72 + c0) = rw[i]; }
  GLOAD(0); SSTORE(0);
  __syncthreads();
  const int nk = K >> 6;
#pragma unroll 1
  for (int kt = 0; kt < nk; ++kt) {
    const int buf = kt & 1;
    if (kt + 1 < nk) { GLOAD((kt + 1) * 64); }
    const bf16_t* aT = sT + buf * 9216 + (wr * 64) * 72;
    const bf16_t* aW = sW + buf * 9216 + (wc * 64) * 72;
    wmma<4, 4, 2>(acc, aW, 72, aT, 72, fr, fq);
    if (kt + 1 < nk) { SSTORE(buf ^ 1); }
    __syncthreads();
  }
#undef GLOAD
#undef SSTORE
}
__device__ __forceinline__ void zero_acc(f32x4 (&acc)[4][4]) {
#pragma unroll
  for (int a = 0; a < 4; ++a)
#pragma unroll
    for (int b = 0; b < 4; ++b) acc[a][b] = (f32x4){0.f, 0.f, 0.f, 0.f};
}


template <int NT, int NSTAGE>
__device__ __forceinline__ void gemm_glds(f32x4 (&acc)[4][NT], const bf16_t* Tp, long ldt, const bf16_t* Wp, long ldw, int K, char* smem) {
  constexpr int TR = 2 * NT * 16, STAGE_B = (TR + 128) * 64, LT = TR / 64, LPS = LT + 2;
  static_assert(NSTAGE * STAGE_B <= SMEM_BYTES, "ring too large");
  static_assert(NSTAGE == 3 || NSTAGE == 4, "waits below are written for 3 or 4 stages");
  const int tid = get_tid(), lane = tid & 63, wid = tid >> 6, wr = wid >> 1, wc = wid & 1, fr = lane & 15, fq = lane >> 4;
  const int lr = tid >> 2, cp = tid & 3, lc = (cp ^ ((lr >> 2) & 3)) * 8;
  const bf16_t* gT = Tp + (long)lr * ldt + lc;
  const int plr = ((lr >> 5) & 1) * 32 + ((lr >> 2) & 3) * 8 + ((lr >> 4) & 1) * 4 + (lr & 3);
  const bf16_t* gW = Wp + (long)plr * ldw + lc;
  const int rd_off = fr * 64 + ((fq ^ ((fr >> 2) & 3)) * 16);
#define GL_ISSUE(kt_, slot_) do { char* sb_ = smem + (slot_) * STAGE_B + tid * 16; \
    _Pragma("unroll") for (int i_ = 0; i_ < LT; ++i_) __builtin_amdgcn_global_load_lds((const unsigned*)(gT + (long)i_ * 64 * ldt + (kt_) * 32), (__attribute__((address_space(3))) unsigned*)(sb_ + i_ * 4096), 16, 0, 0); \
    _Pragma("unroll") for (int i_ = 0; i_ < 2; ++i_) __builtin_amdgcn_global_load_lds((const unsigned*)(gW + (long)i_ * 64 * ldw + (kt_) * 32), (__attribute__((address_space(3))) unsigned*)(sb_ + TR * 64 + i_ * 4096), 16, 0, 0); } while (0)
  asm volatile("s_waitcnt vmcnt(0)" ::: "memory");
  __builtin_amdgcn_s_barrier();
  const int nk = K >> 5;
#pragma unroll
  for (int s_ = 0; s_ < NSTAGE - 1; ++s_) if (s_ < nk) GL_ISSUE(s_, s_);
  int slot = 0, islot = NSTAGE - 1;
#pragma unroll 1
  for (int kt = 0; kt < nk; ++kt) {
    const int rem = nk - 1 - kt;
    if (NSTAGE == 4) {
      if (rem >= 2) asm volatile("s_waitcnt vmcnt(%0)" ::"n"(2 * LPS) : "memory");
      else if (rem == 1) asm volatile("s_waitcnt vmcnt(%0)" ::"n"(LPS) : "memory");
      else asm volatile("s_waitcnt vmcnt(0)" ::: "memory");
    } else {
      if (rem >= 1) asm volatile("s_waitcnt vmcnt(%0)" ::"n"(LPS) : "memory");
      else asm volatile("s_waitcnt vmcnt(0)" ::: "memory");
    }
    __builtin_amdgcn_s_barrier();
    const unsigned aT = (unsigned)(uintptr_t)(smem + slot * STAGE_B + (wr * NT * 16) * 64 + rd_off);
    const unsigned aW = (unsigned)(uintptr_t)(smem + slot * STAGE_B + TR * 64 + (wc * 64) * 64 + rd_off);
    bf16x8 a[4], b[NT];
#pragma unroll
    for (int mi = 0; mi < 4; ++mi) asm volatile("ds_read_b128 %0, %1 offset:%2" : "=v"(a[mi]) : "v"(aW), "n"(mi * 1024));
#pragma unroll
    for (int ni = 0; ni < NT; ++ni) asm volatile("ds_read_b128 %0, %1 offset:%2" : "=v"(b[ni]) : "v"(aT), "n"(ni * 1024));
    if constexpr (NT == 4) asm volatile("s_waitcnt lgkmcnt(0)" : "+v"(a[0]), "+v"(a[1]), "+v"(a[2]), "+v"(a[3]), "+v"(b[0]), "+v"(b[1]), "+v"(b[2]), "+v"(b[3]));
    else asm volatile("s_waitcnt lgkmcnt(0)" : "+v"(a[0]), "+v"(a[1]), "+v"(a[2]), "+v"(a[3]), "+v"(b[0]), "+v"(b[1]), "+v"(b[2]), "+v"(b[3]), "+v"(b[4]), "+v"(b[5]), "+v"(b[6]), "+v"(b[7]));
    const bool doiss = (kt + NSTAGE - 1 < nk);
    const int ktn = kt + NSTAGE - 1;
    char* sbi = smem + islot * STAGE_B + tid * 16;
#pragma unroll
    for (int mi = 0; mi < 4; ++mi) {
#pragma unroll
      for (int ni = 0; ni < NT; ++ni) acc[mi][ni] = __builtin_amdgcn_mfma_f32_16x16x32_bf16(a[mi], b[ni], acc[mi][ni], 0, 0, 0);
      __builtin_amdgcn_sched_barrier(0);
      if (doiss) {
#pragma unroll
        for (int q = 0; q < 2; ++q) {
          const int idx = mi * 2 + q;
          if (idx < LT) __builtin_amdgcn_global_load_lds((const unsigned*)(gT + (long)idx * 64 * ldt + ktn * 32), (__attribute__((address_space(3))) unsigned*)(sbi + idx * 4096), 16, 0, 0);
          else if (idx < LPS) __builtin_amdgcn_global_load_lds((const unsigned*)(gW + (long)(idx - LT) * 64 * ldw + ktn * 32), (__attribute__((address_space(3))) unsigned*)(sbi + TR * 64 + (idx - LT) * 4096), 16, 0, 0);
        }
      }
      __builtin_amdgcn_sched_barrier(0);
    }
    slot = (slot + 1 == NSTAGE) ? 0 : slot + 1;
    islot = (islot + 1 == NSTAGE) ? 0 : islot + 1;
  }
#undef GL_ISSUE
  __syncthreads();
}

__device__ void inproj_tile(const Params& p, int l, int t, char* smem) {
  constexpr int NT = 8;
  const int tm = t / 52, tn = t % 52;
  const int tid = get_tid(), lane = tid & 63, wid = tid >> 6, wr = wid >> 1, wc = wid & 1, fr = lane & 15, fq = lane >> 4;
  f32x4 acc[4][NT];
#pragma unroll
  for (int a_ = 0; a_ < 4; ++a_)
#pragma unroll
    for (int b_ = 0; b_ < NT; ++b_) acc[a_][b_] = (f32x4){0.f, 0.f, 0.f, 0.f};
  gemm_glds<NT, 3>(acc, p.U() + (size_t)tm * (NT * 32) * 1024, 1024, p.wt_in() + (size_t)l * NWT * 1024 + (size_t)tn * 128 * 1024, 1024, 1024, smem);
  const int g = tn >> 2;
  bf16_t* dst = PRG(g);
#pragma unroll
  for (int ni = 0; ni < NT; ++ni) {
    const int row = tm * (NT * 32) + wr * (NT * 16) + ni * 16 + fr;
    const bool samp = row >= NPROMPT;
    const int rr = samp ? row - NPROMPT : row;
    const int b = samp ? (rr >> 6) : (rr >> 13), tt = samp ? (rr & 63) : (rr & 8191), T = samp ? 64 : 8192, NB = samp ? 8 : 2;
#pragma unroll
    for (int m = 0; m < 2; ++m) {
      const int cg_ = (tn & 3) * 128 + wc * 64 + m * 32 + fq * 8;
      const f32x4 v0 = acc[2 * m][ni], v1 = acc[2 * m + 1][ni];
      u32x4 pk; pk.x = pack2(v0[0], v0[1]); pk.y = pack2(v0[2], v0[3]); pk.z = pack2(v1[0], v1[1]); pk.w = pack2(v1[2], v1[3]);
      *(u32x4*)(dst + (size_t)row * 512 + cg_) = pk;
      if (g == 6 || g == 7) {
        float* o = (g == 6) ? (samp ? p.o_sk() : p.o_pk()) : (samp ? p.o_sv() : p.o_pv());
        const int hh = cg_ >> 7, d = cg_ & 127;
        float* op = o + ((size_t)((l * NB + b) * 4 + hh) * T + tt) * 128 + d;
        *(f32x4*)op = v0; *(f32x4*)(op + 4) = v1;
      } else if (g < 2) {
        if (tt >= T - 3) {
          float* o = samp ? p.o_sconv() : p.o_pconv();
          float* op = o + ((size_t)(l * NB + b) * 3 + (tt - (T - 3))) * 1024 + g * 512 + cg_;
          *(f32x4*)op = v0; *(f32x4*)(op + 4) = v1;
        }
      }
    }
  }
}

struct UnitInfo { int samp, b, h, c, rowbase, seq; };
__device__ __forceinline__ UnitInfo unit_info(int u) {
  UnitInfo i;
  if (u < 1024) { i.samp = 0; i.seq = u >> 7; i.b = i.seq >> 2; i.h = i.seq & 3; i.c = u & 127; i.rowbase = i.b * 8192 + i.c * 64; }
  else { int sq = u - 1024; i.samp = 1; i.seq = sq; i.b = sq >> 2; i.h = sq & 3; i.c = 0; i.rowbase = NPROMPT + i.b * 64; }
  return i;
}

__device__ void sb_unit(const Params& p, int l, int u, char* smem) {
  bf16_t* Qs = (bf16_t*)smem;
  bf16_t* Ks = Qs + 64 * 136;
  bf16_t* Vt = Ks + 64 * 136;
  bf16_t* Ps = Vt + 128 * 72;
  const int tid = get_tid(), lane = tid & 63, w = tid >> 6, fr = lane & 15, fq = lane >> 4;
  const UnitInfo ui = unit_info(u);
  const int nblk = ui.samp ? 65 : ui.c + 1;
  const int hc = ui.h * 128;
  __syncthreads();
  ld_tile<bf16_t>(Qs, PRG(5) + (size_t)ui.rowbase * 512 + hc, 512, tid);
  f32x4 o[8][1];
#pragma unroll
  for (int mi = 0; mi < 8; ++mi) o[mi][0] = (f32x4){0.f, 0.f, 0.f, 0.f};
  float R = 0.f;
  const int tq = 16 * w + fr;
  for (int i = nblk - 1; i >= 0; --i) {
    if (!ui.samp || i == 64) {
      const size_t krow = ui.samp ? (size_t)ui.rowbase : (size_t)ui.b * 8192 + (size_t)i * 64;
      ld_tile<bf16_t>(Ks, PRG(6) + krow * 512 + hc, 512, tid);
      ld_T<bf16_t, 64, 72>(Vt, PRG(7) + krow * 512 + hc, 512, tid);
    } else {
      const size_t off = ((size_t)((l * 8 + ui.b) * 4 + ui.h) * 4096 + (size_t)i * 64) * 128;
      ld_tile<float>(Ks, p.ck + off, 128, tid);
      ld_T<float, 64, 72>(Vt, p.cv + off, 128, tid);
    }
    __syncthreads();
    f32x4 z[4][1];
#pragma unroll
    for (int mi = 0; mi < 4; ++mi) z[mi][0] = (f32x4){0.f, 0.f, 0.f, 0.f};
    wmma<4, 1, 4>(z, Ks, 136, Qs + 16 * w * 136, 136, fr, fq);
    const bool diag = (i == nblk - 1);
    float L[4][4], lsg[4][4], G[4];
#pragma unroll
    for (int mi = 0; mi < 4; ++mi) {
      G[mi] = 0.f;
#pragma unroll
      for (int j = 0; j < 4; ++j) {
        const int kk = mi * 16 + fq * 4 + j;
        const float zz = z[mi][0][j] * 0.08838834764831845f;
        const float sp = softplus(zz);
        const bool valid = !diag || kk < tq;
        L[mi][j] = valid ? -sp : 0.f;
        lsg[mi][j] = valid ? zz - sp : -1e30f;
        G[mi] += L[mi][j];
      }
    }
    float sufm = 0.f;
#pragma unroll
    for (int mi = 3; mi >= 0; --mi) {
      const float g0 = __shfl(G[mi], fr), g1 = __shfl(G[mi], fr + 16), g2 = __shfl(G[mi], fr + 32), g3 = __shfl(G[mi], fr + 48);
      const float later = (fq < 1 ? g1 : 0.f) + (fq < 2 ? g2 : 0.f) + (fq < 3 ? g3 : 0.f);
      const float s3 = R + sufm + later, s2 = s3 + L[mi][3], s1 = s2 + L[mi][2], s0 = s1 + L[mi][1];
      const float a0 = __expf(lsg[mi][0] + s0), a1 = __expf(lsg[mi][1] + s1), a2 = __expf(lsg[mi][2] + s2), a3 = __expf(lsg[mi][3] + s3);
      u32x2 pk; pk.x = pack2(a0, a1); pk.y = pack2(a2, a3);
      *(u32x2*)(Ps + tq * 72 + mi * 16 + fq * 4) = pk;
      sufm += (g0 + g1) + (g2 + g3);
    }
    R += sufm;
    __syncthreads();
    wmma<8, 1, 2>(o, Vt, 72, Ps + 16 * w * 72, 72, fr, fq);
    if (__syncthreads_and(R < -110.f)) break;
  }
  const size_t row = (size_t)ui.rowbase + tq;
#pragma unroll
  for (int mi = 0; mi < 8; ++mi) {
    const int col = hc + mi * 16 + fq * 4;
    u32x2 zz = *(const u32x2*)(PRG(8) + row * 512 + col);
    f32x4 v = o[mi][0];
    u32x2 pk;
    pk.x = pack2(v[0] * silu(lo2f(zz.x)), v[1] * silu(hi2f(zz.x)));
    pk.y = pack2(v[2] * silu(lo2f(zz.y)), v[3] * silu(hi2f(zz.y)));
    *(u32x2*)(p.H() + (size_t)1 * NTOK * 512 + row * 512 + col) = pk;
  }
}

__device__ void mlstm_local(const Params& p, int l, int u, char* smem) {
  bf16_t* kdT = (bf16_t*)smem;
  bf16_t* vT = kdT + 128 * 72;
  bf16_t* xq = vT + 128 * 72;
  bf16_t* xk = xq + 67 * 136;
  float* dec = (float*)(xk + 67 * 136);
  const int tid = get_tid(), lane = tid & 63, w = tid >> 6, fr = lane & 15, fq = lane >> 4;
  const UnitInfo ui = unit_info(u);
  const int hc = ui.h * 128;
  __syncthreads();
  if (w == 0) {
    const float lfv = p.lf()[(ui.rowbase + lane) * 4 + ui.h], igv = p.ig()[(ui.rowbase + lane) * 4 + ui.h];
    float bs = lfv;
#pragma unroll
    for (int o = 1; o < 64; o <<= 1) { float t = __shfl_up(bs, o); if (lane >= o) bs += t; }
    const float g = igv - bs;
    float gm = g;
#pragma unroll
    for (int o = 32; o > 0; o >>= 1) gm = fmaxf(gm, __shfl_xor(gm, o));
    const float bL = __shfl(bs, 63);
    dec[lane] = __expf(g - gm);
    if (lane == 0) { p.ac()[u] = bL + gm; p.Bc()[u] = bL; }
  }
  ld_tile<bf16_t>(xq + 3 * 136, PRG(0) + (size_t)ui.rowbase * 512 + hc, 512, tid);
  ld_tile<bf16_t>(xk + 3 * 136, PRG(1) + (size_t)ui.rowbase * 512 + hc, 512, tid);
  ld_T<bf16_t, 64, 72>(vT, PRG(2) + (size_t)ui.rowbase * 512 + hc, 512, tid);
  {
    const int isk = tid >> 7, ch = tid & 127, col = hc + ch;
    bf16_t* xs = isk ? xk : xq;
    if (ui.samp) {
      const float* cs = p.st_conv + (size_t)(l * 8 + ui.b) * 3072 + isk * 512 + col;
      xs[ch] = f2bf(cs[0]); xs[136 + ch] = f2bf(cs[1024]); xs[272 + ch] = f2bf(cs[2048]);
    } else if (ui.c > 0) {
      const bf16_t* src = PRG(isk) + (size_t)ui.rowbase * 512 + col;
      xs[ch] = src[-3 * 512]; xs[136 + ch] = src[-2 * 512]; xs[272 + ch] = src[-1 * 512];
    } else { xs[ch] = 0; xs[136 + ch] = 0; xs[272 + ch] = 0; }
  }
  __syncthreads();
  {
    const int isk = tid >> 7, ch = tid & 127, col = hc + ch;
    bf16_t* xs = isk ? xk : xq;
    const float* wc_ = p.w_conv + (size_t)l * 4096 + isk * 512 + col;
    const float w0 = wc_[0], w1 = wc_[1024], w2 = wc_[2048], w3 = wc_[3072];
    float x0 = bf2f(xs[ch]), x1 = bf2f(xs[136 + ch]), x2 = bf2f(xs[272 + ch]);
#pragma unroll 8
    for (int t = 0; t < 64; ++t) {
      const float x3 = bf2f(xs[(t + 3) * 136 + ch]);
      float y = silu(w0 * x0 + w1 * x1 + w2 * x2 + w3 * x3);
      if (isk) y *= 0.08838834764831845f;
      const bf16_t yb = f2bf(y);
      xs[t * 136 + ch] = yb;
      if (isk) kdT[ch * 72 + t] = f2bf(bf2f(yb) * dec[t]);
      x0 = x1; x1 = x2; x2 = x3;
    }
  }
  __syncthreads();
#pragma unroll
  for (int i = 0; i < 4; ++i) {
    const int id = tid + 256 * i, r = id >> 4, c = (id & 15) * 8;
    *(u32x4*)(p.QC() + (size_t)(ui.rowbase + r) * 512 + hc + c) = *(const u32x4*)(xq + r * 136 + c);
    *(u32x4*)(p.KC() + (size_t)(ui.rowbase + r) * 512 + hc + c) = *(const u32x4*)(xk + r * 136 + c);
  }
  if (tid < 128) { float s_ = 0.f;
#pragma unroll 8
    for (int t = 0; t < 64; ++t) s_ += bf2f(kdT[tid * 72 + t]); p.nloc()[u * 128 + tid] = s_; }
  f32x4 acc[8][2];
#pragma unroll
  for (int a_ = 0; a_ < 8; ++a_) { acc[a_][0] = (f32x4){0.f, 0.f, 0.f, 0.f}; acc[a_][1] = (f32x4){0.f, 0.f, 0.f, 0.f}; }
  wmma<8, 2, 2>(acc, kdT, 72, vT + 32 * w * 72, 72, fr, fq);
  bf16_t* sm = p.SM() + (size_t)u * 16384;
#pragma unroll
  for (int mi = 0; mi < 8; ++mi)
#pragma unroll
    for (int ni = 0; ni < 2; ++ni) {
      u32x2 pk; pk.x = pack2(acc[mi][ni][0], acc[mi][ni][1]); pk.y = pack2(acc[mi][ni][2], acc[mi][ni][3]);
      *(u32x2*)(sm + (32 * w + ni * 16 + fr) * 128 + mi * 16 + fq * 4) = pk;
    }
}

__device__ __forceinline__ float hgrn_lb(const Params& p, int l, int ch512) {
  if (l == 0) return 0.f;
  return sigm(p.lb_logits[512 + ch512] - p.lb_logits[ch512]);
}
__device__ __forceinline__ void hgrn_gate(float f, float lb, float& lg, float& kh) {
  const float e = __expf(-fabsf(f));
  const float sp = f >= 0.f ? 1.f / (1.f + e) : e / (1.f + e);
  const float sn = f >= 0.f ? e / (1.f + e) : 1.f / (1.f + e);
  lg = (lb == 0.f) ? (fminf(f, 0.f) - __logf(1.f + e)) : __logf(lb + (1.f - lb) * sp);
  kh = (1.f - lb) * sn;
}

__device__ void hgrn_local(const Params& p, int l, int u, char* smem) {
  bf16_t* kdT = (bf16_t*)smem;
  bf16_t* iT = kdT + 128 * 72;
  bf16_t* fs = iT + 128 * 72;
  float* tot = (float*)(fs + 64 * 136);
  const int tid = get_tid(), lane = tid & 63, w = tid >> 6, fr = lane & 15, fq = lane >> 4;
  const UnitInfo ui = unit_info(u);
  const int hc = ui.h * 128;
  __syncthreads();
  ld_tile<bf16_t>(fs, PRG(10) + (size_t)ui.rowbase * 512 + hc, 512, tid);
  ld_T<bf16_t, 64, 72>(iT, PRG(11) + (size_t)ui.rowbase * 512 + hc, 512, tid);
  const int half = tid >> 7, ch = tid & 127;
  const float lb = hgrn_lb(p, l, hc + ch);
  __syncthreads();
  const bf16_t* src = fs + (half * 32) * 136 + ch;
  {
    float run = 0.f;
#pragma unroll 8
    for (int t = 0; t < 32; ++t) { float lg, kh; hgrn_gate(bf2f(src[t * 136]), lb, lg, kh); run += lg; }
    tot[half * 128 + ch] = run;
  }
  __syncthreads();
  {
    const float t0 = tot[ch], t1 = tot[128 + ch];
    const float bcL = t0 + t1;
    float run = half ? t0 : 0.f;
#pragma unroll 8
    for (int t = 0; t < 32; ++t) {
      float lg, kh; hgrn_gate(bf2f(src[t * 136]), lb, lg, kh); run += lg;
      kdT[ch * 72 + half * 32 + t] = f2bf(kh * __expf(bcL - run));
    }
    if (half == 0) p.hbc()[u * 128 + ch] = bcL;
  }
  __syncthreads();
  f32x4 acc[8][2];
#pragma unroll
  for (int a_ = 0; a_ < 8; ++a_) { acc[a_][0] = (f32x4){0.f, 0.f, 0.f, 0.f}; acc[a_][1] = (f32x4){0.f, 0.f, 0.f, 0.f}; }
  wmma<8, 2, 2>(acc, kdT, 72, iT + 32 * w * 72, 72, fr, fq);
  bf16_t* sh = p.SH() + (size_t)u * 16384;
#pragma unroll
  for (int mi = 0; mi < 8; ++mi)
#pragma unroll
    for (int ni = 0; ni < 2; ++ni) {
      u32x2 pk; pk.x = pack2(acc[mi][ni][0], acc[mi][ni][1]); pk.y = pack2(acc[mi][ni][2], acc[mi][ni][3]);
      *(u32x2*)(sh + (32 * w + ni * 16 + fr) * 128 + mi * 16 + fq * 4) = pk;
    }
}

__device__ void scan_phase(const Params& p, int l, char* smem) {
  float* cdc = (float*)smem;
  float* cwl = cdc + 128;
  float* cmi = cwl + 128;
  const int tid = get_tid();
  for (int vb = blockIdx.x; vb < 520; vb += gridDim.x) {
    const int kind = vb >> 8;
    const int seq = (kind == 2) ? (vb - 512) : ((vb >> 5) & 7);
    __syncthreads();
    if (kind != 1) {
      if (tid < 128) { cdc[tid] = p.ac()[seq * 128 + tid]; cwl[tid] = p.Bc()[seq * 128 + tid]; }
      __syncthreads();
      if (tid == 0) {
        float m = 0.f;
        for (int c = 0; c < 128; ++c) {
          const float a = cdc[c], B = cwl[c];
          const float mo = fmaxf(a, B + m);
          cdc[c] = __expf(B + m - mo); cwl[c] = __expf(a - mo); cmi[c] = m; m = mo;
        }
        if (kind == 0 && (vb & 31) == 0) p.o_pm()[l * 8 + seq] = m;
      }
      __syncthreads();
      if (kind == 0 && (vb & 31) == 0 && tid < 128) p.min_()[seq * 128 + tid] = cmi[tid];
    }
    if (kind == 2) {
      if (tid < 128) {
        float n = 0.f;
        float* base = p.nloc() + (size_t)seq * 128 * 128 + tid;
        for (int c0 = 0; c0 < 128; c0 += 16) {
          float lv[16];
#pragma unroll
          for (int j = 0; j < 16; ++j) lv[j] = base[(c0 + j) * 128];
#pragma unroll
          for (int j = 0; j < 16; ++j) { const float nl = lv[j]; lv[j] = n; n = cdc[c0 + j] * n + cwl[c0 + j] * nl; }
#pragma unroll
          for (int j = 0; j < 16; ++j) base[(c0 + j) * 128] = lv[j];
        }
        p.o_pn()[(l * 8 + seq) * 128 + tid] = n;
      }
      continue;
    }
    const int pr = (vb & 31) * 256 + tid, e = pr * 2, er = e >> 7, ec = e & 127;
    unsigned* base = (unsigned*)((kind ? p.SH() : p.SM()) + (size_t)seq * 128 * 16384) + pr;
    const float* hb = p.hbc() + (size_t)seq * 128 * 128 + ec;
    float c0v = 0.f, c1v = 0.f;
    unsigned lv[16], nx[16];
    float2 hv[16], hn[16];
#pragma unroll
    for (int j = 0; j < 16; ++j) { nx[j] = base[(size_t)j * 8192]; hn[j] = kind ? *(const float2*)(hb + j * 128) : make_float2(0.f, 0.f); }
    for (int c0 = 0; c0 < 128; c0 += 16) {
#pragma unroll
      for (int j = 0; j < 16; ++j) { lv[j] = nx[j]; hv[j] = hn[j]; }
      if (c0 + 16 < 128) {
#pragma unroll
        for (int j = 0; j < 16; ++j) { nx[j] = base[(size_t)(c0 + 16 + j) * 8192]; if (kind) hn[j] = *(const float2*)(hb + (c0 + 16 + j) * 128); }
      }
#pragma unroll
      for (int j = 0; j < 16; ++j) {
        const unsigned v = lv[j];
        lv[j] = pack2(c0v, c1v);
        const float d0 = kind ? __expf(hv[j].x) : cdc[c0 + j];
        const float d1 = kind ? __expf(hv[j].y) : d0;
        const float wl = kind ? 1.f : cwl[c0 + j];
        c0v = d0 * c0v + wl * lo2f(v); c1v = d1 * c1v + wl * hi2f(v);
      }
#pragma unroll
      for (int j = 0; j < 16; ++j) base[(size_t)(c0 + j) * 8192] = lv[j];
    }
    float* o = (kind ? p.o_pS() : p.o_pC()) + (size_t)(l * 8 + seq) * 16384;
    o[ec * 128 + er] = c0v; o[(ec + 1) * 128 + er] = c1v;
  }
  const int gt = blockIdx.x * 256 + tid, nth = gridDim.x * 256;
  for (int it = gt; it < 524288; it += nth) {
    const int kind = it >> 18, sq = (it >> 13) & 31, pr = it & 8191, e = pr * 2, u = 1024 + sq, er = e >> 7, ec = e & 127;
    if (kind == 0) {
      const float* c0p = p.st_C + (size_t)(l * 32 + sq) * 16384;
      const float C0 = c0p[ec * 128 + er], C1 = c0p[(ec + 1) * 128 + er], m = p.st_m[l * 32 + sq];
      unsigned* slot = (unsigned*)(p.SM() + (size_t)u * 16384) + pr;
      const unsigned lv = *slot;
      const float a = p.ac()[u], B = p.Bc()[u];
      const float mo = fmaxf(a, B + m), dc = __expf(B + m - mo), wl = __expf(a - mo);
      *slot = pack2(C0, C1);
      float* o = p.o_sC() + (size_t)(l * 32 + sq) * 16384;
      o[ec * 128 + er] = dc * C0 + wl * lo2f(lv); o[(ec + 1) * 128 + er] = dc * C1 + wl * hi2f(lv);
      if (pr == 0) { p.min_()[u] = m; p.o_sm()[l * 32 + sq] = mo; }
    } else {
      const float* s0p = p.st_S + (size_t)(l * 32 + sq) * 16384;
      const float S0 = s0p[ec * 128 + er], S1 = s0p[(ec + 1) * 128 + er];
      unsigned* slot = (unsigned*)(p.SH() + (size_t)u * 16384) + pr;
      const unsigned lv = *slot;
      const float d0 = __expf(p.hbc()[u * 128 + ec]), d1 = __expf(p.hbc()[u * 128 + ec + 1]);
      *slot = pack2(S0, S1);
      float* o = p.o_sS() + (size_t)(l * 32 + sq) * 16384;
      o[ec * 128 + er] = d0 * S0 + lo2f(lv); o[(ec + 1) * 128 + er] = d1 * S1 + hi2f(lv);
    }
  }
  for (int it = gt; it < 4096; it += nth) {
    const int sq = it >> 7, d = it & 127, u = 1024 + sq;
    const float n0 = p.st_n[(l * 32 + sq) * 128 + d], m = p.st_m[l * 32 + sq];
    const float a = p.ac()[u], B = p.Bc()[u];
    const float mo = fmaxf(a, B + m), dc = __expf(B + m - mo), wl = __expf(a - mo);
    const float nl = p.nloc()[u * 128 + d];
    p.nloc()[u * 128 + d] = n0;
    p.o_sn()[(l * 32 + sq) * 128 + d] = dc * n0 + wl * nl;
  }
}

__device__ void mlstm_out(const Params& p, int l, int u, char* smem) {
  bf16_t* Qs = (bf16_t*)smem;
  bf16_t* CT = Qs + 64 * 136;
  bf16_t* Ks = CT;
  bf16_t* Vt = Ks + 64 * 136;
  bf16_t* Ps = Vt + 144 * 72;
  float* misc = (float*)(smem + 17408 + 47360);
  float *bsum = misc, *gs = misc + 64, *mt = misc + 128, *wint = misc + 192;
  const int tid = get_tid(), lane = tid & 63, w = tid >> 6, fr = lane & 15, fq = lane >> 4;
  const UnitInfo ui = unit_info(u);
  const int hc = ui.h * 128;
  __syncthreads();
  if (w == 0) {
    const float lfv = p.lf()[(ui.rowbase + lane) * 4 + ui.h], igv = p.ig()[(ui.rowbase + lane) * 4 + ui.h];
    float bs = lfv;
#pragma unroll
    for (int o = 1; o < 64; o <<= 1) { float t = __shfl_up(bs, o); if (lane >= o) bs += t; }
    const float g = igv - bs;
    float cm = g;
#pragma unroll
    for (int o = 1; o < 64; o <<= 1) { float t = __shfl_up(cm, o); if (lane >= o) cm = fmaxf(cm, t); }
    const float m_in = p.min_()[u];
    const float mtt = bs + fmaxf(cm, m_in);
    bsum[lane] = bs; gs[lane] = g; mt[lane] = mtt; wint[lane] = __expf(bs + m_in - mtt);
  }
  ld_tile<bf16_t>(Qs, p.QC() + (size_t)ui.rowbase * 512 + hc, 512, tid);
  ld_tile128<bf16_t>(CT, p.SM() + (size_t)u * 16384, 128, tid);
  if (tid < 128) CT[128 * 136 + tid] = f2bf(p.nloc()[u * 128 + tid]);
  for (int i = tid; i < 15 * 128; i += 256) CT[(129 + (i >> 7)) * 136 + (i & 127)] = 0;
  __syncthreads();
  f32x4 acc[9][1];
#pragma unroll
  for (int mi = 0; mi < 9; ++mi) acc[mi][0] = (f32x4){0.f, 0.f, 0.f, 0.f};
  wmma<9, 1, 4>(acc, CT, 136, Qs + 16 * w * 136, 136, fr, fq);
  const int t = 16 * w + fr;
  const float wi = wint[t];
#pragma unroll
  for (int mi = 0; mi < 9; ++mi) acc[mi][0] *= wi;
  __syncthreads();
  ld_tile<bf16_t>(Ks, p.KC() + (size_t)ui.rowbase * 512 + hc, 512, tid);
  ld_T<bf16_t, 64, 72>(Vt, PRG(2) + (size_t)ui.rowbase * 512 + hc, 512, tid);
  if (tid < 64) Vt[128 * 72 + tid] = 0x3F80;
  for (int i = tid; i < 15 * 64; i += 256) Vt[(129 + (i >> 6)) * 72 + (i & 63)] = 0;
  __syncthreads();
  f32x4 st[4][1];
#pragma unroll
  for (int mi = 0; mi < 4; ++mi) st[mi][0] = (f32x4){0.f, 0.f, 0.f, 0.f};
  wmma<4, 1, 4>(st, Ks, 136, Qs + 16 * w * 136, 136, fr, fq);
  const float bt = bsum[t], mtt = mt[t];
#pragma unroll
  for (int mi = 0; mi < 4; ++mi) {
    float a[4];
#pragma unroll
    for (int j = 0; j < 4; ++j) {
      const int s = mi * 16 + fq * 4 + j;
      a[j] = (s <= t) ? st[mi][0][j] * __expf(bt + gs[s] - mtt) : 0.f;
    }
    u32x2 pk; pk.x = pack2(a[0], a[1]); pk.y = pack2(a[2], a[3]);
    *(u32x2*)(Ps + t * 72 + mi * 16 + fq * 4) = pk;
  }
  __syncthreads();
  wmma<9, 1, 2>(acc, Vt, 72, Ps + 16 * w * 72, 72, fr, fq);
  const float den = __shfl(acc[8][0][0], fr);
  const float inv = 1.f / fmaxf(fabsf(den), __expf(-mtt));
  float ss = 0.f;
#pragma unroll
  for (int mi = 0; mi < 8; ++mi) { acc[mi][0] *= inv; ss += acc[mi][0][0] * acc[mi][0][0] + acc[mi][0][1] * acc[mi][0][1] + acc[mi][0][2] * acc[mi][0][2] + acc[mi][0][3] * acc[mi][0][3]; }
  ss += __shfl_xor(ss, 16); ss += __shfl_xor(ss, 32);
  const float rs = rsqrtf(ss * (1.f / 128.f) + 1e-6f);
  const size_t row = (size_t)ui.rowbase + t;
#pragma unroll
  for (int mi = 0; mi < 8; ++mi) {
    const int col = hc + mi * 16 + fq * 4;
    const u32x2 ov = *(const u32x2*)(PRG(3) + row * 512 + col);
    const u32x2 zv = *(const u32x2*)(PRG(4) + row * 512 + col);
    const float4 g = *(const float4*)(p.g_ml + l * 512 + col);
    const f32x4 v = acc[mi][0];
    u32x2 pk;
    pk.x = pack2(v[0] * rs * g.x * sigm(lo2f(ov.x)) * silu(lo2f(zv.x)), v[1] * rs * g.y * sigm(hi2f(ov.x)) * silu(hi2f(zv.x)));
    pk.y = pack2(v[2] * rs * g.z * sigm(lo2f(ov.y)) * silu(lo2f(zv.y)), v[3] * rs * g.w * sigm(hi2f(ov.y)) * silu(hi2f(zv.y)));
    *(u32x2*)(p.H() + row * 512 + col) = pk;
  }
}

__device__ __forceinline__ bf16x8 scale_frag(const bf16_t* src, const float* ea, const float* eb, float sgn, bool clampit) {
  u32x4 raw = *(const u32x4*)src;
  float4 a0 = *(const float4*)ea, a1 = *(const float4*)(ea + 4);
  float4 b0 = {0.f, 0.f, 0.f, 0.f}, b1 = {0.f, 0.f, 0.f, 0.f};
  if (eb) { b0 = *(const float4*)eb; b1 = *(const float4*)(eb + 4); }
  float e[8] = {a0.x - b0.x, a0.y - b0.y, a0.z - b0.z, a0.w - b0.w, a1.x - b1.x, a1.y - b1.y, a1.z - b1.z, a1.w - b1.w};
  float v[8] = {lo2f(raw.x), hi2f(raw.x), lo2f(raw.y), hi2f(raw.y), lo2f(raw.z), hi2f(raw.z), lo2f(raw.w), hi2f(raw.w)};
  unsigned o[4];
#pragma unroll
  for (int i = 0; i < 4; ++i) {
    float x0 = sgn * e[2 * i], x1 = sgn * e[2 * i + 1];
    if (clampit) { x0 = fminf(x0, 80.f); x1 = fminf(x1, 80.f); }
    o[i] = pack2(v[2 * i] * __expf(x0), v[2 * i + 1] * __expf(x1));
  }
  u32x4 r = {o[0], o[1], o[2], o[3]};
  return __builtin_bit_cast(bf16x8, r);
}

__device__ void hgrn_out(const Params& p, int l, int u, char* smem) {
  float* bc = (float*)smem;
  bf16_t* ST = (bf16_t*)smem;
  bf16_t* qs = (bf16_t*)(smem + 34816);
  bf16_t* kh = (bf16_t*)(smem + 34816 + 17408);
  bf16_t* iT = kh;
  bf16_t* Ps = (bf16_t*)(smem + 34816 + 17408 + 18432);
  float* tot = (float*)(smem + 79872);
  const int tid = get_tid(), lane = tid & 63, w = tid >> 6, fr = lane & 15, fq = lane >> 4;
  const UnitInfo ui = unit_info(u);
  const int hc = ui.h * 128;
  __syncthreads();
  ld_tile<bf16_t>(qs, PRG(9) + (size_t)ui.rowbase * 512 + hc, 512, tid);
  ld_tile<bf16_t>(kh, PRG(10) + (size_t)ui.rowbase * 512 + hc, 512, tid);
  __syncthreads();
  {
    const int half = tid >> 7, ch = tid & 127;
    const float lb = hgrn_lb(p, l, hc + ch);
    bf16_t* src = kh + (half * 32) * 136 + ch;
    float run = 0.f;
#pragma unroll 8
    for (int t = 0; t < 32; ++t) { float lg, k; hgrn_gate(bf2f(src[t * 136]), lb, lg, k); run += lg; }
    tot[half * 128 + ch] = run;
    __syncthreads();
    run = half ? tot[ch] : 0.f;
#pragma unroll 8
    for (int t = 0; t < 32; ++t) {
      float lg, k; hgrn_gate(bf2f(src[t * 136]), lb, lg, k); run += lg;
      bc[(half * 32 + t) * 132 + ch] = run;
      src[t * 136] = f2bf(k);
    }
  }
  __syncthreads();
  {
    const int I = w, t = 16 * I + fr;
    f32x4 a[4];
#pragma unroll
    for (int J = 0; J < 4; ++J) a[J] = (f32x4){0.f, 0.f, 0.f, 0.f};
#pragma unroll
    for (int kk = 0; kk < 4; ++kk) {
      const int c0 = kk * 32 + fq * 8;
      const float* rI = (I > 0) ? bc + (16 * I - 1) * 132 + c0 : nullptr;
      const bf16x8 bq = scale_frag(qs + t * 136 + c0, bc + t * 132 + c0, rI, 1.f, false);
#pragma unroll
      for (int J = 0; J < 4; ++J) {
        if (J <= I) {
          const int s = 16 * J + fr;
          const bf16x8 ak = scale_frag(kh + s * 136 + c0, bc + s * 132 + c0, rI, -1.f, true);
          a[J] = __builtin_amdgcn_mfma_f32_16x16x32_bf16(ak, bq, a[J], 0, 0, 0);
        }
      }
    }
#pragma unroll
    for (int J = 0; J < 4; ++J) {
      float v[4];
#pragma unroll
      for (int j = 0; j < 4; ++j) { const int s = 16 * J + fq * 4 + j; v[j] = (s <= t) ? a[J][j] : 0.f; }
      u32x2 pk; pk.x = pack2(v[0], v[1]); pk.y = pack2(v[2], v[3]);
      *(u32x2*)(Ps + t * 72 + J * 16 + fq * 4) = pk;
    }
  }
  __syncthreads();
#pragma unroll 4
  for (int i = tid; i < 64 * 128; i += 256) { const int t = i >> 7, c = i & 127; qs[t * 136 + c] = f2bf(bf2f(qs[t * 136 + c]) * __expf(bc[t * 132 + c])); }
  __syncthreads();
  ld_T<bf16_t, 64, 72>(iT, PRG(11) + (size_t)ui.rowbase * 512 + hc, 512, tid);
  ld_tile128<bf16_t>(ST, p.SH() + (size_t)u * 16384, 128, tid);
  __syncthreads();
  f32x4 acc[8][1];
#pragma unroll
  for (int mi = 0; mi < 8; ++mi) acc[mi][0] = (f32x4){0.f, 0.f, 0.f, 0.f};
  wmma<8, 1, 2>(acc, iT, 72, Ps + 16 * w * 72, 72, fr, fq);
  wmma<8, 1, 4>(acc, ST, 136, qs + 16 * w * 136, 136, fr, fq);
  float ss = 0.f;
#pragma unroll
  for (int mi = 0; mi < 8; ++mi) ss += acc[mi][0][0] * acc[mi][0][0] + acc[mi][0][1] * acc[mi][0][1] + acc[mi][0][2] * acc[mi][0][2] + acc[mi][0][3] * acc[mi][0][3];
  ss += __shfl_xor(ss, 16); ss += __shfl_xor(ss, 32);
  const float rs = rsqrtf(ss * (1.f / 128.f) + 1e-6f);
  const size_t row = (size_t)ui.rowbase + 16 * w + fr;
#pragma unroll
  for (int mi = 0; mi < 8; ++mi) {
    const int col = hc + mi * 16 + fq * 4;
    const u32x2 zv = *(const u32x2*)(PRG(12) + row * 512 + col);
    const float4 g = *(const float4*)(p.g_hg + l * 512 + col);
    const f32x4 v = acc[mi][0];
    u32x2 pk;
    pk.x = pack2(v[0] * rs * g.x * silu(lo2f(zv.x)), v[1] * rs * g.y * silu(hi2f(zv.x)));
    pk.y = pack2(v[2] * rs * g.z * silu(lo2f(zv.y)), v[3] * rs * g.w * silu(hi2f(zv.y)));
    *(u32x2*)(p.H() + (size_t)2 * NTOK * 512 + row * 512 + col) = pk;
  }
}

__device__ void merge_tile(const Params& p, int l, int t, char* smem) {
  const int tm = t >> 3, tn = t & 7;
  const int tid = get_tid(), lane = tid & 63, wid = tid >> 6, wr = wid >> 1, wc = wid & 1, fr = lane & 15, fq = lane >> 4;
#pragma unroll 1
  for (int b = 0; b < 3; ++b) {
    f32x4 acc[4][4]; zero_acc(acc);
    gemm_kloop<bf16_t>(acc, p.U() + (size_t)tm * 128 * 1024, 1024, p.wt_in() + (size_t)l * NWT * 1024 + (size_t)(NMAIN + b * 1024 + tn * 128) * 1024, 1024, 1024, smem);
#pragma unroll
    for (int ni = 0; ni < 4; ++ni)
#pragma unroll
      for (int mi = 0; mi < 4; ++mi) {
        f32x4 v; v[0] = sigm(acc[mi][ni][0]); v[1] = sigm(acc[mi][ni][1]); v[2] = sigm(acc[mi][ni][2]); v[3] = sigm(acc[mi][ni][3]);
        *(f32x4*)(p.r() + ((size_t)tm * 128 + wr * 64 + ni * 16 + fr) * 1024 + tn * 128 + wc * 64 + mi * 16 + fq * 4) = v;
      }
    zero_acc(acc);
    gemm_kloop<bf16_t>(acc, p.H() + (size_t)b * NTOK * 512 + (size_t)tm * 128 * 512, 512, p.wt_br() + (size_t)(l * 3 + b) * 1024 * 512 + (size_t)tn * 128 * 512, 512, 512, smem);
#pragma unroll
    for (int ni = 0; ni < 4; ++ni) {
      const size_t row = (size_t)tm * 128 + wr * 64 + ni * 16 + fr;
#pragma unroll
      for (int mi = 0; mi < 4; ++mi) {
        const int col = tn * 128 + wc * 64 + mi * 16 + fq * 4;
        f32x4 v = *(const f32x4*)(p.r() + row * 1024 + col) * acc[mi][ni];
        float* part = p.y() + row * 1024 + col;
        if (b > 0) v += *(const f32x4*)part;
        if (b < 2) *(f32x4*)part = v;
        else { u32x2 pk; pk.x = pack2(v[0], v[1]); pk.y = pack2(v[2], v[3]); *(u32x2*)(p.merged() + row * 1024 + col) = pk; }
      }
    }
  }
}

__device__ void outproj_tile(const Params& p, int l, int t, char* smem) {
  const int tm = t >> 3, tn = t & 7;
  const int tid = get_tid(), lane = tid & 63, wid = tid >> 6, wr = wid >> 1, wc = wid & 1, fr = lane & 15, fq = lane >> 4;
  f32x4 acc[4][4]; zero_acc(acc);
  gemm_kloop<bf16_t>(acc, p.merged() + (size_t)tm * 128 * 1024, 1024, p.wt_out() + (size_t)l * 1048576 + (size_t)tn * 128 * 1024, 1024, 1024, smem);
#pragma unroll
  for (int ni = 0; ni < 4; ++ni) {
    const size_t row = (size_t)tm * 128 + wr * 64 + ni * 16 + fr;
#pragma unroll
    for (int mi = 0; mi < 4; ++mi) *(f32x4*)(p.y() + row * 1024 + tn * 128 + wc * 64 + mi * 16 + fq * 4) = acc[mi][ni];
  }
}


__device__ void outproj_tile256(const Params& p, int l, int t, char* smem) {
  constexpr int NT = 8;
  const int tm = t >> 3, tn = t & 7;
  const int tid = get_tid(), lane = tid & 63, wid = tid >> 6, wr = wid >> 1, wc = wid & 1, fr = lane & 15, fq = lane >> 4;
  f32x4 acc[4][NT];
#pragma unroll
  for (int a_ = 0; a_ < 4; ++a_)
#pragma unroll
    for (int b_ = 0; b_ < NT; ++b_) acc[a_][b_] = (f32x4){0.f, 0.f, 0.f, 0.f};
  gemm_glds<NT, 3>(acc, p.merged() + (size_t)tm * 256 * 1024, 1024, p.wt_out() + (size_t)l * 1048576 + (size_t)tn * 128 * 1024, 1024, 1024, smem);
#pragma unroll
  for (int ni = 0; ni < NT; ++ni) {
    const size_t row = (size_t)tm * 256 + wr * 128 + ni * 16 + fr;
#pragma unroll
    for (int m = 0; m < 2; ++m) {
      float* op = p.y() + row * 1024 + tn * 128 + wc * 64 + m * 32 + fq * 8;
      *(f32x4*)op = acc[2 * m][ni]; *(f32x4*)(op + 4) = acc[2 * m + 1][ni];
    }
  }
}


__device__ void gate_tile256(const Params& p, int l, int t, char* smem) {
  constexpr int NT = 8;
  const int tm = t / 24, tn = t % 24;
  const int tid = get_tid(), lane = tid & 63, wid = tid >> 6, wr = wid >> 1, wc = wid & 1, fr = lane & 15, fq = lane >> 4;
  f32x4 acc[4][NT];
#pragma unroll
  for (int a_ = 0; a_ < 4; ++a_)
#pragma unroll
    for (int b_ = 0; b_ < NT; ++b_) acc[a_][b_] = (f32x4){0.f, 0.f, 0.f, 0.f};
  gemm_glds<NT, 3>(acc, p.U() + (size_t)tm * 256 * 1024, 1024, p.wt_in() + (size_t)l * NWT * 1024 + (size_t)(NMAIN + tn * 128) * 1024, 1024, 1024, smem);
#pragma unroll
  for (int ni = 0; ni < NT; ++ni) {
    const size_t row = (size_t)tm * 256 + wr * 128 + ni * 16 + fr;
#pragma unroll
    for (int m = 0; m < 2; ++m) {
      const f32x4 v0 = acc[2 * m][ni], v1 = acc[2 * m + 1][ni];
      u32x4 pk; pk.x = pack2(sigm(v0[0]), sigm(v0[1])); pk.y = pack2(sigm(v0[2]), sigm(v0[3])); pk.z = pack2(sigm(v1[0]), sigm(v1[1])); pk.w = pack2(sigm(v1[2]), sigm(v1[3]));
      *(u32x4*)(p.Gb(tn >> 3) + row * 1024 + (tn & 7) * 128 + wc * 64 + m * 32 + fq * 8) = pk;
    }
  }
}
__device__ void merge_tile_g(const Params& p, int l, int t, char* smem) {
  const int tm = t >> 3, tn = t & 7;
  const int tid = get_tid(), lane = tid & 63, wid = tid >> 6, wr = wid >> 1, wc = wid & 1, fr = lane & 15, fq = lane >> 4;
  f32x4 macc[4][4]; zero_acc(macc);
#pragma unroll 1
  for (int b = 0; b < 3; ++b) {
    f32x4 acc[4][4]; zero_acc(acc);
    gemm_kloop<bf16_t>(acc, p.H() + (size_t)b * NTOK * 512 + (size_t)tm * 128 * 512, 512, p.wt_br() + (size_t)(l * 3 + b) * 1024 * 512 + (size_t)tn * 128 * 512, 512, 512, smem);
#pragma unroll
    for (int ni = 0; ni < 4; ++ni) {
      const size_t row = (size_t)tm * 128 + wr * 64 + ni * 16 + fr;
#pragma unroll
      for (int mi = 0; mi < 4; ++mi) {
        const u32x2 g = *(const u32x2*)(p.Gb(b) + row * 1024 + tn * 128 + wc * 64 + mi * 16 + fq * 4);
        macc[mi][ni][0] += lo2f(g.x) * acc[mi][ni][0]; macc[mi][ni][1] += hi2f(g.x) * acc[mi][ni][1];
        macc[mi][ni][2] += lo2f(g.y) * acc[mi][ni][2]; macc[mi][ni][3] += hi2f(g.y) * acc[mi][ni][3];
      }
    }
  }
#pragma unroll
  for (int ni = 0; ni < 4; ++ni) {
    const size_t row = (size_t)tm * 128 + wr * 64 + ni * 16 + fr;
#pragma unroll
    for (int mi = 0; mi < 4; ++mi) {
      u32x2 pk; pk.x = pack2(macc[mi][ni][0], macc[mi][ni][1]); pk.y = pack2(macc[mi][ni][2], macc[mi][ni][3]);
      *(u32x2*)(p.merged() + row * 1024 + tn * 128 + wc * 64 + mi * 16 + fq * 4) = pk;
    }
  }
}

__device__ void postnorm_phase(const Params& p, int l) {
  const int lane = threadIdx.x & 63, wid = threadIdx.x >> 6;
  const float* gp = p.g_post + l * 1024;
  for (int row = blockIdx.x * 4 + wid; row < NTOK; row += gridDim.x * 4) {
    const float* x = xrow(p, l, row);
    const float* y = p.y() + (size_t)row * 1024;
    float4 v[4]; float ss = 0.f;
#pragma unroll
    for (int i = 0; i < 4; ++i) { v[i] = *(const float4*)(y + i * 256 + lane * 4); ss += v[i].x * v[i].x + v[i].y * v[i].y + v[i].z * v[i].z + v[i].w * v[i].w; }
#pragma unroll
    for (int o = 32; o > 0; o >>= 1) ss += __shfl_xor(ss, o);
    const float rstd = rsqrtf(ss * (1.f / 1024.f) + 1e-6f);
#pragma unroll
    for (int i = 0; i < 4; ++i) {
      const int k = i * 256 + lane * 4;
      const float4 g = *(const float4*)(gp + k), xv = *(const float4*)(x + k);
      float4 r; r.x = xv.x + v[i].x * rstd * g.x; r.y = xv.y + v[i].y * rstd * g.y; r.z = xv.z + v[i].z * rstd * g.z; r.w = xv.w + v[i].w * rstd * g.w;
      u32x2 pk; pk.x = pack2(r.x, r.y); pk.y = pack2(r.z, r.w);
      *(u32x2*)(p.rb() + (size_t)row * 1024 + k) = pk;
    }
  }
}

__device__ void ple_tile(const Params& p, int l, int t, char* smem) {
  const int tm = t >> 3, tn = t & 7;
  const int tid = get_tid(), lane = tid & 63, wid = tid >> 6, wr = wid >> 1, wc = wid & 1, fr = lane & 15, fq = lane >> 4;
  f32x4 acc[4][4]; zero_acc(acc);
  const int row0 = tm * 128;
  const float* pp = row0 < NPROMPT ? p.p_p + ((size_t)l * NPROMPT + row0) * 256 : p.p_s + ((size_t)l * 512 + (row0 - NPROMPT)) * 256;
  gemm_kloop<float>(acc, pp, 256, p.wt_pp() + (size_t)l * 262144 + (size_t)tn * 128 * 256, 256, 256, smem);
  u32x2 pb[4][4];
#pragma unroll
  for (int a = 0; a < 4; ++a)
#pragma unroll
    for (int c = 0; c < 4; ++c) { pb[a][c].x = pack2(acc[a][c][0], acc[a][c][1]); pb[a][c].y = pack2(acc[a][c][2], acc[a][c][3]); }
  zero_acc(acc);
  gemm_kloop<bf16_t>(acc, p.rb() + (size_t)tm * 128 * 1024, 1024, p.wt_pg() + (size_t)l * 1048576 + (size_t)tn * 128 * 1024, 1024, 1024, smem);
#pragma unroll
  for (int ni = 0; ni < 4; ++ni) {
    const size_t row = (size_t)row0 + wr * 64 + ni * 16 + fr;
#pragma unroll
    for (int mi = 0; mi < 4; ++mi) {
      const int col = tn * 128 + wc * 64 + mi * 16 + fq * 4;
      const u32x2 rbv = *(const u32x2*)(p.rb() + row * 1024 + col);
      const f32x4 rv = {lo2f(rbv.x), hi2f(rbv.x), lo2f(rbv.y), hi2f(rbv.y)};
      f32x4 o;
      o[0] = rv[0] + sigm(acc[mi][ni][0]) * lo2f(pb[mi][ni].x); o[1] = rv[1] + sigm(acc[mi][ni][1]) * hi2f(pb[mi][ni].x);
      o[2] = rv[2] + sigm(acc[mi][ni][2]) * lo2f(pb[mi][ni].y); o[3] = rv[3] + sigm(acc[mi][ni][3]) * hi2f(pb[mi][ni].y);
      *(f32x4*)(p.o_y() + row * 1024 + col) = o;
    }
  }
}


template <typename TT>
__device__ __forceinline__ void mini_dot(f32x4& acc, const TT* Trow, const bf16_t* Wrow, int K) {
#pragma unroll 8
  for (int k = 0; k < K; k += 32) {
    const u32x4 tv = ld8(Trow + k), wv = ld8(Wrow + k);
    acc = __builtin_amdgcn_mfma_f32_16x16x32_bf16(__builtin_bit_cast(bf16x8, wv), __builtin_bit_cast(bf16x8, tv), acc, 0, 0, 0);
  }
}
__device__ void merge_mini(const Params& p, int l, int j) {
  const int tid = get_tid(), lane = tid & 63, w = tid >> 6, fr = lane & 15, fq = lane >> 4;
  const size_t row = (size_t)NPROMPT + (j >> 4) * 16 + fr;
  const int cb = (j & 15) * 64 + w * 16;
  f32x4 out = {0.f, 0.f, 0.f, 0.f};
#pragma unroll 1
  for (int b = 0; b < 3; ++b) {
    f32x4 h = {0.f, 0.f, 0.f, 0.f};
    mini_dot<bf16_t>(h, p.H() + (size_t)b * NTOK * 512 + row * 512 + fq * 8, p.wt_br() + (size_t)(l * 3 + b) * 1024 * 512 + (size_t)(cb + fr) * 512 + fq * 8, 512);
    const u32x2 g = *(const u32x2*)(p.Gb(b) + row * 1024 + cb + fq * 4);
    out[0] += lo2f(g.x) * h[0]; out[1] += hi2f(g.x) * h[1]; out[2] += lo2f(g.y) * h[2]; out[3] += hi2f(g.y) * h[3];
  }
  u32x2 pk; pk.x = pack2(out[0], out[1]); pk.y = pack2(out[2], out[3]);
  *(u32x2*)(p.merged() + row * 1024 + cb + fq * 4) = pk;
}
__device__ void outproj_mini(const Params& p, int l, int j) {
  const int tid = get_tid(), lane = tid & 63, w = tid >> 6, fr = lane & 15, fq = lane >> 4;
  const size_t row = (size_t)NPROMPT + (j >> 4) * 16 + fr;
  const int cb = (j & 15) * 64 + w * 16;
  f32x4 y = {0.f, 0.f, 0.f, 0.f};
  mini_dot<bf16_t>(y, p.merged() + row * 1024 + fq * 8, p.wt_out() + (size_t)l * 1048576 + (size_t)(cb + fr) * 1024 + fq * 8, 1024);
  *(f32x4*)(p.y() + row * 1024 + cb + fq * 4) = y;
}
__device__ void ple_mini(const Params& p, int l, int j) {
  const int tid = get_tid(), lane = tid & 63, w = tid >> 6, fr = lane & 15, fq = lane >> 4;
  const int srow = (j >> 4) * 16 + fr;
  const size_t row = (size_t)NPROMPT + srow;
  const int cb = (j & 15) * 64 + w * 16;
  f32x4 g = {0.f, 0.f, 0.f, 0.f}, pa = {0.f, 0.f, 0.f, 0.f};
  mini_dot<float>(pa, p.p_s + ((size_t)l * 512 + srow) * 256 + fq * 8, p.wt_pp() + (size_t)l * 262144 + (size_t)(cb + fr) * 256 + fq * 8, 256);
  mini_dot<bf16_t>(g, p.rb() + row * 1024 + fq * 8, p.wt_pg() + (size_t)l * 1048576 + (size_t)(cb + fr) * 1024 + fq * 8, 1024);
  const u32x2 rbv = *(const u32x2*)(p.rb() + row * 1024 + cb + fq * 4);
  const f32x4 rv = {lo2f(rbv.x), hi2f(rbv.x), lo2f(rbv.y), hi2f(rbv.y)};
  f32x4 o; o[0] = rv[0] + sigm(g[0]) * pa[0]; o[1] = rv[1] + sigm(g[1]) * pa[1]; o[2] = rv[2] + sigm(g[2]) * pa[2]; o[3] = rv[3] + sigm(g[3]) * pa[3];
  *(f32x4*)(p.o_y() + row * 1024 + cb + fq * 4) = o;
}

#define XB_TMO      128
#define XB_XCNT(j)  (256  + 64 * (j))
#define XB_XSUB(j)  (1280 + 64 * (j))
#define XB_XGEN(j)  (2304 + 64 * (j))
#define XB_TOP      3328
#define XB_TOPGEN   3392
#define XCD_BAR_WORDS 3456
#define XB_SPIN_CAP (1u << 18)
#define LAS __attribute__((address_space(3)))
__device__ __forceinline__ unsigned xb_ld(unsigned* p)              { return __hip_atomic_load(p, __ATOMIC_RELAXED, __HIP_MEMORY_SCOPE_AGENT); }
__device__ __forceinline__ unsigned xb_add(unsigned* p, unsigned v) { return __hip_atomic_fetch_add(p, v, __ATOMIC_RELAXED, __HIP_MEMORY_SCOPE_AGENT); }
__device__ __forceinline__ unsigned xb_xcc_id() { return (unsigned)__builtin_amdgcn_s_getreg((3 << 11) | 20) & 0xFu; }
#define XB_SPIN(cond, bar) do { unsigned _sp = 0; while (cond) { __builtin_amdgcn_s_sleep(1); \
    if ((++_sp & 255u) == 0u) { if (xb_ld(&(bar)[XB_TMO])) break; if (_sp > XB_SPIN_CAP) { atomicAdd(&(bar)[XB_TMO], 1u); break; } } } } while (0)
__device__ __forceinline__ void xcd_barrier_complete(unsigned* bar, unsigned x, unsigned& nloc, unsigned& nx) {
    const unsigned G = gridDim.x * gridDim.y * gridDim.z;
    unsigned sum, cnt, mine, sp = 0u;
    for (;;) {
        sum = 0u; cnt = 0u; mine = 0u;
#pragma unroll
        for (unsigned j = 0; j < 16; ++j) { const unsigned c = xb_ld(&bar[XB_XCNT(j)]); sum += c; cnt += (c > 0u) ? 1u : 0u; mine = (j == x) ? c : mine; }
        if (sum == G) break;
        __builtin_amdgcn_s_sleep(1);
        if ((++sp & 255u) == 0u) { if (xb_ld(&bar[XB_TMO])) break; if (sp > XB_SPIN_CAP) { atomicAdd(&bar[XB_TMO], 1u); break; } }
    }
    nloc = mine > 0u ? mine : 1u; nx = cnt > 0u ? cnt : 1u;
}
__device__ __forceinline__ void xcd_barrier(unsigned* bar, volatile LAS unsigned* st) {
    asm volatile("s_waitcnt vmcnt(0)" ::: "memory");
    __syncthreads();
    if (threadIdx.x == 0) {
        const unsigned x = xb_xcc_id();
        __builtin_amdgcn_s_waitcnt(0);
        unsigned nloc = st[0], nx = st[1];
        if (nloc == 0u) { xcd_barrier_complete(bar, x, nloc, nx); st[0] = nloc; st[1] = nx; }
        const unsigned old = xb_add(&bar[XB_XSUB(x)], 1u);
        const unsigned gen = old / nloc;
        if (old + 1u == (gen + 1u) * nloc) {
            __builtin_amdgcn_fence(__ATOMIC_RELEASE, "agent");
            asm volatile("s_waitcnt vmcnt(0)" ::: "memory");
            const unsigned og = xb_add(&bar[XB_TOP], 1u);
            const unsigned tg = og / nx;
            if (og + 1u == (tg + 1u) * nx) xb_add(&bar[XB_TOPGEN], 1u);
            else XB_SPIN(xb_ld(&bar[XB_TOPGEN]) == tg, bar);
            __builtin_amdgcn_fence(__ATOMIC_ACQUIRE, "agent");
            xb_add(&bar[XB_XGEN(x)], 1u);
            asm volatile("s_waitcnt vmcnt(0)" ::: "memory");
        } else {
            XB_SPIN(xb_ld(&bar[XB_XGEN(x)]) == gen, bar);
            __builtin_amdgcn_fence(__ATOMIC_ACQUIRE, "agent");
            asm volatile("s_waitcnt vmcnt(0)" ::: "memory");
        }
    }
    __syncthreads();
}

template <int PH>
__device__ __forceinline__ void run_phase(const Params& p, char* smem) {
  const int bid = blockIdx.x, nb = gridDim.x;
  if (PH == 0) {
    for (int t = bid; t < 1696; t += nb) wconv_tile(p, t, smem);
    for (int i = bid * 256 + get_tid(); i < 2 * 8 * 1024; i += nb * 256) { const int ll = i >> 13, j = (i >> 10) & 7, k = i & 1023; p.wg8()[i] = p.w_in[((size_t)ll * 1024 + k) * NINSRC + 2560 + j]; }
    return;
  }
  constexpr int l = (PH - 1) / NPL, s = (PH - 1) % NPL;
  if (!((PHMASK >> s) & 1)) return;
  switch (s) {
    case 0: norm_phase(p, l, smem); break;
    case 1: {
      const int per = (66 * 52) / 8, xcd = bid & 7, nloc = (nb + 7 - xcd) >> 3;
      for (int j = bid >> 3; j < per; j += nloc) {
        const int sq = xcd * per + j;
        const int tmg = sq / 416, rem = sq % 416, gm = (tmg == 8) ? 2 : 8;
        const int tng = rem / (gm * 8), rem2 = rem % (gm * 8), wdt = (tng == 6) ? 4 : 8;
        inproj_tile(p, l, (tmg * 8 + rem2 / wdt) * 52 + tng * 8 + rem2 % wdt, smem);
      }
      break;
    }
    case 2:
      for (int v = bid; v < 3 * NUNIT; v += nb) {
        const int ty = v % 3, u = v / 3;
        if (ty == 0) sb_unit(p, l, u, smem); else if (ty == 1) mlstm_local(p, l, u, smem); else hgrn_local(p, l, u, smem);
      }
      break;
    case 3: scan_phase(p, l, smem); break;
    case 4:
      for (int v = bid; v < 2 * NUNIT; v += nb) { if (v & 1) hgrn_out(p, l, v >> 1, smem); else mlstm_out(p, l, v >> 1, smem); }
      break;
    case 5: for (int t = bid; t < 1024; t += nb) merge_tile(p, l, t, smem); for (int j = bid; j < 512; j += nb) merge_mini(p, l, j); break;
    case 6: for (int t = bid; t < 1024; t += nb) outproj_tile(p, l, t, smem); for (int j = bid; j < 512; j += nb) outproj_mini(p, l, j); break;
    case 7: postnorm_phase(p, l); break;
    case 8: for (int t = bid; t < 1024; t += nb) ple_tile(p, l, t, smem); for (int j = bid; j < 512; j += nb) ple_mini(p, l, j); break;
  }
}

template <int PH>
__global__ void __launch_bounds__(256, 2) phase_kernel(Params p) {
  __shared__ __attribute__((aligned(16))) char smem[SMEM_BYTES];
  run_phase<PH>(p, smem);
}

#if FUSED
__device__ __forceinline__ int fetch_work(unsigned* ctr, volatile int* slot) {
  __syncthreads();
  if (threadIdx.x == 0) *slot = (int)__hip_atomic_fetch_add(ctr, 1u, __ATOMIC_RELAXED, __HIP_MEMORY_SCOPE_AGENT);
  __syncthreads();
  return *slot;
}
__device__ __forceinline__ void run_phase_rt(const Params& p, int ph, char* smem, volatile int* wslot) {
  const int bid = blockIdx.x, nb = gridDim.x;
  unsigned* ctr = (unsigned*)(p.ws + WS_BAR + 14336) + ph * 16;
  int l = 0, s = 0;
  if (ph == 0) { for (int t = bid; t < 848; t += nb) wconv_tile(p, t, smem); }
  else { if (ph == 1) return; l = (ph - 1) / NPL; s = (ph - 1) % NPL; }
  switch (s) {
    case 0: norm_phase(p, l, smem); break;
    case 1: {
      const int per = (66 * 52) / 8, xcd0 = (int)(xb_xcc_id() & 7u);
      for (int dx = 0; dx < 8; ++dx) {
        const int xcd = (xcd0 + dx) & 7;
        for (;;) {
          const int j = fetch_work(ctr + xcd, wslot);
          if (j >= per) break;
          const int sq = xcd * per + j;
          const int tmg = sq / 416, rem = sq % 416, gm = (tmg == 8) ? 2 : 8;
          const int tng = rem / (gm * 8), rem2 = rem % (gm * 8), wdt = (tng == 6) ? 4 : 8;
          inproj_tile(p, l, (tmg * 8 + rem2 / wdt) * 52 + tng * 8 + rem2 % wdt, smem);
        }
      }
      break;
    }
    case 2:
      for (;;) {
        const int v = fetch_work(ctr, wslot);
        if (v >= 3 * NUNIT + (l == 0 ? 848 : 0)) break;
        if (v < NUNIT) sb_unit(p, l, v, smem); else if (v < 2 * NUNIT) mlstm_local(p, l, v - NUNIT, smem); else if (v < 3 * NUNIT) hgrn_local(p, l, v - 2 * NUNIT, smem);
        else wconv_tile(p, 848 + (v - 3 * NUNIT), smem);
      }
      break;
    case 3: {
      scan_phase(p, l, smem);
      const int v = fetch_work(ctr + 8, wslot);
      if (v < 1584) gate_tile256(p, l, v < 48 ? 1536 + v : v - 48, smem);
      break;
    }
    case 4: {
      unsigned* gq = ctr - 16 + 8;
      bool gleft = true, uleft = true;
      while (gleft || uleft) {
        if (gleft) { const int v = fetch_work(gq, wslot); if (v < 1584) gate_tile256(p, l, v < 48 ? 1536 + v : v - 48, smem); else gleft = false; }
        for (int k = 0; k < 2 && uleft; ++k) {
          const int u = fetch_work(ctr, wslot);
          if (u >= 2 * NUNIT) uleft = false;
          else if (u < NUNIT) hgrn_out(p, l, u, smem); else mlstm_out(p, l, u - NUNIT, smem);
        }
      }
      break;
    }
    case 5: for (;;) { const int v = fetch_work(ctr, wslot); if (v >= 1536) break; if (v < 1024) merge_tile_g(p, l, v, smem); else merge_mini(p, l, v - 1024); } break;
    case 6: for (;;) { const int v = fetch_work(ctr, wslot); if (v >= 1024) break; if (v < 512) outproj_tile256(p, l, v, smem); else outproj_mini(p, l, v - 512); } break;
    case 7: postnorm_phase(p, l); break;
    case 8: for (;;) { const int v = fetch_work(ctr, wslot); if (v >= 1536) break; if (v < 1024) ple_tile(p, l, v, smem); else ple_mini(p, l, v - 1024); } break;
  }
}

__global__ void __launch_bounds__(256, 2) mega(Params p_unused) {
  __shared__ __attribute__((aligned(16))) char smem[SMEM_BYTES];
  __shared__ uint4 xb_words;
  __shared__ int wslot;
  if (threadIdx.x == 0) {
    typedef const Params __attribute__((address_space(4))) * KP4;
    KP4 kp = (KP4)__builtin_amdgcn_kernarg_segment_ptr();
    asm volatile("" : "+s"(kp));
    char* wsb = ((const Params*)kp)->ws;
    xb_words = make_uint4(0u, 0u, 0u, 0u); (void)xb_add((unsigned*)(wsb + WS_BAR) + XB_XCNT(xb_xcc_id()), 1u);
  }
  __syncthreads();
  typedef const Params __attribute__((address_space(4))) * KP4;
#ifdef PROBE_KIND
  unsigned long long t_acc = 0;
#endif
#pragma unroll 1
  for (int ph = 0; ph < NPHASE; ++ph) {
    KP4 kp = (KP4)__builtin_amdgcn_kernarg_segment_ptr();
    asm volatile("" : "+s"(kp));
    const Params q = *(const Params*)kp;
#ifdef PROBE_KIND
    const unsigned long long tp0 = __builtin_amdgcn_s_memrealtime();
#endif
    run_phase_rt(q, ph, smem, &wslot);
#ifdef PROBE_KIND
    const unsigned long long tp1 = __builtin_amdgcn_s_memrealtime();
    if ((PROBE_KIND == 9 && ph == 0) || (PROBE_KIND < 9 && ph > 0 && (ph - 1) % NPL == PROBE_KIND)) t_acc += tp1 - tp0;
#endif
    if (ph + 1 < NPHASE && ph != 1) xcd_barrier((unsigned*)(q.ws + WS_BAR), (volatile LAS unsigned*)&xb_words);
    if (gridDim.y == 7777u) cg::this_grid().sync();
#ifdef PROBE_KIND
    if (PROBE_KIND == 10 && (PROBE_SEL < 0 || (ph > 0 && (ph - 1) % NPL == PROBE_SEL))) t_acc += __builtin_amdgcn_s_memrealtime() - tp1;
#endif
  }
#ifdef PROBE_GEMM
  {
    KP4 kp = (KP4)__builtin_amdgcn_kernarg_segment_ptr();
    asm volatile("" : "+s"(kp));
    const Params q = *(const Params*)kp;
    xcd_barrier((unsigned*)(q.ws + WS_BAR), (volatile LAS unsigned*)&xb_words);
    const unsigned long long tg0 = __builtin_amdgcn_s_memrealtime();
    f32x4 acc[4][8];
#pragma unroll
    for (int a_ = 0; a_ < 4; ++a_)
#pragma unroll
      for (int b_ = 0; b_ < 8; ++b_) acc[a_][b_] = (f32x4){0.f, 0.f, 0.f, 0.f};
    const int bid = blockIdx.x;
#pragma unroll 1
    for (int it = 0; it < 8; ++it) {
      int tm, tn;
      if (PROBE_GEMM == 0) { tm = 0; tn = 0; }
      else if (PROBE_GEMM == 1) { tm = bid & 63; tn = ((bid >> 6) * 6 + it) % 52; }
      else { const int xcd = bid & 7, idx = bid >> 3; tm = xcd * 8 + (idx & 7); tn = ((idx >> 3) + 8 * it) % 52; }
      gemm_glds<8, 3>(acc, q.U() + (size_t)tm * 256 * 1024, 1024, q.wt_in() + (size_t)tn * 128 * 1024, 1024, 1024, smem);
    }
    float sum = 0.f;
#pragma unroll
    for (int a_ = 0; a_ < 4; ++a_)
#pragma unroll
      for (int b_ = 0; b_ < 8; ++b_) sum += acc[a_][b_][0] + acc[a_][b_][1] + acc[a_][b_][2] + acc[a_][b_][3];
    if (sum == 123456.789f) q.hbc()[0] = sum;
    const unsigned long long tg1 = __builtin_amdgcn_s_memrealtime();
    if (blockIdx.x == 0) { while (__builtin_amdgcn_s_memrealtime() - tg1 < 4 * (tg1 - tg0)) __builtin_amdgcn_s_sleep(32); }
  }
#endif
#ifdef PROBE_KIND
  if (blockIdx.x == PROBE_BLOCK) { const unsigned long long te = __builtin_amdgcn_s_memrealtime(); while (__builtin_amdgcn_s_memrealtime() - te < 4 * t_acc) __builtin_amdgcn_s_sleep(32); }
#endif
}
#endif

template <int PH>
static void launch_all(const Params& p, int grid, hipStream_t stream) {
  hipLaunchKernelGGL(phase_kernel<PH>, dim3(grid), dim3(256), 0, stream, p);
  if constexpr (PH + 1 < NPHASE) launch_all<PH + 1>(p, grid, stream);
}

extern "C" void kernel_launch(void* const* d_in, const int* in_sizes, int n_in, void* d_out, int out_size, void* d_ws, size_t ws_size, hipStream_t stream) {
  Params p;
  memset(&p, 0, sizeof(p));
  const float* const* in = (const float* const*)d_in;
  p.x_p = in[0]; p.x_s = in[1]; p.p_p = in[2]; p.p_s = in[3]; p.st_C = in[4]; p.st_n = in[5]; p.st_m = in[6]; p.st_conv = in[7];
  p.ck = in[8]; p.cv = in[9]; p.st_S = in[10]; p.g_pre = in[11]; p.w_in = in[12]; p.b_i = in[13]; p.b_f = in[14]; p.w_conv = in[15];
  p.g_ml = in[16]; p.lb_logits = in[17]; p.g_hg = in[18]; p.w_br = in[19]; p.w_out = in[20]; p.g_post = in[21]; p.w_pg = in[22]; p.w_pp = in[23];
  p.out = (float*)d_out; p.ws = (char*)d_ws;
  if (WS_TOTAL > ws_size || (size_t)out_size < O_TOTAL) { fprintf(stderr, "workspace/out too small: need %zu have %zu\n", (size_t)WS_TOTAL, ws_size); return; }
  static int grid_blocks = 0;
  if (!grid_blocks) {
    int dev = 0, cus = 0, per_cu = 0;
    (void)hipGetDevice(&dev);
    (void)hipDeviceGetAttribute(&cus, hipDeviceAttributeMultiprocessorCount, dev);
#if FUSED
    (void)hipOccupancyMaxActiveBlocksPerMultiprocessor(&per_cu, mega, 256, 0);
#else
    per_cu = 2;
#endif
    if (per_cu > 2) per_cu = 2;
    if (per_cu < 1) per_cu = 1;
    grid_blocks = cus * per_cu;
  }
#if FUSED
  (void)hipMemsetAsync((char*)d_ws + WS_BAR, 0, 16384, stream);
  void* args[] = {&p};
  hipError_t e = hipLaunchCooperativeKernel((void*)mega, dim3(grid_blocks), dim3(256), args, 0, stream);
  if (e != hipSuccess) fprintf(stderr, "cooperative launch failed: %s (grid %d)\n", hipGetErrorString(e), grid_blocks);
#else
  launch_all<0>(p, grid_blocks, stream);
#endif
}
```

```cpp
#include <hip/hip_runtime.h>
#include <hip/hip_cooperative_groups.h>
#include <stdint.h>
#include <stdio.h>
#include <string.h>
namespace cg = cooperative_groups;

#ifndef FUSED
#define FUSED 1
#endif
#ifndef PHMASK
#define PHMASK 0x3ff
#endif

typedef unsigned short bf16_t;
typedef short bf16x8 __attribute__((ext_vector_type(8)));
typedef float f32x4 __attribute__((ext_vector_type(4)));
typedef unsigned u32x4 __attribute__((ext_vector_type(4)));
typedef unsigned u32x2 __attribute__((ext_vector_type(2)));

constexpr int NTOK = 16896, NPROMPT = 16384, NUNIT = 1056;
constexpr int NINSRC = 9736, NWT = 9728, NMAIN = 6656;
constexpr int SMEM_BYTES = 80896;
constexpr int NPL = 9;
constexpr int NPHASE = 1 + 2 * NPL;

constexpr size_t al256(size_t x) { return (x + 255) & ~(size_t)255; }
constexpr size_t WS_WT_IN = 0;
constexpr size_t WS_WT_BR = WS_WT_IN + al256((size_t)2 * NWT * 1024 * 2);
constexpr size_t WS_WT_OUT = WS_WT_BR + al256((size_t)2 * 3 * 1024 * 512 * 2);
constexpr size_t WS_WT_PG = WS_WT_OUT + al256((size_t)2 * 1048576 * 2);
constexpr size_t WS_WT_PP = WS_WT_PG + al256((size_t)2 * 1048576 * 2);
constexpr size_t WS_U = WS_WT_PP + al256((size_t)2 * 262144 * 2);
constexpr size_t WS_PR = WS_U + al256((size_t)NTOK * 1024 * 2);
constexpr size_t WS_QC = WS_PR + al256((size_t)13 * NTOK * 512 * 2);
constexpr size_t WS_KC = WS_QC + al256((size_t)NTOK * 512 * 2);
constexpr size_t WS_SM = WS_KC + al256((size_t)NTOK * 512 * 2);
constexpr size_t WS_SH = WS_SM + al256((size_t)NUNIT * 16384 * 2);
constexpr size_t WS_H = WS_SH + al256((size_t)NUNIT * 16384 * 2);
constexpr size_t WS_IG = WS_H + al256((size_t)3 * NTOK * 512 * 2);
constexpr size_t WS_LF = WS_IG + al256((size_t)NTOK * 16);
constexpr size_t WS_AC = WS_LF + al256((size_t)NTOK * 16);
constexpr size_t WS_BC = WS_AC + al256(NUNIT * 4);
constexpr size_t WS_MIN = WS_BC + al256(NUNIT * 4);
constexpr size_t WS_NLOC = WS_MIN + al256(NUNIT * 4);
constexpr size_t WS_HBC = WS_NLOC + al256((size_t)NUNIT * 512);
constexpr size_t WS_BAR = WS_HBC + al256((size_t)NUNIT * 512);
constexpr size_t WS_WG8 = WS_BAR + 16384;
constexpr size_t WS_TOTAL = WS_WG8 + 65536;
constexpr size_t GRP = (size_t)NTOK * 512 * 2;
constexpr size_t WS_G0 = WS_PR + 0 * GRP, WS_G1 = WS_PR + 5 * GRP, WS_G2 = WS_PR + 7 * GRP;
constexpr size_t WS_MERGED = WS_PR + 2 * GRP;
constexpr size_t WS_Y = WS_PR + 9 * GRP;
constexpr size_t WS_RB = WS_PR + 0 * GRP;
constexpr size_t WS_R = WS_PR + 5 * GRP;
static_assert(WS_Y + (size_t)NTOK * 1024 * 4 <= WS_QC, "alias overflow");
constexpr size_t O_PC = 16777216 + 524288, O_PN = O_PC + 262144, O_PM = O_PN + 2048, O_PCONV = O_PM + 16, O_PK = O_PCONV + 12288, O_PV = O_PK + 16777216,
                 O_PS = O_PV + 16777216, O_SC = O_PS + 262144, O_SN = O_SC + 1048576, O_SM = O_SN + 8192, O_SCONV = O_SM + 64, O_SK = O_SCONV + 49152,
                 O_SV = O_SK + 524288, O_SS = O_SV + 524288, O_TOTAL = O_SS + 1048576;

struct Params {
  const float *x_p, *x_s, *p_p, *p_s, *st_C, *st_n, *st_m, *st_conv, *ck, *cv, *st_S;
  const float *g_pre, *w_in, *b_i, *b_f, *w_conv, *g_ml, *lb_logits, *g_hg, *w_br, *w_out, *g_post, *w_pg, *w_pp;
  float* out; char* ws;
#define WSP(name, T, off) __device__ __forceinline__ T* name() const { return (T*)(ws + (off)); }
#define OUTP(name, off) __device__ __forceinline__ float* name() const { return out + (off); }
  OUTP(o_y, 0) OUTP(o_pC, O_PC) OUTP(o_pn, O_PN) OUTP(o_pm, O_PM) OUTP(o_pconv, O_PCONV) OUTP(o_pk, O_PK) OUTP(o_pv, O_PV) OUTP(o_pS, O_PS)
  OUTP(o_sC, O_SC) OUTP(o_sn, O_SN) OUTP(o_sm, O_SM) OUTP(o_sconv, O_SCONV) OUTP(o_sk, O_SK) OUTP(o_sv, O_SV) OUTP(o_sS, O_SS)
  WSP(wt_in, bf16_t, WS_WT_IN) WSP(wt_br, bf16_t, WS_WT_BR) WSP(wt_out, bf16_t, WS_WT_OUT) WSP(wt_pg, bf16_t, WS_WT_PG) WSP(wt_pp, bf16_t, WS_WT_PP)
  WSP(U, bf16_t, WS_U) WSP(PR, bf16_t, WS_PR) WSP(QC, bf16_t, WS_QC) WSP(KC, bf16_t, WS_KC) WSP(SM, bf16_t, WS_SM) WSP(SH, bf16_t, WS_SH) WSP(H, bf16_t, WS_H)
  WSP(ig, float, WS_IG) WSP(lf, float, WS_LF) WSP(ac, float, WS_AC) WSP(Bc, float, WS_BC) WSP(min_, float, WS_MIN) WSP(nloc, float, WS_NLOC) WSP(hbc, float, WS_HBC)
  __device__ __forceinline__ bf16_t* Gb(int b) const { return (bf16_t*)(ws + (b == 0 ? WS_G0 : b == 1 ? WS_G1 : WS_G2)); }
  WSP(wg8, float, WS_WG8) WSP(merged, bf16_t, WS_MERGED) WSP(y, float, WS_Y) WSP(r, float, WS_R) WSP(rb, bf16_t, WS_RB)
};

__device__ __forceinline__ int get_tid() { int t = threadIdx.x; asm volatile("" : "+v"(t)); return t; }
__device__ __forceinline__ bf16_t f2bf(float f) { unsigned u = __float_as_uint(f); u += 0x7fffu + ((u >> 16) & 1u); return (bf16_t)(u >> 16); }
__device__ __forceinline__ float bf2f(bf16_t h) { return __uint_as_float(((unsigned)h) << 16); }
__device__ __forceinline__ unsigned pack2(float a, float b) { return (unsigned)f2bf(a) | ((unsigned)f2bf(b) << 16); }
__device__ __forceinline__ float lo2f(unsigned v) { return __uint_as_float(v << 16); }
__device__ __forceinline__ float hi2f(unsigned v) { return __uint_as_float(v & 0xffff0000u); }
__device__ __forceinline__ float sigm(float x) { return 1.f / (1.f + __expf(-x)); }
__device__ __forceinline__ float silu(float x) { return x / (1.f + __expf(-x)); }
__device__ __forceinline__ float softplus(float x) { return fmaxf(x, 0.f) + __logf(1.f + __expf(-fabsf(x))); }
__device__ __forceinline__ float logsigm(float x) { return fminf(x, 0.f) - __logf(1.f + __expf(-fabsf(x))); }

template <int MT, int NT, int KS>
__device__ __forceinline__ void wmma(f32x4 (&acc)[MT][NT], const bf16_t* A, int lda, const bf16_t* B, int ldb, int fr, int fq) {
#pragma unroll
  for (int kk = 0; kk < KS; ++kk) {
    bf16x8 a[MT], b[NT];
#pragma unroll
    for (int mi = 0; mi < MT; ++mi) a[mi] = *(const bf16x8*)(A + (mi * 16 + fr) * lda + kk * 32 + fq * 8);
#pragma unroll
    for (int ni = 0; ni < NT; ++ni) b[ni] = *(const bf16x8*)(B + (ni * 16 + fr) * ldb + kk * 32 + fq * 8);
#pragma unroll
    for (int mi = 0; mi < MT; ++mi)
#pragma unroll
      for (int ni = 0; ni < NT; ++ni) acc[mi][ni] = __builtin_amdgcn_mfma_f32_16x16x32_bf16(a[mi], b[ni], acc[mi][ni], 0, 0, 0);
  }
}

__device__ __forceinline__ u32x4 ld8(const bf16_t* s) { return *(const u32x4*)s; }
__device__ __forceinline__ u32x4 ld8(const float* s) {
  float4 a = *(const float4*)s, b = *(const float4*)(s + 4);
  u32x4 r; r.x = pack2(a.x, a.y); r.y = pack2(a.z, a.w); r.z = pack2(b.x, b.y); r.w = pack2(b.z, b.w); return r;
}
template <typename T>
__device__ __forceinline__ void ld_tile(bf16_t* dst, const T* src, long ld, int tid) {
#pragma unroll
  for (int i = 0; i < 4; ++i) { int id = tid + 256 * i; int r = id >> 4, c = (id & 15) * 8; *(u32x4*)(dst + r * 136 + c) = ld8(src + (long)r * ld + c); }
}
template <typename T>
__device__ __forceinline__ void ld_tile128(bf16_t* dst, const T* src, long ld, int tid) {
#pragma unroll
  for (int i = 0; i < 8; ++i) { int id = tid + 256 * i; int r = id >> 4, c = (id & 15) * 8; *(u32x4*)(dst + r * 136 + c) = ld8(src + (long)r * ld + c); }
}
template <typename T, int ROWS, int DLD>
__device__ __forceinline__ void ld_T(bf16_t* dst, const T* src, long ld, int tid) {
#pragma unroll 2
  for (int id = tid; id < ROWS * 16; id += 256) {
    int r = id % ROWS, c = (id / ROWS) * 8;
    u32x4 v = ld8(src + (long)r * ld + c);
    bf16_t* d = dst + c * DLD + r;
    d[0] = (bf16_t)(v.x & 0xffff); d[DLD] = (bf16_t)(v.x >> 16); d[2 * DLD] = (bf16_t)(v.y & 0xffff); d[3 * DLD] = (bf16_t)(v.y >> 16);
    d[4 * DLD] = (bf16_t)(v.z & 0xffff); d[5 * DLD] = (bf16_t)(v.z >> 16); d[6 * DLD] = (bf16_t)(v.w & 0xffff); d[7 * DLD] = (bf16_t)(v.w >> 16);
  }
}

#define PRG(g) (p.PR() + (size_t)(g) * NTOK * 512)

__device__ __forceinline__ const float* xrow(const Params& p, int l, int row) {
  if (l == 0) return row < NPROMPT ? p.x_p + (size_t)row * 1024 : p.x_s + (size_t)(row - NPROMPT) * 1024;
  return p.o_y() + (size_t)row * 1024;
}

__device__ void wconv_tile(const Params& p, int t, char* smem) {
  float* tile = (float*)smem;
  const int tid = get_tid();
  int l = t / 848, r = t % 848;
  const float* src; bf16_t* dst; int K, ldsrc, kt, nt, skip = 1 << 30;
  if (r < 608) { src = p.w_in + (size_t)l * 1024 * NINSRC; dst = p.wt_in() + (size_t)l * NWT * 1024; K = 1024; ldsrc = NINSRC; kt = r % 16; nt = r / 16; skip = 2560; }
  else if (r < 704) { r -= 608; int b = r / 32; r %= 32; src = p.w_br + (size_t)(l * 3 + b) * 512 * 1024; dst = p.wt_br() + (size_t)(l * 3 + b) * 1024 * 512; K = 512; ldsrc = 1024; kt = r % 8; nt = r / 8; }
  else if (r < 768) { r -= 704; src = p.w_out + (size_t)l * 1048576; dst = p.wt_out() + (size_t)l * 1048576; K = 1024; ldsrc = 1024; kt = r % 16; nt = r / 16; }
  else if (r < 832) { r -= 768; src = p.w_pg + (size_t)l * 1048576; dst = p.wt_pg() + (size_t)l * 1048576; K = 1024; ldsrc = 1024; kt = r % 16; nt = r / 16; }
  else { r -= 832; src = p.w_pp + (size_t)l * 262144; dst = p.wt_pp() + (size_t)l * 262144; K = 256; ldsrc = 1024; kt = r % 4; nt = r / 4; }
  const int n0 = nt * 256, k0 = kt * 64;
  __syncthreads();
#pragma unroll
  for (int i = 0; i < 16; ++i) {
    const int k = i * 4 + (tid >> 6), n4 = (tid & 63) * 4;
    int ns = n0 + n4; if (ns >= skip) ns += 8;
    *(float4*)(tile + k * 260 + n4) = *(const float4*)(src + (size_t)(k0 + k) * ldsrc + ns);
  }
  __syncthreads();
  bf16_t* drow = dst + (size_t)(n0 + tid) * K + k0;
#pragma unroll
  for (int c = 0; c < 8; ++c) {
    u32x4 pk;
    pk.x = pack2(tile[(c * 8 + 0) * 260 + tid], tile[(c * 8 + 1) * 260 + tid]);
    pk.y = pack2(tile[(c * 8 + 2) * 260 + tid], tile[(c * 8 + 3) * 260 + tid]);
    pk.z = pack2(tile[(c * 8 + 4) * 260 + tid], tile[(c * 8 + 5) * 260 + tid]);
    pk.w = pack2(tile[(c * 8 + 6) * 260 + tid], tile[(c * 8 + 7) * 260 + tid]);
    *(u32x4*)(drow + c * 8) = pk;
  }
}

__device__ void norm_phase(const Params& p, int l, char* smem) {
  const int lane = threadIdx.x & 63, wid = threadIdx.x >> 6;
  const float* gp = p.g_pre + l * 1024;
  float* wgs = (float*)smem;
  __syncthreads();
  {
    const float* wsrc = p.w_in + (size_t)l * 1024 * NINSRC + 2560;
    for (int k = threadIdx.x; k < 1024; k += 256) {
      const float4 a = *(const float4*)(wsrc + (size_t)k * NINSRC), b = *(const float4*)(wsrc + (size_t)k * NINSRC + 4);
      wgs[k] = a.x; wgs[1024 + k] = a.y; wgs[2048 + k] = a.z; wgs[3072 + k] = a.w;
      wgs[4096 + k] = b.x; wgs[5120 + k] = b.y; wgs[6144 + k] = b.z; wgs[7168 + k] = b.w;
    }
  }
  __syncthreads();
  const float* wg = wgs;
  for (int row = blockIdx.x * 4 + wid; row < NTOK; row += gridDim.x * 4) {
    const float* x = xrow(p, l, row);
    float4 v[4]; float ss = 0.f;
#pragma unroll
    for (int i = 0; i < 4; ++i) { v[i] = *(const float4*)(x + i * 256 + lane * 4); ss += v[i].x * v[i].x + v[i].y * v[i].y + v[i].z * v[i].z + v[i].w * v[i].w; }
#pragma unroll
    for (int o = 32; o > 0; o >>= 1) ss += __shfl_xor(ss, o);
    const float rstd = rsqrtf(ss * (1.f / 1024.f) + 1e-6f);
    float d0 = 0, d1 = 0, d2 = 0, d3 = 0, d4 = 0, d5 = 0, d6 = 0, d7 = 0;
#pragma unroll
    for (int i = 0; i < 4; ++i) {
      const int k = i * 256 + lane * 4;
      float4 g = *(const float4*)(gp + k);
      float u0 = v[i].x * rstd * g.x, u1 = v[i].y * rstd * g.y, u2 = v[i].z * rstd * g.z, u3 = v[i].w * rstd * g.w;
      u32x2 pk; pk.x = pack2(u0, u1); pk.y = pack2(u2, u3);
      *(u32x2*)(p.U() + (size_t)row * 1024 + k) = pk;
      const float* wp = wg + k;
      float4 w;
      w = *(const float4*)(wp);            d0 += u0 * w.x + u1 * w.y + u2 * w.z + u3 * w.w;
      w = *(const float4*)(wp + 1024);     d1 += u0 * w.x + u1 * w.y + u2 * w.z + u3 * w.w;
      w = *(const float4*)(wp + 2 * 1024); d2 += u0 * w.x + u1 * w.y + u2 * w.z + u3 * w.w;
      w = *(const float4*)(wp + 3 * 1024); d3 += u0 * w.x + u1 * w.y + u2 * w.z + u3 * w.w;
      w = *(const float4*)(wp + 4 * 1024); d4 += u0 * w.x + u1 * w.y + u2 * w.z + u3 * w.w;
      w = *(const float4*)(wp + 5 * 1024); d5 += u0 * w.x + u1 * w.y + u2 * w.z + u3 * w.w;
      w = *(const float4*)(wp + 6 * 1024); d6 += u0 * w.x + u1 * w.y + u2 * w.z + u3 * w.w;
      w = *(const float4*)(wp + 7 * 1024); d7 += u0 * w.x + u1 * w.y + u2 * w.z + u3 * w.w;
    }
#pragma unroll
    for (int o = 32; o > 0; o >>= 1) {
      d0 += __shfl_xor(d0, o); d1 += __shfl_xor(d1, o); d2 += __shfl_xor(d2, o); d3 += __shfl_xor(d3, o);
      d4 += __shfl_xor(d4, o); d5 += __shfl_xor(d5, o); d6 += __shfl_xor(d6, o); d7 += __shfl_xor(d7, o);
    }
    if (lane < 4) {
      float di = lane == 0 ? d0 : lane == 1 ? d1 : lane == 2 ? d2 : d3;
      float df = lane == 0 ? d4 : lane == 1 ? d5 : lane == 2 ? d6 : d7;
      p.ig()[row * 4 + lane] = di + p.b_i[l * 4 + lane];
      p.lf()[row * 4 + lane] = logsigm(df + p.b_f[l * 4 + lane]);
    }
  }
}

template <typename TA>
__device__ __forceinline__ void gemm_kloop(f32x4 (&acc)[4][4], const TA* Tp, long ldt, const bf16_t* Wp, long ldw, int K, char* smem) {
  bf16_t* sT = (bf16_t*)smem;
  bf16_t* sW = sT + 2 * 9216;
  const int tid = get_tid(), lane = tid & 63, wid = tid >> 6, wr = wid >> 1, wc = wid & 1, fr = lane & 15, fq = lane >> 4;
  u32x4 rt[4], rw[4];
  const int r0 = tid >> 3, c0 = (tid & 7) * 8;
#define GLOAD(k0) _Pragma("unroll") for (int i = 0; i < 4; ++i) { rt[i] = ld8(Tp + (long)(r0 + 32 * i) * ldt + (k0) + c0); rw[i] = ld8(Wp + (long)(r0 + 32 * i) * ldw + (k0) + c0); }
#define SSTORE(buf) _Pragma("unroll") for (int i = 0; i < 4; ++i) { *(u32x4*)(sT + (buf) * 9216 + (r0 + 32 * i) * 72 + c0) = rt[i]; *(u32x4*)(sW + (buf) * 9216 + (r0 + 32 * i) * 72 + c0) = rw[i]; }
  GLOAD(0); SSTORE(0);
  __syncthreads();
  const int nk = K >> 6;
#pragma unroll 1
  for (int kt = 0; kt < nk; ++kt) {
    const int buf = kt & 1;
    if (kt + 1 < nk) { GLOAD((kt + 1) * 64); }
    const bf16_t* aT = sT + buf * 9216 + (wr * 64) * 72;
    const bf16_t* aW = sW + buf * 9216 + (wc * 64) * 72;
    wmma<4, 4, 2>(acc, aW, 72, aT, 72, fr, fq);
    if (kt + 1 < nk) { SSTORE(buf ^ 1); }
    __syncthreads();
  }
#undef GLOAD
#undef SSTORE
}
__device__ __forceinline__ void zero_acc(f32x4 (&acc)[4][4]) {
#pragma unroll
  for (int a = 0; a < 4; ++a)
#pragma unroll
    for (int b = 0; b < 4; ++b) acc[a][b] = (f32x4){0.f, 0.f, 0.f, 0.f};
}


template <int NT, int NSTAGE>
__device__ __forceinline__ void gemm_glds(f32x4 (&acc)[4][NT], const bf16_t* Tp, long ldt, const bf16_t* Wp, long ldw, int K, char* smem) {
  constexpr int TR = 2 * NT * 16, STAGE_B = (TR + 128) * 64, LT = TR / 64, LPS = LT + 2;
  static_assert(NSTAGE * STAGE_B <= SMEM_BYTES, "ring too large");
  static_assert(NSTAGE == 3 || NSTAGE == 4, "waits below are written for 3 or 4 stages");
  const int tid = get_tid(), lane = tid & 63, wid = tid >> 6, wr = wid >> 1, wc = wid & 1, fr = lane & 15, fq = lane >> 4;
  const int lr = tid >> 2, cp = tid & 3, lc = (cp ^ ((lr >> 2) & 3)) * 8;
  const bf16_t* gT = Tp + (long)lr * ldt + lc;
  const int plr = ((lr >> 5) & 1) * 32 + ((lr >> 2) & 3) * 8 + ((lr >> 4) & 1) * 4 + (lr & 3);
  const bf16_t* gW = Wp + (long)plr * ldw + lc;
  const int rd_off = fr * 64 + ((fq ^ ((fr >> 2) & 3)) * 16);
#define GL_ISSUE(kt_, slot_) do { char* sb_ = smem + (slot_) * STAGE_B + tid * 16; \
    _Pragma("unroll") for (int i_ = 0; i_ < LT; ++i_) __builtin_amdgcn_global_load_lds((const unsigned*)(gT + (long)i_ * 64 * ldt + (kt_) * 32), (__attribute__((address_space(3))) unsigned*)(sb_ + i_ * 4096), 16, 0, 0); \
    _Pragma("unroll") for (int i_ = 0; i_ < 2; ++i_) __builtin_amdgcn_global_load_lds((const unsigned*)(gW + (long)i_ * 64 * ldw + (kt_) * 32), (__attribute__((address_space(3))) unsigned*)(sb_ + TR * 64 + i_ * 4096), 16, 0, 0); } while (0)
  asm volatile("s_waitcnt vmcnt(0)" ::: "memory");
  __builtin_amdgcn_s_barrier();
  const int nk = K >> 5;
#pragma unroll
  for (int s_ = 0; s_ < NSTAGE - 1; ++s_) if (s_ < nk) GL_ISSUE(s_, s_);
  int slot = 0, islot = NSTAGE - 1;
#pragma unroll 1
  for (int kt = 0; kt < nk; ++kt) {
    const int rem = nk - 1 - kt;
    if (NSTAGE == 4) {
      if (rem >= 2) asm volatile("s_waitcnt vmcnt(%0)" ::"n"(2 * LPS) : "memory");
      else if (rem == 1) asm volatile("s_waitcnt vmcnt(%0)" ::"n"(LPS) : "memory");
      else asm volatile("s_waitcnt vmcnt(0)" ::: "memory");
    } else {
      if (rem >= 1) asm volatile("s_waitcnt vmcnt(%0)" ::"n"(LPS) : "memory");
      else asm volatile("s_waitcnt vmcnt(0)" ::: "memory");
    }
    __builtin_amdgcn_s_barrier();
    const unsigned aT = (unsigned)(uintptr_t)(smem + slot * STAGE_B + (wr * NT * 16) * 64 + rd_off);
    const unsigned aW = (unsigned)(uintptr_t)(smem + slot * STAGE_B + TR * 64 + (wc * 64) * 64 + rd_off);
    bf16x8 a[4], b[NT];
#pragma unroll
    for (int mi = 0; mi < 4; ++mi) asm volatile("ds_read_b128 %0, %1 offset:%2" : "=v"(a[mi]) : "v"(aW), "n"(mi * 1024));
#pragma unroll
    for (int ni = 0; ni < NT; ++ni) asm volatile("ds_read_b128 %0, %1 offset:%2" : "=v"(b[ni]) : "v"(aT), "n"(ni * 1024));
    if constexpr (NT == 4) asm volatile("s_waitcnt lgkmcnt(2)" : "+v"(a[0]), "+v"(a[1]), "+v"(a[2]), "+v"(a[3]), "+v"(b[0]), "+v"(b[1]));
    else asm volatile("s_waitcnt lgkmcnt(4)" : "+v"(a[0]), "+v"(a[1]), "+v"(a[2]), "+v"(a[3]), "+v"(b[0]), "+v"(b[1]), "+v"(b[2]), "+v"(b[3]));
    const bool doiss = (kt + NSTAGE - 1 < nk);
    const int ktn = kt + NSTAGE - 1;
    char* sbi = smem + islot * STAGE_B + tid * 16;
#pragma unroll
    for (int g = 0; g < 4; ++g) {
      if (g == 2) {
        if constexpr (NT == 4) asm volatile("s_waitcnt lgkmcnt(0)" : "+v"(b[2]), "+v"(b[3]));
        else asm volatile("s_waitcnt lgkmcnt(0)" : "+v"(b[4]), "+v"(b[5]), "+v"(b[6]), "+v"(b[7]));
      }
#pragma unroll
      for (int nn = 0; nn < NT / 4; ++nn)
#pragma unroll
        for (int mi = 0; mi < 4; ++mi) { const int ni = g * (NT / 4) + nn; acc[mi][ni] = __builtin_amdgcn_mfma_f32_16x16x32_bf16(a[mi], b[ni], acc[mi][ni], 0, 0, 0); }
      __builtin_amdgcn_sched_barrier(0);
      if (doiss) {
#pragma unroll
        for (int q = 0; q < 2; ++q) {
          const int idx = g * 2 + q;
          if (idx < LT) __builtin_amdgcn_global_load_lds((const unsigned*)(gT + (long)idx * 64 * ldt + ktn * 32), (__attribute__((address_space(3))) unsigned*)(sbi + idx * 4096), 16, 0, 0);
          else if (idx < LPS) __builtin_amdgcn_global_load_lds((const unsigned*)(gW + (long)(idx - LT) * 64 * ldw + ktn * 32), (__attribute__((address_space(3))) unsigned*)(sbi + TR * 64 + (idx - LT) * 4096), 16, 0, 0);
        }
      }
      __builtin_amdgcn_sched_barrier(0);
    }
    slot = (slot + 1 == NSTAGE) ? 0 : slot + 1;
    islot = (islot + 1 == NSTAGE) ? 0 : islot + 1;
  }
#undef GL_ISSUE
  __syncthreads();
}

__device__ void inproj_tile(const Params& p, int l, int t, char* smem) {
  constexpr int NT = 8;
  const int tm = t / 52, tn = t % 52;
  const int tid = get_tid(), lane = tid & 63, wid = tid >> 6, wr = wid >> 1, wc = wid & 1, fr = lane & 15, fq = lane >> 4;
  f32x4 acc[4][NT];
#pragma unroll
  for (int a_ = 0; a_ < 4; ++a_)
#pragma unroll
    for (int b_ = 0; b_ < NT; ++b_) acc[a_][b_] = (f32x4){0.f, 0.f, 0.f, 0.f};
  gemm_glds<NT, 3>(acc, p.U() + (size_t)tm * (NT * 32) * 1024, 1024, p.wt_in() + (size_t)l * NWT * 1024 + (size_t)tn * 128 * 1024, 1024, 1024, smem);
  const int g = tn >> 2;
  bf16_t* dst = PRG(g);
#pragma unroll
  for (int ni = 0; ni < NT; ++ni) {
    const int row = tm * (NT * 32) + wr * (NT * 16) + ni * 16 + fr;
    const bool samp = row >= NPROMPT;
    const int rr = samp ? row - NPROMPT : row;
    const int b = samp ? (rr >> 6) : (rr >> 13), tt = samp ? (rr & 63) : (rr & 8191), T = samp ? 64 : 8192, NB = samp ? 8 : 2;
#pragma unroll
    for (int m = 0; m < 2; ++m) {
      const int cg_ = (tn & 3) * 128 + wc * 64 + m * 32 + fq * 8;
      const f32x4 v0 = acc[2 * m][ni], v1 = acc[2 * m + 1][ni];
      u32x4 pk; pk.x = pack2(v0[0], v0[1]); pk.y = pack2(v0[2], v0[3]); pk.z = pack2(v1[0], v1[1]); pk.w = pack2(v1[2], v1[3]);
      *(u32x4*)(dst + (size_t)row * 512 + cg_) = pk;
      if (g == 6 || g == 7) {
        float* o = (g == 6) ? (samp ? p.o_sk() : p.o_pk()) : (samp ? p.o_sv() : p.o_pv());
        const int hh = cg_ >> 7, d = cg_ & 127;
        float* op = o + ((size_t)((l * NB + b) * 4 + hh) * T + tt) * 128 + d;
        *(f32x4*)op = v0; *(f32x4*)(op + 4) = v1;
      } else if (g < 2) {
        if (tt >= T - 3) {
          float* o = samp ? p.o_sconv() : p.o_pconv();
          float* op = o + ((size_t)(l * NB + b) * 3 + (tt - (T - 3))) * 1024 + g * 512 + cg_;
          *(f32x4*)op = v0; *(f32x4*)(op + 4) = v1;
        }
      }
    }
  }
}

struct UnitInfo { int samp, b, h, c, rowbase, seq; };
__device__ __forceinline__ UnitInfo unit_info(int u) {
  UnitInfo i;
  if (u < 1024) { i.samp = 0; i.seq = u >> 7; i.b = i.seq >> 2; i.h = i.seq & 3; i.c = u & 127; i.rowbase = i.b * 8192 + i.c * 64; }
  else { int sq = u - 1024; i.samp = 1; i.seq = sq; i.b = sq >> 2; i.h = sq & 3; i.c = 0; i.rowbase = NPROMPT + i.b * 64; }
  return i;
}

__device__ void sb_unit(const Params& p, int l, int u, char* smem) {
  bf16_t* Qs = (bf16_t*)smem;
  bf16_t* Ks = Qs + 64 * 136;
  bf16_t* Vt = Ks + 64 * 136;
  bf16_t* Ps = Vt + 128 * 72;
  const int tid = get_tid(), lane = tid & 63, w = tid >> 6, fr = lane & 15, fq = lane >> 4;
  const UnitInfo ui = unit_info(u);
  const int nblk = ui.samp ? 65 : ui.c + 1;
  const int hc = ui.h * 128;
  __syncthreads();
  ld_tile<bf16_t>(Qs, PRG(5) + (size_t)ui.rowbase * 512 + hc, 512, tid);
  f32x4 o[8][1];
#pragma unroll
  for (int mi = 0; mi < 8; ++mi) o[mi][0] = (f32x4){0.f, 0.f, 0.f, 0.f};
  float R = 0.f;
  const int tq = 16 * w + fr;
  for (int i = nblk - 1; i >= 0; --i) {
    if (!ui.samp || i == 64) {
      const size_t krow = ui.samp ? (size_t)ui.rowbase : (size_t)ui.b * 8192 + (size_t)i * 64;
      ld_tile<bf16_t>(Ks, PRG(6) + krow * 512 + hc, 512, tid);
      ld_T<bf16_t, 64, 72>(Vt, PRG(7) + krow * 512 + hc, 512, tid);
    } else {
      const size_t off = ((size_t)((l * 8 + ui.b) * 4 + ui.h) * 4096 + (size_t)i * 64) * 128;
      ld_tile<float>(Ks, p.ck + off, 128, tid);
      ld_T<float, 64, 72>(Vt, p.cv + off, 128, tid);
    }
    __syncthreads();
    f32x4 z[4][1];
#pragma unroll
    for (int mi = 0; mi < 4; ++mi) z[mi][0] = (f32x4){0.f, 0.f, 0.f, 0.f};
    wmma<4, 1, 4>(z, Ks, 136, Qs + 16 * w * 136, 136, fr, fq);
    const bool diag = (i == nblk - 1);
    float L[4][4], lsg[4][4], G[4];
#pragma unroll
    for (int mi = 0; mi < 4; ++mi) {
      G[mi] = 0.f;
#pragma unroll
      for (int j = 0; j < 4; ++j) {
        const int kk = mi * 16 + fq * 4 + j;
        const float zz = z[mi][0][j] * 0.08838834764831845f;
        const float sp = softplus(zz);
        const bool valid = !diag || kk < tq;
        L[mi][j] = valid ? -sp : 0.f;
        lsg[mi][j] = valid ? zz - sp : -1e30f;
        G[mi] += L[mi][j];
      }
    }
    float sufm = 0.f;
#pragma unroll
    for (int mi = 3; mi >= 0; --mi) {
      const float g0 = __shfl(G[mi], fr), g1 = __shfl(G[mi], fr + 16), g2 = __shfl(G[mi], fr + 32), g3 = __shfl(G[mi], fr + 48);
      const float later = (fq < 1 ? g1 : 0.f) + (fq < 2 ? g2 : 0.f) + (fq < 3 ? g3 : 0.f);
      const float s3 = R + sufm + later, s2 = s3 + L[mi][3], s1 = s2 + L[mi][2], s0 = s1 + L[mi][1];
      const float a0 = __expf(lsg[mi][0] + s0), a1 = __expf(lsg[mi][1] + s1), a2 = __expf(lsg[mi][2] + s2), a3 = __expf(lsg[mi][3] + s3);
      u32x2 pk; pk.x = pack2(a0, a1); pk.y = pack2(a2, a3);
      *(u32x2*)(Ps + tq * 72 + mi * 16 + fq * 4) = pk;
      sufm += (g0 + g1) + (g2 + g3);
    }
    R += sufm;
    __syncthreads();
    wmma<8, 1, 2>(o, Vt, 72, Ps + 16 * w * 72, 72, fr, fq);
    if (__syncthreads_and(R < -110.f)) break;
  }
  const size_t row = (size_t)ui.rowbase + tq;
#pragma unroll
  for (int mi = 0; mi < 8; ++mi) {
    const int col = hc + mi * 16 + fq * 4;
    u32x2 zz = *(const u32x2*)(PRG(8) + row * 512 + col);
    f32x4 v = o[mi][0];
    u32x2 pk;
    pk.x = pack2(v[0] * silu(lo2f(zz.x)), v[1] * silu(hi2f(zz.x)));
    pk.y = pack2(v[2] * silu(lo2f(zz.y)), v[3] * silu(hi2f(zz.y)));
    *(u32x2*)(p.H() + (size_t)1 * NTOK * 512 + row * 512 + col) = pk;
  }
}

__device__ void mlstm_local(const Params& p, int l, int u, char* smem) {
  bf16_t* kdT = (bf16_t*)smem;
  bf16_t* vT = kdT + 128 * 72;
  bf16_t* xq = vT + 128 * 72;
  bf16_t* xk = xq + 67 * 136;
  float* dec = (float*)(xk + 67 * 136);
  const int tid = get_tid(), lane = tid & 63, w = tid >> 6, fr = lane & 15, fq = lane >> 4;
  const UnitInfo ui = unit_info(u);
  const int hc = ui.h * 128;
  __syncthreads();
  if (w == 0) {
    const float lfv = p.lf()[(ui.rowbase + lane) * 4 + ui.h], igv = p.ig()[(ui.rowbase + lane) * 4 + ui.h];
    float bs = lfv;
#pragma unroll
    for (int o = 1; o < 64; o <<= 1) { float t = __shfl_up(bs, o); if (lane >= o) bs += t; }
    const float g = igv - bs;
    float gm = g;
#pragma unroll
    for (int o = 32; o > 0; o >>= 1) gm = fmaxf(gm, __shfl_xor(gm, o));
    const float bL = __shfl(bs, 63);
    dec[lane] = __expf(g - gm);
    if (lane == 0) { p.ac()[u] = bL + gm; p.Bc()[u] = bL; }
  }
  ld_tile<bf16_t>(xq + 3 * 136, PRG(0) + (size_t)ui.rowbase * 512 + hc, 512, tid);
  ld_tile<bf16_t>(xk + 3 * 136, PRG(1) + (size_t)ui.rowbase * 512 + hc, 512, tid);
  ld_T<bf16_t, 64, 72>(vT, PRG(2) + (size_t)ui.rowbase * 512 + hc, 512, tid);
  {
    const int isk = tid >> 7, ch = tid & 127, col = hc + ch;
    bf16_t* xs = isk ? xk : xq;
    if (ui.samp) {
      const float* cs = p.st_conv + (size_t)(l * 8 + ui.b) * 3072 + isk * 512 + col;
      xs[ch] = f2bf(cs[0]); xs[136 + ch] = f2bf(cs[1024]); xs[272 + ch] = f2bf(cs[2048]);
    } else if (ui.c > 0) {
      const bf16_t* src = PRG(isk) + (size_t)ui.rowbase * 512 + col;
      xs[ch] = src[-3 * 512]; xs[136 + ch] = src[-2 * 512]; xs[272 + ch] = src[-1 * 512];
    } else { xs[ch] = 0; xs[136 + ch] = 0; xs[272 + ch] = 0; }
  }
  __syncthreads();
  {
    const int isk = tid >> 7, ch = tid & 127, col = hc + ch;
    bf16_t* xs = isk ? xk : xq;
    const float* wc_ = p.w_conv + (size_t)l * 4096 + isk * 512 + col;
    const float w0 = wc_[0], w1 = wc_[1024], w2 = wc_[2048], w3 = wc_[3072];
    float x0 = bf2f(xs[ch]), x1 = bf2f(xs[136 + ch]), x2 = bf2f(xs[272 + ch]);
#pragma unroll 8
    for (int t = 0; t < 64; ++t) {
      const float x3 = bf2f(xs[(t + 3) * 136 + ch]);
      float y = silu(w0 * x0 + w1 * x1 + w2 * x2 + w3 * x3);
      if (isk) y *= 0.08838834764831845f;
      const bf16_t yb = f2bf(y);
      xs[t * 136 + ch] = yb;
      if (isk) kdT[ch * 72 + t] = f2bf(bf2f(yb) * dec[t]);
      x0 = x1; x1 = x2; x2 = x3;
    }
  }
  __syncthreads();
#pragma unroll
  for (int i = 0; i < 4; ++i) {
    const int id = tid + 256 * i, r = id >> 4, c = (id & 15) * 8;
    *(u32x4*)(p.QC() + (size_t)(ui.rowbase + r) * 512 + hc + c) = *(const u32x4*)(xq + r * 136 + c);
    *(u32x4*)(p.KC() + (size_t)(ui.rowbase + r) * 512 + hc + c) = *(const u32x4*)(xk + r * 136 + c);
  }
  if (tid < 128) { float s_ = 0.f;
#pragma unroll 8
    for (int t = 0; t < 64; ++t) s_ += bf2f(kdT[tid * 72 + t]); p.nloc()[u * 128 + tid] = s_; }
  f32x4 acc[8][2];
#pragma unroll
  for (int a_ = 0; a_ < 8; ++a_) { acc[a_][0] = (f32x4){0.f, 0.f, 0.f, 0.f}; acc[a_][1] = (f32x4){0.f, 0.f, 0.f, 0.f}; }
  wmma<8, 2, 2>(acc, kdT, 72, vT + 32 * w * 72, 72, fr, fq);
  bf16_t* sm = p.SM() + (size_t)u * 16384;
#pragma unroll
  for (int mi = 0; mi < 8; ++mi)
#pragma unroll
    for (int ni = 0; ni < 2; ++ni) {
      u32x2 pk; pk.x = pack2(acc[mi][ni][0], acc[mi][ni][1]); pk.y = pack2(acc[mi][ni][2], acc[mi][ni][3]);
      *(u32x2*)(sm + (32 * w + ni * 16 + fr) * 128 + mi * 16 + fq * 4) = pk;
    }
}

__device__ __forceinline__ float hgrn_lb(const Params& p, int l, int ch512) {
  if (l == 0) return 0.f;
  return sigm(p.lb_logits[512 + ch512] - p.lb_logits[ch512]);
}
__device__ __forceinline__ void hgrn_gate(float f, float lb, float& lg, float& kh) {
  const float e = __expf(-fabsf(f));
  const float sp = f >= 0.f ? 1.f / (1.f + e) : e / (1.f + e);
  const float sn = f >= 0.f ? e / (1.f + e) : 1.f / (1.f + e);
  lg = (lb == 0.f) ? (fminf(f, 0.f) - __logf(1.f + e)) : __logf(lb + (1.f - lb) * sp);
  kh = (1.f - lb) * sn;
}

__device__ void hgrn_local(const Params& p, int l, int u, char* smem) {
  bf16_t* kdT = (bf16_t*)smem;
  bf16_t* iT = kdT + 128 * 72;
  bf16_t* fs = iT + 128 * 72;
  float* tot = (float*)(fs + 64 * 136);
  const int tid = get_tid(), lane = tid & 63, w = tid >> 6, fr = lane & 15, fq = lane >> 4;
  const UnitInfo ui = unit_info(u);
  const int hc = ui.h * 128;
  __syncthreads();
  ld_tile<bf16_t>(fs, PRG(10) + (size_t)ui.rowbase * 512 + hc, 512, tid);
  ld_T<bf16_t, 64, 72>(iT, PRG(11) + (size_t)ui.rowbase * 512 + hc, 512, tid);
  const int half = tid >> 7, ch = tid & 127;
  const float lb = hgrn_lb(p, l, hc + ch);
  __syncthreads();
  const bf16_t* src = fs + (half * 32) * 136 + ch;
  {
    float run = 0.f;
#pragma unroll 8
    for (int t = 0; t < 32; ++t) { float lg, kh; hgrn_gate(bf2f(src[t * 136]), lb, lg, kh); run += lg; }
    tot[half * 128 + ch] = run;
  }
  __syncthreads();
  {
    const float t0 = tot[ch], t1 = tot[128 + ch];
    const float bcL = t0 + t1;
    float run = half ? t0 : 0.f;
#pragma unroll 8
    for (int t = 0; t < 32; ++t) {
      float lg, kh; hgrn_gate(bf2f(src[t * 136]), lb, lg, kh); run += lg;
      kdT[ch * 72 + half * 32 + t] = f2bf(kh * __expf(bcL - run));
    }
    if (half == 0) p.hbc()[u * 128 + ch] = bcL;
  }
  __syncthreads();
  f32x4 acc[8][2];
#pragma unroll
  for (int a_ = 0; a_ < 8; ++a_) { acc[a_][0] = (f32x4){0.f, 0.f, 0.f, 0.f}; acc[a_][1] = (f32x4){0.f, 0.f, 0.f, 0.f}; }
  wmma<8, 2, 2>(acc, kdT, 72, iT + 32 * w * 72, 72, fr, fq);
  bf16_t* sh = p.SH() + (size_t)u * 16384;
#pragma unroll
  for (int mi = 0; mi < 8; ++mi)
#pragma unroll
    for (int ni = 0; ni < 2; ++ni) {
      u32x2 pk; pk.x = pack2(acc[mi][ni][0], acc[mi][ni][1]); pk.y = pack2(acc[mi][ni][2], acc[mi][ni][3]);
      *(u32x2*)(sh + (32 * w + ni * 16 + fr) * 128 + mi * 16 + fq * 4) = pk;
    }
}

__device__ void scan_phase(const Params& p, int l, char* smem) {
  float* cdc = (float*)smem;
  float* cwl = cdc + 128;
  float* cmi = cwl + 128;
  const int tid = get_tid();
  for (int vb = blockIdx.x; vb < 520; vb += gridDim.x) {
    const int kind = vb >> 8;
    const int seq = (kind == 2) ? (vb - 512) : ((vb >> 5) & 7);
    __syncthreads();
    if (kind != 1) {
      if (tid < 128) { cdc[tid] = p.ac()[seq * 128 + tid]; cwl[tid] = p.Bc()[seq * 128 + tid]; }
      __syncthreads();
      if (tid == 0) {
        float m = 0.f;
        for (int c = 0; c < 128; ++c) {
          const float a = cdc[c], B = cwl[c];
          const float mo = fmaxf(a, B + m);
          cdc[c] = __expf(B + m - mo); cwl[c] = __expf(a - mo); cmi[c] = m; m = mo;
        }
        if (kind == 0 && (vb & 31) == 0) p.o_pm()[l * 8 + seq] = m;
      }
      __syncthreads();
      if (kind == 0 && (vb & 31) == 0 && tid < 128) p.min_()[seq * 128 + tid] = cmi[tid];
    }
    if (kind == 2) {
      if (tid < 128) {
        float n = 0.f;
        float* base = p.nloc() + (size_t)seq * 128 * 128 + tid;
        for (int c0 = 0; c0 < 128; c0 += 16) {
          float lv[16];
#pragma unroll
          for (int j = 0; j < 16; ++j) lv[j] = base[(c0 + j) * 128];
#pragma unroll
          for (int j = 0; j < 16; ++j) { const float nl = lv[j]; lv[j] = n; n = cdc[c0 + j] * n + cwl[c0 + j] * nl; }
#pragma unroll
          for (int j = 0; j < 16; ++j) base[(c0 + j) * 128] = lv[j];
        }
        p.o_pn()[(l * 8 + seq) * 128 + tid] = n;
      }
      continue;
    }
    const int pr = (vb & 31) * 256 + tid, e = pr * 2, er = e >> 7, ec = e & 127;
    unsigned* base = (unsigned*)((kind ? p.SH() : p.SM()) + (size_t)seq * 128 * 16384) + pr;
    const float* hb = p.hbc() + (size_t)seq * 128 * 128 + ec;
    float c0v = 0.f, c1v = 0.f;
    unsigned lv[16], nx[16];
    float2 hv[16], hn[16];
#pragma unroll
    for (int j = 0; j < 16; ++j) { nx[j] = base[(size_t)j * 8192]; hn[j] = kind ? *(const float2*)(hb + j * 128) : make_float2(0.f, 0.f); }
    for (int c0 = 0; c0 < 128; c0 += 16) {
#pragma unroll
      for (int j = 0; j < 16; ++j) { lv[j] = nx[j]; hv[j] = hn[j]; }
      if (c0 + 16 < 128) {
#pragma unroll
        for (int j = 0; j < 16; ++j) { nx[j] = base[(size_t)(c0 + 16 + j) * 8192]; if (kind) hn[j] = *(const float2*)(hb + (c0 + 16 + j) * 128); }
      }
#pragma unroll
      for (int j = 0; j < 16; ++j) {
        const unsigned v = lv[j];
        lv[j] = pack2(c0v, c1v);
        const float d0 = kind ? __expf(hv[j].x) : cdc[c0 + j];
        const float d1 = kind ? __expf(hv[j].y) : d0;
        const float wl = kind ? 1.f : cwl[c0 + j];
        c0v = d0 * c0v + wl * lo2f(v); c1v = d1 * c1v + wl * hi2f(v);
      }
#pragma unroll
      for (int j = 0; j < 16; ++j) base[(size_t)(c0 + j) * 8192] = lv[j];
    }
    float* o = (kind ? p.o_pS() : p.o_pC()) + (size_t)(l * 8 + seq) * 16384;
    o[ec * 128 + er] = c0v; o[(ec + 1) * 128 + er] = c1v;
  }
  const int gt = blockIdx.x * 256 + tid, nth = gridDim.x * 256;
  for (int it = gt; it < 524288; it += nth) {
    const int kind = it >> 18, sq = (it >> 13) & 31, pr = it & 8191, e = pr * 2, u = 1024 + sq, er = e >> 7, ec = e & 127;
    if (kind == 0) {
      const float* c0p = p.st_C + (size_t)(l * 32 + sq) * 16384;
      const float C0 = c0p[ec * 128 + er], C1 = c0p[(ec + 1) * 128 + er], m = p.st_m[l * 32 + sq];
      unsigned* slot = (unsigned*)(p.SM() + (size_t)u * 16384) + pr;
      const unsigned lv = *slot;
      const float a = p.ac()[u], B = p.Bc()[u];
      const float mo = fmaxf(a, B + m), dc = __expf(B + m - mo), wl = __expf(a - mo);
      *slot = pack2(C0, C1);
      float* o = p.o_sC() + (size_t)(l * 32 + sq) * 16384;
      o[ec * 128 + er] = dc * C0 + wl * lo2f(lv); o[(ec + 1) * 128 + er] = dc * C1 + wl * hi2f(lv);
      if (pr == 0) { p.min_()[u] = m; p.o_sm()[l * 32 + sq] = mo; }
    } else {
      const float* s0p = p.st_S + (size_t)(l * 32 + sq) * 16384;
      const float S0 = s0p[ec * 128 + er], S1 = s0p[(ec + 1) * 128 + er];
      unsigned* slot = (unsigned*)(p.SH() + (size_t)u * 16384) + pr;
      const unsigned lv = *slot;
      const float d0 = __expf(p.hbc()[u * 128 + ec]), d1 = __expf(p.hbc()[u * 128 + ec + 1]);
      *slot = pack2(S0, S1);
      float* o = p.o_sS() + (size_t)(l * 32 + sq) * 16384;
      o[ec * 128 + er] = d0 * S0 + lo2f(lv); o[(ec + 1) * 128 + er] = d1 * S1 + hi2f(lv);
    }
  }
  for (int it = gt; it < 4096; it += nth) {
    const int sq = it >> 7, d = it & 127, u = 1024 + sq;
    const float n0 = p.st_n[(l * 32 + sq) * 128 + d], m = p.st_m[l * 32 + sq];
    const float a = p.ac()[u], B = p.Bc()[u];
    const float mo = fmaxf(a, B + m), dc = __expf(B + m - mo), wl = __expf(a - mo);
    const float nl = p.nloc()[u * 128 + d];
    p.nloc()[u * 128 + d] = n0;
    p.o_sn()[(l * 32 + sq) * 128 + d] = dc * n0 + wl * nl;
  }
}

__device__ void mlstm_out(const Params& p, int l, int u, char* smem) {
  bf16_t* Qs = (bf16_t*)smem;
  bf16_t* CT = Qs + 64 * 136;
  bf16_t* Ks = CT;
  bf16_t* Vt = Ks + 64 * 136;
  bf16_t* Ps = Vt + 144 * 72;
  float* misc = (float*)(smem + 17408 + 47360);
  float *bsum = misc, *gs = misc + 64, *mt = misc + 128, *wint = misc + 192;
  const int tid = get_tid(), lane = tid & 63, w = tid >> 6, fr = lane & 15, fq = lane >> 4;
  const UnitInfo ui = unit_info(u);
  const int hc = ui.h * 128;
  __syncthreads();
  if (w == 0) {
    const float lfv = p.lf()[(ui.rowbase + lane) * 4 + ui.h], igv = p.ig()[(ui.rowbase + lane) * 4 + ui.h];
    float bs = lfv;
#pragma unroll
    for (int o = 1; o < 64; o <<= 1) { float t = __shfl_up(bs, o); if (lane >= o) bs += t; }
    const float g = igv - bs;
    float cm = g;
#pragma unroll
    for (int o = 1; o < 64; o <<= 1) { float t = __shfl_up(cm, o); if (lane >= o) cm = fmaxf(cm, t); }
    const float m_in = p.min_()[u];
    const float mtt = bs + fmaxf(cm, m_in);
    bsum[lane] = bs; gs[lane] = g; mt[lane] = mtt; wint[lane] = __expf(bs + m_in - mtt);
  }
  ld_tile<bf16_t>(Qs, p.QC() + (size_t)ui.rowbase * 512 + hc, 512, tid);
  ld_tile128<bf16_t>(CT, p.SM() + (size_t)u * 16384, 128, tid);
  if (tid < 128) CT[128 * 136 + tid] = f2bf(p.nloc()[u * 128 + tid]);
  for (int i = tid; i < 15 * 128; i += 256) CT[(129 + (i >> 7)) * 136 + (i & 127)] = 0;
  __syncthreads();
  f32x4 acc[9][1];
#pragma unroll
  for (int mi = 0; mi < 9; ++mi) acc[mi][0] = (f32x4){0.f, 0.f, 0.f, 0.f};
  wmma<9, 1, 4>(acc, CT, 136, Qs + 16 * w * 136, 136, fr, fq);
  const int t = 16 * w + fr;
  const float wi = wint[t];
#pragma unroll
  for (int mi = 0; mi < 9; ++mi) acc[mi][0] *= wi;
  __syncthreads();
  ld_tile<bf16_t>(Ks, p.KC() + (size_t)ui.rowbase * 512 + hc, 512, tid);
  ld_T<bf16_t, 64, 72>(Vt, PRG(2) + (size_t)ui.rowbase * 512 + hc, 512, tid);
  if (tid < 64) Vt[128 * 72 + tid] = 0x3F80;
  for (int i = tid; i < 15 * 64; i += 256) Vt[(129 + (i >> 6)) * 72 + (i & 63)] = 0;
  __syncthreads();
  f32x4 st[4][1];
#pragma unroll
  for (int mi = 0; mi < 4; ++mi) st[mi][0] = (f32x4){0.f, 0.f, 0.f, 0.f};
  wmma<4, 1, 4>(st, Ks, 136, Qs + 16 * w * 136, 136, fr, fq);
  const float bt = bsum[t], mtt = mt[t];
#pragma unroll
  for (int mi = 0; mi < 4; ++mi) {
    float a[4];
#pragma unroll
    for (int j = 0; j < 4; ++j) {
      const int s = mi * 16 + fq * 4 + j;
      a[j] = (s <= t) ? st[mi][0][j] * __expf(bt + gs[s] - mtt) : 0.f;
    }
    u32x2 pk; pk.x = pack2(a[0], a[1]); pk.y = pack2(a[2], a[3]);
    *(u32x2*)(Ps + t * 72 + mi * 16 + fq * 4) = pk;
  }
  __syncthreads();
  wmma<9, 1, 2>(acc, Vt, 72, Ps + 16 * w * 72, 72, fr, fq);
  const float den = __shfl(acc[8][0][0], fr);
  const float inv = 1.f / fmaxf(fabsf(den), __expf(-mtt));
  float ss = 0.f;
#pragma unroll
  for (int mi = 0; mi < 8; ++mi) { acc[mi][0] *= inv; ss += acc[mi][0][0] * acc[mi][0][0] + acc[mi][0][1] * acc[mi][0][1] + acc[mi][0][2] * acc[mi][0][2] + acc[mi][0][3] * acc[mi][0][3]; }
  ss += __shfl_xor(ss, 16); ss += __shfl_xor(ss, 32);
  const float rs = rsqrtf(ss * (1.f / 128.f) + 1e-6f);
  const size_t row = (size_t)ui.rowbase + t;
#pragma unroll
  for (int mi = 0; mi < 8; ++mi) {
    const int col = hc + mi * 16 + fq * 4;
    const u32x2 ov = *(const u32x2*)(PRG(3) + row * 512 + col);
    const u32x2 zv = *(const u32x2*)(PRG(4) + row * 512 + col);
    const float4 g = *(const float4*)(p.g_ml + l * 512 + col);
    const f32x4 v = acc[mi][0];
    u32x2 pk;
    pk.x = pack2(v[0] * rs * g.x * sigm(lo2f(ov.x)) * silu(lo2f(zv.x)), v[1] * rs * g.y * sigm(hi2f(ov.x)) * silu(hi2f(zv.x)));
    pk.y = pack2(v[2] * rs * g.z * sigm(lo2f(ov.y)) * silu(lo2f(zv.y)), v[3] * rs * g.w * sigm(hi2f(ov.y)) * silu(hi2f(zv.y)));
    *(u32x2*)(p.H() + row * 512 + col) = pk;
  }
}

__device__ __forceinline__ bf16x8 scale_frag(const bf16_t* src, const float* ea, const float* eb, float sgn, bool clampit) {
  u32x4 raw = *(const u32x4*)src;
  float4 a0 = *(const float4*)ea, a1 = *(const float4*)(ea + 4);
  float4 b0 = {0.f, 0.f, 0.f, 0.f}, b1 = {0.f, 0.f, 0.f, 0.f};
  if (eb) { b0 = *(const float4*)eb; b1 = *(const float4*)(eb + 4); }
  float e[8] = {a0.x - b0.x, a0.y - b0.y, a0.z - b0.z, a0.w - b0.w, a1.x - b1.x, a1.y - b1.y, a1.z - b1.z, a1.w - b1.w};
  float v[8] = {lo2f(raw.x), hi2f(raw.x), lo2f(raw.y), hi2f(raw.y), lo2f(raw.z), hi2f(raw.z), lo2f(raw.w), hi2f(raw.w)};
  unsigned o[4];
#pragma unroll
  for (int i = 0; i < 4; ++i) {
    float x0 = sgn * e[2 * i], x1 = sgn * e[2 * i + 1];
    if (clampit) { x0 = fminf(x0, 80.f); x1 = fminf(x1, 80.f); }
    o[i] = pack2(v[2 * i] * __expf(x0), v[2 * i + 1] * __expf(x1));
  }
  u32x4 r = {o[0], o[1], o[2], o[3]};
  return __builtin_bit_cast(bf16x8, r);
}

__device__ void hgrn_out(const Params& p, int l, int u, char* smem) {
  float* bc = (float*)smem;
  bf16_t* ST = (bf16_t*)smem;
  bf16_t* qs = (bf16_t*)(smem + 34816);
  bf16_t* kh = (bf16_t*)(smem + 34816 + 17408);
  bf16_t* iT = kh;
  bf16_t* Ps = (bf16_t*)(smem + 34816 + 17408 + 18432);
  float* tot = (float*)(smem + 79872);
  const int tid = get_tid(), lane = tid & 63, w = tid >> 6, fr = lane & 15, fq = lane >> 4;
  const UnitInfo ui = unit_info(u);
  const int hc = ui.h * 128;
  __syncthreads();
  ld_tile<bf16_t>(qs, PRG(9) + (size_t)ui.rowbase * 512 + hc, 512, tid);
  ld_tile<bf16_t>(kh, PRG(10) + (size_t)ui.rowbase * 512 + hc, 512, tid);
  __syncthreads();
  {
    const int half = tid >> 7, ch = tid & 127;
    const float lb = hgrn_lb(p, l, hc + ch);
    bf16_t* src = kh + (half * 32) * 136 + ch;
    float run = 0.f;
#pragma unroll 8
    for (int t = 0; t < 32; ++t) { float lg, k; hgrn_gate(bf2f(src[t * 136]), lb, lg, k); run += lg; }
    tot[half * 128 + ch] = run;
    __syncthreads();
    run = half ? tot[ch] : 0.f;
#pragma unroll 8
    for (int t = 0; t < 32; ++t) {
      float lg, k; hgrn_gate(bf2f(src[t * 136]), lb, lg, k); run += lg;
      bc[(half * 32 + t) * 132 + ch] = run;
      src[t * 136] = f2bf(k);
    }
  }
  __syncthreads();
  {
    const int I = w, t = 16 * I + fr;
    f32x4 a[4];
#pragma unroll
    for (int J = 0; J < 4; ++J) a[J] = (f32x4){0.f, 0.f, 0.f, 0.f};
#pragma unroll
    for (int kk = 0; kk < 4; ++kk) {
      const int c0 = kk * 32 + fq * 8;
      const float* rI = (I > 0) ? bc + (16 * I - 1) * 132 + c0 : nullptr;
      const bf16x8 bq = scale_frag(qs + t * 136 + c0, bc + t * 132 + c0, rI, 1.f, false);
#pragma unroll
      for (int J = 0; J < 4; ++J) {
        if (J <= I) {
          const int s = 16 * J + fr;
          const bf16x8 ak = scale_frag(kh + s * 136 + c0, bc + s * 132 + c0, rI, -1.f, true);
          a[J] = __builtin_amdgcn_mfma_f32_16x16x32_bf16(ak, bq, a[J], 0, 0, 0);
        }
      }
    }
#pragma unroll
    for (int J = 0; J < 4; ++J) {
      float v[4];
#pragma unroll
      for (int j = 0; j < 4; ++j) { const int s = 16 * J + fq * 4 + j; v[j] = (s <= t) ? a[J][j] : 0.f; }
      u32x2 pk; pk.x = pack2(v[0], v[1]); pk.y = pack2(v[2], v[3]);
      *(u32x2*)(Ps + t * 72 + J * 16 + fq * 4) = pk;
    }
  }
  __syncthreads();
#pragma unroll 4
  for (int i = tid; i < 64 * 128; i += 256) { const int t = i >> 7, c = i & 127; qs[t * 136 + c] = f2bf(bf2f(qs[t * 136 + c]) * __expf(bc[t * 132 + c])); }
  __syncthreads();
  ld_T<bf16_t, 64, 72>(iT, PRG(11) + (size_t)ui.rowbase * 512 + hc, 512, tid);
  ld_tile128<bf16_t>(ST, p.SH() + (size_t)u * 16384, 128, tid);
  __syncthreads();
  f32x4 acc[8][1];
#pragma unroll
  for (int mi = 0; mi < 8; ++mi) acc[mi][0] = (f32x4){0.f, 0.f, 0.f, 0.f};
  wmma<8, 1, 2>(acc, iT, 72, Ps + 16 * w * 72, 72, fr, fq);
  wmma<8, 1, 4>(acc, ST, 136, qs + 16 * w * 136, 136, fr, fq);
  float ss = 0.f;
#pragma unroll
  for (int mi = 0; mi < 8; ++mi) ss += acc[mi][0][0] * acc[mi][0][0] + acc[mi][0][1] * acc[mi][0][1] + acc[mi][0][2] * acc[mi][0][2] + acc[mi][0][3] * acc[mi][0][3];
  ss += __shfl_xor(ss, 16); ss += __shfl_xor(ss, 32);
  const float rs = rsqrtf(ss * (1.f / 128.f) + 1e-6f);
  const size_t row = (size_t)ui.rowbase + 16 * w + fr;
#pragma unroll
  for (int mi = 0; mi < 8; ++mi) {
    const int col = hc + mi * 16 + fq * 4;
    const u32x2 zv = *(const u32x2*)(PRG(12) + row * 512 + col);
    const float4 g = *(const float4*)(p.g_hg + l * 512 + col);
    const f32x4 v = acc[mi][0];
    u32x2 pk;
    pk.x = pack2(v[0] * rs * g.x * silu(lo2f(zv.x)), v[1] * rs * g.y * silu(hi2f(zv.x)));
    pk.y = pack2(v[2] * rs * g.z * silu(lo2f(zv.y)), v[3] * rs * g.w * silu(hi2f(zv.y)));
    *(u32x2*)(p.H() + (size_t)2 * NTOK * 512 + row * 512 + col) = pk;
  }
}

__device__ void merge_tile(const Params& p, int l, int t, char* smem) {
  const int tm = t >> 3, tn = t & 7;
  const int tid = get_tid(), lane = tid & 63, wid = tid >> 6, wr = wid >> 1, wc = wid & 1, fr = lane & 15, fq = lane >> 4;
#pragma unroll 1
  for (int b = 0; b < 3; ++b) {
    f32x4 acc[4][4]; zero_acc(acc);
    gemm_kloop<bf16_t>(acc, p.U() + (size_t)tm * 128 * 1024, 1024, p.wt_in() + (size_t)l * NWT * 1024 + (size_t)(NMAIN + b * 1024 + tn * 128) * 1024, 1024, 1024, smem);
#pragma unroll
    for (int ni = 0; ni < 4; ++ni)
#pragma unroll
      for (int mi = 0; mi < 4; ++mi) {
        f32x4 v; v[0] = sigm(acc[mi][ni][0]); v[1] = sigm(acc[mi][ni][1]); v[2] = sigm(acc[mi][ni][2]); v[3] = sigm(acc[mi][ni][3]);
        *(f32x4*)(p.r() + ((size_t)tm * 128 + wr * 64 + ni * 16 + fr) * 1024 + tn * 128 + wc * 64 + mi * 16 + fq * 4) = v;
      }
    zero_acc(acc);
    gemm_kloop<bf16_t>(acc, p.H() + (size_t)b * NTOK * 512 + (size_t)tm * 128 * 512, 512, p.wt_br() + (size_t)(l * 3 + b) * 1024 * 512 + (size_t)tn * 128 * 512, 512, 512, smem);
#pragma unroll
    for (int ni = 0; ni < 4; ++ni) {
      const size_t row = (size_t)tm * 128 + wr * 64 + ni * 16 + fr;
#pragma unroll
      for (int mi = 0; mi < 4; ++mi) {
        const int col = tn * 128 + wc * 64 + mi * 16 + fq * 4;
        f32x4 v = *(const f32x4*)(p.r() + row * 1024 + col) * acc[mi][ni];
        float* part = p.y() + row * 1024 + col;
        if (b > 0) v += *(const f32x4*)part;
        if (b < 2) *(f32x4*)part = v;
        else { u32x2 pk; pk.x = pack2(v[0], v[1]); pk.y = pack2(v[2], v[3]); *(u32x2*)(p.merged() + row * 1024 + col) = pk; }
      }
    }
  }
}

__device__ void outproj_tile(const Params& p, int l, int t, char* smem) {
  const int tm = t >> 3, tn = t & 7;
  const int tid = get_tid(), lane = tid & 63, wid = tid >> 6, wr = wid >> 1, wc = wid & 1, fr = lane & 15, fq = lane >> 4;
  f32x4 acc[4][4]; zero_acc(acc);
  gemm_kloop<bf16_t>(acc, p.merged() + (size_t)tm * 128 * 1024, 1024, p.wt_out() + (size_t)l * 1048576 + (size_t)tn * 128 * 1024, 1024, 1024, smem);
#pragma unroll
  for (int ni = 0; ni < 4; ++ni) {
    const size_t row = (size_t)tm * 128 + wr * 64 + ni * 16 + fr;
#pragma unroll
    for (int mi = 0; mi < 4; ++mi) *(f32x4*)(p.y() + row * 1024 + tn * 128 + wc * 64 + mi * 16 + fq * 4) = acc[mi][ni];
  }
}


__device__ void outproj_tile256(const Params& p, int l, int t, char* smem) {
  constexpr int NT = 8;
  const int tm = t >> 3, tn = t & 7;
  const int tid = get_tid(), lane = tid & 63, wid = tid >> 6, wr = wid >> 1, wc = wid & 1, fr = lane & 15, fq = lane >> 4;
  f32x4 acc[4][NT];
#pragma unroll
  for (int a_ = 0; a_ < 4; ++a_)
#pragma unroll
    for (int b_ = 0; b_ < NT; ++b_) acc[a_][b_] = (f32x4){0.f, 0.f, 0.f, 0.f};
  gemm_glds<NT, 3>(acc, p.merged() + (size_t)tm * 256 * 1024, 1024, p.wt_out() + (size_t)l * 1048576 + (size_t)tn * 128 * 1024, 1024, 1024, smem);
#pragma unroll
  for (int ni = 0; ni < NT; ++ni) {
    const size_t row = (size_t)tm * 256 + wr * 128 + ni * 16 + fr;
#pragma unroll
    for (int m = 0; m < 2; ++m) {
      float* op = p.y() + row * 1024 + tn * 128 + wc * 64 + m * 32 + fq * 8;
      *(f32x4*)op = acc[2 * m][ni]; *(f32x4*)(op + 4) = acc[2 * m + 1][ni];
    }
  }
}


__device__ void gate_tile256(const Params& p, int l, int t, char* smem) {
  constexpr int NT = 8;
  const int tm = t / 24, tn = t % 24;
  const int tid = get_tid(), lane = tid & 63, wid = tid >> 6, wr = wid >> 1, wc = wid & 1, fr = lane & 15, fq = lane >> 4;
  f32x4 acc[4][NT];
#pragma unroll
  for (int a_ = 0; a_ < 4; ++a_)
#pragma unroll
    for (int b_ = 0; b_ < NT; ++b_) acc[a_][b_] = (f32x4){0.f, 0.f, 0.f, 0.f};
  gemm_glds<NT, 3>(acc, p.U() + (size_t)tm * 256 * 1024, 1024, p.wt_in() + (size_t)l * NWT * 1024 + (size_t)(NMAIN + tn * 128) * 1024, 1024, 1024, smem);
#pragma unroll
  for (int ni = 0; ni < NT; ++ni) {
    const size_t row = (size_t)tm * 256 + wr * 128 + ni * 16 + fr;
#pragma unroll
    for (int m = 0; m < 2; ++m) {
      const f32x4 v0 = acc[2 * m][ni], v1 = acc[2 * m + 1][ni];
      u32x4 pk; pk.x = pack2(sigm(v0[0]), sigm(v0[1])); pk.y = pack2(sigm(v0[2]), sigm(v0[3])); pk.z = pack2(sigm(v1[0]), sigm(v1[1])); pk.w = pack2(sigm(v1[2]), sigm(v1[3]));
      *(u32x4*)(p.Gb(tn >> 3) + row * 1024 + (tn & 7) * 128 + wc * 64 + m * 32 + fq * 8) = pk;
    }
  }
}
__device__ void merge_tile_g(const Params& p, int l, int t, char* smem) {
  const int tm = t >> 3, tn = t & 7;
  const int tid = get_tid(), lane = tid & 63, wid = tid >> 6, wr = wid >> 1, wc = wid & 1, fr = lane & 15, fq = lane >> 4;
  f32x4 macc[4][4]; zero_acc(macc);
#pragma unroll 1
  for (int b = 0; b < 3; ++b) {
    f32x4 acc[4][4]; zero_acc(acc);
    gemm_kloop<bf16_t>(acc, p.H() + (size_t)b * NTOK * 512 + (size_t)tm * 128 * 512, 512, p.wt_br() + (size_t)(l * 3 + b) * 1024 * 512 + (size_t)tn * 128 * 512, 512, 512, smem);
#pragma unroll
    for (int ni = 0; ni < 4; ++ni) {
      const size_t row = (size_t)tm * 128 + wr * 64 + ni * 16 + fr;
#pragma unroll
      for (int mi = 0; mi < 4; ++mi) {
        const u32x2 g = *(const u32x2*)(p.Gb(b) + row * 1024 + tn * 128 + wc * 64 + mi * 16 + fq * 4);
        macc[mi][ni][0] += lo2f(g.x) * acc[mi][ni][0]; macc[mi][ni][1] += hi2f(g.x) * acc[mi][ni][1];
        macc[mi][ni][2] += lo2f(g.y) * acc[mi][ni][2]; macc[mi][ni][3] += hi2f(g.y) * acc[mi][ni][3];
      }
    }
  }
#pragma unroll
  for (int ni = 0; ni < 4; ++ni) {
    const size_t row = (size_t)tm * 128 + wr * 64 + ni * 16 + fr;
#pragma unroll
    for (int mi = 0; mi < 4; ++mi) {
      u32x2 pk; pk.x = pack2(macc[mi][ni][0], macc[mi][ni][1]); pk.y = pack2(macc[mi][ni][2], macc[mi][ni][3]);
      *(u32x2*)(p.merged() + row * 1024 + tn * 128 + wc * 64 + mi * 16 + fq * 4) = pk;
    }
  }
}

__device__ void postnorm_phase(const Params& p, int l) {
  const int lane = threadIdx.x & 63, wid = threadIdx.x >> 6;
  const float* gp = p.g_post + l * 1024;
  for (int row = blockIdx.x * 4 + wid; row < NTOK; row += gridDim.x * 4) {
    const float* x = xrow(p, l, row);
    const float* y = p.y() + (size_t)row * 1024;
    float4 v[4]; float ss = 0.f;
#pragma unroll
    for (int i = 0; i < 4; ++i) { v[i] = *(const float4*)(y + i * 256 + lane * 4); ss += v[i].x * v[i].x + v[i].y * v[i].y + v[i].z * v[i].z + v[i].w * v[i].w; }
#pragma unroll
    for (int o = 32; o > 0; o >>= 1) ss += __shfl_xor(ss, o);
    const float rstd = rsqrtf(ss * (1.f / 1024.f) + 1e-6f);
#pragma unroll
    for (int i = 0; i < 4; ++i) {
      const int k = i * 256 + lane * 4;
      const float4 g = *(const float4*)(gp + k), xv = *(const float4*)(x + k);
      float4 r; r.x = xv.x + v[i].x * rstd * g.x; r.y = xv.y + v[i].y * rstd * g.y; r.z = xv.z + v[i].z * rstd * g.z; r.w = xv.w + v[i].w * rstd * g.w;
      u32x2 pk; pk.x = pack2(r.x, r.y); pk.y = pack2(r.z, r.w);
      *(u32x2*)(p.rb() + (size_t)row * 1024 + k) = pk;
    }
  }
}

__device__ void ple_tile(const Params& p, int l, int t, char* smem) {
  const int tm = t >> 3, tn = t & 7;
  const int tid = get_tid(), lane = tid & 63, wid = tid >> 6, wr = wid >> 1, wc = wid & 1, fr = lane & 15, fq = lane >> 4;
  f32x4 acc[4][4]; zero_acc(acc);
  const int row0 = tm * 128;
  const float* pp = row0 < NPROMPT ? p.p_p + ((size_t)l * NPROMPT + row0) * 256 : p.p_s + ((size_t)l * 512 + (row0 - NPROMPT)) * 256;
  gemm_kloop<float>(acc, pp, 256, p.wt_pp() + (size_t)l * 262144 + (size_t)tn * 128 * 256, 256, 256, smem);
  u32x2 pb[4][4];
#pragma unroll
  for (int a = 0; a < 4; ++a)
#pragma unroll
    for (int c = 0; c < 4; ++c) { pb[a][c].x = pack2(acc[a][c][0], acc[a][c][1]); pb[a][c].y = pack2(acc[a][c][2], acc[a][c][3]); }
  zero_acc(acc);
  gemm_kloop<bf16_t>(acc, p.rb() + (size_t)tm * 128 * 1024, 1024, p.wt_pg() + (size_t)l * 1048576 + (size_t)tn * 128 * 1024, 1024, 1024, smem);
#pragma unroll
  for (int ni = 0; ni < 4; ++ni) {
    const size_t row = (size_t)row0 + wr * 64 + ni * 16 + fr;
#pragma unroll
    for (int mi = 0; mi < 4; ++mi) {
      const int col = tn * 128 + wc * 64 + mi * 16 + fq * 4;
      const u32x2 rbv = *(const u32x2*)(p.rb() + row * 1024 + col);
      const f32x4 rv = {lo2f(rbv.x), hi2f(rbv.x), lo2f(rbv.y), hi2f(rbv.y)};
      f32x4 o;
      o[0] = rv[0] + sigm(acc[mi][ni][0]) * lo2f(pb[mi][ni].x); o[1] = rv[1] + sigm(acc[mi][ni][1]) * hi2f(pb[mi][ni].x);
      o[2] = rv[2] + sigm(acc[mi][ni][2]) * lo2f(pb[mi][ni].y); o[3] = rv[3] + sigm(acc[mi][ni][3]) * hi2f(pb[mi][ni].y);
      *(f32x4*)(p.o_y() + row * 1024 + col) = o;
    }
  }
}


template <typename TT>
__device__ __forceinline__ void mini_dot(f32x4& acc, const TT* Trow, const bf16_t* Wrow, int K) {
#pragma unroll 8
  for (int k = 0; k < K; k += 32) {
    const u32x4 tv = ld8(Trow + k), wv = ld8(Wrow + k);
    acc = __builtin_amdgcn_mfma_f32_16x16x32_bf16(__builtin_bit_cast(bf16x8, wv), __builtin_bit_cast(bf16x8, tv), acc, 0, 0, 0);
  }
}
__device__ void merge_mini(const Params& p, int l, int j) {
  const int tid = get_tid(), lane = tid & 63, w = tid >> 6, fr = lane & 15, fq = lane >> 4;
  const size_t row = (size_t)NPROMPT + (j >> 4) * 16 + fr;
  const int cb = (j & 15) * 64 + w * 16;
  f32x4 out = {0.f, 0.f, 0.f, 0.f};
#pragma unroll 1
  for (int b = 0; b < 3; ++b) {
    f32x4 h = {0.f, 0.f, 0.f, 0.f};
    mini_dot<bf16_t>(h, p.H() + (size_t)b * NTOK * 512 + row * 512 + fq * 8, p.wt_br() + (size_t)(l * 3 + b) * 1024 * 512 + (size_t)(cb + fr) * 512 + fq * 8, 512);
    const u32x2 g = *(const u32x2*)(p.Gb(b) + row * 1024 + cb + fq * 4);
    out[0] += lo2f(g.x) * h[0]; out[1] += hi2f(g.x) * h[1]; out[2] += lo2f(g.y) * h[2]; out[3] += hi2f(g.y) * h[3];
  }
  u32x2 pk; pk.x = pack2(out[0], out[1]); pk.y = pack2(out[2], out[3]);
  *(u32x2*)(p.merged() + row * 1024 + cb + fq * 4) = pk;
}
__device__ void outproj_mini(const Params& p, int l, int j) {
  const int tid = get_tid(), lane = tid & 63, w = tid >> 6, fr = lane & 15, fq = lane >> 4;
  const size_t row = (size_t)NPROMPT + (j >> 4) * 16 + fr;
  const int cb = (j & 15) * 64 + w * 16;
  f32x4 y = {0.f, 0.f, 0.f, 0.f};
  mini_dot<bf16_t>(y, p.merged() + row * 1024 + fq * 8, p.wt_out() + (size_t)l * 1048576 + (size_t)(cb + fr) * 1024 + fq * 8, 1024);
  *(f32x4*)(p.y() + row * 1024 + cb + fq * 4) = y;
}
__device__ void ple_mini(const Params& p, int l, int j) {
  const int tid = get_tid(), lane = tid & 63, w = tid >> 6, fr = lane & 15, fq = lane >> 4;
  const int srow = (j >> 4) * 16 + fr;
  const size_t row = (size_t)NPROMPT + srow;
  const int cb = (j & 15) * 64 + w * 16;
  f32x4 g = {0.f, 0.f, 0.f, 0.f}, pa = {0.f, 0.f, 0.f, 0.f};
  mini_dot<float>(pa, p.p_s + ((size_t)l * 512 + srow) * 256 + fq * 8, p.wt_pp() + (size_t)l * 262144 + (size_t)(cb + fr) * 256 + fq * 8, 256);
  mini_dot<bf16_t>(g, p.rb() + row * 1024 + fq * 8, p.wt_pg() + (size_t)l * 1048576 + (size_t)(cb + fr) * 1024 + fq * 8, 1024);
  const u32x2 rbv = *(const u32x2*)(p.rb() + row * 1024 + cb + fq * 4);
  const f32x4 rv = {lo2f(rbv.x), hi2f(rbv.x), lo2f(rbv.y), hi2f(rbv.y)};
  f32x4 o; o[0] = rv[0] + sigm(g[0]) * pa[0]; o[1] = rv[1] + sigm(g[1]) * pa[1]; o[2] = rv[2] + sigm(g[2]) * pa[2]; o[3] = rv[3] + sigm(g[3]) * pa[3];
  *(f32x4*)(p.o_y() + row * 1024 + cb + fq * 4) = o;
}

#define XB_TMO      128
#define XB_XCNT(j)  (256  + 64 * (j))
#define XB_XSUB(j)  (1280 + 64 * (j))
#define XB_XGEN(j)  (2304 + 64 * (j))
#define XB_TOP      3328
#define XB_TOPGEN   3392
#define XCD_BAR_WORDS 3456
#define XB_SPIN_CAP (1u << 18)
#define LAS __attribute__((address_space(3)))
__device__ __forceinline__ unsigned xb_ld(unsigned* p)              { return __hip_atomic_load(p, __ATOMIC_RELAXED, __HIP_MEMORY_SCOPE_AGENT); }
__device__ __forceinline__ unsigned xb_add(unsigned* p, unsigned v) { return __hip_atomic_fetch_add(p, v, __ATOMIC_RELAXED, __HIP_MEMORY_SCOPE_AGENT); }
__device__ __forceinline__ unsigned xb_xcc_id() { return (unsigned)__builtin_amdgcn_s_getreg((3 << 11) | 20) & 0xFu; }
#define XB_SPIN(cond, bar) do { unsigned _sp = 0; while (cond) { __builtin_amdgcn_s_sleep(1); \
    if ((++_sp & 255u) == 0u) { if (xb_ld(&(bar)[XB_TMO])) break; if (_sp > XB_SPIN_CAP) { atomicAdd(&(bar)[XB_TMO], 1u); break; } } } } while (0)
__device__ __forceinline__ void xcd_barrier_complete(unsigned* bar, unsigned x, unsigned& nloc, unsigned& nx) {
    const unsigned G = gridDim.x * gridDim.y * gridDim.z;
    unsigned sum, cnt, mine, sp = 0u;
    for (;;) {
        sum = 0u; cnt = 0u; mine = 0u;
#pragma unroll
        for (unsigned j = 0; j < 16; ++j) { const unsigned c = xb_ld(&bar[XB_XCNT(j)]); sum += c; cnt += (c > 0u) ? 1u : 0u; mine = (j == x) ? c : mine; }
        if (sum == G) break;
        __builtin_amdgcn_s_sleep(1);
        if ((++sp & 255u) == 0u) { if (xb_ld(&bar[XB_TMO])) break; if (sp > XB_SPIN_CAP) { atomicAdd(&bar[XB_TMO], 1u); break; } }
    }
    nloc = mine > 0u ? mine : 1u; nx = cnt > 0u ? cnt : 1u;
}
__device__ __forceinline__ void xcd_barrier(unsigned* bar, volatile LAS unsigned* st) {
    asm volatile("s_waitcnt vmcnt(0)" ::: "memory");
    __syncthreads();
    if (threadIdx.x == 0) {
        const unsigned x = xb_xcc_id();
        __builtin_amdgcn_s_waitcnt(0);
        unsigned nloc = st[0], nx = st[1];
        if (nloc == 0u) { xcd_barrier_complete(bar, x, nloc, nx); st[0] = nloc; st[1] = nx; }
        const unsigned old = xb_add(&bar[XB_XSUB(x)], 1u);
        const unsigned gen = old / nloc;
        if (old + 1u == (gen + 1u) * nloc) {
            __builtin_amdgcn_fence(__ATOMIC_RELEASE, "agent");
            asm volatile("s_waitcnt vmcnt(0)" ::: "memory");
            const unsigned og = xb_add(&bar[XB_TOP], 1u);
            const unsigned tg = og / nx;
            if (og + 1u == (tg + 1u) * nx) xb_add(&bar[XB_TOPGEN], 1u);
            else XB_SPIN(xb_ld(&bar[XB_TOPGEN]) == tg, bar);
            __builtin_amdgcn_fence(__ATOMIC_ACQUIRE, "agent");
            xb_add(&bar[XB_XGEN(x)], 1u);
            asm volatile("s_waitcnt vmcnt(0)" ::: "memory");
        } else {
            XB_SPIN(xb_ld(&bar[XB_XGEN(x)]) == gen, bar);
            __builtin_amdgcn_fence(__ATOMIC_ACQUIRE, "agent");
            asm volatile("s_waitcnt vmcnt(0)" ::: "memory");
        }
    }
    __syncthreads();
}

template <int PH>
__device__ __forceinline__ void run_phase(const Params& p, char* smem) {
  const int bid = blockIdx.x, nb = gridDim.x;
  if (PH == 0) {
    for (int t = bid; t < 1696; t += nb) wconv_tile(p, t, smem);
    for (int i = bid * 256 + get_tid(); i < 2 * 8 * 1024; i += nb * 256) { const int ll = i >> 13, j = (i >> 10) & 7, k = i & 1023; p.wg8()[i] = p.w_in[((size_t)ll * 1024 + k) * NINSRC + 2560 + j]; }
    return;
  }
  constexpr int l = (PH - 1) / NPL, s = (PH - 1) % NPL;
  if (!((PHMASK >> s) & 1)) return;
  switch (s) {
    case 0: norm_phase(p, l, smem); break;
    case 1: {
      const int per = (66 * 52) / 8, xcd = bid & 7, nloc = (nb + 7 - xcd) >> 3;
      for (int j = bid >> 3; j < per; j += nloc) {
        const int sq = xcd * per + j;
        const int tmg = sq / 416, rem = sq % 416, gm = (tmg == 8) ? 2 : 8;
        const int tng = rem / (gm * 8), rem2 = rem % (gm * 8), wdt = (tng == 6) ? 4 : 8;
        inproj_tile(p, l, (tmg * 8 + rem2 / wdt) * 52 + tng * 8 + rem2 % wdt, smem);
      }
      break;
    }
    case 2:
      for (int v = bid; v < 3 * NUNIT; v += nb) {
        const int ty = v % 3, u = v / 3;
        if (ty == 0) sb_unit(p, l, u, smem); else if (ty == 1) mlstm_local(p, l, u, smem); else hgrn_local(p, l, u, smem);
      }
      break;
    case 3: scan_phase(p, l, smem); break;
    case 4:
      for (int v = bid; v < 2 * NUNIT; v += nb) { if (v & 1) hgrn_out(p, l, v >> 1, smem); else mlstm_out(p, l, v >> 1, smem); }
      break;
    case 5: for (int t = bid; t < 1024; t += nb) merge_tile(p, l, t, smem); for (int j = bid; j < 512; j += nb) merge_mini(p, l, j); break;
    case 6: for (int t = bid; t < 1024; t += nb) outproj_tile(p, l, t, smem); for (int j = bid; j < 512; j += nb) outproj_mini(p, l, j); break;
    case 7: postnorm_phase(p, l); break;
    case 8: for (int t = bid; t < 1024; t += nb) ple_tile(p, l, t, smem); for (int j = bid; j < 512; j += nb) ple_mini(p, l, j); break;
  }
}

template <int PH>
__global__ void __launch_bounds__(256, 2) phase_kernel(Params p) {
  __shared__ __attribute__((aligned(16))) char smem[SMEM_BYTES];
  run_phase<PH>(p, smem);
}

#if FUSED
__device__ __forceinline__ int fetch_work(unsigned* ctr, volatile int* slot) {
  __syncthreads();
  if (threadIdx.x == 0) *slot = (int)__hip_atomic_fetch_add(ctr, 1u, __ATOMIC_RELAXED, __HIP_MEMORY_SCOPE_AGENT);
  __syncthreads();
  return *slot;
}
__device__ __forceinline__ void run_phase_rt(const Params& p, int ph, char* smem, volatile int* wslot) {
  const int bid = blockIdx.x, nb = gridDim.x;
  unsigned* ctr = (unsigned*)(p.ws + WS_BAR + 14336) + ph * 16;
  int l = 0, s = 0;
  if (ph == 0) { for (int t = bid; t < 848; t += nb) wconv_tile(p, t, smem); }
  else { if (ph == 1) return; l = (ph - 1) / NPL; s = (ph - 1) % NPL; }
  switch (s) {
    case 0: norm_phase(p, l, smem); break;
    case 1: {
      const int per = (66 * 52) / 8, xcd0 = (int)(xb_xcc_id() & 7u);
      for (int dx = 0; dx < 8; ++dx) {
        const int xcd = (xcd0 + dx) & 7;
        for (;;) {
          const int j = fetch_work(ctr + xcd, wslot);
          if (j >= per) break;
          const int sq = xcd * per + j;
          const int tmg = sq / 416, rem = sq % 416, gm = (tmg == 8) ? 2 : 8;
          const int tng = rem / (gm * 8), rem2 = rem % (gm * 8), wdt = (tng == 6) ? 4 : 8;
          inproj_tile(p, l, (tmg * 8 + rem2 / wdt) * 52 + tng * 8 + rem2 % wdt, smem);
        }
      }
      break;
    }
    case 2:
      for (;;) {
        const int v = fetch_work(ctr, wslot);
        if (v >= 3 * NUNIT + (l == 0 ? 848 : 0)) break;
        if (v < NUNIT) sb_unit(p, l, v, smem); else if (v < 2 * NUNIT) mlstm_local(p, l, v - NUNIT, smem); else if (v < 3 * NUNIT) hgrn_local(p, l, v - 2 * NUNIT, smem);
        else wconv_tile(p, 848 + (v - 3 * NUNIT), smem);
      }
      break;
    case 3: {
      scan_phase(p, l, smem);
      const int v = fetch_work(ctr + 8, wslot);
      if (v < 1584) gate_tile256(p, l, v < 48 ? 1536 + v : v - 48, smem);
      break;
    }
    case 4: {
      unsigned* gq = ctr - 16 + 8;
      bool gleft = true, uleft = true;
      while (gleft || uleft) {
        if (gleft) { const int v = fetch_work(gq, wslot); if (v < 1584) gate_tile256(p, l, v < 48 ? 1536 + v : v - 48, smem); else gleft = false; }
        for (int k = 0; k < 2 && uleft; ++k) {
          const int u = fetch_work(ctr, wslot);
          if (u >= 2 * NUNIT) uleft = false;
          else if (u < NUNIT) hgrn_out(p, l, u, smem); else mlstm_out(p, l, u - NUNIT, smem);
        }
      }
      break;
    }
    case 5: for (;;) { const int v = fetch_work(ctr, wslot); if (v >= 1536) break; if (v < 1024) merge_tile_g(p, l, v, smem); else merge_mini(p, l, v - 1024); } break;
    case 6: for (;;) { const int v = fetch_work(ctr, wslot); if (v >= 1024) break; if (v < 512) outproj_tile256(p, l, v, smem); else outproj_mini(p, l, v - 512); } break;
    case 7: postnorm_phase(p, l); break;
    case 8: for (;;) { const int v = fetch_work(ctr, wslot); if (v >= 1536) break; if (v < 1024) ple_tile(p, l, v, smem); else ple_mini(p, l, v - 1024); } break;
  }
}

__global__ void __launch_bounds__(256, 2) mega(Params p_unused) {
  __shared__ __attribute__((aligned(16))) char smem[SMEM_BYTES];
  __shared__ uint4 xb_words;
  __shared__ int wslot;
  if (threadIdx.x == 0) {
    typedef const Params __attribute__((address_space(4))) * KP4;
    KP4 kp = (KP4)__builtin_amdgcn_kernarg_segment_ptr();
    asm volatile("" : "+s"(kp));
    char* wsb = ((const Params*)kp)->ws;
    xb_words = make_uint4(0u, 0u, 0u, 0u); (void)xb_add((unsigned*)(wsb + WS_BAR) + XB_XCNT(xb_xcc_id()), 1u);
  }
  __syncthreads();
  typedef const Params __attribute__((address_space(4))) * KP4;
#ifdef PROBE_KIND
  unsigned long long t_acc = 0;
#endif
#pragma unroll 1
  for (int ph = 0; ph < NPHASE; ++ph) {
    KP4 kp = (KP4)__builtin_amdgcn_kernarg_segment_ptr();
    asm volatile("" : "+s"(kp));
    const Params q = *(const Params*)kp;
#ifdef PROBE_KIND
    const unsigned long long tp0 = __builtin_amdgcn_s_memrealtime();
#endif
    run_phase_rt(q, ph, smem, &wslot);
#ifdef PROBE_KIND
    const unsigned long long tp1 = __builtin_amdgcn_s_memrealtime();
    if ((PROBE_KIND == 9 && ph == 0) || (PROBE_KIND < 9 && ph > 0 && (ph - 1) % NPL == PROBE_KIND)) t_acc += tp1 - tp0;
#endif
    if (ph + 1 < NPHASE && ph != 1) xcd_barrier((unsigned*)(q.ws + WS_BAR), (volatile LAS unsigned*)&xb_words);
    if (gridDim.y == 7777u) cg::this_grid().sync();
#ifdef PROBE_KIND
    if (PROBE_KIND == 10 && (PROBE_SEL < 0 || (ph > 0 && (ph - 1) % NPL == PROBE_SEL))) t_acc += __builtin_amdgcn_s_memrealtime() - tp1;
#endif
  }
#ifdef PROBE_GEMM
  {
    KP4 kp = (KP4)__builtin_amdgcn_kernarg_segment_ptr();
    asm volatile("" : "+s"(kp));
    const Params q = *(const Params*)kp;
    xcd_barrier((unsigned*)(q.ws + WS_BAR), (volatile LAS unsigned*)&xb_words);
    const unsigned long long tg0 = __builtin_amdgcn_s_memrealtime();
    f32x4 acc[4][8];
#pragma unroll
    for (int a_ = 0; a_ < 4; ++a_)
#pragma unroll
      for (int b_ = 0; b_ < 8; ++b_) acc[a_][b_] = (f32x4){0.f, 0.f, 0.f, 0.f};
    const int bid = blockIdx.x;
#pragma unroll 1
    for (int it = 0; it < 8; ++it) {
      int tm, tn;
      if (PROBE_GEMM == 0) { tm = 0; tn = 0; }
      else if (PROBE_GEMM == 1) { tm = bid & 63; tn = ((bid >> 6) * 6 + it) % 52; }
      else { const int xcd = bid & 7, idx = bid >> 3; tm = xcd * 8 + (idx & 7); tn = ((idx >> 3) + 8 * it) % 52; }
      gemm_glds<8, 3>(acc, q.U() + (size_t)tm * 256 * 1024, 1024, q.wt_in() + (size_t)tn * 128 * 1024, 1024, 1024, smem);
    }
    float sum = 0.f;
#pragma unroll
    for (int a_ = 0; a_ < 4; ++a_)
#pragma unroll
      for (int b_ = 0; b_ < 8; ++b_) sum += acc[a_][b_][0] + acc[a_][b_][1] + acc[a_][b_][2] + acc[a_][b_][3];
    if (sum == 123456.789f) q.hbc()[0] = sum;
    const unsigned long long tg1 = __builtin_amdgcn_s_memrealtime();
    if (blockIdx.x == 0) { while (__builtin_amdgcn_s_memrealtime() - tg1 < 4 * (tg1 - tg0)) __builtin_amdgcn_s_sleep(32); }
  }
#endif
#ifdef PROBE_KIND
  if (blockIdx.x == PROBE_BLOCK) { const unsigned long long te = __builtin_amdgcn_s_memrealtime(); while (__builtin_amdgcn_s_memrealtime() - te < 4 * t_acc) __builtin_amdgcn_s_sleep(32); }
#endif
}
#endif

template <int PH>
static void launch_all(const Params& p, int grid, hipStream_t stream) {
  hipLaunchKernelGGL(phase_kernel<PH>, dim3(grid), dim3(256), 0, stream, p);
  if constexpr (PH + 1 < NPHASE) launch_all<PH + 1>(p, grid, stream);
}

extern "C" void kernel_launch(void* const* d_in, const int* in_sizes, int n_in, void* d_out, int out_size, void* d_ws, size_t ws_size, hipStream_t stream) {
  Params p;
  memset(&p, 0, sizeof(p));
  const float* const* in = (const float* const*)d_in;
  p.x_p = in[0]; p.x_s = in[1]; p.p_p = in[2]; p.p_s = in[3]; p.st_C = in[4]; p.st_n = in[5]; p.st_m = in[6]; p.st_conv = in[7];
  p.ck = in[8]; p.cv = in[9]; p.st_S = in[10]; p.g_pre = in[11]; p.w_in = in[12]; p.b_i = in[13]; p.b_f = in[14]; p.w_conv = in[15];
  p.g_ml = in[16]; p.lb_logits = in[17]; p.g_hg = in[18]; p.w_br = in[19]; p.w_out = in[20]; p.g_post = in[21]; p.w_pg = in[22]; p.w_pp = in[23];
  p.out = (float*)d_out; p.ws = (char*)d_ws;
  if (WS_TOTAL > ws_size || (size_t)out_size < O_TOTAL) { fprintf(stderr, "workspace/out too small: need %zu have %zu\n", (size_t)WS_TOTAL, ws_size); return; }
  static int grid_blocks = 0;
  if (!grid_blocks) {
    int dev = 0, cus = 0, per_cu = 0;
    (void)hipGetDevice(&dev);
    (void)hipDeviceGetAttribute(&cus, hipDeviceAttributeMultiprocessorCount, dev);
#if FUSED
    (void)hipOccupancyMaxActiveBlocksPerMultiprocessor(&per_cu, mega, 256, 0);
#else
    per_cu = 2;
#endif
    if (per_cu > 2) per_cu = 2;
    if (per_cu < 1) per_cu = 1;
    grid_blocks = cus * per_cu;
  }
#if FUSED
  (void)hipMemsetAsync((char*)d_ws + WS_BAR, 0, 16384, stream);
  void* args[] = {&p};
  hipError_t e = hipLaunchCooperativeKernel((void*)mega, dim3(grid_blocks), dim3(256), args, 0, stream);
  if (e != hipSuccess) fprintf(stderr, "cooperative launch failed: %s (grid %d)\n", hipGetErrorString(e), grid_blocks);
#else
  launch_all<0>(p, grid_blocks, stream);
#endif
}
```

```cpp
#include <hip/hip_runtime.h>
#include <hip/hip_cooperative_groups.h>
#include <stdint.h>
#include <stdio.h>
#include <string.h>
namespace cg = cooperative_groups;

#ifndef FUSED
#define FUSED 1
#endif
#ifndef PHMASK
#define PHMASK 0x3ff
#endif

typedef unsigned short bf16_t;
typedef short bf16x8 __attribute__((ext_vector_type(8)));
typedef float f32x4 __attribute__((ext_vector_type(4)));
typedef unsigned u32x4 __attribute__((ext_vector_type(4)));
typedef unsigned u32x2 __attribute__((ext_vector_type(2)));

constexpr int NTOK = 16896, NPROMPT = 16384, NUNIT = 1056;
constexpr int NINSRC = 9736, NWT = 9728, NMAIN = 6656;
constexpr int SMEM_BYTES = 80896;
constexpr int NPL = 9;
constexpr int NPHASE = 1 + 2 * NPL;

constexpr size_t al256(size_t x) { return (x + 255) & ~(size_t)255; }
constexpr size_t WS_WT_IN = 0;
constexpr size_t WS_WT_BR = WS_WT_IN + al256((size_t)2 * NWT * 1024 * 2);
constexpr size_t WS_WT_OUT = WS_WT_BR + al256((size_t)2 * 3 * 1024 * 512 * 2);
constexpr size_t WS_WT_PG = WS_WT_OUT + al256((size_t)2 * 1048576 * 2);
constexpr size_t WS_WT_PP = WS_WT_PG + al256((size_t)2 * 1048576 * 2);
constexpr size_t WS_U = WS_WT_PP + al256((size_t)2 * 262144 * 2);
constexpr size_t WS_PR = WS_U + al256((size_t)NTOK * 1024 * 2);
constexpr size_t WS_QC = WS_PR + al256((size_t)13 * NTOK * 512 * 2);
constexpr size_t WS_KC = WS_QC + al256((size_t)NTOK * 512 * 2);
constexpr size_t WS_SM = WS_KC + al256((size_t)NTOK * 512 * 2);
constexpr size_t WS_SH = WS_SM + al256((size_t)NUNIT * 16384 * 2);
constexpr size_t WS_H = WS_SH + al256((size_t)NUNIT * 16384 * 2);
constexpr size_t WS_IG = WS_H + al256((size_t)3 * NTOK * 512 * 2);
constexpr size_t WS_LF = WS_IG + al256((size_t)NTOK * 16);
constexpr size_t WS_AC = WS_LF + al256((size_t)NTOK * 16);
constexpr size_t WS_BC = WS_AC + al256(NUNIT * 4);
constexpr size_t WS_MIN = WS_BC + al256(NUNIT * 4);
constexpr size_t WS_NLOC = WS_MIN + al256(NUNIT * 4);
constexpr size_t WS_HBC = WS_NLOC + al256((size_t)NUNIT * 512);
constexpr size_t WS_BAR = WS_HBC + al256((size_t)NUNIT * 512);
constexpr size_t WS_WG8 = WS_BAR + 16384;
constexpr size_t WS_TOTAL = WS_WG8 + 65536;
constexpr size_t GRP = (size_t)NTOK * 512 * 2;
constexpr size_t WS_G0 = WS_PR + 0 * GRP, WS_G1 = WS_PR + 5 * GRP, WS_G2 = WS_PR + 7 * GRP;
constexpr size_t WS_MERGED = WS_PR + 2 * GRP;
constexpr size_t WS_Y = WS_PR + 9 * GRP;
constexpr size_t WS_RB = WS_PR + 0 * GRP;
constexpr size_t WS_R = WS_PR + 5 * GRP;
static_assert(WS_Y + (size_t)NTOK * 1024 * 4 <= WS_QC, "alias overflow");
constexpr size_t O_PC = 16777216 + 524288, O_PN = O_PC + 262144, O_PM = O_PN + 2048, O_PCONV = O_PM + 16, O_PK = O_PCONV + 12288, O_PV = O_PK + 16777216,
                 O_PS = O_PV + 16777216, O_SC = O_PS + 262144, O_SN = O_SC + 1048576, O_SM = O_SN + 8192, O_SCONV = O_SM + 64, O_SK = O_SCONV + 49152,
                 O_SV = O_SK + 524288, O_SS = O_SV + 524288, O_TOTAL = O_SS + 1048576;

struct Params {
  const float *x_p, *x_s, *p_p, *p_s, *st_C, *st_n, *st_m, *st_conv, *ck, *cv, *st_S;
  const float *g_pre, *w_in, *b_i, *b_f, *w_conv, *g_ml, *lb_logits, *g_hg, *w_br, *w_out, *g_post, *w_pg, *w_pp;
  float* out; char* ws;
#define WSP(name, T, off) __device__ __forceinline__ T* name() const { return (T*)(ws + (off)); }
#define OUTP(name, off) __device__ __forceinline__ float* name() const { return out + (off); }
  OUTP(o_y, 0) OUTP(o_pC, O_PC) OUTP(o_pn, O_PN) OUTP(o_pm, O_PM) OUTP(o_pconv, O_PCONV) OUTP(o_pk, O_PK) OUTP(o_pv, O_PV) OUTP(o_pS, O_PS)
  OUTP(o_sC, O_SC) OUTP(o_sn, O_SN) OUTP(o_sm, O_SM) OUTP(o_sconv, O_SCONV) OUTP(o_sk, O_SK) OUTP(o_sv, O_SV) OUTP(o_sS, O_SS)
  WSP(wt_in, bf16_t, WS_WT_IN) WSP(wt_br, bf16_t, WS_WT_BR) WSP(wt_out, bf16_t, WS_WT_OUT) WSP(wt_pg, bf16_t, WS_WT_PG) WSP(wt_pp, bf16_t, WS_WT_PP)
  WSP(U, bf16_t, WS_U) WSP(PR, bf16_t, WS_PR) WSP(QC, bf16_t, WS_QC) WSP(KC, bf16_t, WS_KC) WSP(SM, bf16_t, WS_SM) WSP(SH, bf16_t, WS_SH) WSP(H, bf16_t, WS_H)
  WSP(ig, float, WS_IG) WSP(lf, float, WS_LF) WSP(ac, float, WS_AC) WSP(Bc, float, WS_BC) WSP(min_, float, WS_MIN) WSP(nloc, float, WS_NLOC) WSP(hbc, float, WS_HBC)
  __device__ __forceinline__ bf16_t* Gb(int b) const { return (bf16_t*)(ws + (b == 0 ? WS_G0 : b == 1 ? WS_G1 : WS_G2)); }
  WSP(wg8, float, WS_WG8) WSP(merged, bf16_t, WS_MERGED) WSP(y, float, WS_Y) WSP(r, float, WS_R) WSP(rb, bf16_t, WS_RB)
};

__device__ __forceinline__ int get_tid() { int t = threadIdx.x; asm volatile("" : "+v"(t)); return t; }
__device__ __forceinline__ bf16_t f2bf(float f) { unsigned u = __float_as_uint(f); u += 0x7fffu + ((u >> 16) & 1u); return (bf16_t)(u >> 16); }
__device__ __forceinline__ float bf2f(bf16_t h) { return __uint_as_float(((unsigned)h) << 16); }
__device__ __forceinline__ unsigned pack2(float a, float b) { return (unsigned)f2bf(a) | ((unsigned)f2bf(b) << 16); }
__device__ __forceinline__ float lo2f(unsigned v) { return __uint_as_float(v << 16); }
__device__ __forceinline__ float hi2f(unsigned v) { return __uint_as_float(v & 0xffff0000u); }
__device__ __forceinline__ float sigm(float x) { return 1.f / (1.f + __expf(-x)); }
__device__ __forceinline__ float silu(float x) { return x / (1.f + __expf(-x)); }
__device__ __forceinline__ float softplus(float x) { return fmaxf(x, 0.f) + __logf(1.f + __expf(-fabsf(x))); }
__device__ __forceinline__ float logsigm(float x) { return fminf(x, 0.f) - __logf(1.f + __expf(-fabsf(x))); }

template <int MT, int NT, int KS>
__device__ __forceinline__ void wmma(f32x4 (&acc)[MT][NT], const bf16_t* A, int lda, const bf16_t* B, int ldb, int fr, int fq) {
#pragma unroll
  for (int kk = 0; kk < KS; ++kk) {
    bf16x8 a[MT], b[NT];
#pragma unroll
    for (int mi = 0; mi < MT; ++mi) a[mi] = *(const bf16x8*)(A + (mi * 16 + fr) * lda + kk * 32 + fq * 8);
#pragma unroll
    for (int ni = 0; ni < NT; ++ni) b[ni] = *(const bf16x8*)(B + (ni * 16 + fr) * ldb + kk * 32 + fq * 8);
#pragma unroll
    for (int mi = 0; mi < MT; ++mi)
#pragma unroll
      for (int ni = 0; ni < NT; ++ni) acc[mi][ni] = __builtin_amdgcn_mfma_f32_16x16x32_bf16(a[mi], b[ni], acc[mi][ni], 0, 0, 0);
  }
}

__device__ __forceinline__ u32x4 ld8(const bf16_t* s) { return *(const u32x4*)s; }
__device__ __forceinline__ u32x4 ld8(const float* s) {
  float4 a = *(const float4*)s, b = *(const float4*)(s + 4);
  u32x4 r; r.x = pack2(a.x, a.y); r.y = pack2(a.z, a.w); r.z = pack2(b.x, b.y); r.w = pack2(b.z, b.w); return r;
}
template <typename T>
__device__ __forceinline__ void ld_tile(bf16_t* dst, const T* src, long ld, int tid) {
#pragma unroll
  for (int i = 0; i < 4; ++i) { int id = tid + 256 * i; int r = id >> 4, c = (id & 15) * 8; *(u32x4*)(dst + r * 136 + c) = ld8(src + (long)r * ld + c); }
}
template <typename T>
__device__ __forceinline__ void ld_tile128(bf16_t* dst, const T* src, long ld, int tid) {
#pragma unroll
  for (int i = 0; i < 8; ++i) { int id = tid + 256 * i; int r = id >> 4, c = (id & 15) * 8; *(u32x4*)(dst + r * 136 + c) = ld8(src + (long)r * ld + c); }
}
template <typename T, int ROWS, int DLD>
__device__ __forceinline__ void ld_T(bf16_t* dst, const T* src, long ld, int tid) {
#pragma unroll 2
  for (int id = tid; id < ROWS * 16; id += 256) {
    int r = id % ROWS, c = (id / ROWS) * 8;
    u32x4 v = ld8(src + (long)r * ld + c);
    bf16_t* d = dst + c * DLD + r;
    d[0] = (bf16_t)(v.x & 0xffff); d[DLD] = (bf16_t)(v.x >> 16); d[2 * DLD] = (bf16_t)(v.y & 0xffff); d[3 * DLD] = (bf16_t)(v.y >> 16);
    d[4 * DLD] = (bf16_t)(v.z & 0xffff); d[5 * DLD] = (bf16_t)(v.z >> 16); d[6 * DLD] = (bf16_t)(v.w & 0xffff); d[7 * DLD] = (bf16_t)(v.w >> 16);
  }
}

#define PRG(g) (p.PR() + (size_t)(g) * NTOK * 512)

__device__ __forceinline__ const float* xrow(const Params& p, int l, int row) {
  if (l == 0) return row < NPROMPT ? p.x_p + (size_t)row * 1024 : p.x_s + (size_t)(row - NPROMPT) * 1024;
  return p.o_y() + (size_t)row * 1024;
}

__device__ void wconv_tile(const Params& p, int t, char* smem) {
  float* tile = (float*)smem;
  const int tid = get_tid();
  int l = t / 848, r = t % 848;
  const float* src; bf16_t* dst; int K, ldsrc, kt, nt, skip = 1 << 30;
  if (r < 608) { src = p.w_in + (size_t)l * 1024 * NINSRC; dst = p.wt_in() + (size_t)l * NWT * 1024; K = 1024; ldsrc = NINSRC; kt = r % 16; nt = r / 16; skip = 2560; }
  else if (r < 704) { r -= 608; int b = r / 32; r %= 32; src = p.w_br + (size_t)(l * 3 + b) * 512 * 1024; dst = p.wt_br() + (size_t)(l * 3 + b) * 1024 * 512; K = 512; ldsrc = 1024; kt = r % 8; nt = r / 8; }
  else if (r < 768) { r -= 704; src = p.w_out + (size_t)l * 1048576; dst = p.wt_out() + (size_t)l * 1048576; K = 1024; ldsrc = 1024; kt = r % 16; nt = r / 16; }
  else if (r < 832) { r -= 768; src = p.w_pg + (size_t)l * 1048576; dst = p.wt_pg() + (size_t)l * 1048576; K = 1024; ldsrc = 1024; kt = r % 16; nt = r / 16; }
  else { r -= 832; src = p.w_pp + (size_t)l * 262144; dst = p.wt_pp() + (size_t)l * 262144; K = 256; ldsrc = 1024; kt = r % 4; nt = r / 4; }
  const int n0 = nt * 256, k0 = kt * 64;
  __syncthreads();
#pragma unroll
  for (int i = 0; i < 16; ++i) {
    const int k = i * 4 + (tid >> 6), n4 = (tid & 63) * 4;
    int ns = n0 + n4; if (ns >= skip) ns += 8;
    *(float4*)(tile + k * 260 + n4) = *(const float4*)(src + (size_t)(k0 + k) * ldsrc + ns);
  }
  __syncthreads();
  bf16_t* drow = dst + (size_t)(n0 + tid) * K + k0;
#pragma unroll
  for (int c = 0; c < 8; ++c) {
    u32x4 pk;
    pk.x = pack2(tile[(c * 8 + 0) * 260 + tid], tile[(c * 8 + 1) * 260 + tid]);
    pk.y = pack2(tile[(c * 8 + 2) * 260 + tid], tile[(c * 8 + 3) * 260 + tid]);
    pk.z = pack2(tile[(c * 8 + 4) * 260 + tid], tile[(c * 8 + 5) * 260 + tid]);
    pk.w = pack2(tile[(c * 8 + 6) * 260 + tid], tile[(c * 8 + 7) * 260 + tid]);
    *(u32x4*)(drow + c * 8) = pk;
  }
}

__device__ void norm_phase(const Params& p, int l, char* smem) {
  const int lane = threadIdx.x & 63, wid = threadIdx.x >> 6;
  const float* gp = p.g_pre + l * 1024;
  float* wgs = (float*)smem;
  __syncthreads();
  {
    const float* wsrc = p.w_in + (size_t)l * 1024 * NINSRC + 2560;
    for (int k = threadIdx.x; k < 1024; k += 256) {
      const float4 a = *(const float4*)(wsrc + (size_t)k * NINSRC), b = *(const float4*)(wsrc + (size_t)k * NINSRC + 4);
      wgs[k] = a.x; wgs[1024 + k] = a.y; wgs[2048 + k] = a.z; wgs[3072 + k] = a.w;
      wgs[4096 + k] = b.x; wgs[5120 + k] = b.y; wgs[6144 + k] = b.z; wgs[7168 + k] = b.w;
    }
  }
  __syncthreads();
  const float* wg = wgs;
  for (int row = blockIdx.x * 4 + wid; row < NTOK; row += gridDim.x * 4) {
    const float* x = xrow(p, l, row);
    float4 v[4]; float ss = 0.f;
#pragma unroll
    for (int i = 0; i < 4; ++i) { v[i] = *(const float4*)(x + i * 256 + lane * 4); ss += v[i].x * v[i].x + v[i].y * v[i].y + v[i].z * v[i].z + v[i].w * v[i].w; }
#pragma unroll
    for (int o = 32; o > 0; o >>= 1) ss += __shfl_xor(ss, o);
    const float rstd = rsqrtf(ss * (1.f / 1024.f) + 1e-6f);
    float d0 = 0, d1 = 0, d2 = 0, d3 = 0, d4 = 0, d5 = 0, d6 = 0, d7 = 0;
#pragma unroll
    for (int i = 0; i < 4; ++i) {
      const int k = i * 256 + lane * 4;
      float4 g = *(const float4*)(gp + k);
      float u0 = v[i].x * rstd * g.x, u1 = v[i].y * rstd * g.y, u2 = v[i].z * rstd * g.z, u3 = v[i].w * rstd * g.w;
      u32x2 pk; pk.x = pack2(u0, u1); pk.y = pack2(u2, u3);
      *(u32x2*)(p.U() + (size_t)row * 1024 + k) = pk;
      const float* wp = wg + k;
      float4 w;
      w = *(const float4*)(wp);            d0 += u0 * w.x + u1 * w.y + u2 * w.z + u3 * w.w;
      w = *(const float4*)(wp + 1024);     d1 += u0 * w.x + u1 * w.y + u2 * w.z + u3 * w.w;
      w = *(const float4*)(wp + 2 * 1024); d2 += u0 * w.x + u1 * w.y + u2 * w.z + u3 * w.w;
      w = *(const float4*)(wp + 3 * 1024); d3 += u0 * w.x + u1 * w.y + u2 * w.z + u3 * w.w;
      w = *(const float4*)(wp + 4 * 1024); d4 += u0 * w.x + u1 * w.y + u2 * w.z + u3 * w.w;
      w = *(const float4*)(wp + 5 * 1024); d5 += u0 * w.x + u1 * w.y + u2 * w.z + u3 * w.w;
      w = *(const float4*)(wp + 6 * 1024); d6 += u0 * w.x + u1 * w.y + u2 * w.z + u3 * w.w;
      w = *(const float4*)(wp + 7 * 1024); d7 += u0 * w.x + u1 * w.y + u2 * w.z + u3 * w.w;
    }
#pragma unroll
    for (int o = 32; o > 0; o >>= 1) {
      d0 += __shfl_xor(d0, o); d1 += __shfl_xor(d1, o); d2 += __shfl_xor(d2, o); d3 += __shfl_xor(d3, o);
      d4 += __shfl_xor(d4, o); d5 += __shfl_xor(d5, o); d6 += __shfl_xor(d6, o); d7 += __shfl_xor(d7, o);
    }
    if (lane < 4) {
      float di = lane == 0 ? d0 : lane == 1 ? d1 : lane == 2 ? d2 : d3;
      float df = lane == 0 ? d4 : lane == 1 ? d5 : lane == 2 ? d6 : d7;
      p.ig()[row * 4 + lane] = di + p.b_i[l * 4 + lane];
      p.lf()[row * 4 + lane] = logsigm(df + p.b_f[l * 4 + lane]);
    }
  }
}

template <typename TA>
__device__ __forceinline__ void gemm_kloop(f32x4 (&acc)[4][4], const TA* Tp, long ldt, const bf16_t* Wp, long ldw, int K, char* smem) {
  bf16_t* sT = (bf16_t*)smem;
  bf16_t* sW = sT + 2 * 9216;
  const int tid = get_tid(), lane = tid & 63, wid = tid >> 6, wr = wid >> 1, wc = wid & 1, fr = lane & 15, fq = lane >> 4;
  u32x4 rt[4], rw[4];
  const int r0 = tid >> 3, c0 = (tid & 7) * 8;
#define GLOAD(k0) _Pragma("unroll") for (int i = 0; i < 4; ++i) { rt[i] = ld8(Tp + (long)(r0 + 32 * i) * ldt + (k0) + c0); rw[i] = ld8(Wp + (long)(r0 + 32 * i) * ldw + (k0) + c0); }
#define SSTORE(buf) _Pragma("unroll") for (int i = 0; i < 4; ++i) { *(u32x4*)(sT + (buf) * 9216 + (r0 + 32 * i) * 72 + c0) = rt[i]; *(u32x4*)(sW + (buf) * 9216 + (r0 + 32 * i) * 72 + c0) = rw[i]; }
  GLOAD(0); SSTORE(0);
  __syncthreads();
  const int nk = K >> 6;
#pragma unroll 1
  for (int kt = 0; kt < nk; ++kt) {
    const int buf = kt & 1;
    if (kt + 1 < nk) { GLOAD((kt + 1) * 64); }
    const bf16_t* aT = sT + buf * 9216 + (wr * 64) * 72;
    const bf16_t* aW = sW + buf * 9216 + (wc * 64) * 72;
    wmma<4, 4, 2>(acc, aW, 72, aT, 72, fr, fq);
    if (kt + 1 < nk) { SSTORE(buf ^ 1); }
    __syncthreads();
  }
#undef GLOAD
#undef SSTORE
}
__device__ __forceinline__ void zero_acc(f32x4 (&acc)[4][4]) {
#pragma unroll
  for (int a = 0; a < 4; ++a)
#pragma unroll
    for (int b = 0; b < 4; ++b) acc[a][b] = (f32x4){0.f, 0.f, 0.f, 0.f};
}


template <int NT, int NSTAGE>
__device__ __forceinline__ void gemm_glds(f32x4 (&acc)[4][NT], const bf16_t* Tp, long ldt, const bf16_t* Wp, long ldw, int K, char* smem) {
  constexpr int TR = 2 * NT * 16, STAGE_B = (TR + 128) * 64, LT = TR / 64, LPS = LT + 2;
  static_assert(NSTAGE * STAGE_B <= SMEM_BYTES, "ring too large");
  static_assert(NSTAGE == 3 || NSTAGE == 4, "waits below are written for 3 or 4 stages");
  const int tid = get_tid(), lane = tid & 63, wid = tid >> 6, wr = wid >> 1, wc = wid & 1, fr = lane & 15, fq = lane >> 4;
  const int lr = tid >> 2, cp = tid & 3, lc = (cp ^ ((lr >> 2) & 3)) * 8;
  const bf16_t* gT = Tp + (long)lr * ldt + lc;
  const int plr = ((lr >> 5) & 1) * 32 + ((lr >> 2) & 3) * 8 + ((lr >> 4) & 1) * 4 + (lr & 3);
  const bf16_t* gW = Wp + (long)plr * ldw + lc;
  const int rd_off = fr * 64 + ((fq ^ ((fr >> 2) & 3)) * 16);
#define GL_ISSUE(kt_, slot_) do { char* sb_ = smem + (slot_) * STAGE_B + tid * 16; \
    _Pragma("unroll") for (int i_ = 0; i_ < LT; ++i_) __builtin_amdgcn_global_load_lds((const unsigned*)(gT + (long)i_ * 64 * ldt + (kt_) * 32), (__attribute__((address_space(3))) unsigned*)(sb_ + i_ * 4096), 16, 0, 0); \
    _Pragma("unroll") for (int i_ = 0; i_ < 2; ++i_) __builtin_amdgcn_global_load_lds((const unsigned*)(gW + (long)i_ * 64 * ldw + (kt_) * 32), (__attribute__((address_space(3))) unsigned*)(sb_ + TR * 64 + i_ * 4096), 16, 0, 0); } while (0)
  asm volatile("s_waitcnt vmcnt(0)" ::: "memory");
  __builtin_amdgcn_s_barrier();
  const int nk = K >> 5;
#pragma unroll
  for (int s_ = 0; s_ < NSTAGE - 1; ++s_) if (s_ < nk) GL_ISSUE(s_, s_);
  int slot = 0, islot = NSTAGE - 1;
#pragma unroll 1
  for (int kt = 0; kt < nk; ++kt) {
    const int rem = nk - 1 - kt;
    if (NSTAGE == 4) {
      if (rem >= 2) asm volatile("s_waitcnt vmcnt(%0)" ::"n"(2 * LPS) : "memory");
      else if (rem == 1) asm volatile("s_waitcnt vmcnt(%0)" ::"n"(LPS) : "memory");
      else asm volatile("s_waitcnt vmcnt(0)" ::: "memory");
    } else {
      if (rem >= 1) asm volatile("s_waitcnt vmcnt(%0)" ::"n"(LPS) : "memory");
      else asm volatile("s_waitcnt vmcnt(0)" ::: "memory");
    }
    __builtin_amdgcn_s_barrier();
    const unsigned aT = (unsigned)(uintptr_t)(smem + slot * STAGE_B + (wr * NT * 16) * 64 + rd_off);
    const unsigned aW = (unsigned)(uintptr_t)(smem + slot * STAGE_B + TR * 64 + (wc * 64) * 64 + rd_off);
    bf16x8 a[4], b[NT];
#pragma unroll
    for (int mi = 0; mi < 4; ++mi) asm volatile("ds_read_b128 %0, %1 offset:%2" : "=v"(a[mi]) : "v"(aW), "n"(mi * 1024));
#pragma unroll
    for (int ni = 0; ni < NT; ++ni) asm volatile("ds_read_b128 %0, %1 offset:%2" : "=v"(b[ni]) : "v"(aT), "n"(ni * 1024));
    if constexpr (NT == 4) asm volatile("s_waitcnt lgkmcnt(2)" : "+v"(a[0]), "+v"(a[1]), "+v"(a[2]), "+v"(a[3]), "+v"(b[0]), "+v"(b[1]));
    else asm volatile("s_waitcnt lgkmcnt(4)" : "+v"(a[0]), "+v"(a[1]), "+v"(a[2]), "+v"(a[3]), "+v"(b[0]), "+v"(b[1]), "+v"(b[2]), "+v"(b[3]));
    const bool doiss = (kt + NSTAGE - 1 < nk);
    const int ktn = kt + NSTAGE - 1;
    char* sbi = smem + islot * STAGE_B + tid * 16;
#pragma unroll
    for (int g = 0; g < 4; ++g) {
      if (g == 2) {
        if constexpr (NT == 4) asm volatile("s_waitcnt lgkmcnt(0)" : "+v"(b[2]), "+v"(b[3]));
        else asm volatile("s_waitcnt lgkmcnt(0)" : "+v"(b[4]), "+v"(b[5]), "+v"(b[6]), "+v"(b[7]));
      }
#pragma unroll
      for (int nn = 0; nn < NT / 4; ++nn)
#pragma unroll
        for (int mi = 0; mi < 4; ++mi) { const int ni = g * (NT / 4) + nn; acc[mi][ni] = __builtin_amdgcn_mfma_f32_16x16x32_bf16(a[mi], b[ni], acc[mi][ni], 0, 0, 0); }
      __builtin_amdgcn_sched_barrier(0);
      if (doiss) {
#pragma unroll
        for (int q = 0; q < 2; ++q) {
          const int idx = g * 2 + q;
          if (idx < LT) __builtin_amdgcn_global_load_lds((const unsigned*)(gT + (long)idx * 64 * ldt + ktn * 32), (__attribute__((address_space(3))) unsigned*)(sbi + idx * 4096), 16, 0, 0);
          else if (idx < LPS) __builtin_amdgcn_global_load_lds((const unsigned*)(gW + (long)(idx - LT) * 64 * ldw + ktn * 32), (__attribute__((address_space(3))) unsigned*)(sbi + TR * 64 + (idx - LT) * 4096), 16, 0, 0);
        }
      }
      __builtin_amdgcn_sched_barrier(0);
    }
    slot = (slot + 1 == NSTAGE) ? 0 : slot + 1;
    islot = (islot + 1 == NSTAGE) ? 0 : islot + 1;
  }
#undef GL_ISSUE
  __syncthreads();
}

__device__ void inproj_tile(const Params& p, int l, int t, char* smem) {
  constexpr int NT = 8;
  const int tm = t / 52, tn = t % 52;
  const int tid = get_tid(), lane = tid & 63, wid = tid >> 6, wr = wid >> 1, wc = wid & 1, fr = lane & 15, fq = lane >> 4;
  f32x4 acc[4][NT];
#pragma unroll
  for (int a_ = 0; a_ < 4; ++a_)
#pragma unroll
    for (int b_ = 0; b_ < NT; ++b_) acc[a_][b_] = (f32x4){0.f, 0.f, 0.f, 0.f};
  gemm_glds<NT, 3>(acc, p.U() + (size_t)tm * (NT * 32) * 1024, 1024, p.wt_in() + (size_t)l * NWT * 1024 + (size_t)tn * 128 * 1024, 1024, 1024, smem);
  const int g = tn >> 2;
  bf16_t* dst = PRG(g);
#pragma unroll
  for (int ni = 0; ni < NT; ++ni) {
    const int row = tm * (NT * 32) + wr * (NT * 16) + ni * 16 + fr;
    const bool samp = row >= NPROMPT;
    const int rr = samp ? row - NPROMPT : row;
    const int b = samp ? (rr >> 6) : (rr >> 13), tt = samp ? (rr & 63) : (rr & 8191), T = samp ? 64 : 8192, NB = samp ? 8 : 2;
#pragma unroll
    for (int m = 0; m < 2; ++m) {
      const int cg_ = (tn & 3) * 128 + wc * 64 + m * 32 + fq * 8;
      const f32x4 v0 = acc[2 * m][ni], v1 = acc[2 * m + 1][ni];
      u32x4 pk; pk.x = pack2(v0[0], v0[1]); pk.y = pack2(v0[2], v0[3]); pk.z = pack2(v1[0], v1[1]); pk.w = pack2(v1[2], v1[3]);
      *(u32x4*)(dst + (size_t)row * 512 + cg_) = pk;
      if (g == 6 || g == 7) {
        float* o = (g == 6) ? (samp ? p.o_sk() : p.o_pk()) : (samp ? p.o_sv() : p.o_pv());
        const int hh = cg_ >> 7, d = cg_ & 127;
        float* op = o + ((size_t)((l * NB + b) * 4 + hh) * T + tt) * 128 + d;
        *(f32x4*)op = v0; *(f32x4*)(op + 4) = v1;
      } else if (g < 2) {
        if (tt >= T - 3) {
          float* o = samp ? p.o_sconv() : p.o_pconv();
          float* op = o + ((size_t)(l * NB + b) * 3 + (tt - (T - 3))) * 1024 + g * 512 + cg_;
          *(f32x4*)op = v0; *(f32x4*)(op + 4) = v1;
        }
      }
    }
  }
}

struct UnitInfo { int samp, b, h, c, rowbase, seq; };
__device__ __forceinline__ UnitInfo unit_info(int u) {
  UnitInfo i;
  if (u < 1024) { i.samp = 0; i.seq = u >> 7; i.b = i.seq >> 2; i.h = i.seq & 3; i.c = u & 127; i.rowbase = i.b * 8192 + i.c * 64; }
  else { int sq = u - 1024; i.samp = 1; i.seq = sq; i.b = sq >> 2; i.h = sq & 3; i.c = 0; i.rowbase = NPROMPT + i.b * 64; }
  return i;
}

__device__ void sb_unit(const Params& p, int l, int u, char* smem) {
  bf16_t* Qs = (bf16_t*)smem;
  bf16_t* Ks = Qs + 64 * 136;
  bf16_t* Vt = Ks + 64 * 136;
  bf16_t* Ps = Vt + 128 * 72;
  const int tid = get_tid(), lane = tid & 63, w = tid >> 6, fr = lane & 15, fq = lane >> 4;
  const UnitInfo ui = unit_info(u);
  const int nblk = ui.samp ? 65 : ui.c + 1;
  const int hc = ui.h * 128;
  __syncthreads();
  ld_tile<bf16_t>(Qs, PRG(5) + (size_t)ui.rowbase * 512 + hc, 512, tid);
  f32x4 o[8][1];
#pragma unroll
  for (int mi = 0; mi < 8; ++mi) o[mi][0] = (f32x4){0.f, 0.f, 0.f, 0.f};
  float R = 0.f;
  const int tq = 16 * w + fr;
  u32x4 kr[4], vr[4];
#define SB_ISSUE(blk_) do { const bf16_t* kp_ = PRG(6) + ((size_t)ui.b * 8192 + (size_t)(blk_) * 64) * 512 + hc; const bf16_t* vp_ = PRG(7) + ((size_t)ui.b * 8192 + (size_t)(blk_) * 64) * 512 + hc; \
    _Pragma("unroll") for (int j_ = 0; j_ < 4; ++j_) { const int id_ = tid + 256 * j_; kr[j_] = *(const u32x4*)(kp_ + (long)(id_ >> 4) * 512 + (id_ & 15) * 8); vr[j_] = *(const u32x4*)(vp_ + (long)(id_ & 63) * 512 + (id_ >> 6) * 8); } } while (0)
#define SB_COMMIT() do { _Pragma("unroll") for (int j_ = 0; j_ < 4; ++j_) { const int id_ = tid + 256 * j_; *(u32x4*)(Ks + (id_ >> 4) * 136 + (id_ & 15) * 8) = kr[j_]; \
      bf16_t* d_ = Vt + ((id_ >> 6) * 8) * 72 + (id_ & 63); const u32x4 v_ = vr[j_]; \
      d_[0] = (bf16_t)(v_.x & 0xffff); d_[72] = (bf16_t)(v_.x >> 16); d_[144] = (bf16_t)(v_.y & 0xffff); d_[216] = (bf16_t)(v_.y >> 16); \
      d_[288] = (bf16_t)(v_.z & 0xffff); d_[360] = (bf16_t)(v_.z >> 16); d_[432] = (bf16_t)(v_.w & 0xffff); d_[504] = (bf16_t)(v_.w >> 16); } } while (0)
  if (!ui.samp) SB_ISSUE(nblk - 1);
  for (int i = nblk - 1; i >= 0; --i) {
    if (!ui.samp) {
      SB_COMMIT();
      if (i > 0) SB_ISSUE(i - 1);
    } else if (i == 64) {
      const size_t krow = (size_t)ui.rowbase;
      ld_tile<bf16_t>(Ks, PRG(6) + krow * 512 + hc, 512, tid);
      ld_T<bf16_t, 64, 72>(Vt, PRG(7) + krow * 512 + hc, 512, tid);
    } else {
      const size_t off = ((size_t)((l * 8 + ui.b) * 4 + ui.h) * 4096 + (size_t)i * 64) * 128;
      ld_tile<float>(Ks, p.ck + off, 128, tid);
      ld_T<float, 64, 72>(Vt, p.cv + off, 128, tid);
    }
    __syncthreads();
    f32x4 z[4][1];
#pragma unroll
    for (int mi = 0; mi < 4; ++mi) z[mi][0] = (f32x4){0.f, 0.f, 0.f, 0.f};
    wmma<4, 1, 4>(z, Ks, 136, Qs + 16 * w * 136, 136, fr, fq);
    const bool diag = (i == nblk - 1);
    float L[4][4], lsg[4][4], G[4];
#pragma unroll
    for (int mi = 0; mi < 4; ++mi) {
      G[mi] = 0.f;
#pragma unroll
      for (int j = 0; j < 4; ++j) {
        const int kk = mi * 16 + fq * 4 + j;
        const float zz = z[mi][0][j] * 0.08838834764831845f;
        const float sp = softplus(zz);
        const bool valid = !diag || kk < tq;
        L[mi][j] = valid ? -sp : 0.f;
        lsg[mi][j] = valid ? zz - sp : -1e30f;
        G[mi] += L[mi][j];
      }
    }
    float sufm = 0.f;
#pragma unroll
    for (int mi = 3; mi >= 0; --mi) {
      const float g0 = __shfl(G[mi], fr), g1 = __shfl(G[mi], fr + 16), g2 = __shfl(G[mi], fr + 32), g3 = __shfl(G[mi], fr + 48);
      const float later = (fq < 1 ? g1 : 0.f) + (fq < 2 ? g2 : 0.f) + (fq < 3 ? g3 : 0.f);
      const float s3 = R + sufm + later, s2 = s3 + L[mi][3], s1 = s2 + L[mi][2], s0 = s1 + L[mi][1];
      const float a0 = __expf(lsg[mi][0] + s0), a1 = __expf(lsg[mi][1] + s1), a2 = __expf(lsg[mi][2] + s2), a3 = __expf(lsg[mi][3] + s3);
      u32x2 pk; pk.x = pack2(a0, a1); pk.y = pack2(a2, a3);
      *(u32x2*)(Ps + tq * 72 + mi * 16 + fq * 4) = pk;
      sufm += (g0 + g1) + (g2 + g3);
    }
    R += sufm;
    __syncthreads();
    wmma<8, 1, 2>(o, Vt, 72, Ps + 16 * w * 72, 72, fr, fq);
    if (__syncthreads_and(R < -110.f)) break;
  }
  const size_t row = (size_t)ui.rowbase + tq;
#pragma unroll
  for (int mi = 0; mi < 8; ++mi) {
    const int col = hc + mi * 16 + fq * 4;
    u32x2 zz = *(const u32x2*)(PRG(8) + row * 512 + col);
    f32x4 v = o[mi][0];
    u32x2 pk;
    pk.x = pack2(v[0] * silu(lo2f(zz.x)), v[1] * silu(hi2f(zz.x)));
    pk.y = pack2(v[2] * silu(lo2f(zz.y)), v[3] * silu(hi2f(zz.y)));
    *(u32x2*)(p.H() + (size_t)1 * NTOK * 512 + row * 512 + col) = pk;
  }
}

#undef SB_ISSUE
#undef SB_COMMIT
__device__ void mlstm_local(const Params& p, int l, int u, char* smem) {
  bf16_t* kdT = (bf16_t*)smem;
  bf16_t* vT = kdT + 128 * 72;
  bf16_t* xq = vT + 128 * 72;
  bf16_t* xk = xq + 67 * 136;
  float* dec = (float*)(xk + 67 * 136);
  const int tid = get_tid(), lane = tid & 63, w = tid >> 6, fr = lane & 15, fq = lane >> 4;
  const UnitInfo ui = unit_info(u);
  const int hc = ui.h * 128;
  __syncthreads();
  if (w == 0) {
    const float lfv = p.lf()[(ui.rowbase + lane) * 4 + ui.h], igv = p.ig()[(ui.rowbase + lane) * 4 + ui.h];
    float bs = lfv;
#pragma unroll
    for (int o = 1; o < 64; o <<= 1) { float t = __shfl_up(bs, o); if (lane >= o) bs += t; }
    const float g = igv - bs;
    float gm = g;
#pragma unroll
    for (int o = 32; o > 0; o >>= 1) gm = fmaxf(gm, __shfl_xor(gm, o));
    const float bL = __shfl(bs, 63);
    dec[lane] = __expf(g - gm);
    if (lane == 0) { p.ac()[u] = bL + gm; p.Bc()[u] = bL; }
  }
  ld_tile<bf16_t>(xq + 3 * 136, PRG(0) + (size_t)ui.rowbase * 512 + hc, 512, tid);
  ld_tile<bf16_t>(xk + 3 * 136, PRG(1) + (size_t)ui.rowbase * 512 + hc, 512, tid);
  ld_T<bf16_t, 64, 72>(vT, PRG(2) + (size_t)ui.rowbase * 512 + hc, 512, tid);
  {
    const int isk = tid >> 7, ch = tid & 127, col = hc + ch;
    bf16_t* xs = isk ? xk : xq;
    if (ui.samp) {
      const float* cs = p.st_conv + (size_t)(l * 8 + ui.b) * 3072 + isk * 512 + col;
      xs[ch] = f2bf(cs[0]); xs[136 + ch] = f2bf(cs[1024]); xs[272 + ch] = f2bf(cs[2048]);
    } else if (ui.c > 0) {
      const bf16_t* src = PRG(isk) + (size_t)ui.rowbase * 512 + col;
      xs[ch] = src[-3 * 512]; xs[136 + ch] = src[-2 * 512]; xs[272 + ch] = src[-1 * 512];
    } else { xs[ch] = 0; xs[136 + ch] = 0; xs[272 + ch] = 0; }
  }
  __syncthreads();
  {
    const int isk = tid >> 7, ch = tid & 127, col = hc + ch;
    bf16_t* xs = isk ? xk : xq;
    const float* wc_ = p.w_conv + (size_t)l * 4096 + isk * 512 + col;
    const float w0 = wc_[0], w1 = wc_[1024], w2 = wc_[2048], w3 = wc_[3072];
    float x0 = bf2f(xs[ch]), x1 = bf2f(xs[136 + ch]), x2 = bf2f(xs[272 + ch]);
#pragma unroll 8
    for (int t = 0; t < 64; ++t) {
      const float x3 = bf2f(xs[(t + 3) * 136 + ch]);
      float y = silu(w0 * x0 + w1 * x1 + w2 * x2 + w3 * x3);
      if (isk) y *= 0.08838834764831845f;
      const bf16_t yb = f2bf(y);
      xs[t * 136 + ch] = yb;
      if (isk) kdT[ch * 72 + t] = f2bf(bf2f(yb) * dec[t]);
      x0 = x1; x1 = x2; x2 = x3;
    }
  }
  __syncthreads();
#pragma unroll
  for (int i = 0; i < 4; ++i) {
    const int id = tid + 256 * i, r = id >> 4, c = (id & 15) * 8;
    *(u32x4*)(p.QC() + (size_t)(ui.rowbase + r) * 512 + hc + c) = *(const u32x4*)(xq + r * 136 + c);
    *(u32x4*)(p.KC() + (size_t)(ui.rowbase + r) * 512 + hc + c) = *(const u32x4*)(xk + r * 136 + c);
  }
  if (tid < 128) { float s_ = 0.f;
#pragma unroll 8
    for (int t = 0; t < 64; ++t) s_ += bf2f(kdT[tid * 72 + t]); p.nloc()[u * 128 + tid] = s_; }
  f32x4 acc[8][2];
#pragma unroll
  for (int a_ = 0; a_ < 8; ++a_) { acc[a_][0] = (f32x4){0.f, 0.f, 0.f, 0.f}; acc[a_][1] = (f32x4){0.f, 0.f, 0.f, 0.f}; }
  wmma<8, 2, 2>(acc, kdT, 72, vT + 32 * w * 72, 72, fr, fq);
  bf16_t* sm = p.SM() + (size_t)u * 16384;
#pragma unroll
  for (int mi = 0; mi < 8; ++mi)
#pragma unroll
    for (int ni = 0; ni < 2; ++ni) {
      u32x2 pk; pk.x = pack2(acc[mi][ni][0], acc[mi][ni][1]); pk.y = pack2(acc[mi][ni][2], acc[mi][ni][3]);
      *(u32x2*)(sm + (32 * w + ni * 16 + fr) * 128 + mi * 16 + fq * 4) = pk;
    }
}

__device__ __forceinline__ float hgrn_lb(const Params& p, int l, int ch512) {
  if (l == 0) return 0.f;
  return sigm(p.lb_logits[512 + ch512] - p.lb_logits[ch512]);
}
__device__ __forceinline__ void hgrn_gate(float f, float lb, float& lg, float& kh) {
  const float e = __expf(-fabsf(f));
  const float sp = f >= 0.f ? 1.f / (1.f + e) : e / (1.f + e);
  const float sn = f >= 0.f ? e / (1.f + e) : 1.f / (1.f + e);
  lg = (lb == 0.f) ? (fminf(f, 0.f) - __logf(1.f + e)) : __logf(lb + (1.f - lb) * sp);
  kh = (1.f - lb) * sn;
}

__device__ void hgrn_local(const Params& p, int l, int u, char* smem) {
  bf16_t* kdT = (bf16_t*)smem;
  bf16_t* iT = kdT + 128 * 72;
  bf16_t* fs = iT + 128 * 72;
  float* tot = (float*)(fs + 64 * 136);
  const int tid = get_tid(), lane = tid & 63, w = tid >> 6, fr = lane & 15, fq = lane >> 4;
  const UnitInfo ui = unit_info(u);
  const int hc = ui.h * 128;
  __syncthreads();
  ld_tile<bf16_t>(fs, PRG(10) + (size_t)ui.rowbase * 512 + hc, 512, tid);
  ld_T<bf16_t, 64, 72>(iT, PRG(11) + (size_t)ui.rowbase * 512 + hc, 512, tid);
  const int half = tid >> 7, ch = tid & 127;
  const float lb = hgrn_lb(p, l, hc + ch);
  __syncthreads();
  const bf16_t* src = fs + (half * 32) * 136 + ch;
  {
    float run = 0.f;
#pragma unroll 8
    for (int t = 0; t < 32; ++t) { float lg, kh; hgrn_gate(bf2f(src[t * 136]), lb, lg, kh); run += lg; }
    tot[half * 128 + ch] = run;
  }
  __syncthreads();
  {
    const float t0 = tot[ch], t1 = tot[128 + ch];
    const float bcL = t0 + t1;
    float run = half ? t0 : 0.f;
#pragma unroll 8
    for (int t = 0; t < 32; ++t) {
      float lg, kh; hgrn_gate(bf2f(src[t * 136]), lb, lg, kh); run += lg;
      kdT[ch * 72 + half * 32 + t] = f2bf(kh * __expf(bcL - run));
    }
    if (half == 0) p.hbc()[u * 128 + ch] = bcL;
  }
  __syncthreads();
  f32x4 acc[8][2];
#pragma unroll
  for (int a_ = 0; a_ < 8; ++a_) { acc[a_][0] = (f32x4){0.f, 0.f, 0.f, 0.f}; acc[a_][1] = (f32x4){0.f, 0.f, 0.f, 0.f}; }
  wmma<8, 2, 2>(acc, kdT, 72, iT + 32 * w * 72, 72, fr, fq);
  bf16_t* sh = p.SH() + (size_t)u * 16384;
#pragma unroll
  for (int mi = 0; mi < 8; ++mi)
#pragma unroll
    for (int ni = 0; ni < 2; ++ni) {
      u32x2 pk; pk.x = pack2(acc[mi][ni][0], acc[mi][ni][1]); pk.y = pack2(acc[mi][ni][2], acc[mi][ni][3]);
      *(u32x2*)(sh + (32 * w + ni * 16 + fr) * 128 + mi * 16 + fq * 4) = pk;
    }
}

__device__ void scan_phase(const Params& p, int l, char* smem) {
  float* cdc = (float*)smem;
  float* cwl = cdc + 128;
  float* cmi = cwl + 128;
  const int tid = get_tid();
  for (int vb = blockIdx.x; vb < 520; vb += gridDim.x) {
    const int kind = vb >> 8;
    const int seq = (kind == 2) ? (vb - 512) : ((vb >> 5) & 7);
    __syncthreads();
    if (kind != 1) {
      if (tid < 128) { cdc[tid] = p.ac()[seq * 128 + tid]; cwl[tid] = p.Bc()[seq * 128 + tid]; }
      __syncthreads();
      if (tid == 0) {
        float m = 0.f;
        for (int c = 0; c < 128; ++c) {
          const float a = cdc[c], B = cwl[c];
          const float mo = fmaxf(a, B + m);
          cdc[c] = __expf(B + m - mo); cwl[c] = __expf(a - mo); cmi[c] = m; m = mo;
        }
        if (kind == 0 && (vb & 31) == 0) p.o_pm()[l * 8 + seq] = m;
      }
      __syncthreads();
      if (kind == 0 && (vb & 31) == 0 && tid < 128) p.min_()[seq * 128 + tid] = cmi[tid];
    }
    if (kind == 2) {
      if (tid < 128) {
        float n = 0.f;
        float* base = p.nloc() + (size_t)seq * 128 * 128 + tid;
        for (int c0 = 0; c0 < 128; c0 += 16) {
          float lv[16];
#pragma unroll
          for (int j = 0; j < 16; ++j) lv[j] = base[(c0 + j) * 128];
#pragma unroll
          for (int j = 0; j < 16; ++j) { const float nl = lv[j]; lv[j] = n; n = cdc[c0 + j] * n + cwl[c0 + j] * nl; }
#pragma unroll
          for (int j = 0; j < 16; ++j) base[(c0 + j) * 128] = lv[j];
        }
        p.o_pn()[(l * 8 + seq) * 128 + tid] = n;
      }
      continue;
    }
    const int pr = (vb & 31) * 256 + tid, e = pr * 2, er = e >> 7, ec = e & 127;
    unsigned* base = (unsigned*)((kind ? p.SH() : p.SM()) + (size_t)seq * 128 * 16384) + pr;
    const float* hb = p.hbc() + (size_t)seq * 128 * 128 + ec;
    float c0v = 0.f, c1v = 0.f;
    unsigned lv[16], nx[16];
    float2 hv[16], hn[16];
#pragma unroll
    for (int j = 0; j < 16; ++j) { nx[j] = base[(size_t)j * 8192]; hn[j] = kind ? *(const float2*)(hb + j * 128) : make_float2(0.f, 0.f); }
    for (int c0 = 0; c0 < 128; c0 += 16) {
#pragma unroll
      for (int j = 0; j < 16; ++j) { lv[j] = nx[j]; hv[j] = hn[j]; }
      if (c0 + 16 < 128) {
#pragma unroll
        for (int j = 0; j < 16; ++j) { nx[j] = base[(size_t)(c0 + 16 + j) * 8192]; if (kind) hn[j] = *(const float2*)(hb + (c0 + 16 + j) * 128); }
      }
#pragma unroll
      for (int j = 0; j < 16; ++j) {
        const unsigned v = lv[j];
        lv[j] = pack2(c0v, c1v);
        const float d0 = kind ? __expf(hv[j].x) : cdc[c0 + j];
        const float d1 = kind ? __expf(hv[j].y) : d0;
        const float wl = kind ? 1.f : cwl[c0 + j];
        c0v = d0 * c0v + wl * lo2f(v); c1v = d1 * c1v + wl * hi2f(v);
      }
#pragma unroll
      for (int j = 0; j < 16; ++j) base[(size_t)(c0 + j) * 8192] = lv[j];
    }
    float* o = (kind ? p.o_pS() : p.o_pC()) + (size_t)(l * 8 + seq) * 16384;
    o[ec * 128 + er] = c0v; o[(ec + 1) * 128 + er] = c1v;
  }
  const int gt = blockIdx.x * 256 + tid, nth = gridDim.x * 256;
  for (int it = gt; it < 524288; it += nth) {
    const int kind = it >> 18, sq = (it >> 13) & 31, pr = it & 8191, e = pr * 2, u = 1024 + sq, er = e >> 7, ec = e & 127;
    if (kind == 0) {
      const float* c0p = p.st_C + (size_t)(l * 32 + sq) * 16384;
      const float C0 = c0p[ec * 128 + er], C1 = c0p[(ec + 1) * 128 + er], m = p.st_m[l * 32 + sq];
      unsigned* slot = (unsigned*)(p.SM() + (size_t)u * 16384) + pr;
      const unsigned lv = *slot;
      const float a = p.ac()[u], B = p.Bc()[u];
      const float mo = fmaxf(a, B + m), dc = __expf(B + m - mo), wl = __expf(a - mo);
      *slot = pack2(C0, C1);
      float* o = p.o_sC() + (size_t)(l * 32 + sq) * 16384;
      o[ec * 128 + er] = dc * C0 + wl * lo2f(lv); o[(ec + 1) * 128 + er] = dc * C1 + wl * hi2f(lv);
      if (pr == 0) { p.min_()[u] = m; p.o_sm()[l * 32 + sq] = mo; }
    } else {
      const float* s0p = p.st_S + (size_t)(l * 32 + sq) * 16384;
      const float S0 = s0p[ec * 128 + er], S1 = s0p[(ec + 1) * 128 + er];
      unsigned* slot = (unsigned*)(p.SH() + (size_t)u * 16384) + pr;
      const unsigned lv = *slot;
      const float d0 = __expf(p.hbc()[u * 128 + ec]), d1 = __expf(p.hbc()[u * 128 + ec + 1]);
      *slot = pack2(S0, S1);
      float* o = p.o_sS() + (size_t)(l * 32 + sq) * 16384;
      o[ec * 128 + er] = d0 * S0 + lo2f(lv); o[(ec + 1) * 128 + er] = d1 * S1 + hi2f(lv);
    }
  }
  for (int it = gt; it < 4096; it += nth) {
    const int sq = it >> 7, d = it & 127, u = 1024 + sq;
    const float n0 = p.st_n[(l * 32 + sq) * 128 + d], m = p.st_m[l * 32 + sq];
    const float a = p.ac()[u], B = p.Bc()[u];
    const float mo = fmaxf(a, B + m), dc = __expf(B + m - mo), wl = __expf(a - mo);
    const float nl = p.nloc()[u * 128 + d];
    p.nloc()[u * 128 + d] = n0;
    p.o_sn()[(l * 32 + sq) * 128 + d] = dc * n0 + wl * nl;
  }
}

__device__ void mlstm_out(const Params& p, int l, int u, char* smem) {
  bf16_t* Qs = (bf16_t*)smem;
  bf16_t* CT = Qs + 64 * 136;
  bf16_t* Ks = CT;
  bf16_t* Vt = Ks + 64 * 136;
  bf16_t* Ps = Vt + 144 * 72;
  float* misc = (float*)(smem + 17408 + 47360);
  float *bsum = misc, *gs = misc + 64, *mt = misc + 128, *wint = misc + 192;
  const int tid = get_tid(), lane = tid & 63, w = tid >> 6, fr = lane & 15, fq = lane >> 4;
  const UnitInfo ui = unit_info(u);
  const int hc = ui.h * 128;
  __syncthreads();
  if (w == 0) {
    const float lfv = p.lf()[(ui.rowbase + lane) * 4 + ui.h], igv = p.ig()[(ui.rowbase + lane) * 4 + ui.h];
    float bs = lfv;
#pragma unroll
    for (int o = 1; o < 64; o <<= 1) { float t = __shfl_up(bs, o); if (lane >= o) bs += t; }
    const float g = igv - bs;
    float cm = g;
#pragma unroll
    for (int o = 1; o < 64; o <<= 1) { float t = __shfl_up(cm, o); if (lane >= o) cm = fmaxf(cm, t); }
    const float m_in = p.min_()[u];
    const float mtt = bs + fmaxf(cm, m_in);
    bsum[lane] = bs; gs[lane] = g; mt[lane] = mtt; wint[lane] = __expf(bs + m_in - mtt);
  }
  ld_tile<bf16_t>(Qs, p.QC() + (size_t)ui.rowbase * 512 + hc, 512, tid);
  ld_tile128<bf16_t>(CT, p.SM() + (size_t)u * 16384, 128, tid);
  if (tid < 128) CT[128 * 136 + tid] = f2bf(p.nloc()[u * 128 + tid]);
  for (int i = tid; i < 15 * 128; i += 256) CT[(129 + (i >> 7)) * 136 + (i & 127)] = 0;
  __syncthreads();
  f32x4 acc[9][1];
#pragma unroll
  for (int mi = 0; mi < 9; ++mi) acc[mi][0] = (f32x4){0.f, 0.f, 0.f, 0.f};
  wmma<9, 1, 4>(acc, CT, 136, Qs + 16 * w * 136, 136, fr, fq);
  const int t = 16 * w + fr;
  const float wi = wint[t];
#pragma unroll
  for (int mi = 0; mi < 9; ++mi) acc[mi][0] *= wi;
  __syncthreads();
  ld_tile<bf16_t>(Ks, p.KC() + (size_t)ui.rowbase * 512 + hc, 512, tid);
  ld_T<bf16_t, 64, 72>(Vt, PRG(2) + (size_t)ui.rowbase * 512 + hc, 512, tid);
  if (tid < 64) Vt[128 * 72 + tid] = 0x3F80;
  for (int i = tid; i < 15 * 64; i += 256) Vt[(129 + (i >> 6)) * 72 + (i & 63)] = 0;
  __syncthreads();
  f32x4 st[4][1];
#pragma unroll
  for (int mi = 0; mi < 4; ++mi) st[mi][0] = (f32x4){0.f, 0.f, 0.f, 0.f};
  wmma<4, 1, 4>(st, Ks, 136, Qs + 16 * w * 136, 136, fr, fq);
  const float bt = bsum[t], mtt = mt[t];
#pragma unroll
  for (int mi = 0; mi < 4; ++mi) {
    float a[4];
#pragma unroll
    for (int j = 0; j < 4; ++j) {
      const int s = mi * 16 + fq * 4 + j;
      a[j] = (s <= t) ? st[mi][0][j] * __expf(bt + gs[s] - mtt) : 0.f;
    }
    u32x2 pk; pk.x = pack2(a[0], a[1]); pk.y = pack2(a[2], a[3]);
    *(u32x2*)(Ps + t * 72 + mi * 16 + fq * 4) = pk;
  }
  __syncthreads();
  wmma<9, 1, 2>(acc, Vt, 72, Ps + 16 * w * 72, 72, fr, fq);
  const float den = __shfl(acc[8][0][0], fr);
  const float inv = 1.f / fmaxf(fabsf(den), __expf(-mtt));
  float ss = 0.f;
#pragma unroll
  for (int mi = 0; mi < 8; ++mi) { acc[mi][0] *= inv; ss += acc[mi][0][0] * acc[mi][0][0] + acc[mi][0][1] * acc[mi][0][1] + acc[mi][0][2] * acc[mi][0][2] + acc[mi][0][3] * acc[mi][0][3]; }
  ss += __shfl_xor(ss, 16); ss += __shfl_xor(ss, 32);
  const float rs = rsqrtf(ss * (1.f / 128.f) + 1e-6f);
  const size_t row = (size_t)ui.rowbase + t;
#pragma unroll
  for (int mi = 0; mi < 8; ++mi) {
    const int col = hc + mi * 16 + fq * 4;
    const u32x2 ov = *(const u32x2*)(PRG(3) + row * 512 + col);
    const u32x2 zv = *(const u32x2*)(PRG(4) + row * 512 + col);
    const float4 g = *(const float4*)(p.g_ml + l * 512 + col);
    const f32x4 v = acc[mi][0];
    u32x2 pk;
    pk.x = pack2(v[0] * rs * g.x * sigm(lo2f(ov.x)) * silu(lo2f(zv.x)), v[1] * rs * g.y * sigm(hi2f(ov.x)) * silu(hi2f(zv.x)));
    pk.y = pack2(v[2] * rs * g.z * sigm(lo2f(ov.y)) * silu(lo2f(zv.y)), v[3] * rs * g.w * sigm(hi2f(ov.y)) * silu(hi2f(zv.y)));
    *(u32x2*)(p.H() + row * 512 + col) = pk;
  }
}

__device__ __forceinline__ bf16x8 scale_frag(const bf16_t* src, const float* ea, const float* eb, float sgn, bool clampit) {
  u32x4 raw = *(const u32x4*)src;
  float4 a0 = *(const float4*)ea, a1 = *(const float4*)(ea + 4);
  float4 b0 = {0.f, 0.f, 0.f, 0.f}, b1 = {0.f, 0.f, 0.f, 0.f};
  if (eb) { b0 = *(const float4*)eb; b1 = *(const float4*)(eb + 4); }
  float e[8] = {a0.x - b0.x, a0.y - b0.y, a0.z - b0.z, a0.w - b0.w, a1.x - b1.x, a1.y - b1.y, a1.z - b1.z, a1.w - b1.w};
  float v[8] = {lo2f(raw.x), hi2f(raw.x), lo2f(raw.y), hi2f(raw.y), lo2f(raw.z), hi2f(raw.z), lo2f(raw.w), hi2f(raw.w)};
  unsigned o[4];
#pragma unroll
  for (int i = 0; i < 4; ++i) {
    float x0 = sgn * e[2 * i], x1 = sgn * e[2 * i + 1];
    if (clampit) { x0 = fminf(x0, 80.f); x1 = fminf(x1, 80.f); }
    o[i] = pack2(v[2 * i] * __expf(x0), v[2 * i + 1] * __expf(x1));
  }
  u32x4 r = {o[0], o[1], o[2], o[3]};
  return __builtin_bit_cast(bf16x8, r);
}

__device__ void hgrn_out(const Params& p, int l, int u, char* smem) {
  float* bc = (float*)smem;
  bf16_t* ST = (bf16_t*)smem;
  bf16_t* qs = (bf16_t*)(smem + 34816);
  bf16_t* kh = (bf16_t*)(smem + 34816 + 17408);
  bf16_t* iT = kh;
  bf16_t* Ps = (bf16_t*)(smem + 34816 + 17408 + 18432);
  float* tot = (float*)(smem + 79872);
  const int tid = get_tid(), lane = tid & 63, w = tid >> 6, fr = lane & 15, fq = lane >> 4;
  const UnitInfo ui = unit_info(u);
  const int hc = ui.h * 128;
  __syncthreads();
  ld_tile<bf16_t>(qs, PRG(9) + (size_t)ui.rowbase * 512 + hc, 512, tid);
  ld_tile<bf16_t>(kh, PRG(10) + (size_t)ui.rowbase * 512 + hc, 512, tid);
  __syncthreads();
  {
    const int half = tid >> 7, ch = tid & 127;
    const float lb = hgrn_lb(p, l, hc + ch);
    bf16_t* src = kh + (half * 32) * 136 + ch;
    float run = 0.f;
#pragma unroll 8
    for (int t = 0; t < 32; ++t) { float lg, k; hgrn_gate(bf2f(src[t * 136]), lb, lg, k); run += lg; }
    tot[half * 128 + ch] = run;
    __syncthreads();
    run = half ? tot[ch] : 0.f;
#pragma unroll 8
    for (int t = 0; t < 32; ++t) {
      float lg, k; hgrn_gate(bf2f(src[t * 136]), lb, lg, k); run += lg;
      bc[(half * 32 + t) * 132 + ch] = run;
      src[t * 136] = f2bf(k);
    }
  }
  __syncthreads();
  {
    const int I = w, t = 16 * I + fr;
    f32x4 a[4];
#pragma unroll
    for (int J = 0; J < 4; ++J) a[J] = (f32x4){0.f, 0.f, 0.f, 0.f};
#pragma unroll
    for (int kk = 0; kk < 4; ++kk) {
      const int c0 = kk * 32 + fq * 8;
      const float* rI = (I > 0) ? bc + (16 * I - 1) * 132 + c0 : nullptr;
      const bf16x8 bq = scale_frag(qs + t * 136 + c0, bc + t * 132 + c0, rI, 1.f, false);
#pragma unroll
      for (int J = 0; J < 4; ++J) {
        if (J <= I) {
          const int s = 16 * J + fr;
          const bf16x8 ak = scale_frag(kh + s * 136 + c0, bc + s * 132 + c0, rI, -1.f, true);
          a[J] = __builtin_amdgcn_mfma_f32_16x16x32_bf16(ak, bq, a[J], 0, 0, 0);
        }
      }
    }
#pragma unroll
    for (int J = 0; J < 4; ++J) {
      float v[4];
#pragma unroll
      for (int j = 0; j < 4; ++j) { const int s = 16 * J + fq * 4 + j; v[j] = (s <= t) ? a[J][j] : 0.f; }
      u32x2 pk; pk.x = pack2(v[0], v[1]); pk.y = pack2(v[2], v[3]);
      *(u32x2*)(Ps + t * 72 + J * 16 + fq * 4) = pk;
    }
  }
  __syncthreads();
#pragma unroll 4
  for (int i = tid; i < 64 * 128; i += 256) { const int t = i >> 7, c = i & 127; qs[t * 136 + c] = f2bf(bf2f(qs[t * 136 + c]) * __expf(bc[t * 132 + c])); }
  __syncthreads();
  ld_T<bf16_t, 64, 72>(iT, PRG(11) + (size_t)ui.rowbase * 512 + hc, 512, tid);
  ld_tile128<bf16_t>(ST, p.SH() + (size_t)u * 16384, 128, tid);
  __syncthreads();
  f32x4 acc[8][1];
#pragma unroll
  for (int mi = 0; mi < 8; ++mi) acc[mi][0] = (f32x4){0.f, 0.f, 0.f, 0.f};
  wmma<8, 1, 2>(acc, iT, 72, Ps + 16 * w * 72, 72, fr, fq);
  wmma<8, 1, 4>(acc, ST, 136, qs + 16 * w * 136, 136, fr, fq);
  float ss = 0.f;
#pragma unroll
  for (int mi = 0; mi < 8; ++mi) ss += acc[mi][0][0] * acc[mi][0][0] + acc[mi][0][1] * acc[mi][0][1] + acc[mi][0][2] * acc[mi][0][2] + acc[mi][0][3] * acc[mi][0][3];
  ss += __shfl_xor(ss, 16); ss += __shfl_xor(ss, 32);
  const float rs = rsqrtf(ss * (1.f / 128.f) + 1e-6f);
  const size_t row = (size_t)ui.rowbase + 16 * w + fr;
#pragma unroll
  for (int mi = 0; mi < 8; ++mi) {
    const int col = hc + mi * 16 + fq * 4;
    const u32x2 zv = *(const u32x2*)(PRG(12) + row * 512 + col);
    const float4 g = *(const float4*)(p.g_hg + l * 512 + col);
    const f32x4 v = acc[mi][0];
    u32x2 pk;
    pk.x = pack2(v[0] * rs * g.x * silu(lo2f(zv.x)), v[1] * rs * g.y * silu(hi2f(zv.x)));
    pk.y = pack2(v[2] * rs * g.z * silu(lo2f(zv.y)), v[3] * rs * g.w * silu(hi2f(zv.y)));
    *(u32x2*)(p.H() + (size_t)2 * NTOK * 512 + row * 512 + col) = pk;
  }
}

__device__ void merge_tile(const Params& p, int l, int t, char* smem) {
  const int tm = t >> 3, tn = t & 7;
  const int tid = get_tid(), lane = tid & 63, wid = tid >> 6, wr = wid >> 1, wc = wid & 1, fr = lane & 15, fq = lane >> 4;
#pragma unroll 1
  for (int b = 0; b < 3; ++b) {
    f32x4 acc[4][4]; zero_acc(acc);
    gemm_kloop<bf16_t>(acc, p.U() + (size_t)tm * 128 * 1024, 1024, p.wt_in() + (size_t)l * NWT * 1024 + (size_t)(NMAIN + b * 1024 + tn * 128) * 1024, 1024, 1024, smem);
#pragma unroll
    for (int ni = 0; ni < 4; ++ni)
#pragma unroll
      for (int mi = 0; mi < 4; ++mi) {
        f32x4 v; v[0] = sigm(acc[mi][ni][0]); v[1] = sigm(acc[mi][ni][1]); v[2] = sigm(acc[mi][ni][2]); v[3] = sigm(acc[mi][ni][3]);
        *(f32x4*)(p.r() + ((size_t)tm * 128 + wr * 64 + ni * 16 + fr) * 1024 + tn * 128 + wc * 64 + mi * 16 + fq * 4) = v;
      }
    zero_acc(acc);
    gemm_kloop<bf16_t>(acc, p.H() + (size_t)b * NTOK * 512 + (size_t)tm * 128 * 512, 512, p.wt_br() + (size_t)(l * 3 + b) * 1024 * 512 + (size_t)tn * 128 * 512, 512, 512, smem);
#pragma unroll
    for (int ni = 0; ni < 4; ++ni) {
      const size_t row = (size_t)tm * 128 + wr * 64 + ni * 16 + fr;
#pragma unroll
      for (int mi = 0; mi < 4; ++mi) {
        const int col = tn * 128 + wc * 64 + mi * 16 + fq * 4;
        f32x4 v = *(const f32x4*)(p.r() + row * 1024 + col) * acc[mi][ni];
        float* part = p.y() + row * 1024 + col;
        if (b > 0) v += *(const f32x4*)part;
        if (b < 2) *(f32x4*)part = v;
        else { u32x2 pk; pk.x = pack2(v[0], v[1]); pk.y = pack2(v[2], v[3]); *(u32x2*)(p.merged() + row * 1024 + col) = pk; }
      }
    }
  }
}

__device__ void outproj_tile(const Params& p, int l, int t, char* smem) {
  const int tm = t >> 3, tn = t & 7;
  const int tid = get_tid(), lane = tid & 63, wid = tid >> 6, wr = wid >> 1, wc = wid & 1, fr = lane & 15, fq = lane >> 4;
  f32x4 acc[4][4]; zero_acc(acc);
  gemm_kloop<bf16_t>(acc, p.merged() + (size_t)tm * 128 * 1024, 1024, p.wt_out() + (size_t)l * 1048576 + (size_t)tn * 128 * 1024, 1024, 1024, smem);
#pragma unroll
  for (int ni = 0; ni < 4; ++ni) {
    const size_t row = (size_t)tm * 128 + wr * 64 + ni * 16 + fr;
#pragma unroll
    for (int mi = 0; mi < 4; ++mi) *(f32x4*)(p.y() + row * 1024 + tn * 128 + wc * 64 + mi * 16 + fq * 4) = acc[mi][ni];
  }
}


__device__ void outproj_tile256(const Params& p, int l, int t, char* smem) {
  constexpr int NT = 8;
  const int tm = t >> 3, tn = t & 7;
  const int tid = get_tid(), lane = tid & 63, wid = tid >> 6, wr = wid >> 1, wc = wid & 1, fr = lane & 15, fq = lane >> 4;
  f32x4 acc[4][NT];
#pragma unroll
  for (int a_ = 0; a_ < 4; ++a_)
#pragma unroll
    for (int b_ = 0; b_ < NT; ++b_) acc[a_][b_] = (f32x4){0.f, 0.f, 0.f, 0.f};
  gemm_glds<NT, 3>(acc, p.merged() + (size_t)tm * 256 * 1024, 1024, p.wt_out() + (size_t)l * 1048576 + (size_t)tn * 128 * 1024, 1024, 1024, smem);
#pragma unroll
  for (int ni = 0; ni < NT; ++ni) {
    const size_t row = (size_t)tm * 256 + wr * 128 + ni * 16 + fr;
#pragma unroll
    for (int m = 0; m < 2; ++m) {
      float* op = p.y() + row * 1024 + tn * 128 + wc * 64 + m * 32 + fq * 8;
      *(f32x4*)op = acc[2 * m][ni]; *(f32x4*)(op + 4) = acc[2 * m + 1][ni];
    }
  }
}


__device__ void gate_tile256(const Params& p, int l, int t, char* smem) {
  constexpr int NT = 8;
  const int tm = t / 24, tn = t % 24;
  const int tid = get_tid(), lane = tid & 63, wid = tid >> 6, wr = wid >> 1, wc = wid & 1, fr = lane & 15, fq = lane >> 4;
  f32x4 acc[4][NT];
#pragma unroll
  for (int a_ = 0; a_ < 4; ++a_)
#pragma unroll
    for (int b_ = 0; b_ < NT; ++b_) acc[a_][b_] = (f32x4){0.f, 0.f, 0.f, 0.f};
  gemm_glds<NT, 3>(acc, p.U() + (size_t)tm * 256 * 1024, 1024, p.wt_in() + (size_t)l * NWT * 1024 + (size_t)(NMAIN + tn * 128) * 1024, 1024, 1024, smem);
#pragma unroll
  for (int ni = 0; ni < NT; ++ni) {
    const size_t row = (size_t)tm * 256 + wr * 128 + ni * 16 + fr;
#pragma unroll
    for (int m = 0; m < 2; ++m) {
      const f32x4 v0 = acc[2 * m][ni], v1 = acc[2 * m + 1][ni];
      u32x4 pk; pk.x = pack2(sigm(v0[0]), sigm(v0[1])); pk.y = pack2(sigm(v0[2]), sigm(v0[3])); pk.z = pack2(sigm(v1[0]), sigm(v1[1])); pk.w = pack2(sigm(v1[2]), sigm(v1[3]));
      *(u32x4*)(p.Gb(tn >> 3) + row * 1024 + (tn & 7) * 128 + wc * 64 + m * 32 + fq * 8) = pk;
    }
  }
}
__device__ void merge_tile_g(const Params& p, int l, int t, char* smem) {
  const int tm = t >> 3, tn = t & 7;
  const int tid = get_tid(), lane = tid & 63, wid = tid >> 6, wr = wid >> 1, wc = wid & 1, fr = lane & 15, fq = lane >> 4;
  f32x4 macc[4][4]; zero_acc(macc);
#pragma unroll 1
  for (int b = 0; b < 3; ++b) {
    f32x4 acc[4][4]; zero_acc(acc);
    gemm_kloop<bf16_t>(acc, p.H() + (size_t)b * NTOK * 512 + (size_t)tm * 128 * 512, 512, p.wt_br() + (size_t)(l * 3 + b) * 1024 * 512 + (size_t)tn * 128 * 512, 512, 512, smem);
#pragma unroll
    for (int ni = 0; ni < 4; ++ni) {
      const size_t row = (size_t)tm * 128 + wr * 64 + ni * 16 + fr;
#pragma unroll
      for (int mi = 0; mi < 4; ++mi) {
        const u32x2 g = *(const u32x2*)(p.Gb(b) + row * 1024 + tn * 128 + wc * 64 + mi * 16 + fq * 4);
        macc[mi][ni][0] += lo2f(g.x) * acc[mi][ni][0]; macc[mi][ni][1] += hi2f(g.x) * acc[mi][ni][1];
        macc[mi][ni][2] += lo2f(g.y) * acc[mi][ni][2]; macc[mi][ni][3] += hi2f(g.y) * acc[mi][ni][3];
      }
    }
  }
#pragma unroll
  for (int ni = 0; ni < 4; ++ni) {
    const size_t row = (size_t)tm * 128 + wr * 64 + ni * 16 + fr;
#pragma unroll
    for (int mi = 0; mi < 4; ++mi) {
      u32x2 pk; pk.x = pack2(macc[mi][ni][0], macc[mi][ni][1]); pk.y = pack2(macc[mi][ni][2], macc[mi][ni][3]);
      *(u32x2*)(p.merged() + row * 1024 + tn * 128 + wc * 64 + mi * 16 + fq * 4) = pk;
    }
  }
}

__device__ void postnorm_phase(const Params& p, int l) {
  const int lane = threadIdx.x & 63, wid = threadIdx.x >> 6;
  const float* gp = p.g_post + l * 1024;
  for (int row = blockIdx.x * 4 + wid; row < NTOK; row += gridDim.x * 4) {
    const float* x = xrow(p, l, row);
    const float* y = p.y() + (size_t)row * 1024;
    float4 v[4]; float ss = 0.f;
#pragma unroll
    for (int i = 0; i < 4; ++i) { v[i] = *(const float4*)(y + i * 256 + lane * 4); ss += v[i].x * v[i].x + v[i].y * v[i].y + v[i].z * v[i].z + v[i].w * v[i].w; }
#pragma unroll
    for (int o = 32; o > 0; o >>= 1) ss += __shfl_xor(ss, o);
    const float rstd = rsqrtf(ss * (1.f / 1024.f) + 1e-6f);
#pragma unroll
    for (int i = 0; i < 4; ++i) {
      const int k = i * 256 + lane * 4;
      const float4 g = *(const float4*)(gp + k), xv = *(const float4*)(x + k);
      float4 r; r.x = xv.x + v[i].x * rstd * g.x; r.y = xv.y + v[i].y * rstd * g.y; r.z = xv.z + v[i].z * rstd * g.z; r.w = xv.w + v[i].w * rstd * g.w;
      u32x2 pk; pk.x = pack2(r.x, r.y); pk.y = pack2(r.z, r.w);
      *(u32x2*)(p.rb() + (size_t)row * 1024 + k) = pk;
    }
  }
}

__device__ void ple_tile(const Params& p, int l, int t, char* smem) {
  const int tm = t >> 3, tn = t & 7;
  const int tid = get_tid(), lane = tid & 63, wid = tid >> 6, wr = wid >> 1, wc = wid & 1, fr = lane & 15, fq = lane >> 4;
  f32x4 acc[4][4]; zero_acc(acc);
  const int row0 = tm * 128;
  const float* pp = row0 < NPROMPT ? p.p_p + ((size_t)l * NPROMPT + row0) * 256 : p.p_s + ((size_t)l * 512 + (row0 - NPROMPT)) * 256;
  gemm_kloop<float>(acc, pp, 256, p.wt_pp() + (size_t)l * 262144 + (size_t)tn * 128 * 256, 256, 256, smem);
  u32x2 pb[4][4];
#pragma unroll
  for (int a = 0; a < 4; ++a)
#pragma unroll
    for (int c = 0; c < 4; ++c) { pb[a][c].x = pack2(acc[a][c][0], acc[a][c][1]); pb[a][c].y = pack2(acc[a][c][2], acc[a][c][3]); }
  zero_acc(acc);
  gemm_kloop<bf16_t>(acc, p.rb() + (size_t)tm * 128 * 1024, 1024, p.wt_pg() + (size_t)l * 1048576 + (size_t)tn * 128 * 1024, 1024, 1024, smem);
#pragma unroll
  for (int ni = 0; ni < 4; ++ni) {
    const size_t row = (size_t)row0 + wr * 64 + ni * 16 + fr;
#pragma unroll
    for (int mi = 0; mi < 4; ++mi) {
      const int col = tn * 128 + wc * 64 + mi * 16 + fq * 4;
      const u32x2 rbv = *(const u32x2*)(p.rb() + row * 1024 + col);
      const f32x4 rv = {lo2f(rbv.x), hi2f(rbv.x), lo2f(rbv.y), hi2f(rbv.y)};
      f32x4 o;
      o[0] = rv[0] + sigm(acc[mi][ni][0]) * lo2f(pb[mi][ni].x); o[1] = rv[1] + sigm(acc[mi][ni][1]) * hi2f(pb[mi][ni].x);
      o[2] = rv[2] + sigm(acc[mi][ni][2]) * lo2f(pb[mi][ni].y); o[3] = rv[3] + sigm(acc[mi][ni][3]) * hi2f(pb[mi][ni].y);
      *(f32x4*)(p.o_y() + row * 1024 + col) = o;
    }
  }
}


template <typename TT>
__device__ __forceinline__ void mini_dot(f32x4& acc, const TT* Trow, const bf16_t* Wrow, int K) {
#pragma unroll 8
  for (int k = 0; k < K; k += 32) {
    const u32x4 tv = ld8(Trow + k), wv = ld8(Wrow + k);
    acc = __builtin_amdgcn_mfma_f32_16x16x32_bf16(__builtin_bit_cast(bf16x8, wv), __builtin_bit_cast(bf16x8, tv), acc, 0, 0, 0);
  }
}
__device__ void merge_mini(const Params& p, int l, int j) {
  const int tid = get_tid(), lane = tid & 63, w = tid >> 6, fr = lane & 15, fq = lane >> 4;
  const size_t row = (size_t)NPROMPT + (j >> 4) * 16 + fr;
  const int cb = (j & 15) * 64 + w * 16;
  f32x4 out = {0.f, 0.f, 0.f, 0.f};
#pragma unroll 1
  for (int b = 0; b < 3; ++b) {
    f32x4 h = {0.f, 0.f, 0.f, 0.f};
    mini_dot<bf16_t>(h, p.H() + (size_t)b * NTOK * 512 + row * 512 + fq * 8, p.wt_br() + (size_t)(l * 3 + b) * 1024 * 512 + (size_t)(cb + fr) * 512 + fq * 8, 512);
    const u32x2 g = *(const u32x2*)(p.Gb(b) + row * 1024 + cb + fq * 4);
    out[0] += lo2f(g.x) * h[0]; out[1] += hi2f(g.x) * h[1]; out[2] += lo2f(g.y) * h[2]; out[3] += hi2f(g.y) * h[3];
  }
  u32x2 pk; pk.x = pack2(out[0], out[1]); pk.y = pack2(out[2], out[3]);
  *(u32x2*)(p.merged() + row * 1024 + cb + fq * 4) = pk;
}
__device__ void outproj_mini(const Params& p, int l, int j) {
  const int tid = get_tid(), lane = tid & 63, w = tid >> 6, fr = lane & 15, fq = lane >> 4;
  const size_t row = (size_t)NPROMPT + (j >> 4) * 16 + fr;
  const int cb = (j & 15) * 64 + w * 16;
  f32x4 y = {0.f, 0.f, 0.f, 0.f};
  mini_dot<bf16_t>(y, p.merged() + row * 1024 + fq * 8, p.wt_out() + (size_t)l * 1048576 + (size_t)(cb + fr) * 1024 + fq * 8, 1024);
  *(f32x4*)(p.y() + row * 1024 + cb + fq * 4) = y;
}
__device__ void ple_mini(const Params& p, int l, int j) {
  const int tid = get_tid(), lane = tid & 63, w = tid >> 6, fr = lane & 15, fq = lane >> 4;
  const int srow = (j >> 4) * 16 + fr;
  const size_t row = (size_t)NPROMPT + srow;
  const int cb = (j & 15) * 64 + w * 16;
  f32x4 g = {0.f, 0.f, 0.f, 0.f}, pa = {0.f, 0.f, 0.f, 0.f};
  mini_dot<float>(pa, p.p_s + ((size_t)l * 512 + srow) * 256 + fq * 8, p.wt_pp() + (size_t)l * 262144 + (size_t)(cb + fr) * 256 + fq * 8, 256);
  mini_dot<bf16_t>(g, p.rb() + row * 1024 + fq * 8, p.wt_pg() + (size_t)l * 1048576 + (size_t)(cb + fr) * 1024 + fq * 8, 1024);
  const u32x2 rbv = *(const u32x2*)(p.rb() + row * 1024 + cb + fq * 4);
  const f32x4 rv = {lo2f(rbv.x), hi2f(rbv.x), lo2f(rbv.y), hi2f(rbv.y)};
  f32x4 o; o[0] = rv[0] + sigm(g[0]) * pa[0]; o[1] = rv[1] + sigm(g[1]) * pa[1]; o[2] = rv[2] + sigm(g[2]) * pa[2]; o[3] = rv[3] + sigm(g[3]) * pa[3];
  *(f32x4*)(p.o_y() + row * 1024 + cb + fq * 4) = o;
}

#define XB_TMO      128
#define XB_XCNT(j)  (256  + 64 * (j))
#define XB_XSUB(j)  (1280 + 64 * (j))
#define XB_XGEN(j)  (2304 + 64 * (j))
#define XB_TOP      3328
#define XB_TOPGEN   3392
#define XCD_BAR_WORDS 3456
#define XB_SPIN_CAP (1u << 18)
#define LAS __attribute__((address_space(3)))
__device__ __forceinline__ unsigned xb_ld(unsigned* p)              { return __hip_atomic_load(p, __ATOMIC_RELAXED, __HIP_MEMORY_SCOPE_AGENT); }
__device__ __forceinline__ unsigned xb_add(unsigned* p, unsigned v) { return __hip_atomic_fetch_add(p, v, __ATOMIC_RELAXED, __HIP_MEMORY_SCOPE_AGENT); }
__device__ __forceinline__ unsigned xb_xcc_id() { return (unsigned)__builtin_amdgcn_s_getreg((3 << 11) | 20) & 0xFu; }
#define XB_SPIN(cond, bar) do { unsigned _sp = 0; while (cond) { __builtin_amdgcn_s_sleep(1); \
    if ((++_sp & 255u) == 0u) { if (xb_ld(&(bar)[XB_TMO])) break; if (_sp > XB_SPIN_CAP) { atomicAdd(&(bar)[XB_TMO], 1u); break; } } } } while (0)
__device__ __forceinline__ void xcd_barrier_complete(unsigned* bar, unsigned x, unsigned& nloc, unsigned& nx) {
    const unsigned G = gridDim.x * gridDim.y * gridDim.z;
    unsigned sum, cnt, mine, sp = 0u;
    for (;;) {
        sum = 0u; cnt = 0u; mine = 0u;
#pragma unroll
        for (unsigned j = 0; j < 16; ++j) { const unsigned c = xb_ld(&bar[XB_XCNT(j)]); sum += c; cnt += (c > 0u) ? 1u : 0u; mine = (j == x) ? c : mine; }
        if (sum == G) break;
        __builtin_amdgcn_s_sleep(1);
        if ((++sp & 255u) == 0u) { if (xb_ld(&bar[XB_TMO])) break; if (sp > XB_SPIN_CAP) { atomicAdd(&bar[XB_TMO], 1u); break; } }
    }
    nloc = mine > 0u ? mine : 1u; nx = cnt > 0u ? cnt : 1u;
}
__device__ __forceinline__ void xcd_barrier(unsigned* bar, volatile LAS unsigned* st) {
    asm volatile("s_waitcnt vmcnt(0)" ::: "memory");
    __syncthreads();
    if (threadIdx.x == 0) {
        const unsigned x = xb_xcc_id();
        __builtin_amdgcn_s_waitcnt(0);
        unsigned nloc = st[0], nx = st[1];
        if (nloc == 0u) { xcd_barrier_complete(bar, x, nloc, nx); st[0] = nloc; st[1] = nx; }
        const unsigned old = xb_add(&bar[XB_XSUB(x)], 1u);
        const unsigned gen = old / nloc;
        if (old + 1u == (gen + 1u) * nloc) {
            __builtin_amdgcn_fence(__ATOMIC_RELEASE, "agent");
            asm volatile("s_waitcnt vmcnt(0)" ::: "memory");
            const unsigned og = xb_add(&bar[XB_TOP], 1u);
            const unsigned tg = og / nx;
            if (og + 1u == (tg + 1u) * nx) xb_add(&bar[XB_TOPGEN], 1u);
            else XB_SPIN(xb_ld(&bar[XB_TOPGEN]) == tg, bar);
            __builtin_amdgcn_fence(__ATOMIC_ACQUIRE, "agent");
            xb_add(&bar[XB_XGEN(x)], 1u);
            asm volatile("s_waitcnt vmcnt(0)" ::: "memory");
        } else {
            XB_SPIN(xb_ld(&bar[XB_XGEN(x)]) == gen, bar);
            __builtin_amdgcn_fence(__ATOMIC_ACQUIRE, "agent");
            asm volatile("s_waitcnt vmcnt(0)" ::: "memory");
        }
    }
    __syncthreads();
}

template <int PH>
__device__ __forceinline__ void run_phase(const Params& p, char* smem) {
  const int bid = blockIdx.x, nb = gridDim.x;
  if (PH == 0) {
    for (int t = bid; t < 1696; t += nb) wconv_tile(p, t, smem);
    for (int i = bid * 256 + get_tid(); i < 2 * 8 * 1024; i += nb * 256) { const int ll = i >> 13, j = (i >> 10) & 7, k = i & 1023; p.wg8()[i] = p.w_in[((size_t)ll * 1024 + k) * NINSRC + 2560 + j]; }
    return;
  }
  constexpr int l = (PH - 1) / NPL, s = (PH - 1) % NPL;
  if (!((PHMASK >> s) & 1)) return;
  switch (s) {
    case 0: norm_phase(p, l, smem); break;
    case 1: {
      const int per = (66 * 52) / 8, xcd = bid & 7, nloc = (nb + 7 - xcd) >> 3;
      for (int j = bid >> 3; j < per; j += nloc) {
        const int sq = xcd * per + j;
        const int tmg = sq / 416, rem = sq % 416, gm = (tmg == 8) ? 2 : 8;
        const int tng = rem / (gm * 8), rem2 = rem % (gm * 8), wdt = (tng == 6) ? 4 : 8;
        inproj_tile(p, l, (tmg * 8 + rem2 / wdt) * 52 + tng * 8 + rem2 % wdt, smem);
      }
      break;
    }
    case 2:
      for (int v = bid; v < 3 * NUNIT; v += nb) {
        const int ty = v % 3, u = v / 3;
        if (ty == 0) sb_unit(p, l, u, smem); else if (ty == 1) mlstm_local(p, l, u, smem); else hgrn_local(p, l, u, smem);
      }
      break;
    case 3: scan_phase(p, l, smem); break;
    case 4:
      for (int v = bid; v < 2 * NUNIT; v += nb) { if (v & 1) hgrn_out(p, l, v >> 1, smem); else mlstm_out(p, l, v >> 1, smem); }
      break;
    case 5: for (int t = bid; t < 1024; t += nb) merge_tile(p, l, t, smem); for (int j = bid; j < 512; j += nb) merge_mini(p, l, j); break;
    case 6: for (int t = bid; t < 1024; t += nb) outproj_tile(p, l, t, smem); for (int j = bid; j < 512; j += nb) outproj_mini(p, l, j); break;
    case 7: postnorm_phase(p, l); break;
    case 8: for (int t = bid; t < 1024; t += nb) ple_tile(p, l, t, smem); for (int j = bid; j < 512; j += nb) ple_mini(p, l, j); break;
  }
}

template <int PH>
__global__ void __launch_bounds__(256, 2) phase_kernel(Params p) {
  __shared__ __attribute__((aligned(16))) char smem[SMEM_BYTES];
  run_phase<PH>(p, smem);
}

#if FUSED
__device__ __forceinline__ int fetch_work(unsigned* ctr, volatile int* slot) {
  __syncthreads();
  if (threadIdx.x == 0) *slot = (int)__hip_atomic_fetch_add(ctr, 1u, __ATOMIC_RELAXED, __HIP_MEMORY_SCOPE_AGENT);
  __syncthreads();
  return *slot;
}
__device__ __forceinline__ void run_phase_rt(const Params& p, int ph, char* smem, volatile int* wslot) {
  const int bid = blockIdx.x, nb = gridDim.x;
  unsigned* ctr = (unsigned*)(p.ws + WS_BAR + 14336) + ph * 16;
  int l = 0, s = 0;
  if (ph == 0) { for (int t = bid; t < 848; t += nb) wconv_tile(p, t, smem); }
  else { if (ph == 1) return; l = (ph - 1) / NPL; s = (ph - 1) % NPL; }
  switch (s) {
    case 0: norm_phase(p, l, smem); break;
    case 1: {
      const int per = (66 * 52) / 8, xcd0 = (int)(xb_xcc_id() & 7u);
      for (int dx = 0; dx < 8; ++dx) {
        const int xcd = (xcd0 + dx) & 7;
        for (;;) {
          const int j = fetch_work(ctr + xcd, wslot);
          if (j >= per) break;
          const int sq = xcd * per + j;
          const int tmg = sq / 416, rem = sq % 416, gm = (tmg == 8) ? 2 : 8;
          const int tng = rem / (gm * 8), rem2 = rem % (gm * 8), wdt = (tng == 6) ? 4 : 8;
          inproj_tile(p, l, (tmg * 8 + rem2 / wdt) * 52 + tng * 8 + rem2 % wdt, smem);
        }
      }
      break;
    }
    case 2:
      for (;;) {
        const int v = fetch_work(ctr, wslot);
        if (v >= 3 * NUNIT + (l == 0 ? 848 : 0)) break;
        if (v < NUNIT) sb_unit(p, l, v, smem); else if (v < 2 * NUNIT) mlstm_local(p, l, v - NUNIT, smem); else if (v < 3 * NUNIT) hgrn_local(p, l, v - 2 * NUNIT, smem);
        else wconv_tile(p, 848 + (v - 3 * NUNIT), smem);
      }
      break;
    case 3: {
      scan_phase(p, l, smem);
      const int v = fetch_work(ctr + 8, wslot);
      if (v < 1584) gate_tile256(p, l, v < 48 ? 1536 + v : v - 48, smem);
      break;
    }
    case 4: {
      unsigned* gq = ctr - 16 + 8;
      bool gleft = true, uleft = true;
      while (gleft || uleft) {
        if (gleft) { const int v = fetch_work(gq, wslot); if (v < 1584) gate_tile256(p, l, v < 48 ? 1536 + v : v - 48, smem); else gleft = false; }
        for (int k = 0; k < 2 && uleft; ++k) {
          const int u = fetch_work(ctr, wslot);
          if (u >= 2 * NUNIT) uleft = false;
          else if (u < NUNIT) hgrn_out(p, l, u, smem); else mlstm_out(p, l, u - NUNIT, smem);
        }
      }
      break;
    }
    case 5: for (;;) { const int v = fetch_work(ctr, wslot); if (v >= 1536) break; if (v < 1024) merge_tile_g(p, l, v, smem); else merge_mini(p, l, v - 1024); } break;
    case 6: for (;;) { const int v = fetch_work(ctr, wslot); if (v >= 1024) break; if (v < 512) outproj_tile256(p, l, v, smem); else outproj_mini(p, l, v - 512); } break;
    case 7: postnorm_phase(p, l); break;
    case 8: for (;;) { const int v = fetch_work(ctr, wslot); if (v >= 1536) break; if (v < 1024) ple_tile(p, l, v, smem); else ple_mini(p, l, v - 1024); } break;
  }
}

__global__ void __launch_bounds__(256, 2) mega(Params p_unused) {
  __shared__ __attribute__((aligned(16))) char smem[SMEM_BYTES];
  __shared__ uint4 xb_words;
  __shared__ int wslot;
  if (threadIdx.x == 0) {
    typedef const Params __attribute__((address_space(4))) * KP4;
    KP4 kp = (KP4)__builtin_amdgcn_kernarg_segment_ptr();
    asm volatile("" : "+s"(kp));
    char* wsb = ((const Params*)kp)->ws;
    xb_words = make_uint4(0u, 0u, 0u, 0u); (void)xb_add((unsigned*)(wsb + WS_BAR) + XB_XCNT(xb_xcc_id()), 1u);
  }
  __syncthreads();
  typedef const Params __attribute__((address_space(4))) * KP4;
#ifdef PROBE_KIND
  unsigned long long t_acc = 0;
#endif
#pragma unroll 1
  for (int ph = 0; ph < NPHASE; ++ph) {
    KP4 kp = (KP4)__builtin_amdgcn_kernarg_segment_ptr();
    asm volatile("" : "+s"(kp));
    const Params q = *(const Params*)kp;
#ifdef PROBE_KIND
    const unsigned long long tp0 = __builtin_amdgcn_s_memrealtime();
#endif
    run_phase_rt(q, ph, smem, &wslot);
#ifdef PROBE_KIND
    const unsigned long long tp1 = __builtin_amdgcn_s_memrealtime();
    if ((PROBE_KIND == 9 && ph == 0) || (PROBE_KIND < 9 && ph > 0 && (ph - 1) % NPL == PROBE_KIND)) t_acc += tp1 - tp0;
#endif
    if (ph + 1 < NPHASE && ph != 1) xcd_barrier((unsigned*)(q.ws + WS_BAR), (volatile LAS unsigned*)&xb_words);
    if (gridDim.y == 7777u) cg::this_grid().sync();
#ifdef PROBE_KIND
    if (PROBE_KIND == 10 && (PROBE_SEL < 0 || (ph > 0 && (ph - 1) % NPL == PROBE_SEL))) t_acc += __builtin_amdgcn_s_memrealtime() - tp1;
#endif
  }
#ifdef PROBE_GEMM
  {
    KP4 kp = (KP4)__builtin_amdgcn_kernarg_segment_ptr();
    asm volatile("" : "+s"(kp));
    const Params q = *(const Params*)kp;
    xcd_barrier((unsigned*)(q.ws + WS_BAR), (volatile LAS unsigned*)&xb_words);
    const unsigned long long tg0 = __builtin_amdgcn_s_memrealtime();
    f32x4 acc[4][8];
#pragma unroll
    for (int a_ = 0; a_ < 4; ++a_)
#pragma unroll
      for (int b_ = 0; b_ < 8; ++b_) acc[a_][b_] = (f32x4){0.f, 0.f, 0.f, 0.f};
    const int bid = blockIdx.x;
#pragma unroll 1
    for (int it = 0; it < 8; ++it) {
      int tm, tn;
      if (PROBE_GEMM == 0) { tm = 0; tn = 0; }
      else if (PROBE_GEMM == 1) { tm = bid & 63; tn = ((bid >> 6) * 6 + it) % 52; }
      else { const int xcd = bid & 7, idx = bid >> 3; tm = xcd * 8 + (idx & 7); tn = ((idx >> 3) + 8 * it) % 52; }
      gemm_glds<8, 3>(acc, q.U() + (size_t)tm * 256 * 1024, 1024, q.wt_in() + (size_t)tn * 128 * 1024, 1024, 1024, smem);
    }
    float sum = 0.f;
#pragma unroll
    for (int a_ = 0; a_ < 4; ++a_)
#pragma unroll
      for (int b_ = 0; b_ < 8; ++b_) sum += acc[a_][b_][0] + acc[a_][b_][1] + acc[a_][b_][2] + acc[a_][b_][3];
    if (sum == 123456.789f) q.hbc()[0] = sum;
    const unsigned long long tg1 = __builtin_amdgcn_s_memrealtime();
    if (blockIdx.x == 0) { while (__builtin_amdgcn_s_memrealtime() - tg1 < 4 * (tg1 - tg0)) __builtin_amdgcn_s_sleep(32); }
  }
#endif
#ifdef PROBE_KIND
  if (blockIdx.x == PROBE_BLOCK) { const unsigned long long te = __builtin_amdgcn_s_memrealtime(); while (__builtin_amdgcn_s_memrealtime() - te < 4 * t_acc) __builtin_amdgcn_s_sleep(32); }
#endif
}
#endif

template <int PH>
static void launch_all(const Params& p, int grid, hipStream_t stream) {
  hipLaunchKernelGGL(phase_kernel<PH>, dim3(grid), dim3(256), 0, stream, p);
  if constexpr (PH + 1 < NPHASE) launch_all<PH + 1>(p, grid, stream);
}

extern "C" void kernel_launch(void* const* d_in, const int* in_sizes, int n_in, void* d_out, int out_size, void* d_ws, size_t ws_size, hipStream_t stream) {
  Params p;
  memset(&p, 0, sizeof(p));
  const float* const* in = (const float* const*)d_in;
  p.x_p = in[0]; p.x_s = in[1]; p.p_p = in[2]; p.p_s = in[3]; p.st_C = in[4]; p.st_n = in[5]; p.st_m = in[6]; p.st_conv = in[7];
  p.ck = in[8]; p.cv = in[9]; p.st_S = in[10]; p.g_pre = in[11]; p.w_in = in[12]; p.b_i = in[13]; p.b_f = in[14]; p.w_conv = in[15];
  p.g_ml = in[16]; p.lb_logits = in[17]; p.g_hg = in[18]; p.w_br = in[19]; p.w_out = in[20]; p.g_post = in[21]; p.w_pg = in[22]; p.w_pp = in[23];
  p.out = (float*)d_out; p.ws = (char*)d_ws;
  if (WS_TOTAL > ws_size || (size_t)out_size < O_TOTAL) { fprintf(stderr, "workspace/out too small: need %zu have %zu\n", (size_t)WS_TOTAL, ws_size); return; }
  static int grid_blocks = 0;
  if (!grid_blocks) {
    int dev = 0, cus = 0, per_cu = 0;
    (void)hipGetDevice(&dev);
    (void)hipDeviceGetAttribute(&cus, hipDeviceAttributeMultiprocessorCount, dev);
#if FUSED
    (void)hipOccupancyMaxActiveBlocksPerMultiprocessor(&per_cu, mega, 256, 0);
#else
    per_cu = 2;
#endif
    if (per_cu > 2) per_cu = 2;
    if (per_cu < 1) per_cu = 1;
    grid_blocks = cus * per_cu;
  }
#if FUSED
  (void)hipMemsetAsync((char*)d_ws + WS_BAR, 0, 16384, stream);
  void* args[] = {&p};
  hipError_t e = hipLaunchCooperativeKernel((void*)mega, dim3(grid_blocks), dim3(256), args, 0, stream);
  if (e != hipSuccess) fprintf(stderr, "cooperative launch failed: %s (grid %d)\n", hipGetErrorString(e), grid_blocks);
#else
  launch_all<0>(p, grid_blocks, stream);
#endif
}
```
